# Optimizing an MI355X kernel written in HIP

```python
import math
import jax
import jax.numpy as jnp
from jax import lax
import numpy as np

D_MODEL = 2048
BATCH = 4
SEQ = 4096
DEPTH = 4

N_META = 16
N_HEADS = 8
HEAD_DIM = 128
V_DIM = 2 * HEAD_DIM
ROT_DIM = HEAD_DIM // 4
ROPE_THETA = 500000.0
Q_BLOCK = 128
ATTN_QK = N_HEADS * 2 * HEAD_DIM
ATTN_V = N_HEADS * V_DIM
LRU_WIDTH = 5 * D_MODEL // 4
LRU_BLOCKS = 16
LRU_BLOCK_W = LRU_WIDTH // LRU_BLOCKS
CONV_W = 4
LRU_C = 8.0
D_FF = ((8 * D_MODEL // 3 + 255) // 256) * 256
N_IN = 2 * ATTN_QK + ATTN_V + 2 * LRU_WIDTH + 2 * D_MODEL
EPS = 1e-6

kernel_name = 'hybrid_diffattn_rglru_macaron_meta'


def rms_norm(x, g):
    xf = x.astype(jnp.float32)
    y = xf * lax.rsqrt(jnp.mean(xf * xf, axis=-1, keepdims=True) + EPS)
    return (y * g.astype(jnp.float32)).astype(x.dtype)


def swiglu(u, w_gate, w_up, w_down):
    return (jax.nn.silu(u @ w_gate) * (u @ w_up)) @ w_down


def rotary_tables(t):
    inv_freq = ROPE_THETA ** (-jnp.arange(0, ROT_DIM, 2, dtype=jnp.float32) / ROT_DIM)
    ang = jnp.arange(t, dtype=jnp.float32)[:, None] * inv_freq[None, :]
    return jnp.cos(ang), jnp.sin(ang)


def apply_partial_rope(x, cos, sin):
    half = ROT_DIM // 2
    xr = x[..., :ROT_DIM].astype(jnp.float32)
    x1, x2 = xr[..., :half], xr[..., half:]
    c = cos[None, :, None, None, :]
    s = sin[None, :, None, None, :]
    rot = jnp.concatenate([x1 * c - x2 * s, x2 * c + x1 * s], axis=-1).astype(x.dtype)
    return jnp.concatenate([rot, x[..., ROT_DIM:]], axis=-1)


def diff_attention(q, k, v, lam, lam_init, subln, cos, sin):
    b, t = q.shape[0], q.shape[1]
    q = apply_partial_rope(q.reshape(b, t, N_HEADS, 2, HEAD_DIM), cos, sin)
    k = apply_partial_rope(k.reshape(b, t, N_HEADS, 2, HEAD_DIM), cos, sin)
    qf = q.astype(jnp.float32) * (HEAD_DIM ** -0.5)
    kf = k.astype(jnp.float32)
    vf = v.reshape(b, t, N_HEADS, V_DIM).astype(jnp.float32)
    starts = [0] + list(range(N_META, t, Q_BLOCK))
    ends = starts[1:] + [t]
    outs = []
    for s, e in zip(starts, ends):
        sc = jnp.einsum('bqhcd,bkhcd->bhcqk', qf[:, s:e], kf[:, :e])
        causal = jnp.arange(e)[None, :] <= jnp.arange(s, e)[:, None]
        p = jax.nn.softmax(jnp.where(causal, sc, -jnp.inf), axis=-1)
        p = p[:, :, 0] - lam * p[:, :, 1]
        outs.append(jnp.einsum('bhqk,bkhe->bqhe', p, vf[:, :e]))
    o = jnp.concatenate(outs, axis=1)
    o = o * lax.rsqrt(jnp.mean(o * o, axis=-1, keepdims=True) + EPS)
    o = o * subln.astype(jnp.float32) * (1.0 - lam_init)
    return o.reshape(b, t, ATTN_V).astype(v.dtype)


def _lru_combine(e1, e2):
    a1, b1 = e1
    a2, b2 = e2
    return a1 * a2, a2 * b1 + b2


def rglru_branch(xr, yr, conv_w, conv_b, gx_w, gx_b, ga_w, ga_b, a_param):
    b, t, _ = xr.shape
    xp = jnp.pad(xr, ((0, 0), (CONV_W - 1, 0), (0, 0)))
    xc = conv_b + sum(xp[:, CONV_W - 1 - j: CONV_W - 1 - j + t] * conv_w[j] for j in range(CONV_W))
    xb = xc.reshape(b, t, LRU_BLOCKS, LRU_BLOCK_W)
    r = jax.nn.sigmoid(jnp.einsum('btnk,nkj->btnj', xb, ga_w).reshape(b, t, LRU_WIDTH) + ga_b)
    i = jax.nn.sigmoid(jnp.einsum('btnk,nkj->btnj', xb, gx_w).reshape(b, t, LRU_WIDTH) + gx_b)
    log_a = LRU_C * r.astype(jnp.float32) * jax.nn.log_sigmoid(a_param.astype(jnp.float32))
    a = jnp.exp(log_a)
    mult = jnp.sqrt(-jnp.expm1(2.0 * log_a))
    bx = mult * (i * xc).astype(jnp.float32)
    _, h = lax.associative_scan(_lru_combine, (a, bx), axis=1)
    return h.astype(xr.dtype) * jax.nn.gelu(yr)


def hybrid_mixer(u, w_in, b_gate, lq1, lk1, lq2, lk2, subln, conv_w, conv_b,
                 gx_w, gx_b, ga_w, ga_b, a_param, w_ba, w_bl, w_o, cos, sin, lam_init):
    z = u @ w_in
    cuts = [ATTN_QK, 2 * ATTN_QK, 2 * ATTN_QK + ATTN_V,
            2 * ATTN_QK + ATTN_V + LRU_WIDTH, 2 * ATTN_QK + ATTN_V + 2 * LRU_WIDTH]
    q, k, v, xr, yr, zg = jnp.split(z, cuts, axis=-1)
    g = jax.nn.sigmoid(zg + b_gate)
    g_attn, g_lru = g[..., :D_MODEL], g[..., D_MODEL:]
    lam = (jnp.exp(jnp.sum(lq1.astype(jnp.float32) * lk1.astype(jnp.float32)))
           - jnp.exp(jnp.sum(lq2.astype(jnp.float32) * lk2.astype(jnp.float32))) + lam_init)
    o_attn = diff_attention(q, k, v, lam, lam_init, subln, cos, sin) @ w_ba
    o_lru = rglru_branch(xr, yr, conv_w, conv_b, gx_w, gx_b, ga_w, ga_b, a_param) @ w_bl
    return (g_attn * o_attn + g_lru * o_lru) @ w_o


def setup_inputs(seed: int = 0) -> dict:
    key = jax.random.key(seed)
    ks = iter(jax.random.split(key, 40))

    def w(shape, fan_in):
        return jax.random.normal(next(ks), shape, jnp.float32) * (fan_in ** -0.5)

    def gain(shape):
        return 1.0 + 0.02 * jax.random.normal(next(ks), shape, jnp.float32)

    def small(shape, scale=0.01):
        return scale * jax.random.normal(next(ks), shape, jnp.float32)

    x = jax.random.normal(next(ks), (BATCH, SEQ, D_MODEL), jnp.float32)
    meta_tokens = jax.random.normal(next(ks), (N_META, D_MODEL), jnp.float32)
    u = jax.random.uniform(next(ks), (DEPTH, LRU_WIDTH), jnp.float32, 0.9, 0.999)
    p = u ** (1.0 / LRU_C)
    lru_a_param = jnp.log(p) - jnp.log1p(-p)
    return {
        'x': x,
        'meta_tokens': meta_tokens,
        'norm_ffn1': gain((DEPTH, D_MODEL)),
        'ffn1_w_gate': w((DEPTH, D_MODEL, D_FF), D_MODEL),
        'ffn1_w_up': w((DEPTH, D_MODEL, D_FF), D_MODEL),
        'ffn1_w_down': w((DEPTH, D_FF, D_MODEL), D_FF),
        'norm_mix': gain((DEPTH, D_MODEL)),
        'w_in': w((DEPTH, D_MODEL, N_IN), D_MODEL),
        'b_gate': small((DEPTH, 2 * D_MODEL)),
        'lambda_q1': small((DEPTH, HEAD_DIM), 0.1),
        'lambda_k1': small((DEPTH, HEAD_DIM), 0.1),
        'lambda_q2': small((DEPTH, HEAD_DIM), 0.1),
        'lambda_k2': small((DEPTH, HEAD_DIM), 0.1),
        'attn_subln': gain((DEPTH, V_DIM)),
        'conv_w': w((DEPTH, CONV_W, LRU_WIDTH), CONV_W),
        'conv_b': small((DEPTH, LRU_WIDTH)),
        'gate_x_w': w((DEPTH, LRU_BLOCKS, LRU_BLOCK_W, LRU_BLOCK_W), LRU_BLOCK_W),
        'gate_x_b': small((DEPTH, LRU_WIDTH)),
        'gate_a_w': w((DEPTH, LRU_BLOCKS, LRU_BLOCK_W, LRU_BLOCK_W), LRU_BLOCK_W),
        'gate_a_b': small((DEPTH, LRU_WIDTH)),
        'lru_a_param': lru_a_param,
        'w_branch_attn': w((DEPTH, ATTN_V, D_MODEL), ATTN_V),
        'w_branch_lru': w((DEPTH, LRU_WIDTH, D_MODEL), LRU_WIDTH),
        'w_out': w((DEPTH, D_MODEL, D_MODEL), D_MODEL),
        'norm_ffn2': gain((DEPTH, D_MODEL)),
        'ffn2_w_gate': w((DEPTH, D_MODEL, D_FF), D_MODEL),
        'ffn2_w_up': w((DEPTH, D_MODEL, D_FF), D_MODEL),
        'ffn2_w_down': w((DEPTH, D_FF, D_MODEL), D_FF),
        'final_norm': gain((D_MODEL,)),
    }


def reference(x, meta_tokens, norm_ffn1, ffn1_w_gate, ffn1_w_up, ffn1_w_down, norm_mix,
              w_in, b_gate, lambda_q1, lambda_k1, lambda_q2, lambda_k2, attn_subln,
              conv_w, conv_b, gate_x_w, gate_x_b, gate_a_w, gate_a_b, lru_a_param,
              w_branch_attn, w_branch_lru, w_out, norm_ffn2, ffn2_w_gate, ffn2_w_up,
              ffn2_w_down, final_norm):
    b = x.shape[0]
    meta = jnp.broadcast_to(meta_tokens.astype(x.dtype)[None], (b, N_META, D_MODEL))
    h = jnp.concatenate([meta, x], axis=1)
    cos, sin = rotary_tables(h.shape[1])
    for l in range(DEPTH):
        lam_init = 0.8 - 0.6 * math.exp(-0.3 * l)
        h = h + 0.5 * swiglu(rms_norm(h, norm_ffn1[l]), ffn1_w_gate[l], ffn1_w_up[l], ffn1_w_down[l])
        h = h + hybrid_mixer(rms_norm(h, norm_mix[l]), w_in[l], b_gate[l],
                             lambda_q1[l], lambda_k1[l], lambda_q2[l], lambda_k2[l], attn_subln[l],
                             conv_w[l], conv_b[l], gate_x_w[l], gate_x_b[l], gate_a_w[l], gate_a_b[l],
                             lru_a_param[l], w_branch_attn[l], w_branch_lru[l], w_out[l],
                             cos, sin, lam_init)
        h = h + 0.5 * swiglu(rms_norm(h, norm_ffn2[l]), ffn2_w_gate[l], ffn2_w_up[l], ffn2_w_down[l])
    return rms_norm(h, final_norm)[:, N_META:]
```

```cpp
#include <hip/hip_runtime.h>
#include <cstdio>
#include <cstdint>
#include <cmath>
__device__ __forceinline__ int tid_fresh() { int t = threadIdx.x; asm volatile("" : "+v"(t)); return t; }
namespace pg8 {
#define PG8_LAS __attribute__((address_space(3)))
typedef unsigned short bf16_t;
typedef short bf16x8 __attribute__((ext_vector_type(8)));
typedef float f32x4 __attribute__((ext_vector_type(4)));
typedef unsigned u32x4 __attribute__((ext_vector_type(4)));
constexpr int BM = 256, BK = 64, HALF = 128, HTB = HALF * BK * 2  , STAGE_BYTES = 8 * HTB, NXCD = 8, WGM = 8;

__host__ __device__ __forceinline__ int lds_byte(int r, int c) { const int st = (r >> 4) * 2 + (c >> 5), rr = r & 15, cc = c & 31, ob = rr * 64 + cc * 2; return st * 1024 + (ob ^ (((ob >> 9) & 1) << 5)); }
__host__ __device__ __forceinline__ void stage_rc(int b, int& R, int& C) { const int st = b / 1024, sb = b % 1024, swz = sb ^ (((sb >> 9) & 1) << 5); R = (st >> 1) * 16 + swz / 64; C = (st & 1) * 32 + (swz % 64) / 2; }
__host__ __device__ __forceinline__ int perm32(int rho) { const int n = rho >> 4, i = rho & 15; return 8 * (i >> 2) + 4 * n + (i & 3); }

struct Unit { int pm, pn; };
struct Gemm { const bf16_t* A; const bf16_t* Bt; int M, N, K; };

struct StaticOrder {
    int nM, nN, nwg, G, c;
    __host__ __device__ void init(int M, int N, int G_, int c_) { nM = M / BM; nN = N / BM; nwg = nM * nN; G = G_; c = c_; }
    __host__ __device__ bool next(int i, Unit& u) const {
        const long L = (long)i * G + c; if (L >= nwg) return false;
        int wgid = (int)L; { const int q = nwg / NXCD, r = nwg % NXCD, xcd = wgid % NXCD, off = wgid / NXCD; wgid = (xcd < r ? xcd * (q + 1) : r * (q + 1) + (xcd - r) * q) + off; }
        const int nig = WGM * nN, gid = wgid / nig, fm = gid * WGM, gsz = (nM - fm) < WGM ? (nM - fm) : WGM;
        u.pm = fm + ((wgid % nig) % gsz); u.pn = (wgid % nig) / gsz; return true;
    }
    __device__ __forceinline__ void a_ready(const Unit&) const {}
    __device__ __forceinline__ void done(const Unit&) const {}
};

__device__ __forceinline__ unsigned cvt_pk_bf16(float lo, float hi) { unsigned r; asm volatile("v_cvt_pk_bf16_f32 %0, %1, %2" : "=v"(r) : "v"(lo), "v"(hi)); return r; }
typedef float f32x2 __attribute__((ext_vector_type(2)));
template <class Epi, class Sched, bool ALIGN_EPI = false, bool SP2 = false>
__device__ __forceinline__ void gemm_phase(PG8_LAS unsigned char* lds, const Gemm g, const Sched& S, const Epi& E) {
    const int tid = tid_fresh(), wid = __builtin_amdgcn_readfirstlane(tid >> 6), lane = tid & 63, wr = wid >> 2, wc = wid & 3, fr = lane & 15, fq = lane >> 4;
    const int K = g.K, nt = K / BK;
    unsigned voffA[2], voffB[2];
#pragma unroll
    for (int i = 0; i < 2; ++i) { int R, C; stage_rc(tid * 16 + i * 8192, R, C); const int Rb = Epi::PERM ? ((R & ~31) + perm32(R & 31)) : R;
        voffA[i] = (unsigned)(R * K + C) * 2u; voffB[i] = (unsigned)(Rb * K + C) * 2u; }
    const size_t kstep = (size_t)(BK * 2);
    const size_t hstep = (size_t)HALF * K * 2;
    const size_t tstep = 2 * hstep;
    const unsigned ldsw = (unsigned)wid * 1024u;
    const int aoff = lds_byte(wr * 64 + fr, fq * 8), boff = lds_byte(wc * 32 + fr, fq * 8);
#define PG8_SA(b, h) (((b) * 2 + (h)) * HTB)
#define PG8_SB(b, h) ((4 + (b) * 2 + (h)) * HTB)
#define PG8_STAGE(bufoff, gbase, voff) do { _Pragma("unroll") for (int _i = 0; _i < 2; ++_i) \
        __builtin_amdgcn_global_load_lds((const unsigned*)((const char*)(gbase) + (voff)[_i]), (PG8_LAS unsigned*)(lds + (bufoff) + ldsw + _i * 8192), 16, 0, 0); } while (0)
#define PG8_LDA(dst, b, h) do { _Pragma("unroll") for (int m = 0; m < 4; ++m) _Pragma("unroll") for (int k = 0; k < 2; ++k) dst[m][k] = *(const PG8_LAS bf16x8*)(lds + PG8_SA(b, h) + aoff + m * 2048 + k * 1024); } while (0)
#define PG8_LDB(dst, b, h) do { _Pragma("unroll") for (int n = 0; n < 2; ++n) _Pragma("unroll") for (int k = 0; k < 2; ++k) dst[n][k] = *(const PG8_LAS bf16x8*)(lds + PG8_SB(b, h) + boff + n * 2048 + k * 1024); } while (0)
#define PG8_MMA(ai, bj, At, Bt) do { __builtin_amdgcn_s_setprio(1); _Pragma("unroll") for (int m = 0; m < 4; ++m) _Pragma("unroll") for (int n = 0; n < 2; ++n) _Pragma("unroll") for (int k = 0; k < 2; ++k) \
        acc[ai][bj][m][n] = __builtin_amdgcn_mfma_f32_16x16x32_bf16(Bt[n][k], At[m][k], acc[ai][bj][m][n], 0, 0, 0); __builtin_amdgcn_s_setprio(0); } while (0)
#define PG8_WAIT_V(n) asm volatile("s_waitcnt vmcnt(" #n ")" ::: "memory")
#define PG8_WAIT_L(n) asm volatile("s_waitcnt lgkmcnt(" #n ")" ::: "memory")
#define PG8_BAR __builtin_amdgcn_s_barrier()
#define PG8_SCHED __builtin_amdgcn_sched_barrier(0)
    Unit cur, nxt; int ui = 0;
    if (!S.next(0, cur)) return;
    f32x4 acc[2][2][4][2];
#pragma unroll
    for (int a = 0; a < 2; ++a)
#pragma unroll
        for (int b = 0; b < 2; ++b)
#pragma unroll
            for (int m = 0; m < 4; ++m)
#pragma unroll
                for (int n = 0; n < 2; ++n) acc[a][b][m][n] = (f32x4){0.f, 0.f, 0.f, 0.f};
    bf16x8 At[4][2], B0[2][2], B1[2][2];
    const char* cA = (const char*)g.A + (size_t)cur.pm * tstep; const char* cB = (const char*)g.Bt + (size_t)cur.pn * tstep;
    S.a_ready(cur);
    if constexpr (SP2) {
        PG8_STAGE(PG8_SB(0, 0), cB, voffB); PG8_STAGE(PG8_SB(0, 1), cB + hstep, voffB); PG8_STAGE(PG8_SA(0, 0), cA, voffA); PG8_STAGE(PG8_SA(0, 1), cA + hstep, voffA);
        if (wr == 1) PG8_BAR;
        PG8_WAIT_V(2); PG8_BAR;
        PG8_STAGE(PG8_SB(1, 0), cB + kstep, voffB); PG8_STAGE(PG8_SA(1, 0), cA + kstep, voffA); PG8_STAGE(PG8_SB(1, 1), cB + hstep + kstep, voffB);
        PG8_WAIT_V(6); PG8_BAR;
    } else {
        PG8_STAGE(PG8_SB(0, 0), cB, voffB); PG8_STAGE(PG8_SA(0, 0), cA, voffA); PG8_STAGE(PG8_SB(0, 1), cB + hstep, voffB); PG8_STAGE(PG8_SA(0, 1), cA + hstep, voffA);
        if (wr == 1) PG8_BAR;
        PG8_WAIT_V(4); PG8_BAR;
        PG8_STAGE(PG8_SB(1, 0), cB + kstep, voffB); PG8_STAGE(PG8_SA(1, 0), cA + kstep, voffA); PG8_STAGE(PG8_SB(1, 1), cB + hstep + kstep, voffB);
        PG8_WAIT_V(6); PG8_BAR;
    }
    for (;;) {
        const bool has_next = S.next(ui + 1, nxt);
        const char* nA = has_next ? (const char*)g.A + (size_t)nxt.pm * tstep : cA; const char* nB = has_next ? (const char*)g.Bt + (size_t)nxt.pn * tstep : cB;
        for (int t = 0; t < nt; t += 2) {
            const bool last = (t == nt - 2);
            const char* a1 = cA + (size_t)(t + 1) * kstep;
            const char* a2 = last ? nA : cA + (size_t)(t + 2) * kstep; const char* b2 = last ? nB : cB + (size_t)(t + 2) * kstep;
            const char* a3 = a2 + kstep; const char* b3 = b2 + kstep;
            if (last && has_next) S.a_ready(nxt);
            if constexpr (SP2) {
            PG8_LDB(B0, 0, 0); PG8_LDB(B1, 0, 1); PG8_SCHED; PG8_LDA(At, 0, 0); PG8_STAGE(PG8_SA(1, 1), a1 + hstep, voffA);
            PG8_WAIT_V(8); PG8_WAIT_L(0); PG8_BAR; PG8_MMA(0, 0, At, B0); PG8_MMA(0, 1, At, B1); PG8_BAR; PG8_SCHED;
            PG8_LDA(At, 0, 1); PG8_STAGE(PG8_SB(0, 0), b2, voffB); PG8_STAGE(PG8_SB(0, 1), b2 + hstep, voffB); PG8_STAGE(PG8_SA(0, 0), a2, voffA);
            PG8_WAIT_V(8); PG8_WAIT_L(0); PG8_BAR; PG8_MMA(1, 0, At, B0); PG8_MMA(1, 1, At, B1); PG8_BAR; PG8_SCHED;
            PG8_LDB(B0, 1, 0); PG8_LDB(B1, 1, 1); PG8_SCHED; PG8_LDA(At, 1, 0); PG8_STAGE(PG8_SA(0, 1), a2 + hstep, voffA);
            PG8_WAIT_V(8); PG8_WAIT_L(0); PG8_BAR; PG8_MMA(0, 0, At, B0); PG8_MMA(0, 1, At, B1); PG8_BAR; PG8_SCHED;
            PG8_LDA(At, 1, 1); PG8_STAGE(PG8_SB(1, 0), b3, voffB); PG8_STAGE(PG8_SB(1, 1), b3 + hstep, voffB); PG8_STAGE(PG8_SA(1, 0), a3, voffA);
            PG8_WAIT_V(8); PG8_WAIT_L(0); PG8_BAR; PG8_MMA(1, 0, At, B0); PG8_MMA(1, 1, At, B1); PG8_BAR; PG8_SCHED;
            } else {
            PG8_LDB(B0, 0, 0); PG8_SCHED; PG8_LDA(At, 0, 0); PG8_STAGE(PG8_SA(1, 1), a1 + hstep, voffA);
            PG8_WAIT_L(8); PG8_BAR; PG8_WAIT_L(0); PG8_MMA(0, 0, At, B0); PG8_BAR; PG8_SCHED;
            PG8_LDB(B1, 0, 1); PG8_STAGE(PG8_SB(0, 0), b2, voffB);
            PG8_BAR; PG8_WAIT_L(0); PG8_MMA(0, 1, At, B1); PG8_BAR;
            PG8_LDA(At, 0, 1); PG8_STAGE(PG8_SA(0, 0), a2, voffA);
            PG8_BAR; PG8_WAIT_L(0); PG8_MMA(1, 0, At, B0); PG8_BAR; PG8_SCHED;
            PG8_STAGE(PG8_SB(0, 1), b2 + hstep, voffB);
            PG8_WAIT_V(6); PG8_BAR; PG8_MMA(1, 1, At, B1); PG8_BAR;
            PG8_LDB(B0, 1, 0); PG8_SCHED; PG8_LDA(At, 1, 0); PG8_STAGE(PG8_SA(0, 1), a2 + hstep, voffA);
            PG8_WAIT_L(8); PG8_BAR; PG8_WAIT_L(0); PG8_MMA(0, 0, At, B0); PG8_BAR; PG8_SCHED;
            PG8_LDB(B1, 1, 1); PG8_STAGE(PG8_SB(1, 0), b3, voffB);
            PG8_BAR; PG8_WAIT_L(0); PG8_MMA(0, 1, At, B1); PG8_BAR;
            PG8_LDA(At, 1, 1); PG8_STAGE(PG8_SA(1, 0), a3, voffA);
            PG8_BAR; PG8_WAIT_L(0); PG8_MMA(1, 0, At, B0); PG8_BAR; PG8_SCHED;
            PG8_STAGE(PG8_SB(1, 1), b3 + hstep, voffB);
            PG8_WAIT_V(6); PG8_BAR; PG8_MMA(1, 1, At, B1); PG8_BAR;
            }
        }
        if constexpr (ALIGN_EPI) { if (wr == 0) PG8_BAR; }
        if constexpr (!Epi::AFTER_DRAIN) { E(acc, cur, wr, wc, fr, fq); S.done(cur); }
        if (!has_next) break;
#pragma unroll
        for (int a = 0; a < 2; ++a)
#pragma unroll
            for (int b = 0; b < 2; ++b)
#pragma unroll
                for (int m = 0; m < 4; ++m)
#pragma unroll
                    for (int n = 0; n < 2; ++n) acc[a][b][m][n] = (f32x4){0.f, 0.f, 0.f, 0.f};
        cur = nxt; cA = nA; cB = nB; ++ui;
        if constexpr (ALIGN_EPI) { if (wr == 1) PG8_BAR; }
    }
    PG8_WAIT_V(0);
    if constexpr (!ALIGN_EPI) { if (wr == 0) PG8_BAR; }
    PG8_BAR;
    if constexpr (Epi::AFTER_DRAIN) { E.fused(acc, cur, wr, wc, fr, fq, lds, wid, lane); S.done(cur); }
#undef PG8_SA
#undef PG8_SB
#undef PG8_STAGE
#undef PG8_LDA
#undef PG8_LDB
#undef PG8_MMA
#undef PG8_WAIT_V
#undef PG8_WAIT_L
#undef PG8_BAR
#undef PG8_SCHED
}
}

#define GAS __attribute__((address_space(1)))
#define LAS __attribute__((address_space(3)))
typedef unsigned short bf16;
typedef unsigned v4u __attribute__((ext_vector_type(4)));
typedef float f32x4 __attribute__((ext_vector_type(4)));
typedef short bf16x8 __attribute__((ext_vector_type(8)));
typedef GAS unsigned gu32;
typedef GAS unsigned long long gu64;
#define RLX_AGENT __ATOMIC_RELAXED, __HIP_MEMORY_SCOPE_AGENT
#define LDS_WAIT() asm volatile("s_waitcnt lgkmcnt(0)" ::: "memory")
#define VM_WAIT() asm volatile("s_waitcnt vmcnt(0)" ::: "memory")
__device__ __forceinline__ unsigned long long rt() { return __builtin_amdgcn_s_memrealtime(); }
__device__ __forceinline__ unsigned f2bf(float f) { unsigned u = __builtin_bit_cast(unsigned, f); return (u + 0x7fffu + ((u >> 16) & 1u)) >> 16; }
__device__ __forceinline__ unsigned pk2(float lo, float hi) { return f2bf(lo) | (f2bf(hi) << 16); }

#define XB_TMO      128
#define XB_XCNT(j)  (256  + 64 * (j))
#define XB_XSUB(j)  (1280 + 64 * (j))
#define XB_XGEN(j)  (2304 + 64 * (j))
#define XB_TOP      3328
#define XB_TOPGEN   3392
#define XCD_BAR_WORDS 3456
#define XB_SPIN_CAP (1u << 18)

__device__ __forceinline__ unsigned xb_ld(unsigned* p)              { return __hip_atomic_load(p, __ATOMIC_RELAXED, __HIP_MEMORY_SCOPE_AGENT); }
__device__ __forceinline__ unsigned xb_add(unsigned* p, unsigned v) { return __hip_atomic_fetch_add(p, v, __ATOMIC_RELAXED, __HIP_MEMORY_SCOPE_AGENT); }
__device__ __forceinline__ unsigned xb_xcc_id() { return (unsigned)__builtin_amdgcn_s_getreg((3 << 11) | 20) & 0xFu; }
#define XB_SPIN(cond, bar) do { unsigned _sp = 0; while (cond) { __builtin_amdgcn_s_sleep(1); \
    if ((++_sp & 255u) == 0u) { if (xb_ld(&(bar)[XB_TMO])) break; if (_sp > XB_SPIN_CAP) { atomicAdd(&(bar)[XB_TMO], 1u); break; } } } } while (0)

struct XcdBarrier {
    unsigned* bar; unsigned x;
    volatile LAS unsigned* st;
};

__device__ __forceinline__ XcdBarrier xcd_barrier_post(unsigned* bar, volatile LAS unsigned* st) {
    XcdBarrier b; b.bar = bar; b.x = xb_xcc_id(); b.st = st;
    if (threadIdx.x == 0) (void)xb_add(&bar[XB_XCNT(b.x)], 1u);
    return b;
}
__device__ __forceinline__ void xcd_barrier_complete(unsigned* bar, unsigned x, unsigned& nloc, unsigned& nx) {
    const unsigned G = gridDim.x * gridDim.y * gridDim.z;
    unsigned sum, cnt, mine, sp = 0u;
    for (;;) {
        sum = 0u; cnt = 0u; mine = 0u;
#pragma unroll
        for (unsigned j = 0; j < 16; ++j) { const unsigned c = xb_ld(&bar[XB_XCNT(j)]); sum += c; cnt += (c > 0u) ? 1u : 0u; mine = (j == x) ? c : mine; }
        if (sum == G) break;
        __builtin_amdgcn_s_sleep(1);
        if ((++sp & 255u) == 0u) { if (xb_ld(&bar[XB_TMO])) break; if (sp > XB_SPIN_CAP) { atomicAdd(&bar[XB_TMO], 1u); break; } }
    }
    nloc = mine > 0u ? mine : 1u; nx = cnt > 0u ? cnt : 1u;
}

__device__ __forceinline__ void xcd_barrier(const XcdBarrier& b) {
    asm volatile("s_waitcnt vmcnt(0)" ::: "memory");
    __syncthreads();
    if (threadIdx.x == 0) {
        unsigned* bar = b.bar;
        __builtin_amdgcn_s_waitcnt(0);
        unsigned nloc = b.st[0], nx = b.st[1];
        if (nloc == 0u) { xcd_barrier_complete(bar, b.x, nloc, nx); b.st[0] = nloc; b.st[1] = nx; }
        const unsigned old = xb_add(&bar[XB_XSUB(b.x)], 1u);
        const unsigned gen = old / nloc;
        if (old + 1u == (gen + 1u) * nloc) {
            __builtin_amdgcn_fence(__ATOMIC_RELEASE, "agent");
            asm volatile("s_waitcnt vmcnt(0)" ::: "memory");
            const unsigned og = xb_add(&bar[XB_TOP], 1u);
            const unsigned tg = og / nx;
            if (og + 1u == (tg + 1u) * nx) xb_add(&bar[XB_TOPGEN], 1u);
            else XB_SPIN(xb_ld(&bar[XB_TOPGEN]) == tg, bar);
            __builtin_amdgcn_fence(__ATOMIC_ACQUIRE, "agent");
            xb_add(&bar[XB_XGEN(b.x)], 1u);
            asm volatile("s_waitcnt vmcnt(0)" ::: "memory");
        } else {
            XB_SPIN(xb_ld(&bar[XB_XGEN(b.x)]) == gen, bar);
            __builtin_amdgcn_fence(__ATOMIC_ACQUIRE, "agent");
            asm volatile("s_waitcnt vmcnt(0)" ::: "memory");
        }
    }
    __syncthreads();
}

namespace att {
constexpr int D = 128;
constexpr float THR = 8.f;
constexpr bool WSKIP = false;
constexpr float SCALE = 0.08838834764831845f;
constexpr int NW = 8, QBLK = 32, KVBLK = 64, QB = NW * QBLK;
constexpr int SHM_V = KVBLK * D * 2, SHM_K = KVBLK * D * 2;
constexpr int LDS_BYTES = 2 * SHM_V + 2 * SHM_K + NW * 64 * 4;
typedef short bf16x8 __attribute__((ext_vector_type(8)));
typedef short s16x4 __attribute__((ext_vector_type(4)));
typedef float f32x16 __attribute__((ext_vector_type(16)));
typedef float f32x4 __attribute__((ext_vector_type(4)));
typedef unsigned u32x4 __attribute__((ext_vector_type(4)));
template <class A, class Bt> struct same_t { static constexpr bool v = false; };
template <class A> struct same_t<A, A> { static constexpr bool v = true; };

#define KSWZ(row, colB) ((row) * 256 + ((colB) ^ (((row) & 7) << 4)))
#define SBAR() __builtin_amdgcn_sched_barrier(0)
__device__ __forceinline__ int v_st(int k, int c) { const int kk = (k & ~0xC) | ((k & 4) << 1) | ((k & 8) >> 1); return ((kk >> 3) * 4 + (c >> 5)) * 512 + ((kk & 7) * 32 + (c & 31)) * 2; }
__device__ __forceinline__ int v_rd_base(int lane) { return ((lane & 3) << 3) | (((lane >> 2) & 3) << 6) | (((lane >> 4) & 1) << 5) | (((lane >> 5) & 1) << 8); }
constexpr int v_rd_off(int d0, int ks, int half) { return d0 * 512 + ks * 4096 + half * 2048; }
__device__ __forceinline__ int crow(int r, int hi) { return (r & 3) + 8 * (r >> 2) + 4 * hi; }
__device__ __forceinline__ unsigned cvtpk(float lo, float hi) {
    unsigned r; asm volatile("v_cvt_pk_bf16_f32 %0, %1, %2" : "=v"(r) : "v"(lo), "v"(hi)); return r;
}
__device__ __forceinline__ bf16x8 pack8(f32x4 a, f32x4 b) {
    u32x4 w = {cvtpk(a[0], a[1]), cvtpk(a[2], a[3]), cvtpk(b[0], b[1]), cvtpk(b[2], b[3])};
    return *reinterpret_cast<bf16x8*>(&w);
}
template <class T> __device__ __forceinline__ bf16x8 load8(const T* p) {
    if constexpr (same_t<T, float>::v) { return pack8(*(const f32x4*)p, *(const f32x4*)(p + 4)); }
    else { return *reinterpret_cast<const bf16x8*>(p); }
}
__device__ __forceinline__ void mask_tile(f32x16& p0, f32x16& p1, int dq, unsigned W) {
    const float NEG = -__builtin_inff();
#pragma unroll
    for (int r = 0; r < 16; ++r) {
        const int c = (r & 3) + 8 * (r >> 2);
        if ((unsigned)(dq - c) >= W) p0[r] = NEG;
        if ((unsigned)(dq - c - 32) >= W) p1[r] = NEG;
    }
}
__device__ __forceinline__ void partialSM(f32x16& p0, f32x16& p1, float& m_reg, float& mn, float& alpha) {
    float pmax = p0[0]; for (int r = 1; r < 16; ++r) pmax = fmaxf(pmax, p0[r]); for (int r = 0; r < 16; ++r) pmax = fmaxf(pmax, p1[r]);
    { auto rr = __builtin_amdgcn_permlane32_swap(__float_as_uint(pmax), __float_as_uint(pmax), false, false);
      pmax = fmaxf(__uint_as_float(rr[0]), __uint_as_float(rr[1])); }
    constexpr float C2 = 1.4426950408889634f * SCALE;
    if (__builtin_expect(__all((pmax - m_reg) * SCALE <= THR), 1)) { mn = m_reg; alpha = 1.f; }
    else { mn = fmaxf(m_reg, pmax); alpha = __builtin_amdgcn_exp2f((m_reg - mn) * C2); m_reg = mn; }
    const float mnL = -mn * C2;
    for (int r = 0; r < 16; ++r) p0[r] = fmaf(p0[r], C2, mnL); for (int r = 0; r < 16; ++r) p1[r] = fmaf(p1[r], C2, mnL);
    for (int r = 0; r < 16; ++r) p0[r] = __builtin_amdgcn_exp2f(p0[r]);
}
__device__ __forceinline__ void finishSM(f32x16& p0, f32x16& p1, float alpha, float& l_reg, bf16x8& pa0, bf16x8& pa1, bf16x8& pa2, bf16x8& pa3) {
    for (int r = 0; r < 16; ++r) p1[r] = __builtin_amdgcn_exp2f(p1[r]);
    float ps = 0; for (int r = 0; r < 16; ++r) ps += p0[r]; for (int r = 0; r < 16; ++r) ps += p1[r];
    { auto rr = __builtin_amdgcn_permlane32_swap(__float_as_uint(ps), __float_as_uint(ps), false, false);
      ps = __uint_as_float(rr[0]) + __uint_as_float(rr[1]); }
    l_reg = l_reg * alpha + ps;
#define PK4(P, B_, OUT) do { unsigned a0 = cvtpk(P[B_+0], P[B_+1]), a1 = cvtpk(P[B_+2], P[B_+3]);                          \
        unsigned b0 = cvtpk(P[B_+4], P[B_+5]), b1 = cvtpk(P[B_+6], P[B_+7]);                                             \
        auto r0 = __builtin_amdgcn_permlane32_swap(a0, b0, false, false); auto r1 = __builtin_amdgcn_permlane32_swap(a1, b1, false, false); \
        u32x4 w = {r0[0], r1[0], r0[1], r1[1]}; OUT = *reinterpret_cast<bf16x8*>(&w); } while (0)
    PK4(p0, 0, pa0); PK4(p0, 8, pa1); PK4(p1, 0, pa2); PK4(p1, 8, pa3);
#undef PK4
}
template <int KB, bool SK>
__device__ __forceinline__ void qkt(f32x16& p0, f32x16& p1, const char* K_lds, int r32, int hi, const bf16x8* qr, bool act) {
    if (SK && !act) { const float NEG = -__builtin_inff();
#pragma unroll
        for (int r = 0; r < 16; ++r) { p0[r] = NEG; p1[r] = NEG; } return; }
    p0 = f32x16{}; p1 = f32x16{};
    const char* kb[4];
#pragma unroll
    for (int dd = 0; dd < 4; ++dd) kb[dd] = K_lds + KB * SHM_K + KSWZ(r32, (dd * 16 + hi * 8) * 2);
#pragma unroll
    for (int d0 = 0; d0 < 8; ++d0) { const char* a = kb[d0 & 3] + (d0 >> 2) * 128;
        bf16x8 b0 = *reinterpret_cast<const bf16x8*>(a);
        bf16x8 b1 = *reinterpret_cast<const bf16x8*>(a + 32 * 256);
        p0 = __builtin_amdgcn_mfma_f32_32x32x16_bf16(b0, qr[d0], p0, 0, 0, 0);
        p1 = __builtin_amdgcn_mfma_f32_32x32x16_bf16(b1, qr[d0], p1, 0, 0, 0); }
}
template <int VB, bool SK>
__device__ __forceinline__ void pv_tile(f32x16* o, int vb0, bf16x8 pa0, bf16x8 pa1, bf16x8 pa2, bf16x8 pa3, bool act) {
    if (SK && !act) return;
#define TRRD(dst, off) asm volatile("ds_read_b64_tr_b16 %0, %1 offset:%2" : "=&v"(dst) : "v"(vb0), "i"(off) : "memory")
#define PV_D0(d0) do { s16x4 l0, l1, l2, l3, h0, h1, h2, h3; constexpr int b_ = VB * SHM_V + v_rd_off(d0, 0, 0);     \
        TRRD(l0, b_); TRRD(h0, b_ + 2048); TRRD(l1, b_ + 4096); TRRD(h1, b_ + 6144); TRRD(l2, b_ + 8192); TRRD(h2, b_ + 10240); TRRD(l3, b_ + 12288); TRRD(h3, b_ + 14336); \
        asm volatile("s_waitcnt lgkmcnt(0)" ::: "memory"); SBAR();                 \
        o[d0] = __builtin_amdgcn_mfma_f32_32x32x16_bf16(pa0, (bf16x8){l0[0], l0[1], l0[2], l0[3], h0[0], h0[1], h0[2], h0[3]}, o[d0], 0, 0, 0);   \
        o[d0] = __builtin_amdgcn_mfma_f32_32x32x16_bf16(pa1, (bf16x8){l1[0], l1[1], l1[2], l1[3], h1[0], h1[1], h1[2], h1[3]}, o[d0], 0, 0, 0);   \
        o[d0] = __builtin_amdgcn_mfma_f32_32x32x16_bf16(pa2, (bf16x8){l2[0], l2[1], l2[2], l2[3], h2[0], h2[1], h2[2], h2[3]}, o[d0], 0, 0, 0);   \
        o[d0] = __builtin_amdgcn_mfma_f32_32x32x16_bf16(pa3, (bf16x8){l3[0], l3[1], l3[2], l3[3], h3[0], h3[1], h3[2], h3[3]}, o[d0], 0, 0, 0); } while (0)
    PV_D0(0); PV_D0(1); PV_D0(2); PV_D0(3);
#undef PV_D0
#undef TRRD
}

template <class TIn, class TOut> struct BlockRef { const TIn* Q; const TIn* K; const TIn* V; TOut* O; int P0; };
template <class TIn> struct Seam {
    bf16x8 qr[8];
    bf16x8 st_v0, st_v1, st_k0, st_k1; f32x4 sf0, sf1, sf2, sf3;
    f32x4 tq[16];
};
__device__ __forceinline__ int swa_jlo(int P0, int W) { const int lowk = P0 - W + 1; return lowk > 0 ? lowk / KVBLK : 0; }
#define ROW(p, k0, rr) ((p) + (size_t)((k0) + (rr)) * D + sc)
#define VMW() asm volatile("s_waitcnt vmcnt(0)" ::: "memory")
#define VMWN(n) asm volatile("s_waitcnt vmcnt(%0)" :: "i"(n) : "memory")
#define SLOAD_H(Kp, Vp, k0) do { S.st_v0 = load8<TIn>(ROW(Vp, k0, sr)); S.st_v1 = load8<TIn>(ROW(Vp, k0, 32 + sr));              \
                         S.st_k0 = load8<TIn>(ROW(Kp, k0, sr)); S.st_k1 = load8<TIn>(ROW(Kp, k0, 32 + sr)); } while (0)
#define SWRITE_HK(bf) do { *(bf16x8*)(K_lds + (bf) * SHM_K + kws) = S.st_k0; *(bf16x8*)(K_lds + (bf) * SHM_K + kws + 32 * 256) = S.st_k1; } while (0)
#define SWRITE_HV(bf) do { *(bf16x8*)(V_lds + (bf) * SHM_V + vst0) = S.st_v0; *(bf16x8*)(V_lds + (bf) * SHM_V + vst1) = S.st_v1; } while (0)
#define SWRITE_H(bf) do { SWRITE_HV(bf); SWRITE_HK(bf); } while (0)
#define SLOAD_F(p, k0) do { S.sf0 = *(const f32x4*)ROW(p, k0, sr); S.sf1 = *(const f32x4*)(ROW(p, k0, sr) + 4);                \
                            S.sf2 = *(const f32x4*)ROW(p, k0, 32 + sr); S.sf3 = *(const f32x4*)(ROW(p, k0, 32 + sr) + 4); } while (0)
#define SWRITE_KF(bf) do { *(bf16x8*)(K_lds + (bf) * SHM_K + kws) = pack8(S.sf0, S.sf1); *(bf16x8*)(K_lds + (bf) * SHM_K + kws + 32 * 256) = pack8(S.sf2, S.sf3); } while (0)
#define SWRITE_VF(bf) do { *(bf16x8*)(V_lds + (bf) * SHM_V + vst0) = pack8(S.sf0, S.sf1); *(bf16x8*)(V_lds + (bf) * SHM_V + vst1) = pack8(S.sf2, S.sf3); } while (0)
template <class TIn, class TOut>
__device__ __forceinline__ void causal_swa_prime(const BlockRef<TIn, TOut>& cur, int W, char* lds, Seam<TIn>& S) {
    constexpr bool F32 = same_t<TIn, float>::v;
    const int tid = tid_fresh(), wid = __builtin_amdgcn_readfirstlane(tid >> 6), lane = tid & 63, r32 = lane & 31, hi = lane >> 5;
    const int sr = tid >> 4, sc = (tid & 15) * 8, kws = KSWZ(sr, sc * 2); char* K_lds = lds + 2 * SHM_V;
    const int kb0 = swa_jlo(cur.P0, W) * KVBLK;
    for (int d0 = 0; d0 < 8; ++d0) S.qr[d0] = load8<TIn>(cur.Q + (size_t)(wid * QBLK + r32) * D + d0 * 16 + hi * 8);
    if constexpr (F32) { SLOAD_F((const float*)cur.K, kb0); VMW(); SWRITE_KF(0); SBAR(); SLOAD_F((const float*)cur.V, kb0); }
    else { SLOAD_H(cur.K, cur.V, kb0); VMW(); SWRITE_HK(0); }
    __syncthreads();
}
template <class TIn, class TOut>
__device__ __forceinline__ void causal_swa_block(const BlockRef<TIn, TOut>& cur, const BlockRef<TIn, TOut>& nxt, int skv, int W, char* lds, Seam<TIn>& S) {
    constexpr bool F32 = same_t<TIn, float>::v;
    const int tid = tid_fresh(), wid = __builtin_amdgcn_readfirstlane(tid >> 6), lane = tid & 63, r32 = lane & 31, hi = lane >> 5;
    const int j_lo = swa_jlo(cur.P0, W);
    int j_hi = (cur.P0 + QB - 1) / KVBLK + 1; if (j_hi > skv / KVBLK) j_hi = skv / KVBLK;
    const int NT = j_hi - j_lo;
    const int kbn = swa_jlo(nxt.P0, W) * KVBLK;
    const int qlo = cur.P0 + wid * QBLK, qm = qlo + r32 - 4 * hi;
    char* V_lds = lds; char* K_lds = lds + 2 * SHM_V;
    float* ws = (float*)(lds + 2 * SHM_V + 2 * SHM_K) + wid * 64; float* li_l = ws, * al_l = ws + 32;
    float m_reg = -1e30f, l_reg = 0; f32x16 o[4] = {};
    const int sr = tid >> 4, sc = (tid & 15) * 8, vst0 = v_st(sr, sc), vst1 = v_st(32 + sr, sc), kws = KSWZ(sr, sc * 2);
    const int vb0 = (int)(uintptr_t)V_lds + v_rd_base(lane);
    const TIn* Kh = cur.K; const TIn* Vh = cur.V;
#define RESC(a) do { if (__any((a) < 1.f)) { if (hi == 0) al_l[r32] = (a); asm volatile("s_waitcnt lgkmcnt(0)" ::: "memory");              \
                     for (int d_ = 0; d_ < 4; ++d_) for (int r = 0; r < 16; ++r) o[d_][r] *= al_l[crow(r, hi)]; } } while (0)
#define KBASE(t) ((j_lo + (t)) * KVBLK)
#define ACT(t) (KBASE(t) <= qlo + QBLK - 1 && KBASE(t) + KVBLK - 1 >= qlo - W + 1)
#define MASKT(P0_, P1_, t) do { const int kb_ = KBASE(t); if ((!SK || ACT(t)) && (kb_ + KVBLK - 1 > qlo || kb_ <= qlo + QBLK - 1 - W)) mask_tile(P0_, P1_, qm - kb_, (unsigned)W); } while (0)
    constexpr int NQL = F32 ? 16 : 8;
    constexpr bool SK = WSKIP && !F32;
#define SEAM_K0() do { VMWN(NQL); if constexpr (F32) { SWRITE_KF(0); SBAR(); SLOAD_F((const float*)nxt.V, kbn); } else { SWRITE_HK(0); } SBAR(); } while (0)
    f32x16 pA0, pA1, pB0, pB1; float mnA, mnB, alA, alB; bf16x8 pa0, pa1, pa2, pa3;
    if constexpr (F32) { VMW(); SWRITE_VF(0); SBAR(); } else { SWRITE_HV(0); SBAR(); }
    if (NT > 1) { if constexpr (F32) SLOAD_F((const float*)Kh, KBASE(1)); else SLOAD_H(Kh, Vh, KBASE(1)); }
    SBAR(); qkt<0, SK>(pA0, pA1, K_lds, r32, hi, S.qr, ACT(0));
    if constexpr (F32) { if (NT > 1) { VMW(); SWRITE_KF(1); SBAR(); SLOAD_F((const float*)Vh, KBASE(1)); } }
    MASKT(pA0, pA1, 0); partialSM(pA0, pA1, m_reg, mnA, alA);
    if (NT > 1) { VMW(); if constexpr (F32) { SWRITE_VF(1); SBAR(); if (NT > 2) SLOAD_F((const float*)Kh, KBASE(2)); } else SWRITE_H(1); }
    __syncthreads();
#define HALF_STEP(PX0, PX1, mnX, alX, PY0, PY1, alY, t, KB, VB, SB) do {                                                      \
        SBAR(); qkt<KB, SK>(PX0, PX1, K_lds, r32, hi, S.qr, ACT(t));                                             \
        finishSM(PY0, PY1, alY, l_reg, pa0, pa1, pa2, pa3); SBAR();                                                           \
        if ((t) + 1 < NT) { if constexpr (F32) { VMW(); SWRITE_KF(SB); SBAR(); SLOAD_F((const float*)Vh, KBASE((t) + 1)); }  \
                            else { SLOAD_H(Kh, Vh, KBASE((t) + 1)); } SBAR(); }                                               \
        pv_tile<VB, SK>(o, vb0, pa0, pa1, pa2, pa3, ACT((t) - 1)); MASKT(PX0, PX1, (t)); partialSM(PX0, PX1, m_reg, mnX, alX);                                        \
        __syncthreads();                                                                                                      \
        if ((t) + 1 < NT) { VMW(); if constexpr (F32) { SWRITE_VF(SB); SBAR(); if ((t) + 2 < NT) SLOAD_F((const float*)Kh, KBASE((t) + 2)); } \
                            else { SWRITE_H(SB); } }                                                                          \
        RESC(alX); __syncthreads(); } while (0)
    for (int t = 1; t + 1 < NT; t += 2) {
        HALF_STEP(pB0, pB1, mnB, alB, pA0, pA1, alA, t, 1, 0, 0);
        HALF_STEP(pA0, pA1, mnA, alA, pB0, pB1, alB, t + 1, 0, 1, 1);
    }
    const bool even = (NT & 1) == 0;
    if (even) { SBAR(); qkt<1, SK>(pB0, pB1, K_lds, r32, hi, S.qr, ACT(NT - 1)); SBAR(); }
#define QROW(e) (nxt.Q + (size_t)(wid * QBLK + r32) * D + ((e) >> 1) * 16 + hi * 8 + ((e) & 1) * 4)
    if constexpr (F32) { SLOAD_F((const float*)nxt.K, kbn); SBAR();
#pragma unroll
        for (int e = 0; e < 8; ++e) S.tq[e] = *(const f32x4*)QROW(e); }
    else { SLOAD_H(nxt.K, nxt.V, kbn); SBAR();
#pragma unroll
        for (int d0 = 0; d0 < 8; ++d0) S.qr[d0] = load8<TIn>(nxt.Q + (size_t)(wid * QBLK + r32) * D + d0 * 16 + hi * 8); }
    SBAR();
    finishSM(pA0, pA1, alA, l_reg, pa0, pa1, pa2, pa3); SBAR();
    if constexpr (F32) {
#pragma unroll
        for (int e = 8; e < 16; ++e) S.tq[e] = *(const f32x4*)QROW(e); SBAR(); }
#undef QROW
    pv_tile<0, SK>(o, vb0, pa0, pa1, pa2, pa3, ACT(even ? NT - 2 : NT - 1));
    if (even) { MASKT(pB0, pB1, NT - 1); partialSM(pB0, pB1, m_reg, mnB, alB); __syncthreads(); RESC(alB);
        finishSM(pB0, pB1, alB, l_reg, pa0, pa1, pa2, pa3); SBAR(); pv_tile<1, SK>(o, vb0, pa0, pa1, pa2, pa3, ACT(NT - 1)); }
    SBAR(); SEAM_K0();
    if (hi == 0) li_l[r32] = l_reg; asm volatile("s_waitcnt lgkmcnt(0)" ::: "memory");
    float rli[16];
#pragma unroll
    for (int r = 0; r < 16; ++r) rli[r] = __builtin_amdgcn_rcpf(li_l[crow(r, hi)]);
    TOut* Ow = cur.O + (size_t)(wid * QBLK) * D;
#pragma unroll
    for (int r = 0; r < 16; ++r) { const int orow = crow(r, hi);
#pragma unroll
        for (int d0 = 0; d0 < 4; ++d0) { const float v = o[d0][r] * rli[r];
            if constexpr (same_t<TOut, float>::v) { Ow[(size_t)orow * D + d0 * 32 + r32] = v; }
            else { const float vn = __shfl_xor(v, 1);
                   if ((r32 & 1) == 0) *(unsigned*)(Ow + (size_t)orow * D + d0 * 32 + r32) = cvtpk(v, vn); } } }
    if constexpr (F32) {
#pragma unroll
        for (int d0 = 0; d0 < 8; ++d0) S.qr[d0] = pack8(S.tq[2 * d0], S.tq[2 * d0 + 1]); }
    __syncthreads();
#undef RESC
#undef KBASE
#undef ACT
#undef MASKT
#undef SEAM_K0
#undef HALF_STEP
}
#undef ROW
#undef VMW
#undef VMWN
#undef SLOAD_H
#undef SWRITE_HK
#undef SWRITE_HV
#undef SWRITE_H
#undef SLOAD_F
#undef SWRITE_KF
#undef SWRITE_VF
#undef KSWZ
#undef SBAR
}
constexpr int DM = 2048, NB = 4, SEQ = 4096, NMETA = 16, MR = NB * SEQ  , MROWS = MR + NMETA, MPAD = MR + 256;
constexpr int DFF = 5632, NGU = 2 * DFF, NIN = 15360, LW = 2560, NHEAD = 8, KVLEN = 4160, DEPTH = 4;
constexpr float EPS = 1e-6f;
constexpr int NWAVES = 8;
#ifndef MK_MULTI
#define MK_MULTI 0
#endif
#ifndef EN_MASK
#define EN_MASK 0xFFFF
#endif
#define EN(k) (((EN_MASK) >> (k)) & 1)
#ifndef NO_META
#define NO_META 0
#endif
constexpr int PH_PER_LAYER = 10, N_PHASES = 2 + DEPTH * PH_PER_LAYER;

constexpr size_t MiB = 1u << 20;
constexpr size_t WS_CTL = 0, CTL_ZERO_BYTES = 2 * MiB;
constexpr size_t WS_ROPE = 2 * MiB;
constexpr size_t WS_QM = 3 * MiB + 512 * 1024;
constexpr size_t WS_W = 4 * MiB;
constexpr size_t W_GU1 = WS_W, W_DN1 = W_GU1 + 44 * MiB, W_IN = W_DN1 + 22 * MiB, W_BA = W_IN + 60 * MiB, W_BL = W_BA + 8 * MiB, W_O = W_BL + 10 * MiB,
                 W_GU2 = W_O + 8 * MiB, W_DN2 = W_GU2 + 44 * MiB;
constexpr size_t WS_H = 224 * MiB;
constexpr size_t WS_HB = 354 * MiB;
constexpr size_t WS_HID = 420 * MiB;
constexpr size_t WS_Q = 600 * MiB;
constexpr size_t WS_K = 664 * MiB;
constexpr size_t WS_V = 729 * MiB;
constexpr size_t WS_XR = 794 * MiB;
constexpr size_t WS_GY = 876 * MiB;
constexpr size_t WS_G = 958 * MiB;
constexpr size_t WS_OP = 1088 * MiB;
constexpr size_t WS_AO = 1216 * MiB;
constexpr size_t WS_LO = 1281 * MiB;
constexpr size_t WS_TMP = 1363 * MiB;
constexpr size_t WS_MIX = 1493 * MiB;
constexpr size_t WS_END = 1558 * MiB;
static_assert(W_DN2 + 22 * MiB <= WS_H && WS_H + (size_t)MPAD * DM * 4 <= WS_HB && WS_HB + (size_t)MPAD * DM * 2 <= WS_HID && WS_HID + (size_t)MPAD * DFF * 2 <= WS_Q, "ws map 1");
static_assert(WS_K + (size_t)64 * KVLEN * 256 <= WS_V && WS_V + (size_t)64 * KVLEN * 256 <= WS_XR && WS_XR + (size_t)MPAD * LW * 2 <= WS_GY && WS_GY + (size_t)MPAD * LW * 2 <= WS_G, "ws map 2");
static_assert(WS_LO + (size_t)MPAD * LW * 2 <= WS_TMP && WS_TMP + (size_t)MPAD * DM * 4 <= WS_MIX && WS_MIX + (size_t)MPAD * DM * 2 <= WS_END, "ws map 3");
constexpr int CW_TMO = 0, CW_CODE = 1, CW_BAR = 4096;
constexpr size_t SSQ_OFF = 65536;
constexpr int N_SSQ = 13;
static_assert(SSQ_OFF + (size_t)N_SSQ * MPAD * 8 <= CTL_ZERO_BYTES, "ssq inside the memset region");

constexpr int RING_BYTES = 131072, LDSCTL_OFF = RING_BYTES, MISC_OFF = LDSCTL_OFF + 320, LDS_BYTES = 147456;

using pg8::bf16_t; using pg8::bf16x8; using pg8::f32x4; using pg8::u32x4; using pg8::cvt_pk_bf16;

__device__ __forceinline__ float wave_sum(float v) {
#pragma unroll
    for (int o = 1; o < 64; o <<= 1) v += __shfl_xor(v, o);
    return v;
}
__device__ __forceinline__ float bf2f(unsigned short u) { return __uint_as_float((unsigned)u << 16); }
__device__ __forceinline__ float bflo(unsigned u) { return __uint_as_float(u << 16); }
__device__ __forceinline__ float bfhi(unsigned u) { return __uint_as_float(u & 0xffff0000u); }
__device__ __forceinline__ unsigned short f2bf16(float f) { return (unsigned short)(cvt_pk_bf16(f, 0.f) & 0xffffu); }
typedef unsigned long long u64;
__device__ __forceinline__ float rstd_from(float ssq) { return rsqrtf(ssq * (1.0f / 2048.0f) + EPS); }
__device__ __forceinline__ float rstd_fx(u64 v) { return rsqrtf((float)v * (1.0f / 4294967296.0f / 2048.0f) + EPS); }
__device__ __forceinline__ u64 ssq_fx(float ss) { return (u64)(ss * 4294967296.0f); }
__device__ __forceinline__ float sigmoid_f(float x) { return __builtin_amdgcn_rcpf(1.0f + __expf(-x)); }
__device__ __forceinline__ float gelu_tanh_f(float y) { const float u = 1.5957691216057308f * (y + 0.044715f * y * y * y); return y * __builtin_amdgcn_rcpf(1.0f + __expf(-u)); }
__device__ __forceinline__ u32x4 pack8f(f32x4 a, f32x4 b) { u32x4 w; w.x = cvt_pk_bf16(a[0], a[1]); w.y = cvt_pk_bf16(a[2], a[3]); w.z = cvt_pk_bf16(b[0], b[1]); w.w = cvt_pk_bf16(b[2], b[3]); return w; }

namespace pg8 {
template <class E> __device__ __forceinline__ void run_epi(const E& e, const f32x4 (&acc)[2][2][4][2], const Unit& u, int wr, int wc, int fr, int fq) {
    const int colin = wc * 32 + 8 * fq;
#pragma unroll
    for (int ai = 0; ai < 2; ++ai)
#pragma unroll
        for (int m = 0; m < 4; ++m) {
            const int row = u.pm * BM + ai * HALF + wr * 64 + m * 16 + fr;
            e.template frag<false>(row, u.pn, colin, acc[ai][0][m][0], acc[ai][0][m][1], acc[ai][1][m][0], acc[ai][1][m][1]);
        }
}
}
#define EPI_COMMON static constexpr bool PERM = true, AFTER_DRAIN = false; \
    __device__ __forceinline__ void operator()(const f32x4 (&acc)[2][2][4][2], const pg8::Unit& u, int wr, int wc, int fr, int fq) const { pg8::run_epi(*this, acc, u, wr, wc, fr, fq); }

struct EpiSwiGLU {
    EPI_COMMON
    bf16_t* HID; const u64* ssq;
    template <bool META> __device__ __forceinline__ void frag(int row, int pn, int colin, f32x4 a0, f32x4 a1, f32x4 b0, f32x4 b1) const {
        const float rs = rstd_fx(ssq[row]);
        f32x4 o0, o1;
#pragma unroll
        for (int e = 0; e < 4; ++e) { const float g0 = a0[e] * rs, g1 = a1[e] * rs; o0[e] = g0 * sigmoid_f(g0) * (b0[e] * rs); o1[e] = g1 * sigmoid_f(g1) * (b1[e] * rs); }
        *(u32x4*)(HID + (size_t)row * DFF + pn * 128 + colin) = pack8f(o0, o1);
    }
};
struct EpiResid {
    EPI_COMMON
    float* H; bf16_t* HB; const float* gnext; u64* ssqn; float alpha;
    template <bool META> __device__ __forceinline__ void frag(int row, int pn, int colin, f32x4 a0, f32x4 a1, f32x4 b0, f32x4 b1) const {
        const int c0 = pn * 256 + colin;
        float* hp = H + (size_t)row * DM + c0;
        const f32x4 h0 = *(const f32x4*)hp + alpha * a0, h1 = *(const f32x4*)(hp + 4) + alpha * a1, h2 = *(const f32x4*)(hp + 128) + alpha * b0, h3 = *(const f32x4*)(hp + 132) + alpha * b1;
        *(f32x4*)hp = h0; *(f32x4*)(hp + 4) = h1; *(f32x4*)(hp + 128) = h2; *(f32x4*)(hp + 132) = h3;
        const float* gp = gnext + c0;
        const f32x4 g0 = *(const f32x4*)gp, g1 = *(const f32x4*)(gp + 4), g2 = *(const f32x4*)(gp + 128), g3 = *(const f32x4*)(gp + 132);
        bf16_t* bp = HB + (size_t)row * DM + c0;
        *(u32x4*)bp = pack8f(h0 * g0, h1 * g1); *(u32x4*)(bp + 128) = pack8f(h2 * g2, h3 * g3);
        float ss = 0.f;
#pragma unroll
        for (int e = 0; e < 4; ++e) ss += h0[e] * h0[e] + h1[e] * h1[e] + h2[e] * h2[e] + h3[e] * h3[e];
        ss += __shfl_xor(ss, 16); ss += __shfl_xor(ss, 32);
        if ((threadIdx.x & 48) == 0) __hip_atomic_fetch_add(ssqn + row, ssq_fx(ss), __ATOMIC_RELAXED, __HIP_MEMORY_SCOPE_AGENT);
    }
};
struct EpiWin {
    EPI_COMMON
    bf16_t *Q, *K, *V, *XR, *GY, *G, *QM; const float* bgate; const u64* ssq; const float* rc; const float* rsn;
    template <bool META> __device__ __forceinline__ void frag(int row, int pn, int colin, f32x4 a0, f32x4 a1, f32x4 b0, f32x4 b1) const {
        const float rs = rstd_fx(ssq[row]);
        a0 = a0 * rs; a1 = a1 * rs; b0 = b0 * rs; b1 = b1 * rs;
        const int mi = row - MR, b = row >> 12, t = row & 4095, pos = META ? mi : t + NMETA;
        if (pn < 24) {
            if (pn < 16 && colin < 32) {
                const f32x4 c = *(const f32x4*)(rc + pos * 16 + (colin >> 1)), s = *(const f32x4*)(rsn + pos * 16 + (colin >> 1));
                const f32x4 r1 = a0 * c - a1 * s, r2 = a1 * c + a0 * s, r3 = b0 * c - b1 * s, r4 = b1 * c + b0 * s;
                a0 = r1; a1 = r2; b0 = r3; b1 = r4;
            }
            const u32x4 wa = pack8f(a0, a1), wb = pack8f(b0, b1);
            const int h = pn & 7;
            if (pn < 8) {
                if (META) { bf16_t* p = QM + ((size_t)(2 * h) * NMETA + mi) * 128 + colin; *(u32x4*)p = wa; *(u32x4*)(p + NMETA * 128) = wb; }
                else { bf16_t* p = Q + ((size_t)(b * 16 + 2 * h) * SEQ + t) * 128 + colin; *(u32x4*)p = wa; *(u32x4*)(p + (size_t)SEQ * 128) = wb; }
            } else {
                bf16_t* base = pn < 16 ? K : V;
                if (META) {
#pragma unroll
                    for (int bb = 0; bb < NB; ++bb) { bf16_t* p = base + ((size_t)(bb * 16 + 2 * h) * KVLEN + mi) * 128 + colin; *(u32x4*)p = wa; *(u32x4*)(p + (size_t)KVLEN * 128) = wb; }
                } else { bf16_t* p = base + ((size_t)(b * 16 + 2 * h) * KVLEN + pos) * 128 + colin; *(u32x4*)p = wa; *(u32x4*)(p + (size_t)KVLEN * 128) = wb; }
            }
        } else if (pn < 34) {
            bf16_t* p = XR + (size_t)row * LW + (pn - 24) * 256 + colin; *(u32x4*)p = pack8f(a0, a1); *(u32x4*)(p + 128) = pack8f(b0, b1);
        } else if (pn < 44) {
#pragma unroll
            for (int e = 0; e < 4; ++e) { a0[e] = gelu_tanh_f(a0[e]); a1[e] = gelu_tanh_f(a1[e]); b0[e] = gelu_tanh_f(b0[e]); b1[e] = gelu_tanh_f(b1[e]); }
            bf16_t* p = GY + (size_t)row * LW + (pn - 34) * 256 + colin; *(u32x4*)p = pack8f(a0, a1); *(u32x4*)(p + 128) = pack8f(b0, b1);
        } else {
            const int c0 = (pn - 44) * 256 + colin; const float* bp = bgate + c0;
            const f32x4 g0 = *(const f32x4*)bp, g1 = *(const f32x4*)(bp + 4), g2 = *(const f32x4*)(bp + 128), g3 = *(const f32x4*)(bp + 132);
#pragma unroll
            for (int e = 0; e < 4; ++e) { a0[e] = sigmoid_f(a0[e] + g0[e]); a1[e] = sigmoid_f(a1[e] + g1[e]); b0[e] = sigmoid_f(b0[e] + g2[e]); b1[e] = sigmoid_f(b1[e] + g3[e]); }
            bf16_t* p = G + (size_t)row * 4096 + c0; *(u32x4*)p = pack8f(a0, a1); *(u32x4*)(p + 128) = pack8f(b0, b1);
        }
    }
};
__device__ __forceinline__ void unpack8(u32x4 w, f32x4& lo, f32x4& hi) { lo = (f32x4){bflo(w.x), bfhi(w.x), bflo(w.y), bfhi(w.y)}; hi = (f32x4){bflo(w.z), bfhi(w.z), bflo(w.w), bfhi(w.w)}; }
struct EpiBa {
    EPI_COMMON
    float* TMP; const bf16_t* G;
    template <bool META> __device__ __forceinline__ void frag(int row, int pn, int colin, f32x4 a0, f32x4 a1, f32x4 b0, f32x4 b1) const {
        const int c0 = pn * 256 + colin; const bf16_t* gp = G + (size_t)row * 4096 + c0;
        f32x4 g0, g1, g2, g3; unpack8(*(const u32x4*)gp, g0, g1); unpack8(*(const u32x4*)(gp + 128), g2, g3);
        float* tp = TMP + (size_t)row * DM + c0;
        *(f32x4*)tp = g0 * a0; *(f32x4*)(tp + 4) = g1 * a1; *(f32x4*)(tp + 128) = g2 * b0; *(f32x4*)(tp + 132) = g3 * b1;
    }
};
struct EpiBl {
    EPI_COMMON
    const float* TMP; const bf16_t* G; bf16_t* MIX;
    template <bool META> __device__ __forceinline__ void frag(int row, int pn, int colin, f32x4 a0, f32x4 a1, f32x4 b0, f32x4 b1) const {
        const int c0 = pn * 256 + colin; const bf16_t* gp = G + (size_t)row * 4096 + 2048 + c0;
        f32x4 g0, g1, g2, g3; unpack8(*(const u32x4*)gp, g0, g1); unpack8(*(const u32x4*)(gp + 128), g2, g3);
        const float* tp = TMP + (size_t)row * DM + c0;
        const f32x4 t0 = *(const f32x4*)tp + g0 * a0, t1 = *(const f32x4*)(tp + 4) + g1 * a1, t2 = *(const f32x4*)(tp + 128) + g2 * b0, t3 = *(const f32x4*)(tp + 132) + g3 * b1;
        bf16_t* mp = MIX + (size_t)row * DM + c0;
        *(u32x4*)mp = pack8f(t0, t1); *(u32x4*)(mp + 128) = pack8f(t2, t3);
    }
};

template <class Epi> __device__ __forceinline__ void meta_gemm(LAS unsigned char* lds, const bf16_t* A16, const bf16_t* Bt, int N, int K, const Epi& E) {
    const int tid = tid_fresh(), wid = __builtin_amdgcn_readfirstlane(tid >> 6), lane = tid & 63, fr = lane & 15, fq = lane >> 4;
    const int nitems = N / 64, ks = K / 8;
    LAS f32x4* red = (LAS f32x4*)lds;
    for (int it = blockIdx.x; it < nitems; it += gridDim.x) {
        const int pn = it >> 2, wc = it & 3;
        f32x4 acc[4];
#pragma unroll
        for (int q = 0; q < 4; ++q) acc[q] = (f32x4){0.f, 0.f, 0.f, 0.f};
        const bf16_t* ap = A16 + (size_t)fr * K + wid * ks + 8 * fq;
        const bf16_t* bp[4];
#pragma unroll
        for (int q = 0; q < 4; ++q) bp[q] = Bt + (size_t)(pn * 256 + (q >> 1) * 128 + wc * 32 + pg8::perm32(16 * (q & 1) + fr)) * K + wid * ks + 8 * fq;
#pragma unroll 2
        for (int kk = 0; kk < ks; kk += 32) {
            const bf16x8 a = *(const bf16x8*)(ap + kk);
#pragma unroll
            for (int q = 0; q < 4; ++q) { const bf16x8 bv = *(const bf16x8*)(bp[q] + kk); acc[q] = __builtin_amdgcn_mfma_f32_16x16x32_bf16(bv, a, acc[q], 0, 0, 0); }
        }
#pragma unroll
        for (int q = 0; q < 4; ++q) red[(wid * 4 + q) * 64 + lane] = acc[q];
        __syncthreads();
        if (wid == 0) {
            f32x4 s[4];
#pragma unroll
            for (int q = 0; q < 4; ++q) { s[q] = red[q * 64 + lane];
#pragma unroll
                for (int w = 1; w < 8; ++w) s[q] = s[q] + red[(w * 4 + q) * 64 + lane]; }
            E.template frag<true>(MR + fr, pn, wc * 32 + 8 * fq, s[0], s[1], s[2], s[3]);
        }
        __syncthreads();
    }
}

template <int MODE> __device__ __forceinline__ int wmap(int n) {
    if (MODE == 1) return ((n >> 7) << 8) + (n & 127);
    if (MODE == 2) return ((n >> 7) << 8) + 128 + (n & 127);
    if (MODE == 3) { if (n >= 4096) return n; const int d = n & 127; if (d >= 32) return n; const int s = d < 16 ? 8 * (d >> 2) + (d & 3) : 8 * ((d - 16) >> 2) + 4 + (d & 3); return (n & ~127) + s; }
    return n;
}
template <int MODE> __device__ __forceinline__ void transpose_item(const float* W, int K, int N, bf16_t* WT, LAS float* scr, int item, int lane) {
    const int nblk = N / 32, kb = item / nblk, nb = item % nblk, k0 = 64 * kb, n0 = 32 * nb;
#pragma unroll 8
    for (int i = 0; i < 32; ++i) { const int kk = 2 * i + (lane >> 5); scr[kk * 33 + (lane & 31)] = W[(size_t)(k0 + kk) * N + n0 + (lane & 31)]; }
    asm volatile("s_waitcnt lgkmcnt(0)" ::: "memory");
    const int c = lane & 7;
#pragma unroll
    for (int j = 0; j < 4; ++j) { const int n = (lane >> 3) + 8 * j; const LAS float* s = scr + (8 * c) * 33 + n;
        u32x4 o; o.x = cvt_pk_bf16(s[0 * 33], s[1 * 33]); o.y = cvt_pk_bf16(s[2 * 33], s[3 * 33]); o.z = cvt_pk_bf16(s[4 * 33], s[5 * 33]); o.w = cvt_pk_bf16(s[6 * 33], s[7 * 33]);
        *(u32x4*)(WT + (size_t)wmap<MODE>(n0 + n) * K + k0 + 8 * c) = o; }
    asm volatile("s_waitcnt lgkmcnt(0)" ::: "memory");
}

struct Args { const float* in[29]; float* out; unsigned char* ws; float invf[16]; int ph_lo, ph_hi; };
static_assert(sizeof(Args) == 31 * 8 + 16 * 4 + 8, "Args has no padding");

constexpr int LRU_TT = 128, LRU_XS = 0, LRU_AS = 0, LRU_BS = 20480, LRU_XC = 41984, LRU_XCS = 168, LRU_WS = LRU_XC + 128 * 336, LRU_GYS = LRU_WS + 80 * 336,
              LRU_SEG = LRU_GYS + 128 * 80, LRU_HIN = LRU_SEG + 3 * 1280, LRU_CST = LRU_HIN + 160, LRU_END = LRU_CST + 480;
static_assert(LRU_END <= RING_BYTES && 131 * 320 <= LRU_XC, "LRU LDS map");
__device__ __forceinline__ void lru_item(LAS unsigned char* lds, int it, const bf16_t* XR, const bf16_t* GY, bf16_t* LO, const float* conv_w, const float* conv_b,
                                         const float* gx_w, const float* gx_b, const float* ga_w, const float* ga_b, const float* a_param) {
    const int tid = tid_fresh(), wid = __builtin_amdgcn_readfirstlane(tid >> 6), lane = tid & 63, fr = lane & 15, fq = lane >> 4;
    const int b = it >> 6, n = (it >> 2) & 15, s = it & 3, cl0 = 40 * s, cg0 = 160 * n + cl0;
    LAS bf16_t* XS = (LAS bf16_t*)(lds + LRU_XS); LAS float* AS = (LAS float*)(lds + LRU_AS); LAS float* BS = (LAS float*)(lds + LRU_BS);
    LAS bf16_t* XC = (LAS bf16_t*)(lds + LRU_XC); LAS bf16_t* WSM = (LAS bf16_t*)(lds + LRU_WS); LAS bf16_t* GYS = (LAS bf16_t*)(lds + LRU_GYS);
    LAS float* SEGA = (LAS float*)(lds + LRU_SEG); LAS float* SEGB = SEGA + 320; LAS float* HSEG = SEGB + 320; LAS float* HIN = (LAS float*)(lds + LRU_HIN); LAS float* CST = (LAS float*)(lds + LRU_CST);
    for (int e = tid; e < 80 * 160; e += 512) { const int row = e % 80, k = e / 80, mt = row >> 4, q = (row >> 2) & 3, r = row & 3, ch = 8 * mt + 2 * q + (r & 1);
        const float* src = (r < 2 ? ga_w : gx_w) + ((size_t)n * 160 + k) * 160 + cl0 + ch; WSM[row * LRU_XCS + k] = f2bf16(*src); }
    if (tid < 40) { CST[tid] = ga_b[cg0 + tid]; CST[40 + tid] = gx_b[cg0 + tid]; CST[80 + tid] = -8.0f * log1pf(__expf(-a_param[cg0 + tid])); HIN[tid] = 0.f; }
    const int c8 = tid % 20, r0 = tid / 20;
    float cw[4][8], cb[8];
#pragma unroll
    for (int e = 0; e < 8; ++e) { cb[e] = conv_b[160 * n + 8 * c8 + e];
#pragma unroll
        for (int j = 0; j < 4; ++j) cw[j][e] = conv_w[j * LW + 160 * n + 8 * c8 + e]; }
    __syncthreads();
    for (int k = 0; k <= 32; ++k) {
        const int p0 = k == 0 ? 0 : NMETA + LRU_TT * (k - 1), nvalid = k == 0 ? NMETA : LRU_TT;
        for (int e = tid; e < 131 * 20; e += 512) { const int rho = e / 20, ch = e % 20, p = p0 - 3 + rho; u32x4 v = (u32x4){0u, 0u, 0u, 0u};
            if (p >= 0 && rho - 3 < nvalid) { const int row = p < NMETA ? MR + p : b * SEQ + p - NMETA; v = *(const u32x4*)(XR + (size_t)row * LW + 160 * n + 8 * ch); }
            *(LAS u32x4*)(XS + rho * 160 + 8 * ch) = v; }
        for (int e = tid; e < 128 * 5; e += 512) { const int t = e / 5, ch = e % 5, p = p0 + t; u32x4 v = (u32x4){0u, 0u, 0u, 0u};
            if (t < nvalid) { const int row = p < NMETA ? MR + p : b * SEQ + p - NMETA; v = *(const u32x4*)(GY + (size_t)row * LW + cg0 + 8 * ch); }
            *(LAS u32x4*)(GYS + t * 40 + 8 * ch) = v; }
        __syncthreads();
        if (tid < 500) {
#pragma unroll
            for (int i = 0; i < 6; ++i) { const int t = r0 + 25 * i; if (t < 128) {
                float o[8];
#pragma unroll
                for (int e = 0; e < 8; ++e) o[e] = cb[e];
#pragma unroll
                for (int j = 0; j < 4; ++j) { const u32x4 xv = *(const LAS u32x4*)(XS + (t + 3 - j) * 160 + 8 * c8);
                    o[0] += cw[j][0] * bflo(xv.x); o[1] += cw[j][1] * bfhi(xv.x); o[2] += cw[j][2] * bflo(xv.y); o[3] += cw[j][3] * bfhi(xv.y);
                    o[4] += cw[j][4] * bflo(xv.z); o[5] += cw[j][5] * bfhi(xv.z); o[6] += cw[j][6] * bflo(xv.w); o[7] += cw[j][7] * bfhi(xv.w); }
                u32x4 w; w.x = cvt_pk_bf16(o[0], o[1]); w.y = cvt_pk_bf16(o[2], o[3]); w.z = cvt_pk_bf16(o[4], o[5]); w.w = cvt_pk_bf16(o[6], o[7]);
                *(LAS u32x4*)(XC + t * LRU_XCS + 8 * c8) = w; } }
        }
        __syncthreads();
        {
            bf16x8 xcf[5];
#pragma unroll
            for (int kk = 0; kk < 5; ++kk) xcf[kk] = *(const LAS bf16x8*)(XC + (16 * wid + fr) * LRU_XCS + 32 * kk + 8 * fq);
            const int t = 16 * wid + fr;
#pragma unroll
            for (int mt = 0; mt < 5; ++mt) {
                f32x4 acc = (f32x4){0.f, 0.f, 0.f, 0.f};
#pragma unroll
                for (int kk = 0; kk < 5; ++kk) { const bf16x8 wf = *(const LAS bf16x8*)(WSM + (16 * mt + fr) * LRU_XCS + 32 * kk + 8 * fq); acc = __builtin_amdgcn_mfma_f32_16x16x32_bf16(wf, xcf[kk], acc, 0, 0, 0); }
#pragma unroll
                for (int e = 0; e < 2; ++e) { const int c = 8 * mt + 2 * fq + e;
                    const float rr = sigmoid_f(acc[e] + CST[c]), ii = sigmoid_f(acc[2 + e] + CST[40 + c]), la = rr * CST[80 + c];
                    float a = __expf(la), bx = sqrtf(-expm1f(2.0f * la)) * ii * bf2f(XC[t * LRU_XCS + cl0 + c]);
                    if (t >= nvalid) { a = 1.f; bx = 0.f; }
                    AS[t * 40 + c] = a; BS[t * 40 + c] = bx; }
            }
        }
        __syncthreads();
        const int sc = tid % 40, sg = tid / 40;
        if (tid < 320) { float A = 1.f, Bv = 0.f;
#pragma unroll
            for (int i = 0; i < 16; ++i) { const int t = 16 * sg + i; const float a = AS[t * 40 + sc]; Bv = a * Bv + BS[t * 40 + sc]; A *= a; }
            SEGA[sg * 40 + sc] = A; SEGB[sg * 40 + sc] = Bv; }
        __syncthreads();
        if (tid < 40) { float h = HIN[tid];
#pragma unroll
            for (int g = 0; g < 8; ++g) { HSEG[g * 40 + tid] = h; h = SEGA[g * 40 + tid] * h + SEGB[g * 40 + tid]; }
            HIN[tid] = h; }
        __syncthreads();
        if (tid < 320) { float h = HSEG[sg * 40 + sc];
#pragma unroll
            for (int i = 0; i < 16; ++i) { const int t = 16 * sg + i; h = AS[t * 40 + sc] * h + BS[t * 40 + sc]; GYS[t * 40 + sc] = f2bf16(h * bf2f(GYS[t * 40 + sc])); } }
        __syncthreads();
        if (k > 0 || b == 0)
            for (int e = tid; e < nvalid * 5; e += 512) { const int t = e / 5, ch = e % 5, p = p0 + t, row = p < NMETA ? MR + p : b * SEQ + p - NMETA;
                *(u32x4*)(LO + (size_t)row * LW + cg0 + 8 * ch) = *(const LAS u32x4*)(GYS + t * 40 + 8 * ch); }
        __syncthreads();
    }
}

__device__ __forceinline__ att::BlockRef<bf16_t, bf16_t> attn_ref(const bf16_t* Qb, const bf16_t* Kb, const bf16_t* Vb, bf16_t* OP, int b, int h, int s, int idx) {
    const int cj = idx >> 1, c = cj >> 1, j = cj & 1, qb = (idx & 1) ? 15 - s : s;
    att::BlockRef<bf16_t, bf16_t> r;
    r.Q = Qb + ((size_t)(b * 16 + 2 * h + c) * SEQ + (size_t)qb * 256) * 128;
    r.K = Kb + (size_t)(b * 16 + 2 * h + c) * KVLEN * 128;
    r.V = Vb + (size_t)(b * 16 + 2 * h + j) * KVLEN * 128;
    r.O = OP + ((size_t)((b * 8 + h) * 4 + cj) * SEQ + (size_t)qb * 256) * 128;
    r.P0 = NMETA + qb * 256;
    return r;
}
__device__ __forceinline__ void attn_phase(char* lds, const bf16_t* Qb, const bf16_t* Kb, const bf16_t* Vb, bf16_t* OP, int vcu, int G) {
    constexpr int W = 1 << 20;
    for (int vw = vcu; vw < 256; vw += G) {
        const int bh = vw >> 3, s = vw & 7, b = bh >> 3, h = bh & 7;
        att::Seam<bf16_t> S;
        att::BlockRef<bf16_t, bf16_t> cur = attn_ref(Qb, Kb, Vb, OP, b, h, s, 0);
        att::causal_swa_prime<bf16_t, bf16_t>(cur, W, lds, S);
#pragma nounroll
        for (int idx = 0; idx < 8; ++idx) {
            const att::BlockRef<bf16_t, bf16_t> nxt = idx < 7 ? attn_ref(Qb, Kb, Vb, OP, b, h, s, idx + 1) : cur;
            att::causal_swa_block<bf16_t, bf16_t>(cur, nxt, KVLEN, W, lds, S);
            cur = nxt;
        }
    }
}

__device__ __forceinline__ float lam_of(const float* lq1, const float* lk1, const float* lq2, const float* lk2, float lam_init, int lane) {
    const float d1 = wave_sum(lq1[lane] * lk1[lane] + lq1[lane + 64] * lk1[lane + 64]), d2 = wave_sum(lq2[lane] * lk2[lane] + lq2[lane + 64] * lk2[lane + 64]);
    return expf(d1) - expf(d2) + lam_init;
}
__device__ __forceinline__ void combine_phase(const bf16_t* OP, bf16_t* AO, const bf16_t* QM, const bf16_t* Kb, const bf16_t* Vb, const float* subln, float lam, float lam_init, int gw, int ngw, int lane) {
    const f32x4 sl = *(const f32x4*)(subln + 4 * lane) * (1.0f - lam_init);
    for (int it = gw; it < MR * 8; it += ngw) {
        const int row = it >> 3, h = it & 7, b = row >> 12, t = row & 4095, j = lane >> 5, dd = 4 * (lane & 31);
        const bf16_t* p0 = OP + ((size_t)((b * 8 + h) * 4 + j) * SEQ + t) * 128 + dd;
        const bf16_t* p1 = p0 + (size_t)2 * SEQ * 128;
        const unsigned long long w0 = *(const unsigned long long*)p0, w1 = *(const unsigned long long*)p1;
        f32x4 x;
        x[0] = bflo((unsigned)w0) - lam * bflo((unsigned)w1); x[1] = bfhi((unsigned)w0) - lam * bfhi((unsigned)w1);
        x[2] = bflo((unsigned)(w0 >> 32)) - lam * bflo((unsigned)(w1 >> 32)); x[3] = bfhi((unsigned)(w0 >> 32)) - lam * bfhi((unsigned)(w1 >> 32));
        const float ss = wave_sum(x[0] * x[0] + x[1] * x[1] + x[2] * x[2] + x[3] * x[3]);
        const float rs = rsqrtf(ss * (1.0f / 256.0f) + EPS);
        x = x * rs * sl;
        *(unsigned long long*)(AO + (size_t)row * DM + h * 256 + 4 * lane) = (unsigned long long)cvt_pk_bf16(x[0], x[1]) | ((unsigned long long)cvt_pk_bf16(x[2], x[3]) << 32);
    }
    for (int it = gw; it < NHEAD * NMETA; it += ngw) {
        const int h = it >> 4, i = it & 15, kj = lane & 15, part = lane >> 4;
        float pc[2];
#pragma unroll
        for (int c = 0; c < 2; ++c) {
            const bf16_t* qp = QM + ((size_t)(2 * h + c) * NMETA + i) * 128 + 32 * part;
            const bf16_t* kp = Kb + ((size_t)(2 * h + c) * KVLEN + kj) * 128 + 32 * part;
            float d = 0.f;
#pragma unroll
            for (int e = 0; e < 4; ++e) { const u32x4 qv = *(const u32x4*)(qp + 8 * e), kv = *(const u32x4*)(kp + 8 * e);
                d += bflo(qv.x) * bflo(kv.x) + bfhi(qv.x) * bfhi(kv.x) + bflo(qv.y) * bflo(kv.y) + bfhi(qv.y) * bfhi(kv.y) + bflo(qv.z) * bflo(kv.z) + bfhi(qv.z) * bfhi(kv.z) + bflo(qv.w) * bflo(kv.w) + bfhi(qv.w) * bfhi(kv.w); }
            d += __shfl_xor(d, 16); d += __shfl_xor(d, 32);
            float sv = kj <= i ? d * 0.08838834764831845f : -INFINITY;
            float m = sv;
#pragma unroll
            for (int o = 1; o < 16; o <<= 1) m = fmaxf(m, __shfl_xor(m, o));
            float p = __expf(sv - m), l = p;
#pragma unroll
            for (int o = 1; o < 16; o <<= 1) l += __shfl_xor(l, o);
            pc[c] = p / l;
        }
        const int j = lane >> 5, dd = 4 * (lane & 31);
        f32x4 o0 = (f32x4){0.f, 0.f, 0.f, 0.f}, o1 = o0;
        for (int k2 = 0; k2 <= i; ++k2) {
            const unsigned long long w = *(const unsigned long long*)(Vb + ((size_t)(2 * h + j) * KVLEN + k2) * 128 + dd);
            const f32x4 v = (f32x4){bflo((unsigned)w), bfhi((unsigned)w), bflo((unsigned)(w >> 32)), bfhi((unsigned)(w >> 32))};
            o0 = o0 + __shfl(pc[0], k2) * v; o1 = o1 + __shfl(pc[1], k2) * v;
        }
        f32x4 x = o0 - lam * o1;
        const float ss = wave_sum(x[0] * x[0] + x[1] * x[1] + x[2] * x[2] + x[3] * x[3]);
        const float rs = rsqrtf(ss * (1.0f / 256.0f) + EPS);
        x = x * rs * sl;
        *(unsigned long long*)(AO + (size_t)(MR + i) * DM + h * 256 + 4 * lane) = (unsigned long long)cvt_pk_bf16(x[0], x[1]) | ((unsigned long long)cvt_pk_bf16(x[2], x[3]) << 32);
    }
}

typedef const __attribute__((address_space(4))) Args* ArgsP;
__device__ __forceinline__ ArgsP fresh_args() { ArgsP p = (ArgsP)__builtin_amdgcn_kernarg_segment_ptr(); asm volatile("" : "+s"(p)); return p; }
#define PH_ARGS ArgsP A = fresh_args(); unsigned char* const ws = A->ws; (void)ws; \
    const int tid = tid_fresh(), lane = tid & 63, wave = __builtin_amdgcn_readfirstlane(tid >> 6), gw = vcu * NWAVES + wave, ngw = G * NWAVES; (void)lane; (void)gw; (void)ngw
#define ssq_base ((u64*)(ws + SSQ_OFF))
#define H ((float*)(ws + WS_H))
#define HB ((bf16_t*)(ws + WS_HB))
#define HID ((bf16_t*)(ws + WS_HID))
#define Qb ((bf16_t*)(ws + WS_Q))
#define Kb ((bf16_t*)(ws + WS_K))
#define Vb ((bf16_t*)(ws + WS_V))
#define QM ((bf16_t*)(ws + WS_QM))
#define XR ((bf16_t*)(ws + WS_XR))
#define GY ((bf16_t*)(ws + WS_GY))
#define GG ((bf16_t*)(ws + WS_G))
#define OP ((bf16_t*)(ws + WS_OP))
#define AO ((bf16_t*)(ws + WS_AO))
#define LO ((bf16_t*)(ws + WS_LO))
#define TMP ((float*)(ws + WS_TMP))
#define MIX ((bf16_t*)(ws + WS_MIX))
#define ropec ((float*)(ws + WS_ROPE))
#define ropes ((float*)(ws + WS_ROPE + 512 * 1024))
#define SSQ(i) (ssq_base + (size_t)(i) * MPAD)
__global__ void __launch_bounds__(NWAVES * 64, 2) mk_fwd(Args args) {
    extern __shared__ __attribute__((aligned(16))) unsigned char lds[];
    LAS unsigned char* L = (LAS unsigned char*)lds;
    volatile LAS unsigned* MISC = (volatile LAS unsigned*)(L + MISC_OFF);
    const int G = gridDim.x, bx = blockIdx.x, vcu = (G % 8 == 0) ? (bx % 8) * (G / 8) + bx / 8 : bx;
    gu32* ctl = (gu32*)(args.ws + WS_CTL);
    for (int u = threadIdx.x; u < (LDS_BYTES - LDSCTL_OFF) / 4; u += NWAVES * 64) ((LAS unsigned*)(L + LDSCTL_OFF))[u] = 0u;
    __syncthreads();
    XcdBarrier bar; bar.bar = (unsigned*)(ctl + CW_BAR); bar.x = 0; bar.st = nullptr;
    if (!MK_MULTI) bar = xcd_barrier_post((unsigned*)(ctl + CW_BAR), MISC + 8);
    const int lo = args.ph_lo, hi = args.ph_hi;
#define IN(k) (lo <= (k) && (k) < hi)
#define SEAM(k) do { if (IN((k) + 1)) xcd_barrier(bar); } while (0)

    if (EN(10) && IN(0)) {
        PH_ARGS; const float* x = A->in[0]; const float* meta = A->in[1]; const float* g1 = A->in[2];
        for (int m = gw; m < MROWS; m += ngw) {
            const float* src = m < MR ? x + (size_t)m * DM : meta + (size_t)(m - MR) * DM; float ss = 0.f;
#pragma unroll
            for (int j = 0; j < 8; ++j) { const int c = 4 * (64 * j + lane); const f32x4 v = *(const f32x4*)(src + c), g = *(const f32x4*)(g1 + c);
                *(f32x4*)(H + (size_t)m * DM + c) = v; ss += v[0] * v[0] + v[1] * v[1] + v[2] * v[2] + v[3] * v[3];
                *(unsigned long long*)(HB + (size_t)m * DM + c) = (unsigned long long)cvt_pk_bf16(v[0] * g[0], v[1] * g[1]) | ((unsigned long long)cvt_pk_bf16(v[2] * g[2], v[3] * g[3]) << 32); }
            ss = wave_sum(ss); if (lane == 0) ssq_base[m] = ssq_fx(ss);
        }
        for (int e = gw * 64 + lane; e < (SEQ + NMETA) * 16; e += ngw * 64) { const int pos = e >> 4, i = e & 15; const float ang = (float)pos * A->invf[i]; ropec[e] = cosf(ang); ropes[e] = sinf(ang); }
        for (int e = gw * 64 + lane; e < 2 * 64 * 48 * 16; e += ngw * 64) { const int kv = e / (64 * 48 * 16), r = e % (64 * 48 * 16), bh = r / (48 * 16), rr = (r / 16) % 48, ch = r % 16;
            *(u32x4*)((kv ? Vb : Kb) + ((size_t)bh * KVLEN + (SEQ + NMETA) + rr) * 128 + 8 * ch) = (u32x4){0u, 0u, 0u, 0u}; }
    }
#pragma nounroll
    for (int l = 0; l < DEPTH; ++l) {
        const int pb = 1 + l * PH_PER_LAYER;
        const float lam_init = 0.8f - 0.6f * expf(-0.3f * (float)l);
        if (EN(0) && IN(pb + 0)) {
            PH_ARGS;
            constexpr int I_G = (DM / 64) * (DFF / 32), I_D = (DFF / 64) * (DM / 32), I_IN = (DM / 64) * (NIN / 32), I_S = (DM / 64) * (DM / 32), I_L = (LW / 64) * (DM / 32);
            constexpr int NIT = 2 * (2 * I_G + I_D) + I_IN + 2 * I_S + I_L;
            const float* wg1 = A->in[3] + (size_t)l * DM * DFF; const float* wu1 = A->in[4] + (size_t)l * DM * DFF; const float* wd1 = A->in[5] + (size_t)l * DFF * DM;
            const float* win = A->in[7] + (size_t)l * DM * NIN; const float* wba = A->in[21] + (size_t)l * DM * DM; const float* wbl = A->in[22] + (size_t)l * LW * DM; const float* wo = A->in[23] + (size_t)l * DM * DM;
            const float* wg2 = A->in[25] + (size_t)l * DM * DFF; const float* wu2 = A->in[26] + (size_t)l * DM * DFF; const float* wd2 = A->in[27] + (size_t)l * DFF * DM;
            LAS float* scr = (LAS float*)(L + wave * 16384);
            for (int it = gw; it < NIT; it += ngw) {
                int r = it;
                if (r < I_G) { transpose_item<1>(wg1, DM, DFF, (bf16_t*)(ws + W_GU1), scr, r, lane); continue; } r -= I_G;
                if (r < I_G) { transpose_item<2>(wu1, DM, DFF, (bf16_t*)(ws + W_GU1), scr, r, lane); continue; } r -= I_G;
                if (r < I_D) { transpose_item<0>(wd1, DFF, DM, (bf16_t*)(ws + W_DN1), scr, r, lane); continue; } r -= I_D;
                if (r < I_IN) { transpose_item<3>(win, DM, NIN, (bf16_t*)(ws + W_IN), scr, r, lane); continue; } r -= I_IN;
                if (r < I_S) { transpose_item<0>(wba, DM, DM, (bf16_t*)(ws + W_BA), scr, r, lane); continue; } r -= I_S;
                if (r < I_L) { transpose_item<0>(wbl, LW, DM, (bf16_t*)(ws + W_BL), scr, r, lane); continue; } r -= I_L;
                if (r < I_S) { transpose_item<0>(wo, DM, DM, (bf16_t*)(ws + W_O), scr, r, lane); continue; } r -= I_S;
                if (r < I_G) { transpose_item<1>(wg2, DM, DFF, (bf16_t*)(ws + W_GU2), scr, r, lane); continue; } r -= I_G;
                if (r < I_G) { transpose_item<2>(wu2, DM, DFF, (bf16_t*)(ws + W_GU2), scr, r, lane); continue; } r -= I_G;
                transpose_item<0>(wd2, DFF, DM, (bf16_t*)(ws + W_DN2), scr, r, lane);
            }
            SEAM(pb + 0);
        }
        if (EN(1) && IN(pb + 1)) {
            PH_ARGS;
            pg8::Gemm g{HB, (const bf16_t*)(ws + W_GU1), MR, NGU, DM}; pg8::StaticOrder S; S.init(MR, NGU, G, bx);
            EpiSwiGLU E{HID, SSQ(3 * l)};
            pg8::gemm_phase<EpiSwiGLU, pg8::StaticOrder, true, true>(L, g, S, E);
            if (!NO_META) meta_gemm(L, HB + (size_t)MR * DM, g.Bt, NGU, DM, E);
            SEAM(pb + 1);
        }
        if (EN(2) && IN(pb + 2)) {
            PH_ARGS;
            pg8::Gemm g{HID, (const bf16_t*)(ws + W_DN1), MR, DM, DFF}; pg8::StaticOrder S; S.init(MR, DM, G, bx);
            EpiResid E{H, HB, A->in[6] + (size_t)l * DM, SSQ(3 * l + 1), 0.5f};
            pg8::gemm_phase<EpiResid, pg8::StaticOrder, true, true>(L, g, S, E);
            if (!NO_META) meta_gemm(L, HID + (size_t)MR * DFF, g.Bt, DM, DFF, E);
            SEAM(pb + 2);
        }
        if (EN(3) && IN(pb + 3)) {
            PH_ARGS;
            pg8::Gemm g{HB, (const bf16_t*)(ws + W_IN), MR, NIN, DM}; pg8::StaticOrder S; S.init(MR, NIN, G, bx);
            EpiWin E{Qb, Kb, Vb, XR, GY, GG, QM, A->in[8] + (size_t)l * 2 * DM, SSQ(3 * l + 1), ropec, ropes};
            pg8::gemm_phase<EpiWin, pg8::StaticOrder, true, true>(L, g, S, E);
            if (!NO_META) meta_gemm(L, HB + (size_t)MR * DM, g.Bt, NIN, DM, E);
            SEAM(pb + 3);
        }
        if (EN(4) && IN(pb + 4)) {
            PH_ARGS;
            if (EN(12)) for (int it = vcu; it < 256; it += G)
                lru_item(L, it, XR, GY, LO, A->in[14] + (size_t)l * 4 * LW, A->in[15] + (size_t)l * LW, A->in[16] + (size_t)l * 16 * 160 * 160, A->in[17] + (size_t)l * LW,
                         A->in[18] + (size_t)l * 16 * 160 * 160, A->in[19] + (size_t)l * LW, A->in[20] + (size_t)l * LW);
            if (EN(13)) attn_phase((char*)lds, Qb, Kb, Vb, OP, vcu, G);
            SEAM(pb + 4);
        }
        if (EN(5) && IN(pb + 5)) {
            PH_ARGS;
            const float lam = lam_of(A->in[9] + l * 128, A->in[10] + l * 128, A->in[11] + l * 128, A->in[12] + l * 128, lam_init, lane);
            combine_phase(OP, AO, QM, Kb, Vb, A->in[13] + l * 256, lam, lam_init, gw, ngw, lane);
            SEAM(pb + 5);
        }
        if (EN(6) && IN(pb + 6)) {
            PH_ARGS;
            pg8::StaticOrder S; S.init(MR, DM, G, bx);
            { pg8::Gemm g{AO, (const bf16_t*)(ws + W_BA), MR, DM, DM}; EpiBa E{TMP, GG};
              pg8::gemm_phase<EpiBa, pg8::StaticOrder, true, true>(L, g, S, E); if (!NO_META) meta_gemm(L, AO + (size_t)MR * DM, g.Bt, DM, DM, E); }
            { pg8::Gemm g{LO, (const bf16_t*)(ws + W_BL), MR, DM, LW}; EpiBl E{TMP, GG, MIX};
              pg8::gemm_phase<EpiBl, pg8::StaticOrder, true, true>(L, g, S, E); if (!NO_META) meta_gemm(L, LO + (size_t)MR * LW, g.Bt, DM, LW, E); }
            SEAM(pb + 6);
        }
        if (EN(7) && IN(pb + 7)) {
            PH_ARGS;
            pg8::Gemm g{MIX, (const bf16_t*)(ws + W_O), MR, DM, DM}; pg8::StaticOrder S; S.init(MR, DM, G, bx);
            EpiResid E{H, HB, A->in[24] + (size_t)l * DM, SSQ(3 * l + 2), 1.0f};
            pg8::gemm_phase<EpiResid, pg8::StaticOrder, true, true>(L, g, S, E);
            if (!NO_META) meta_gemm(L, MIX + (size_t)MR * DM, g.Bt, DM, DM, E);
            SEAM(pb + 7);
        }
        if (EN(8) && IN(pb + 8)) {
            PH_ARGS;
            pg8::Gemm g{HB, (const bf16_t*)(ws + W_GU2), MR, NGU, DM}; pg8::StaticOrder S; S.init(MR, NGU, G, bx);
            EpiSwiGLU E{HID, SSQ(3 * l + 2)};
            pg8::gemm_phase<EpiSwiGLU, pg8::StaticOrder, true, true>(L, g, S, E);
            if (!NO_META) meta_gemm(L, HB + (size_t)MR * DM, g.Bt, NGU, DM, E);
            SEAM(pb + 8);
        }
        if (EN(9) && IN(pb + 9)) {
            PH_ARGS;
            pg8::Gemm g{HID, (const bf16_t*)(ws + W_DN2), MR, DM, DFF}; pg8::StaticOrder S; S.init(MR, DM, G, bx);
            EpiResid E{H, HB, A->in[2] + (size_t)(l + 1 < DEPTH ? l + 1 : 0) * DM, SSQ(3 * l + 3), 0.5f};
            pg8::gemm_phase<EpiResid, pg8::StaticOrder, true, true>(L, g, S, E);
            if (!NO_META) meta_gemm(L, HID + (size_t)MR * DFF, g.Bt, DM, DFF, E);
            SEAM(pb + 9);
        }
    }
    if (EN(11) && IN(N_PHASES - 1)) {
        PH_ARGS;
        const float* gf = A->in[28];
        for (int m = gw; m < MR; m += ngw) {
            f32x4 v[8]; float ss = 0.f;
#pragma unroll
            for (int j = 0; j < 8; ++j) { v[j] = *(const f32x4*)(H + (size_t)m * DM + 4 * (64 * j + lane)); ss += v[j][0] * v[j][0] + v[j][1] * v[j][1] + v[j][2] * v[j][2] + v[j][3] * v[j][3]; }
            const float rs = rstd_from(wave_sum(ss));
#pragma unroll
            for (int j = 0; j < 8; ++j) { const int c = 4 * (64 * j + lane); *(f32x4*)(A->out + (size_t)m * DM + c) = v[j] * rs * *(const f32x4*)(gf + c); }
        }
    }
#undef IN
#undef SEAM
}

extern "C" void kernel_launch(void* const* d_in, const int* in_sizes, int n_in, void* d_out, int out_size, void* d_ws, size_t ws_size, hipStream_t stream) {
    static int grid = 0;
    if (grid == 0) {
        if (n_in != 29 || in_sizes[0] != MR * DM || out_size != MR * DM || ws_size < WS_END) { fprintf(stderr, "kernel_launch: unexpected shapes (n_in %d, ws %zu < %zu?); nothing launched\n", n_in, ws_size, (size_t)WS_END); grid = -1; return; }
        int dev = 0, cus = 0, per_cu = 0;
        if (hipGetDevice(&dev) != hipSuccess || hipDeviceGetAttribute(&cus, hipDeviceAttributeMultiprocessorCount, dev) != hipSuccess) { grid = -1; return; }
        if (hipFuncSetAttribute((const void*)mk_fwd, hipFuncAttributeMaxDynamicSharedMemorySize, LDS_BYTES) != hipSuccess) { fprintf(stderr, "kernel_launch: hipFuncSetAttribute failed\n"); grid = -1; return; }
        if (hipOccupancyMaxActiveBlocksPerMultiprocessor(&per_cu, (const void*)mk_fwd, NWAVES * 64, LDS_BYTES) != hipSuccess || per_cu < 1) { fprintf(stderr, "kernel_launch: occupancy query says %d\n", per_cu); }
        (void)hipGetLastError();
        grid = cus;
    }
    if (grid < 0) return;
    if (hipMemsetAsync((char*)d_ws + WS_CTL, 0, CTL_ZERO_BYTES, stream) != hipSuccess) return;
    Args a{};
    for (int i = 0; i < 29; ++i) a.in[i] = (const float*)d_in[i];
    a.out = (float*)d_out; a.ws = (unsigned char*)d_ws;
    for (int i = 0; i < 16; ++i) a.invf[i] = (float)pow(500000.0, -(double)i / 16.0);
#if MK_MULTI
    for (int p = 0; p < N_PHASES; ++p) { a.ph_lo = p; a.ph_hi = p + 1; hipLaunchKernelGGL(mk_fwd, dim3(grid), dim3(NWAVES * 64), LDS_BYTES, stream, a); }
#else
    a.ph_lo = 0; a.ph_hi = N_PHASES;
    hipLaunchKernelGGL(mk_fwd, dim3(grid), dim3(NWAVES * 64), LDS_BYTES, stream, a);
#endif
    const hipError_t le = hipPeekAtLastError();
    if (le != hipSuccess) fprintf(stderr, "kernel_launch: launch failed: %s\n", hipGetErrorName(le));
}
```

```cpp
#include <hip/hip_runtime.h>
#include <cstdio>
#include <cstdint>
#include <cmath>
__device__ __forceinline__ int tid_fresh() { int t = threadIdx.x; asm volatile("" : "+v"(t)); return t; }
namespace pg8 {
#define PG8_LAS __attribute__((address_space(3)))
typedef unsigned short bf16_t;
typedef short bf16x8 __attribute__((ext_vector_type(8)));
typedef float f32x4 __attribute__((ext_vector_type(4)));
typedef unsigned u32x4 __attribute__((ext_vector_type(4)));
constexpr int BM = 256, BK = 64, HALF = 128, HTB = HALF * BK * 2  , STAGE_BYTES = 8 * HTB, NXCD = 8, WGM = 8;

__host__ __device__ __forceinline__ int lds_byte(int r, int c) { const int st = (r >> 4) * 2 + (c >> 5), rr = r & 15, cc = c & 31, ob = rr * 64 + cc * 2; return st * 1024 + (ob ^ (((ob >> 9) & 1) << 5)); }
__host__ __device__ __forceinline__ void stage_rc(int b, int& R, int& C) { const int st = b / 1024, sb = b % 1024, swz = sb ^ (((sb >> 9) & 1) << 5); R = (st >> 1) * 16 + swz / 64; C = (st & 1) * 32 + (swz % 64) / 2; }
__host__ __device__ __forceinline__ int perm32(int rho) { const int n = rho >> 4, i = rho & 15; return 8 * (i >> 2) + 4 * n + (i & 3); }

struct Unit { int pm, pn; };
struct Gemm { const bf16_t* A; const bf16_t* Bt; int M, N, K; };

struct StaticOrder {
    int nM, nN, nwg, G, c;
    __host__ __device__ void init(int M, int N, int G_, int c_) { nM = M / BM; nN = N / BM; nwg = nM * nN; G = G_; c = c_; }
    __host__ __device__ bool next(int i, Unit& u) const {
        const long L = (long)i * G + c; if (L >= nwg) return false;
        int wgid = (int)L; { const int q = nwg / NXCD, r = nwg % NXCD, xcd = wgid % NXCD, off = wgid / NXCD; wgid = (xcd < r ? xcd * (q + 1) : r * (q + 1) + (xcd - r) * q) + off; }
        const int nig = WGM * nN, gid = wgid / nig, fm = gid * WGM, gsz = (nM - fm) < WGM ? (nM - fm) : WGM;
        u.pm = fm + ((wgid % nig) % gsz); u.pn = (wgid % nig) / gsz; return true;
    }
    __device__ __forceinline__ void a_ready(const Unit&) const {}
    __device__ __forceinline__ void done(const Unit&) const {}
};

__device__ __forceinline__ unsigned cvt_pk_bf16(float lo, float hi) { unsigned r; asm volatile("v_cvt_pk_bf16_f32 %0, %1, %2" : "=v"(r) : "v"(lo), "v"(hi)); return r; }
typedef float f32x2 __attribute__((ext_vector_type(2)));
template <class Epi, class Sched, bool ALIGN_EPI = false, bool SP2 = false>
__device__ __forceinline__ void gemm_phase(PG8_LAS unsigned char* lds, const Gemm g, const Sched& S, const Epi& E) {
    const int tid = tid_fresh(), wid = __builtin_amdgcn_readfirstlane(tid >> 6), lane = tid & 63, wr = wid >> 2, wc = wid & 3, fr = lane & 15, fq = lane >> 4;
    const int K = g.K, nt = K / BK;
    unsigned voffA[2], voffB[2];
#pragma unroll
    for (int i = 0; i < 2; ++i) { int R, C; stage_rc(tid * 16 + i * 8192, R, C); const int Rb = Epi::PERM ? ((R & ~31) + perm32(R & 31)) : R;
        voffA[i] = (unsigned)(R * K + C) * 2u; voffB[i] = (unsigned)(Rb * K + C) * 2u; }
    const size_t kstep = (size_t)(BK * 2);
    const size_t hstep = (size_t)HALF * K * 2;
    const size_t tstep = 2 * hstep;
    const unsigned ldsw = (unsigned)wid * 1024u;
    const int aoff = lds_byte(wr * 64 + fr, fq * 8), boff = lds_byte(wc * 32 + fr, fq * 8);
#define PG8_SA(b, h) (((b) * 2 + (h)) * HTB)
#define PG8_SB(b, h) ((4 + (b) * 2 + (h)) * HTB)
#define PG8_STAGE(bufoff, gbase, voff) do { _Pragma("unroll") for (int _i = 0; _i < 2; ++_i) \
        __builtin_amdgcn_global_load_lds((const unsigned*)((const char*)(gbase) + (voff)[_i]), (PG8_LAS unsigned*)(lds + (bufoff) + ldsw + _i * 8192), 16, 0, 0); } while (0)
#define PG8_LDA(dst, b, h) do { _Pragma("unroll") for (int m = 0; m < 4; ++m) _Pragma("unroll") for (int k = 0; k < 2; ++k) dst[m][k] = *(const PG8_LAS bf16x8*)(lds + PG8_SA(b, h) + aoff + m * 2048 + k * 1024); } while (0)
#define PG8_LDB(dst, b, h) do { _Pragma("unroll") for (int n = 0; n < 2; ++n) _Pragma("unroll") for (int k = 0; k < 2; ++k) dst[n][k] = *(const PG8_LAS bf16x8*)(lds + PG8_SB(b, h) + boff + n * 2048 + k * 1024); } while (0)
#define PG8_MMA(ai, bj, At, Bt) do { __builtin_amdgcn_s_setprio(1); _Pragma("unroll") for (int m = 0; m < 4; ++m) _Pragma("unroll") for (int n = 0; n < 2; ++n) _Pragma("unroll") for (int k = 0; k < 2; ++k) \
        acc[ai][bj][m][n] = __builtin_amdgcn_mfma_f32_16x16x32_bf16(Bt[n][k], At[m][k], acc[ai][bj][m][n], 0, 0, 0); __builtin_amdgcn_s_setprio(0); } while (0)
#define PG8_WAIT_V(n) asm volatile("s_waitcnt vmcnt(" #n ")" ::: "memory")
#define PG8_WAIT_L(n) asm volatile("s_waitcnt lgkmcnt(" #n ")" ::: "memory")
#define PG8_BAR __builtin_amdgcn_s_barrier()
#define PG8_SCHED __builtin_amdgcn_sched_barrier(0)
    Unit cur, nxt; int ui = 0;
    if (!S.next(0, cur)) return;
    f32x4 acc[2][2][4][2];
#pragma unroll
    for (int a = 0; a < 2; ++a)
#pragma unroll
        for (int b = 0; b < 2; ++b)
#pragma unroll
            for (int m = 0; m < 4; ++m)
#pragma unroll
                for (int n = 0; n < 2; ++n) acc[a][b][m][n] = (f32x4){0.f, 0.f, 0.f, 0.f};
    bf16x8 At[4][2], B0[2][2], B1[2][2];
    const char* cA = (const char*)g.A + (size_t)cur.pm * tstep; const char* cB = (const char*)g.Bt + (size_t)cur.pn * tstep;
    S.a_ready(cur);
    if constexpr (SP2) {
        PG8_STAGE(PG8_SB(0, 0), cB, voffB); PG8_STAGE(PG8_SB(0, 1), cB + hstep, voffB); PG8_STAGE(PG8_SA(0, 0), cA, voffA); PG8_STAGE(PG8_SA(0, 1), cA + hstep, voffA);
        if (wr == 1) PG8_BAR;
        PG8_WAIT_V(2); PG8_BAR;
        PG8_STAGE(PG8_SB(1, 0), cB + kstep, voffB); PG8_STAGE(PG8_SA(1, 0), cA + kstep, voffA); PG8_STAGE(PG8_SB(1, 1), cB + hstep + kstep, voffB);
        PG8_WAIT_V(6); PG8_BAR;
    } else {
        PG8_STAGE(PG8_SB(0, 0), cB, voffB); PG8_STAGE(PG8_SA(0, 0), cA, voffA); PG8_STAGE(PG8_SB(0, 1), cB + hstep, voffB); PG8_STAGE(PG8_SA(0, 1), cA + hstep, voffA);
        if (wr == 1) PG8_BAR;
        PG8_WAIT_V(4); PG8_BAR;
        PG8_STAGE(PG8_SB(1, 0), cB + kstep, voffB); PG8_STAGE(PG8_SA(1, 0), cA + kstep, voffA); PG8_STAGE(PG8_SB(1, 1), cB + hstep + kstep, voffB);
        PG8_WAIT_V(6); PG8_BAR;
    }
    for (;;) {
        const bool has_next = S.next(ui + 1, nxt);
        const char* nA = has_next ? (const char*)g.A + (size_t)nxt.pm * tstep : cA; const char* nB = has_next ? (const char*)g.Bt + (size_t)nxt.pn * tstep : cB;
        for (int t = 0; t < nt; t += 2) {
            const bool last = (t == nt - 2);
            const char* a1 = cA + (size_t)(t + 1) * kstep;
            const char* a2 = last ? nA : cA + (size_t)(t + 2) * kstep; const char* b2 = last ? nB : cB + (size_t)(t + 2) * kstep;
            const char* a3 = a2 + kstep; const char* b3 = b2 + kstep;
            if (last && has_next) S.a_ready(nxt);
            if constexpr (SP2) {
            PG8_LDB(B0, 0, 0); PG8_LDB(B1, 0, 1); PG8_SCHED; PG8_LDA(At, 0, 0); PG8_STAGE(PG8_SA(1, 1), a1 + hstep, voffA);
            PG8_WAIT_V(8); PG8_WAIT_L(0); PG8_BAR; PG8_MMA(0, 0, At, B0); PG8_MMA(0, 1, At, B1); PG8_BAR; PG8_SCHED;
            PG8_LDA(At, 0, 1); PG8_STAGE(PG8_SB(0, 0), b2, voffB); PG8_STAGE(PG8_SB(0, 1), b2 + hstep, voffB); PG8_STAGE(PG8_SA(0, 0), a2, voffA);
            PG8_WAIT_V(8); PG8_WAIT_L(0); PG8_BAR; PG8_MMA(1, 0, At, B0); PG8_MMA(1, 1, At, B1); PG8_BAR; PG8_SCHED;
            PG8_LDB(B0, 1, 0); PG8_LDB(B1, 1, 1); PG8_SCHED; PG8_LDA(At, 1, 0); PG8_STAGE(PG8_SA(0, 1), a2 + hstep, voffA);
            PG8_WAIT_V(8); PG8_WAIT_L(0); PG8_BAR; PG8_MMA(0, 0, At, B0); PG8_MMA(0, 1, At, B1); PG8_BAR; PG8_SCHED;
            PG8_LDA(At, 1, 1); PG8_STAGE(PG8_SB(1, 0), b3, voffB); PG8_STAGE(PG8_SB(1, 1), b3 + hstep, voffB); PG8_STAGE(PG8_SA(1, 0), a3, voffA);
            PG8_WAIT_V(8); PG8_WAIT_L(0); PG8_BAR; PG8_MMA(1, 0, At, B0); PG8_MMA(1, 1, At, B1); PG8_BAR; PG8_SCHED;
            } else {
            PG8_LDB(B0, 0, 0); PG8_SCHED; PG8_LDA(At, 0, 0); PG8_STAGE(PG8_SA(1, 1), a1 + hstep, voffA);
            PG8_WAIT_L(8); PG8_BAR; PG8_WAIT_L(0); PG8_MMA(0, 0, At, B0); PG8_BAR; PG8_SCHED;
            PG8_LDB(B1, 0, 1); PG8_STAGE(PG8_SB(0, 0), b2, voffB);
            PG8_BAR; PG8_WAIT_L(0); PG8_MMA(0, 1, At, B1); PG8_BAR;
            PG8_LDA(At, 0, 1); PG8_STAGE(PG8_SA(0, 0), a2, voffA);
            PG8_BAR; PG8_WAIT_L(0); PG8_MMA(1, 0, At, B0); PG8_BAR; PG8_SCHED;
            PG8_STAGE(PG8_SB(0, 1), b2 + hstep, voffB);
            PG8_WAIT_V(6); PG8_BAR; PG8_MMA(1, 1, At, B1); PG8_BAR;
            PG8_LDB(B0, 1, 0); PG8_SCHED; PG8_LDA(At, 1, 0); PG8_STAGE(PG8_SA(0, 1), a2 + hstep, voffA);
            PG8_WAIT_L(8); PG8_BAR; PG8_WAIT_L(0); PG8_MMA(0, 0, At, B0); PG8_BAR; PG8_SCHED;
            PG8_LDB(B1, 1, 1); PG8_STAGE(PG8_SB(1, 0), b3, voffB);
            PG8_BAR; PG8_WAIT_L(0); PG8_MMA(0, 1, At, B1); PG8_BAR;
            PG8_LDA(At, 1, 1); PG8_STAGE(PG8_SA(1, 0), a3, voffA);
            PG8_BAR; PG8_WAIT_L(0); PG8_MMA(1, 0, At, B0); PG8_BAR; PG8_SCHED;
            PG8_STAGE(PG8_SB(1, 1), b3 + hstep, voffB);
            PG8_WAIT_V(6); PG8_BAR; PG8_MMA(1, 1, At, B1); PG8_BAR;
            }
        }
        if constexpr (ALIGN_EPI) { if (wr == 0) PG8_BAR; }
        if constexpr (!Epi::AFTER_DRAIN) { E(acc, cur, wr, wc, fr, fq); S.done(cur); }
        if (!has_next) break;
#pragma unroll
        for (int a = 0; a < 2; ++a)
#pragma unroll
            for (int b = 0; b < 2; ++b)
#pragma unroll
                for (int m = 0; m < 4; ++m)
#pragma unroll
                    for (int n = 0; n < 2; ++n) acc[a][b][m][n] = (f32x4){0.f, 0.f, 0.f, 0.f};
        cur = nxt; cA = nA; cB = nB; ++ui;
        if constexpr (ALIGN_EPI) { if (wr == 1) PG8_BAR; }
    }
    PG8_WAIT_V(0);
    if constexpr (!ALIGN_EPI) { if (wr == 0) PG8_BAR; }
    PG8_BAR;
    if constexpr (Epi::AFTER_DRAIN) { E.fused(acc, cur, wr, wc, fr, fq, lds, wid, lane); S.done(cur); }
#undef PG8_SA
#undef PG8_SB
#undef PG8_STAGE
#undef PG8_LDA
#undef PG8_LDB
#undef PG8_MMA
#undef PG8_WAIT_V
#undef PG8_WAIT_L
#undef PG8_BAR
#undef PG8_SCHED
}
}
namespace pg8 {
template <class Epi, class Sched>
__device__ __forceinline__ void gemm_dual_phase(PG8_LAS unsigned char* lds, const bf16_t* A0, const bf16_t* Bt0, int K0, const bf16_t* A1, const bf16_t* Bt1, int K1, const Sched& S, const Epi& E) {
    const int tid = tid_fresh(), wid = __builtin_amdgcn_readfirstlane(tid >> 6), lane = tid & 63, wr = wid >> 2, wc = wid & 3, fr = lane & 15, fq = lane >> 4;
    unsigned vA0_0, vA0_1, vB0_0, vB0_1, vA1_0, vA1_1, vB1_0, vB1_1;
    { int R, C; stage_rc(tid * 16, R, C); const int Rb = (R & ~31) + perm32(R & 31);
      vA0_0 = (unsigned)(R * K0 + C) * 2u; vB0_0 = (unsigned)(Rb * K0 + C) * 2u; vA1_0 = (unsigned)(R * K1 + C) * 2u; vB1_0 = (unsigned)(Rb * K1 + C) * 2u; }
    { int R, C; stage_rc(tid * 16 + 8192, R, C); const int Rb = (R & ~31) + perm32(R & 31);
      vA0_1 = (unsigned)(R * K0 + C) * 2u; vB0_1 = (unsigned)(Rb * K0 + C) * 2u; vA1_1 = (unsigned)(R * K1 + C) * 2u; vB1_1 = (unsigned)(Rb * K1 + C) * 2u; }
    const size_t kstep = (size_t)(BK * 2);
    const size_t hst0 = (size_t)HALF * K0 * 2, hst1 = (size_t)HALF * K1 * 2;
    const unsigned ldsw = (unsigned)wid * 1024u;
    const int aoff = lds_byte(wr * 64 + fr, fq * 8), boff = lds_byte(wc * 32 + fr, fq * 8);
#define PG8_SA(b, h) (((b) * 2 + (h)) * HTB)
#define PG8_SB(b, h) ((4 + (b) * 2 + (h)) * HTB)
#define PG8_STAGE2(bufoff, gbase, v0, v1) do { \
        __builtin_amdgcn_global_load_lds((const unsigned*)((const char*)(gbase) + (v0)), (PG8_LAS unsigned*)(lds + (bufoff) + ldsw), 16, 0, 0); \
        __builtin_amdgcn_global_load_lds((const unsigned*)((const char*)(gbase) + (v1)), (PG8_LAS unsigned*)(lds + (bufoff) + ldsw + 8192), 16, 0, 0); } while (0)
#define PG8_LDA(dst, b, h) do { _Pragma("unroll") for (int m = 0; m < 4; ++m) _Pragma("unroll") for (int k = 0; k < 2; ++k) dst[m][k] = *(const PG8_LAS bf16x8*)(lds + PG8_SA(b, h) + aoff + m * 2048 + k * 1024); } while (0)
#define PG8_LDB(dst, b, h) do { _Pragma("unroll") for (int n = 0; n < 2; ++n) _Pragma("unroll") for (int k = 0; k < 2; ++k) dst[n][k] = *(const PG8_LAS bf16x8*)(lds + PG8_SB(b, h) + boff + n * 2048 + k * 1024); } while (0)
#define PG8_MMA(ai, bj, At, Bt) do { __builtin_amdgcn_s_setprio(1); _Pragma("unroll") for (int m = 0; m < 4; ++m) _Pragma("unroll") for (int n = 0; n < 2; ++n) _Pragma("unroll") for (int k = 0; k < 2; ++k) \
        acc[ai][bj][m][n] = __builtin_amdgcn_mfma_f32_16x16x32_bf16(Bt[n][k], At[m][k], acc[ai][bj][m][n], 0, 0, 0); __builtin_amdgcn_s_setprio(0); } while (0)
#define PG8_WAIT_V(n) asm volatile("s_waitcnt vmcnt(" #n ")" ::: "memory")
#define PG8_WAIT_L(n) asm volatile("s_waitcnt lgkmcnt(" #n ")" ::: "memory")
#define PG8_BAR __builtin_amdgcn_s_barrier()
#define PG8_SCHED __builtin_amdgcn_sched_barrier(0)
    Unit cur, nxt; int ui = 0;
    if (!S.next(0, cur)) return;
    f32x4 acc[2][2][4][2];
#pragma unroll
    for (int a = 0; a < 2; ++a)
#pragma unroll
        for (int b = 0; b < 2; ++b)
#pragma unroll
            for (int m = 0; m < 4; ++m)
#pragma unroll
                for (int n = 0; n < 2; ++n) acc[a][b][m][n] = (f32x4){0.f, 0.f, 0.f, 0.f};
    bf16x8 At[4][2], B0[2][2], B1[2][2];
    int ty = 0;
    const char* cA = (const char*)A0 + (size_t)cur.pm * (2 * hst0); const char* cB = (const char*)Bt0 + (size_t)cur.pn * (2 * hst0);
    PG8_STAGE2(PG8_SB(0, 0), cB, vB0_0, vB0_1); PG8_STAGE2(PG8_SB(0, 1), cB + hst0, vB0_0, vB0_1); PG8_STAGE2(PG8_SA(0, 0), cA, vA0_0, vA0_1); PG8_STAGE2(PG8_SA(0, 1), cA + hst0, vA0_0, vA0_1);
    if (wr == 1) PG8_BAR;
    PG8_WAIT_V(2); PG8_BAR;
    PG8_STAGE2(PG8_SB(1, 0), cB + kstep, vB0_0, vB0_1); PG8_STAGE2(PG8_SA(1, 0), cA + kstep, vA0_0, vA0_1); PG8_STAGE2(PG8_SB(1, 1), cB + hst0 + kstep, vB0_0, vB0_1);
    PG8_WAIT_V(6); PG8_BAR;
    for (;;) {
        const bool has_next = (ty == 0) ? true : S.next(ui + 1, nxt);
        const int pty = has_next ? (ty ^ 1) : ty;
        const int npm = (ty == 0) ? cur.pm : nxt.pm, npn = (ty == 0) ? cur.pn : nxt.pn;
        const size_t hsc = ty ? hst1 : hst0, hsn = pty ? hst1 : hst0;
        const char* nA = has_next ? (const char*)(pty ? A1 : A0) + (size_t)npm * (2 * hsn) : cA;
        const char* nB = has_next ? (const char*)(pty ? Bt1 : Bt0) + (size_t)npn * (2 * hsn) : cB;
        const unsigned vAc0 = ty ? vA1_0 : vA0_0, vAc1 = ty ? vA1_1 : vA0_1, vBc0 = ty ? vB1_0 : vB0_0, vBc1 = ty ? vB1_1 : vB0_1;
        const unsigned vAn0 = pty ? vA1_0 : vA0_0, vAn1 = pty ? vA1_1 : vA0_1, vBn0 = pty ? vB1_0 : vB0_0, vBn1 = pty ? vB1_1 : vB0_1;
        const int nt = (ty ? K1 : K0) / BK;
        for (int t = 0; t < nt; t += 2) {
            const bool last = (t == nt - 2);
            const char* a1 = cA + (size_t)(t + 1) * kstep;
            const char* a2 = last ? nA : cA + (size_t)(t + 2) * kstep; const char* b2 = last ? nB : cB + (size_t)(t + 2) * kstep;
            const char* a3 = a2 + kstep; const char* b3 = b2 + kstep;
            const size_t hs2 = last ? hsn : hsc;
            const unsigned wA0 = last ? vAn0 : vAc0, wA1 = last ? vAn1 : vAc1, wB0 = last ? vBn0 : vBc0, wB1 = last ? vBn1 : vBc1;
            PG8_LDB(B0, 0, 0); PG8_LDB(B1, 0, 1); PG8_SCHED; PG8_LDA(At, 0, 0); PG8_STAGE2(PG8_SA(1, 1), a1 + hsc, vAc0, vAc1);
            PG8_WAIT_V(8); PG8_WAIT_L(0); PG8_BAR; PG8_MMA(0, 0, At, B0); PG8_MMA(0, 1, At, B1); PG8_BAR; PG8_SCHED;
            PG8_LDA(At, 0, 1); PG8_STAGE2(PG8_SB(0, 0), b2, wB0, wB1); PG8_STAGE2(PG8_SB(0, 1), b2 + hs2, wB0, wB1); PG8_STAGE2(PG8_SA(0, 0), a2, wA0, wA1);
            PG8_WAIT_V(8); PG8_WAIT_L(0); PG8_BAR; PG8_MMA(1, 0, At, B0); PG8_MMA(1, 1, At, B1); PG8_BAR; PG8_SCHED;
            PG8_LDB(B0, 1, 0); PG8_LDB(B1, 1, 1); PG8_SCHED; PG8_LDA(At, 1, 0); PG8_STAGE2(PG8_SA(0, 1), a2 + hs2, wA0, wA1);
            PG8_WAIT_V(8); PG8_WAIT_L(0); PG8_BAR; PG8_MMA(0, 0, At, B0); PG8_MMA(0, 1, At, B1); PG8_BAR; PG8_SCHED;
            PG8_LDA(At, 1, 1); PG8_STAGE2(PG8_SB(1, 0), b3, wB0, wB1); PG8_STAGE2(PG8_SB(1, 1), b3 + hs2, wB0, wB1); PG8_STAGE2(PG8_SA(1, 0), a3, wA0, wA1);
            PG8_WAIT_V(8); PG8_WAIT_L(0); PG8_BAR; PG8_MMA(1, 0, At, B0); PG8_MMA(1, 1, At, B1); PG8_BAR; PG8_SCHED;
        }
        if (wr == 0) PG8_BAR;
        if (ty == 0) E.mid(acc, cur, wr, wc, fr, fq); else E(acc, cur, wr, wc, fr, fq);
        if (!has_next) break;
        if (ty == 1) {
#pragma unroll
            for (int a = 0; a < 2; ++a)
#pragma unroll
                for (int b = 0; b < 2; ++b)
#pragma unroll
                    for (int m = 0; m < 4; ++m)
#pragma unroll
                        for (int n = 0; n < 2; ++n) acc[a][b][m][n] = (f32x4){0.f, 0.f, 0.f, 0.f};
            cur = nxt; ++ui;
        }
        ty ^= 1; cA = nA; cB = nB;
        if (wr == 1) PG8_BAR;
    }
    PG8_WAIT_V(0);
    PG8_BAR;
#undef PG8_SA
#undef PG8_SB
#undef PG8_STAGE2
#undef PG8_LDA
#undef PG8_LDB
#undef PG8_MMA
#undef PG8_WAIT_V
#undef PG8_WAIT_L
#undef PG8_BAR
#undef PG8_SCHED
}
}

#define GAS __attribute__((address_space(1)))
#define LAS __attribute__((address_space(3)))
typedef unsigned short bf16;
typedef unsigned v4u __attribute__((ext_vector_type(4)));
typedef float f32x4 __attribute__((ext_vector_type(4)));
typedef short bf16x8 __attribute__((ext_vector_type(8)));
typedef GAS unsigned gu32;
typedef GAS unsigned long long gu64;
#define RLX_AGENT __ATOMIC_RELAXED, __HIP_MEMORY_SCOPE_AGENT
#define LDS_WAIT() asm volatile("s_waitcnt lgkmcnt(0)" ::: "memory")
#define VM_WAIT() asm volatile("s_waitcnt vmcnt(0)" ::: "memory")
__device__ __forceinline__ unsigned long long rt() { return __builtin_amdgcn_s_memrealtime(); }
__device__ __forceinline__ unsigned f2bf(float f) { unsigned u = __builtin_bit_cast(unsigned, f); return (u + 0x7fffu + ((u >> 16) & 1u)) >> 16; }
__device__ __forceinline__ unsigned pk2(float lo, float hi) { return f2bf(lo) | (f2bf(hi) << 16); }

#define XB_TMO      128
#define XB_XCNT(j)  (256  + 64 * (j))
#define XB_XSUB(j)  (1280 + 64 * (j))
#define XB_XGEN(j)  (2304 + 64 * (j))
#define XB_TOP      3328
#define XB_TOPGEN   3392
#define XCD_BAR_WORDS 3456
#define XB_SPIN_CAP (1u << 18)

__device__ __forceinline__ unsigned xb_ld(unsigned* p)              { return __hip_atomic_load(p, __ATOMIC_RELAXED, __HIP_MEMORY_SCOPE_AGENT); }
__device__ __forceinline__ unsigned xb_add(unsigned* p, unsigned v) { return __hip_atomic_fetch_add(p, v, __ATOMIC_RELAXED, __HIP_MEMORY_SCOPE_AGENT); }
__device__ __forceinline__ unsigned xb_xcc_id() { return (unsigned)__builtin_amdgcn_s_getreg((3 << 11) | 20) & 0xFu; }
#define XB_SPIN(cond, bar) do { unsigned _sp = 0; while (cond) { __builtin_amdgcn_s_sleep(1); \
    if ((++_sp & 255u) == 0u) { if (xb_ld(&(bar)[XB_TMO])) break; if (_sp > XB_SPIN_CAP) { atomicAdd(&(bar)[XB_TMO], 1u); break; } } } } while (0)

struct XcdBarrier {
    unsigned* bar; unsigned x;
    volatile LAS unsigned* st;
};

__device__ __forceinline__ XcdBarrier xcd_barrier_post(unsigned* bar, volatile LAS unsigned* st) {
    XcdBarrier b; b.bar = bar; b.x = xb_xcc_id(); b.st = st;
    if (threadIdx.x == 0) (void)xb_add(&bar[XB_XCNT(b.x)], 1u);
    return b;
}
__device__ __forceinline__ void xcd_barrier_complete(unsigned* bar, unsigned x, unsigned& nloc, unsigned& nx) {
    const unsigned G = gridDim.x * gridDim.y * gridDim.z;
    unsigned sum, cnt, mine, sp = 0u;
    for (;;) {
        sum = 0u; cnt = 0u; mine = 0u;
#pragma unroll
        for (unsigned j = 0; j < 16; ++j) { const unsigned c = xb_ld(&bar[XB_XCNT(j)]); sum += c; cnt += (c > 0u) ? 1u : 0u; mine = (j == x) ? c : mine; }
        if (sum == G) break;
        __builtin_amdgcn_s_sleep(1);
        if ((++sp & 255u) == 0u) { if (xb_ld(&bar[XB_TMO])) break; if (sp > XB_SPIN_CAP) { atomicAdd(&bar[XB_TMO], 1u); break; } }
    }
    nloc = mine > 0u ? mine : 1u; nx = cnt > 0u ? cnt : 1u;
}

__device__ __forceinline__ void xcd_barrier(const XcdBarrier& b) {
    asm volatile("s_waitcnt vmcnt(0)" ::: "memory");
    __syncthreads();
    if (threadIdx.x == 0) {
        unsigned* bar = b.bar;
        __builtin_amdgcn_s_waitcnt(0);
        unsigned nloc = b.st[0], nx = b.st[1];
        if (nloc == 0u) { xcd_barrier_complete(bar, b.x, nloc, nx); b.st[0] = nloc; b.st[1] = nx; }
        const unsigned old = xb_add(&bar[XB_XSUB(b.x)], 1u);
        const unsigned gen = old / nloc;
        if (old + 1u == (gen + 1u) * nloc) {
            __builtin_amdgcn_fence(__ATOMIC_RELEASE, "agent");
            asm volatile("s_waitcnt vmcnt(0)" ::: "memory");
            const unsigned og = xb_add(&bar[XB_TOP], 1u);
            const unsigned tg = og / nx;
            if (og + 1u == (tg + 1u) * nx) xb_add(&bar[XB_TOPGEN], 1u);
            else XB_SPIN(xb_ld(&bar[XB_TOPGEN]) == tg, bar);
            __builtin_amdgcn_fence(__ATOMIC_ACQUIRE, "agent");
            xb_add(&bar[XB_XGEN(b.x)], 1u);
            asm volatile("s_waitcnt vmcnt(0)" ::: "memory");
        } else {
            XB_SPIN(xb_ld(&bar[XB_XGEN(b.x)]) == gen, bar);
            __builtin_amdgcn_fence(__ATOMIC_ACQUIRE, "agent");
            asm volatile("s_waitcnt vmcnt(0)" ::: "memory");
        }
    }
    __syncthreads();
}

namespace att {
constexpr int D = 128;
constexpr float THR = 8.f;
constexpr bool WSKIP = false;
constexpr float SCALE = 0.08838834764831845f;
constexpr int NW = 8, QBLK = 32, KVBLK = 64, QB = NW * QBLK;
constexpr int SHM_V = KVBLK * D * 2, SHM_K = KVBLK * D * 2;
constexpr int LDS_BYTES = 2 * SHM_V + 2 * SHM_K + NW * 64 * 4;
typedef short bf16x8 __attribute__((ext_vector_type(8)));
typedef short s16x4 __attribute__((ext_vector_type(4)));
typedef float f32x16 __attribute__((ext_vector_type(16)));
typedef float f32x4 __attribute__((ext_vector_type(4)));
typedef unsigned u32x4 __attribute__((ext_vector_type(4)));
template <class A, class Bt> struct same_t { static constexpr bool v = false; };
template <class A> struct same_t<A, A> { static constexpr bool v = true; };

#define KSWZ(row, colB) ((row) * 256 + ((colB) ^ (((row) & 7) << 4)))
#define SBAR() __builtin_amdgcn_sched_barrier(0)
__device__ __forceinline__ int v_st(int k, int c) { const int kk = (k & ~0xC) | ((k & 4) << 1) | ((k & 8) >> 1); return ((kk >> 3) * 4 + (c >> 5)) * 512 + ((kk & 7) * 32 + (c & 31)) * 2; }
__device__ __forceinline__ int v_rd_base(int lane) { return ((lane & 3) << 3) | (((lane >> 2) & 3) << 6) | (((lane >> 4) & 1) << 5) | (((lane >> 5) & 1) << 8); }
constexpr int v_rd_off(int d0, int ks, int half) { return d0 * 512 + ks * 4096 + half * 2048; }
__device__ __forceinline__ int crow(int r, int hi) { return (r & 3) + 8 * (r >> 2) + 4 * hi; }
__device__ __forceinline__ unsigned cvtpk(float lo, float hi) {
    unsigned r; asm volatile("v_cvt_pk_bf16_f32 %0, %1, %2" : "=v"(r) : "v"(lo), "v"(hi)); return r;
}
__device__ __forceinline__ bf16x8 pack8(f32x4 a, f32x4 b) {
    u32x4 w = {cvtpk(a[0], a[1]), cvtpk(a[2], a[3]), cvtpk(b[0], b[1]), cvtpk(b[2], b[3])};
    return *reinterpret_cast<bf16x8*>(&w);
}
template <class T> __device__ __forceinline__ bf16x8 load8(const T* p) {
    if constexpr (same_t<T, float>::v) { return pack8(*(const f32x4*)p, *(const f32x4*)(p + 4)); }
    else { return *reinterpret_cast<const bf16x8*>(p); }
}
__device__ __forceinline__ void mask_tile(f32x16& p0, f32x16& p1, int dq, unsigned W) {
    const float NEG = -__builtin_inff();
#pragma unroll
    for (int r = 0; r < 16; ++r) {
        const int c = (r & 3) + 8 * (r >> 2);
        if ((unsigned)(dq - c) >= W) p0[r] = NEG;
        if ((unsigned)(dq - c - 32) >= W) p1[r] = NEG;
    }
}
__device__ __forceinline__ void partialSM(f32x16& p0, f32x16& p1, float& m_reg, float& mn, float& alpha) {
    float pmax = p0[0]; for (int r = 1; r < 16; ++r) pmax = fmaxf(pmax, p0[r]); for (int r = 0; r < 16; ++r) pmax = fmaxf(pmax, p1[r]);
    { auto rr = __builtin_amdgcn_permlane32_swap(__float_as_uint(pmax), __float_as_uint(pmax), false, false);
      pmax = fmaxf(__uint_as_float(rr[0]), __uint_as_float(rr[1])); }
    constexpr float C2 = 1.4426950408889634f * SCALE;
    if (__builtin_expect(__all((pmax - m_reg) * SCALE <= THR), 1)) { mn = m_reg; alpha = 1.f; }
    else { mn = fmaxf(m_reg, pmax); alpha = __builtin_amdgcn_exp2f((m_reg - mn) * C2); m_reg = mn; }
    const float mnL = -mn * C2;
    for (int r = 0; r < 16; ++r) p0[r] = fmaf(p0[r], C2, mnL); for (int r = 0; r < 16; ++r) p1[r] = fmaf(p1[r], C2, mnL);
    for (int r = 0; r < 16; ++r) p0[r] = __builtin_amdgcn_exp2f(p0[r]);
}
__device__ __forceinline__ void finishSM(f32x16& p0, f32x16& p1, float alpha, float& l_reg, bf16x8& pa0, bf16x8& pa1, bf16x8& pa2, bf16x8& pa3) {
    for (int r = 0; r < 16; ++r) p1[r] = __builtin_amdgcn_exp2f(p1[r]);
    float ps = 0; for (int r = 0; r < 16; ++r) ps += p0[r]; for (int r = 0; r < 16; ++r) ps += p1[r];
    { auto rr = __builtin_amdgcn_permlane32_swap(__float_as_uint(ps), __float_as_uint(ps), false, false);
      ps = __uint_as_float(rr[0]) + __uint_as_float(rr[1]); }
    l_reg = l_reg * alpha + ps;
#define PK4(P, B_, OUT) do { unsigned a0 = cvtpk(P[B_+0], P[B_+1]), a1 = cvtpk(P[B_+2], P[B_+3]);                          \
        unsigned b0 = cvtpk(P[B_+4], P[B_+5]), b1 = cvtpk(P[B_+6], P[B_+7]);                                             \
        auto r0 = __builtin_amdgcn_permlane32_swap(a0, b0, false, false); auto r1 = __builtin_amdgcn_permlane32_swap(a1, b1, false, false); \
        u32x4 w = {r0[0], r1[0], r0[1], r1[1]}; OUT = *reinterpret_cast<bf16x8*>(&w); } while (0)
    PK4(p0, 0, pa0); PK4(p0, 8, pa1); PK4(p1, 0, pa2); PK4(p1, 8, pa3);
#undef PK4
}
template <int KB, bool SK>
__device__ __forceinline__ void qkt(f32x16& p0, f32x16& p1, const char* K_lds, int r32, int hi, const bf16x8* qr, bool act) {
    if (SK && !act) { const float NEG = -__builtin_inff();
#pragma unroll
        for (int r = 0; r < 16; ++r) { p0[r] = NEG; p1[r] = NEG; } return; }
    p0 = f32x16{}; p1 = f32x16{};
    const char* kb[4];
#pragma unroll
    for (int dd = 0; dd < 4; ++dd) kb[dd] = K_lds + KB * SHM_K + KSWZ(r32, (dd * 16 + hi * 8) * 2);
#pragma unroll
    for (int d0 = 0; d0 < 8; ++d0) { const char* a = kb[d0 & 3] + (d0 >> 2) * 128;
        bf16x8 b0 = *reinterpret_cast<const bf16x8*>(a);
        bf16x8 b1 = *reinterpret_cast<const bf16x8*>(a + 32 * 256);
        p0 = __builtin_amdgcn_mfma_f32_32x32x16_bf16(b0, qr[d0], p0, 0, 0, 0);
        p1 = __builtin_amdgcn_mfma_f32_32x32x16_bf16(b1, qr[d0], p1, 0, 0, 0); }
}
template <int VB, bool SK>
__device__ __forceinline__ void pv_tile(f32x16* o, int vb0, bf16x8 pa0, bf16x8 pa1, bf16x8 pa2, bf16x8 pa3, bool act) {
    if (SK && !act) return;
#define TRRD(dst, off) asm volatile("ds_read_b64_tr_b16 %0, %1 offset:%2" : "=&v"(dst) : "v"(vb0), "i"(off) : "memory")
#define PV_D0(d0) do { s16x4 l0, l1, l2, l3, h0, h1, h2, h3; constexpr int b_ = VB * SHM_V + v_rd_off(d0, 0, 0);     \
        TRRD(l0, b_); TRRD(h0, b_ + 2048); TRRD(l1, b_ + 4096); TRRD(h1, b_ + 6144); TRRD(l2, b_ + 8192); TRRD(h2, b_ + 10240); TRRD(l3, b_ + 12288); TRRD(h3, b_ + 14336); \
        asm volatile("s_waitcnt lgkmcnt(0)" ::: "memory"); SBAR();                 \
        o[d0] = __builtin_amdgcn_mfma_f32_32x32x16_bf16(pa0, (bf16x8){l0[0], l0[1], l0[2], l0[3], h0[0], h0[1], h0[2], h0[3]}, o[d0], 0, 0, 0);   \
        o[d0] = __builtin_amdgcn_mfma_f32_32x32x16_bf16(pa1, (bf16x8){l1[0], l1[1], l1[2], l1[3], h1[0], h1[1], h1[2], h1[3]}, o[d0], 0, 0, 0);   \
        o[d0] = __builtin_amdgcn_mfma_f32_32x32x16_bf16(pa2, (bf16x8){l2[0], l2[1], l2[2], l2[3], h2[0], h2[1], h2[2], h2[3]}, o[d0], 0, 0, 0);   \
        o[d0] = __builtin_amdgcn_mfma_f32_32x32x16_bf16(pa3, (bf16x8){l3[0], l3[1], l3[2], l3[3], h3[0], h3[1], h3[2], h3[3]}, o[d0], 0, 0, 0); } while (0)
    PV_D0(0); PV_D0(1); PV_D0(2); PV_D0(3);
#undef PV_D0
#undef TRRD
}

template <class TIn, class TOut> struct BlockRef { const TIn* Q; const TIn* K; const TIn* V; TOut* O; int P0; };
template <class TIn> struct Seam {
    bf16x8 qr[8];
    bf16x8 st_v0, st_v1, st_k0, st_k1; f32x4 sf0, sf1, sf2, sf3;
    f32x4 tq[16];
};
__device__ __forceinline__ int swa_jlo(int P0, int W) { const int lowk = P0 - W + 1; return lowk > 0 ? lowk / KVBLK : 0; }
#define ROW(p, k0, rr) ((p) + (size_t)((k0) + (rr)) * D + sc)
#define VMW() asm volatile("s_waitcnt vmcnt(0)" ::: "memory")
#define VMWN(n) asm volatile("s_waitcnt vmcnt(%0)" :: "i"(n) : "memory")
#define SLOAD_H(Kp, Vp, k0) do { S.st_v0 = load8<TIn>(ROW(Vp, k0, sr)); S.st_v1 = load8<TIn>(ROW(Vp, k0, 32 + sr));              \
                         S.st_k0 = load8<TIn>(ROW(Kp, k0, sr)); S.st_k1 = load8<TIn>(ROW(Kp, k0, 32 + sr)); } while (0)
#define SWRITE_HK(bf) do { *(bf16x8*)(K_lds + (bf) * SHM_K + kws) = S.st_k0; *(bf16x8*)(K_lds + (bf) * SHM_K + kws + 32 * 256) = S.st_k1; } while (0)
#define SWRITE_HV(bf) do { *(bf16x8*)(V_lds + (bf) * SHM_V + vst0) = S.st_v0; *(bf16x8*)(V_lds + (bf) * SHM_V + vst1) = S.st_v1; } while (0)
#define SWRITE_H(bf) do { SWRITE_HV(bf); SWRITE_HK(bf); } while (0)
#define SLOAD_F(p, k0) do { S.sf0 = *(const f32x4*)ROW(p, k0, sr); S.sf1 = *(const f32x4*)(ROW(p, k0, sr) + 4);                \
                            S.sf2 = *(const f32x4*)ROW(p, k0, 32 + sr); S.sf3 = *(const f32x4*)(ROW(p, k0, 32 + sr) + 4); } while (0)
#define SWRITE_KF(bf) do { *(bf16x8*)(K_lds + (bf) * SHM_K + kws) = pack8(S.sf0, S.sf1); *(bf16x8*)(K_lds + (bf) * SHM_K + kws + 32 * 256) = pack8(S.sf2, S.sf3); } while (0)
#define SWRITE_VF(bf) do { *(bf16x8*)(V_lds + (bf) * SHM_V + vst0) = pack8(S.sf0, S.sf1); *(bf16x8*)(V_lds + (bf) * SHM_V + vst1) = pack8(S.sf2, S.sf3); } while (0)
template <class TIn, class TOut>
__device__ __forceinline__ void causal_swa_prime(const BlockRef<TIn, TOut>& cur, int W, char* lds, Seam<TIn>& S) {
    constexpr bool F32 = same_t<TIn, float>::v;
    const int tid = tid_fresh(), wid = __builtin_amdgcn_readfirstlane(tid >> 6), lane = tid & 63, r32 = lane & 31, hi = lane >> 5;
    const int sr = tid >> 4, sc = (tid & 15) * 8, kws = KSWZ(sr, sc * 2); char* K_lds = lds + 2 * SHM_V;
    const int kb0 = swa_jlo(cur.P0, W) * KVBLK;
    for (int d0 = 0; d0 < 8; ++d0) S.qr[d0] = load8<TIn>(cur.Q + (size_t)(wid * QBLK + r32) * D + d0 * 16 + hi * 8);
    if constexpr (F32) { SLOAD_F((const float*)cur.K, kb0); VMW(); SWRITE_KF(0); SBAR(); SLOAD_F((const float*)cur.V, kb0); }
    else { SLOAD_H(cur.K, cur.V, kb0); VMW(); SWRITE_HK(0); }
    __syncthreads();
}
template <class TIn, class TOut>
__device__ __forceinline__ void causal_swa_block(const BlockRef<TIn, TOut>& cur, const BlockRef<TIn, TOut>& nxt, int skv, int W, char* lds, Seam<TIn>& S) {
    constexpr bool F32 = same_t<TIn, float>::v;
    const int tid = tid_fresh(), wid = __builtin_amdgcn_readfirstlane(tid >> 6), lane = tid & 63, r32 = lane & 31, hi = lane >> 5;
    const int j_lo = swa_jlo(cur.P0, W);
    int j_hi = (cur.P0 + QB - 1) / KVBLK + 1; if (j_hi > skv / KVBLK) j_hi = skv / KVBLK;
    const int NT = j_hi - j_lo;
    const int kbn = swa_jlo(nxt.P0, W) * KVBLK;
    const int qlo = cur.P0 + wid * QBLK, qm = qlo + r32 - 4 * hi;
    char* V_lds = lds; char* K_lds = lds + 2 * SHM_V;
    float* ws = (float*)(lds + 2 * SHM_V + 2 * SHM_K) + wid * 64; float* li_l = ws, * al_l = ws + 32;
    float m_reg = -1e30f, l_reg = 0; f32x16 o[4] = {};
    const int sr = tid >> 4, sc = (tid & 15) * 8, vst0 = v_st(sr, sc), vst1 = v_st(32 + sr, sc), kws = KSWZ(sr, sc * 2);
    const int vb0 = (int)(uintptr_t)V_lds + v_rd_base(lane);
    const TIn* Kh = cur.K; const TIn* Vh = cur.V;
#define RESC(a) do { if (__any((a) < 1.f)) { if (hi == 0) al_l[r32] = (a); asm volatile("s_waitcnt lgkmcnt(0)" ::: "memory");              \
                     for (int d_ = 0; d_ < 4; ++d_) for (int r = 0; r < 16; ++r) o[d_][r] *= al_l[crow(r, hi)]; } } while (0)
#define KBASE(t) ((j_lo + (t)) * KVBLK)
#define ACT(t) (KBASE(t) <= qlo + QBLK - 1 && KBASE(t) + KVBLK - 1 >= qlo - W + 1)
#define MASKT(P0_, P1_, t) do { const int kb_ = KBASE(t); if ((!SK || ACT(t)) && (kb_ + KVBLK - 1 > qlo || kb_ <= qlo + QBLK - 1 - W)) mask_tile(P0_, P1_, qm - kb_, (unsigned)W); } while (0)
    constexpr int NQL = F32 ? 16 : 8;
    constexpr bool SK = WSKIP && !F32;
#define SEAM_K0() do { VMWN(NQL); if constexpr (F32) { SWRITE_KF(0); SBAR(); SLOAD_F((const float*)nxt.V, kbn); } else { SWRITE_HK(0); } SBAR(); } while (0)
    f32x16 pA0, pA1, pB0, pB1; float mnA, mnB, alA, alB; bf16x8 pa0, pa1, pa2, pa3;
    if constexpr (F32) { VMW(); SWRITE_VF(0); SBAR(); } else { SWRITE_HV(0); SBAR(); }
    if (NT > 1) { if constexpr (F32) SLOAD_F((const float*)Kh, KBASE(1)); else SLOAD_H(Kh, Vh, KBASE(1)); }
    SBAR(); qkt<0, SK>(pA0, pA1, K_lds, r32, hi, S.qr, ACT(0));
    if constexpr (F32) { if (NT > 1) { VMW(); SWRITE_KF(1); SBAR(); SLOAD_F((const float*)Vh, KBASE(1)); } }
    MASKT(pA0, pA1, 0); partialSM(pA0, pA1, m_reg, mnA, alA);
    if (NT > 1) { VMW(); if constexpr (F32) { SWRITE_VF(1); SBAR(); if (NT > 2) SLOAD_F((const float*)Kh, KBASE(2)); } else SWRITE_H(1); }
    __syncthreads();
#define HALF_STEP(PX0, PX1, mnX, alX, PY0, PY1, alY, t, KB, VB, SB) do {                                                      \
        SBAR(); qkt<KB, SK>(PX0, PX1, K_lds, r32, hi, S.qr, ACT(t));                                             \
        finishSM(PY0, PY1, alY, l_reg, pa0, pa1, pa2, pa3); SBAR();                                                           \
        if ((t) + 1 < NT) { if constexpr (F32) { VMW(); SWRITE_KF(SB); SBAR(); SLOAD_F((const float*)Vh, KBASE((t) + 1)); }  \
                            else { SLOAD_H(Kh, Vh, KBASE((t) + 1)); } SBAR(); }                                               \
        pv_tile<VB, SK>(o, vb0, pa0, pa1, pa2, pa3, ACT((t) - 1)); MASKT(PX0, PX1, (t)); partialSM(PX0, PX1, m_reg, mnX, alX);                                        \
        __syncthreads();                                                                                                      \
        if ((t) + 1 < NT) { VMW(); if constexpr (F32) { SWRITE_VF(SB); SBAR(); if ((t) + 2 < NT) SLOAD_F((const float*)Kh, KBASE((t) + 2)); } \
                            else { SWRITE_H(SB); } }                                                                          \
        RESC(alX); __syncthreads(); } while (0)
    for (int t = 1; t + 1 < NT; t += 2) {
        HALF_STEP(pB0, pB1, mnB, alB, pA0, pA1, alA, t, 1, 0, 0);
        HALF_STEP(pA0, pA1, mnA, alA, pB0, pB1, alB, t + 1, 0, 1, 1);
    }
    const bool even = (NT & 1) == 0;
    if (even) { SBAR(); qkt<1, SK>(pB0, pB1, K_lds, r32, hi, S.qr, ACT(NT - 1)); SBAR(); }
#define QROW(e) (nxt.Q + (size_t)(wid * QBLK + r32) * D + ((e) >> 1) * 16 + hi * 8 + ((e) & 1) * 4)
    if constexpr (F32) { SLOAD_F((const float*)nxt.K, kbn); SBAR();
#pragma unroll
        for (int e = 0; e < 8; ++e) S.tq[e] = *(const f32x4*)QROW(e); }
    else { SLOAD_H(nxt.K, nxt.V, kbn); SBAR();
#pragma unroll
        for (int d0 = 0; d0 < 8; ++d0) S.qr[d0] = load8<TIn>(nxt.Q + (size_t)(wid * QBLK + r32) * D + d0 * 16 + hi * 8); }
    SBAR();
    finishSM(pA0, pA1, alA, l_reg, pa0, pa1, pa2, pa3); SBAR();
    if constexpr (F32) {
#pragma unroll
        for (int e = 8; e < 16; ++e) S.tq[e] = *(const f32x4*)QROW(e); SBAR(); }
#undef QROW
    pv_tile<0, SK>(o, vb0, pa0, pa1, pa2, pa3, ACT(even ? NT - 2 : NT - 1));
    if (even) { MASKT(pB0, pB1, NT - 1); partialSM(pB0, pB1, m_reg, mnB, alB); __syncthreads(); RESC(alB);
        finishSM(pB0, pB1, alB, l_reg, pa0, pa1, pa2, pa3); SBAR(); pv_tile<1, SK>(o, vb0, pa0, pa1, pa2, pa3, ACT(NT - 1)); }
    SBAR(); SEAM_K0();
    if (hi == 0) li_l[r32] = l_reg; asm volatile("s_waitcnt lgkmcnt(0)" ::: "memory");
    float rli[16];
#pragma unroll
    for (int r = 0; r < 16; ++r) rli[r] = __builtin_amdgcn_rcpf(li_l[crow(r, hi)]);
    TOut* Ow = cur.O + (size_t)(wid * QBLK) * D;
#pragma unroll
    for (int r = 0; r < 16; ++r) { const int orow = crow(r, hi);
#pragma unroll
        for (int d0 = 0; d0 < 4; ++d0) { const float v = o[d0][r] * rli[r];
            if constexpr (same_t<TOut, float>::v) { Ow[(size_t)orow * D + d0 * 32 + r32] = v; }
            else { const float vn = __shfl_xor(v, 1);
                   if ((r32 & 1) == 0) *(unsigned*)(Ow + (size_t)orow * D + d0 * 32 + r32) = cvtpk(v, vn); } } }
    if constexpr (F32) {
#pragma unroll
        for (int d0 = 0; d0 < 8; ++d0) S.qr[d0] = pack8(S.tq[2 * d0], S.tq[2 * d0 + 1]); }
    __syncthreads();
#undef RESC
#undef KBASE
#undef ACT
#undef MASKT
#undef SEAM_K0
#undef HALF_STEP
}
#undef ROW
#undef VMW
#undef VMWN
#undef SLOAD_H
#undef SWRITE_HK
#undef SWRITE_HV
#undef SWRITE_H
#undef SLOAD_F
#undef SWRITE_KF
#undef SWRITE_VF
constexpr int LDS256_V = 0, LDS256_K = 4 * SHM_V, LDS256_WS = LDS256_K + 2 * SHM_K, LDS256_BYTES = LDS256_WS + NW * 64 * 4;
template <bool COMB>
__device__ __forceinline__ void diff_attn_block(const unsigned short* Q, const unsigned short* K, const unsigned short* V0, const unsigned short* V1, unsigned short* O, int P0, int skv, char* lds,
                                                unsigned short* AOut, int AOP, float lam, const float* sl, float eps) {
    const int tid = tid_fresh(), wid = __builtin_amdgcn_readfirstlane(tid >> 6), lane = tid & 63, r32 = lane & 31, hi = lane >> 5;
    int NT = (P0 + QB - 1) / KVBLK + 1; if (NT > skv / KVBLK) NT = skv / KVBLK;
    const int qlo = P0 + wid * QBLK, qm = qlo + r32 - 4 * hi;
    char* V_lds = lds + LDS256_V; char* K_lds = lds + LDS256_K;
    float* ws = (float*)(lds + LDS256_WS) + wid * 64; float* li_l = ws, * al_l = ws + 32;
    float m_reg = -1e30f, l_reg = 0; f32x16 o[8] = {};
    const int vb0 = (int)(uintptr_t)V_lds + v_rd_base(lane);
    bf16x8 qr[8];
#pragma unroll
    for (int d0 = 0; d0 < 8; ++d0) qr[d0] = *reinterpret_cast<const bf16x8*>(Q + (size_t)(wid * QBLK + r32) * D + d0 * 16 + hi * 8);
    typedef __attribute__((address_space(3))) unsigned* ldsu_t;
    unsigned koff[2], voff[2];
#pragma unroll
    for (int i = 0; i < 2; ++i) { const int q = (2 * wid + i) * 64 + lane;
        { const int row = q >> 4, cs = q & 15; koff[i] = (unsigned)(row * 256 + ((cs ^ (row & 7)) << 4)); }
        { const int st = q >> 5, kk = 8 * (st >> 2) + ((q & 31) >> 2), k = (kk & ~0xC) | ((kk & 4) << 1) | ((kk & 8) >> 1), c = 32 * (st & 3) + 8 * (q & 3); voff[i] = (unsigned)(k * 256 + c * 2); } }
    const unsigned ldsw = (unsigned)wid * 2048u;
#define A256_DMA(t, bf) do { const size_t tb_ = (size_t)(t) * (KVBLK * D * 2); \
        _Pragma("unroll") for (int i = 0; i < 2; ++i) { \
            __builtin_amdgcn_global_load_lds((const unsigned*)((const char*)K + tb_ + koff[i]), (ldsu_t)(K_lds + (bf) * SHM_K + ldsw + i * 1024), 16, 0, 0); \
            __builtin_amdgcn_global_load_lds((const unsigned*)((const char*)V0 + tb_ + voff[i]), (ldsu_t)(V_lds + (2 * (bf)) * SHM_V + ldsw + i * 1024), 16, 0, 0); \
            __builtin_amdgcn_global_load_lds((const unsigned*)((const char*)V1 + tb_ + voff[i]), (ldsu_t)(V_lds + (2 * (bf) + 1) * SHM_V + ldsw + i * 1024), 16, 0, 0); } } while (0)
#define A256_RESC(a) do { if (__any((a) < 1.f)) { if (hi == 0) al_l[r32] = (a); asm volatile("s_waitcnt lgkmcnt(0)" ::: "memory"); \
        _Pragma("unroll") for (int d_ = 0; d_ < 8; ++d_) _Pragma("unroll") for (int r = 0; r < 16; ++r) o[d_][r] *= al_l[crow(r, hi)]; } } while (0)
#define A256_STEP(BUF, tt) do { \
        if ((tt) + 1 < NT) A256_DMA((tt) + 1, 1 - BUF); \
        f32x16 p0, p1; float mn, alpha; bf16x8 pa0, pa1, pa2, pa3; \
        SBAR(); qkt<BUF, false>(p0, p1, K_lds, r32, hi, qr, true); \
        { const int kb_ = (tt) * KVBLK; if (kb_ + KVBLK - 1 > qlo) mask_tile(p0, p1, qm - kb_, 1u << 30); } \
        partialSM(p0, p1, m_reg, mn, alpha); \
        finishSM(p0, p1, alpha, l_reg, pa0, pa1, pa2, pa3); SBAR(); \
        A256_RESC(alpha); \
        pv_tile<2 * BUF, false>(o, vb0, pa0, pa1, pa2, pa3, true); pv_tile<2 * BUF + 1, false>(o + 4, vb0, pa0, pa1, pa2, pa3, true); \
        __syncthreads(); } while (0)
    A256_DMA(0, 0);
    __syncthreads();
    if (wid >= 4) __builtin_amdgcn_s_setprio(1);
    for (int t = 0; t < NT; t += 2) {
        A256_STEP(0, t);
        if (t + 1 < NT) A256_STEP(1, t + 1);
    }
    if (wid >= 4) __builtin_amdgcn_s_setprio(0);
    if (hi == 0) li_l[r32] = l_reg; asm volatile("s_waitcnt lgkmcnt(0)" ::: "memory");
    float rli[16];
#pragma unroll
    for (int r = 0; r < 16; ++r) rli[r] = __builtin_amdgcn_rcpf(li_l[crow(r, hi)]);
#define A256_DPP(v_, ctrl_) __builtin_bit_cast(float, __builtin_amdgcn_update_dpp(0, __builtin_bit_cast(int, (float)(v_)), (ctrl_), 0xf, 0xf, true))
#define A256_SHX(v_, m_) __builtin_bit_cast(float, __builtin_amdgcn_ds_bpermute((lane ^ (m_)) << 2, __builtin_bit_cast(int, (float)(v_))))
    unsigned short* Ow = O + (size_t)(wid * QBLK) * 256;
    if constexpr (!COMB) {
#pragma unroll
        for (int j = 0; j < 16; ++j) { const int d0 = j >> 1, rb = (j & 1) * 8;
            u32x4 w; w.x = cvtpk(o[d0][rb] * rli[rb], o[d0][rb + 1] * rli[rb + 1]); w.y = cvtpk(o[d0][rb + 2] * rli[rb + 2], o[d0][rb + 3] * rli[rb + 3]);
            w.z = cvtpk(o[d0][rb + 4] * rli[rb + 4], o[d0][rb + 5] * rli[rb + 5]); w.w = cvtpk(o[d0][rb + 6] * rli[rb + 6], o[d0][rb + 7] * rli[rb + 7]);
            *(u32x4*)(Ow + (size_t)(j * 64 + lane) * 8) = w; }
    } else {
        float slv[8];
#pragma unroll
        for (int d0 = 0; d0 < 8; ++d0) slv[d0] = sl[d0 * 32 + r32];
        u32x4 pw[16];
#pragma unroll
        for (int j = 0; j < 16; ++j) pw[j] = *(const u32x4*)(Ow + (size_t)(j * 64 + lane) * 8);
#pragma unroll
        for (int r = 0; r < 16; ++r) { const int orow = crow(r, hi); float ss = 0.f;
#pragma unroll
            for (int d0 = 0; d0 < 8; ++d0) { const unsigned wv = pw[2 * d0 + (r >> 3)][(r & 7) >> 1]; const float o0 = (r & 1) ? __uint_as_float(wv & 0xffff0000u) : __uint_as_float(wv << 16);
                const float x = o0 - lam * (o[d0][r] * rli[r]); o[d0][r] = x; ss += x * x; }
            ss += A256_DPP(ss, 0xB1); ss += A256_DPP(ss, 0x4E); ss += A256_DPP(ss, 0x141); ss += A256_DPP(ss, 0x140); ss += A256_SHX(ss, 16);
            const float rs = rsqrtf(ss * (1.0f / 256.0f) + eps);
            unsigned short* ao = AOut + (size_t)(wid * QBLK + orow) * AOP;
#pragma unroll
            for (int d0 = 0; d0 < 8; ++d0) { const float v = o[d0][r] * rs * slv[d0]; const float vn = A256_DPP(v, 0xB1);
                if ((r32 & 1) == 0) *(unsigned*)(ao + d0 * 32 + r32) = cvtpk(v, vn); } }
    }
    asm volatile("s_waitcnt lgkmcnt(0)\n\ts_barrier" ::: "memory");
#undef A256_SHX
#undef A256_DPP
#undef A256_DMA
#undef A256_RESC
#undef A256_STEP
}
#undef KSWZ
#undef SBAR
}
constexpr int DM = 2048, NB = 4, SEQ = 4096, NMETA = 16, MR = NB * SEQ  , MROWS = MR + NMETA, MPAD = MR + 256;
constexpr int DFF = 5632, NGU = 2 * DFF, NIN = 15360, LW = 2560, NHEAD = 8, KVLEN = 4160, DEPTH = 4;
constexpr float EPS = 1e-6f;
constexpr int NWAVES = 8;
#ifndef MK_MULTI
#define MK_MULTI 0
#endif
#ifndef DUAL_BR
#define DUAL_BR 1
#endif
#ifndef FINAL_BF16
#define FINAL_BF16 1
#endif
#ifndef EN_MASK
#define EN_MASK 0xFFFF
#endif
#define EN(k) (((EN_MASK) >> (k)) & 1)
#ifndef PROBE_SEAM
#define PROBE_SEAM -1
#endif
#ifndef PROBE_GAIN
#define PROBE_GAIN 1.0f
#endif
#ifndef DUP_PHASE
#define DUP_PHASE -1
#endif
#define DRY(k) ((k) == (DUP_PHASE) && rep_ == 0)
#define REPM(k) for (int rep_ = 0; rep_ < ((DUP_PHASE) == 20 ? 2 : 1); ++rep_)
#define DRYM ((DUP_PHASE) == 20 && rep_ == 0)
#define REP(k) for (int rep_ = 0; rep_ < ((k) == (DUP_PHASE) ? 2 : 1); ++rep_)
#ifndef NO_META
#define NO_META 0
#endif
constexpr int PH_PER_LAYER = 10, N_PHASES = 2 + DEPTH * PH_PER_LAYER;

constexpr size_t MiB = 1u << 20;
constexpr size_t WS_CTL = 0, CTL_ZERO_BYTES = 2 * MiB;
constexpr size_t WS_ROPE = 2 * MiB;
constexpr size_t WS_QM = 3 * MiB + 512 * 1024;
constexpr size_t WS_W = 4 * MiB, WBUF_STRIDE = 0 * MiB;
constexpr size_t W_GU1 = WS_W, W_DN1 = W_GU1 + 44 * MiB, W_IN = W_DN1 + 22 * MiB, W_BA = W_IN + 60 * MiB, W_BL = W_BA + 8 * MiB, W_O = W_BL + 10 * MiB,
                 W_GU2 = W_O + 8 * MiB, W_DN2 = W_GU2 + 44 * MiB;
constexpr size_t WS_H = 224 * MiB;
constexpr size_t WS_HB = 354 * MiB;
constexpr size_t WS_HID = 420 * MiB;
constexpr size_t WS_Q = 600 * MiB;
constexpr size_t WS_K = 664 * MiB;
constexpr size_t WS_V = 729 * MiB;
constexpr size_t WS_XR = 794 * MiB;
constexpr size_t WS_GY = 876 * MiB;
constexpr size_t WS_G = 958 * MiB;
constexpr size_t WS_OP = 1088 * MiB;
constexpr size_t WS_AO = 1216 * MiB;
constexpr size_t WS_LO = 1281 * MiB;
constexpr size_t WS_TMP = 1363 * MiB;
constexpr size_t WS_MIX = 1493 * MiB;
constexpr size_t WS_END = 1558 * MiB;
static_assert(W_DN2 + 22 * MiB <= WS_H && WS_H + (size_t)MPAD * DM * 4 <= WS_HB && WS_HB + (size_t)MPAD * DM * 2 <= WS_HID && WS_HID + (size_t)MPAD * DFF * 2 <= WS_Q, "ws map 1");
static_assert(WS_K + (size_t)64 * KVLEN * 256 <= WS_V && WS_V + (size_t)64 * KVLEN * 256 <= WS_XR && WS_XR + (size_t)MPAD * LW * 2 <= WS_GY && WS_GY + (size_t)MPAD * LW * 2 <= WS_G, "ws map 2");
static_assert(WS_LO + (size_t)MPAD * LW * 2 <= WS_TMP && WS_TMP + (size_t)MPAD * DM * 4 <= WS_MIX && WS_MIX + (size_t)MPAD * DM * 2 <= WS_END, "ws map 3");
constexpr int CW_TMO = 0, CW_CODE = 1, CW_BAR = 4096, CW_REACH = 8192  , CW_ITEM = 12288  ;
constexpr size_t SSQ_OFF = 65536;
constexpr int N_SSQ = 13;
static_assert(SSQ_OFF + (size_t)N_SSQ * MPAD * 8 <= CTL_ZERO_BYTES, "ssq inside the memset region");

constexpr int RING_BYTES = 143360, LDSCTL_OFF = RING_BYTES, MISC_OFF = LDSCTL_OFF + 320, LDS_BYTES = 147456;

using pg8::bf16_t; using pg8::bf16x8; using pg8::f32x4; using pg8::u32x4; using pg8::cvt_pk_bf16;

__device__ __forceinline__ float wave_sum(float v) {
#pragma unroll
    for (int o = 1; o < 64; o <<= 1) v += __shfl_xor(v, o);
    return v;
}
__device__ __forceinline__ float bf2f(unsigned short u) { return __uint_as_float((unsigned)u << 16); }
__device__ __forceinline__ float bflo(unsigned u) { return __uint_as_float(u << 16); }
__device__ __forceinline__ float bfhi(unsigned u) { return __uint_as_float(u & 0xffff0000u); }
__device__ __forceinline__ unsigned short f2bf16(float f) { return (unsigned short)(cvt_pk_bf16(f, 0.f) & 0xffffu); }
typedef unsigned long long u64;
typedef float f32x2 __attribute__((ext_vector_type(2)));
__device__ __forceinline__ float rstd_from(float ssq) { return rsqrtf(ssq * (1.0f / 2048.0f) + EPS); }
__device__ __forceinline__ float rstd_fx(u64 v) { return rsqrtf((float)v * (1.0f / 4294967296.0f / 2048.0f) + EPS); }
__device__ __forceinline__ u64 ssq_fx(float ss) { return (u64)(ss * 4294967296.0f); }
__device__ __forceinline__ float sigmoid_f(float x) { return __builtin_amdgcn_rcpf(1.0f + __expf(-x)); }
__device__ __forceinline__ float gelu_tanh_f(float y) { const float u = 1.5957691216057308f * (y + 0.044715f * y * y * y); return y * __builtin_amdgcn_rcpf(1.0f + __expf(-u)); }
__device__ __forceinline__ f32x4 sigmoid4(f32x4 x) { f32x4 t = x * -1.4426950408889634f;
#pragma unroll
    for (int e = 0; e < 4; ++e) t[e] = __builtin_amdgcn_exp2f(t[e]);
    t = t + 1.0f;
#pragma unroll
    for (int e = 0; e < 4; ++e) t[e] = __builtin_amdgcn_rcpf(t[e]);
    return t; }
__device__ __forceinline__ f32x4 gelu_tanh4(f32x4 y) { return y * sigmoid4(y * ((y * y) * (0.044715f * 1.5957691216057308f) + 1.5957691216057308f)); }
__device__ __forceinline__ u32x4 pack8f(f32x4 a, f32x4 b) { u32x4 w; w.x = cvt_pk_bf16(a[0], a[1]); w.y = cvt_pk_bf16(a[2], a[3]); w.z = cvt_pk_bf16(b[0], b[1]); w.w = cvt_pk_bf16(b[2], b[3]); return w; }

namespace pg8 {
template <class E> __device__ __forceinline__ void run_epi(const E& e, const f32x4 (&acc)[2][2][4][2], const Unit& u, int wr, int wc, int fr, int fq) {
    const int colin = wc * 32 + 8 * fq, row0 = u.pm * BM + wr * 64 + fr;
    const typename E::Tile tl = e.tile(u.pn, colin);
    typename E::Pre q[8];
#pragma unroll
    for (int i = 0; i < 8; ++i) if (i < E::DEPTH) q[i] = e.pre(row0 + (i >> 2) * HALF + (i & 3) * 16, u.pn, colin);
    asm volatile("" ::: "memory");
#pragma unroll
    for (int i = 0; i < 8; ++i) {
        if (i + E::DEPTH < 8) { q[i + E::DEPTH] = e.pre(row0 + ((i + E::DEPTH) >> 2) * HALF + ((i + E::DEPTH) & 3) * 16, u.pn, colin); asm volatile("" ::: "memory"); }
        e.template frag<false>(row0 + (i >> 2) * HALF + (i & 3) * 16, u.pn, colin, acc[i >> 2][0][i & 3][0], acc[i >> 2][0][i & 3][1], acc[i >> 2][1][i & 3][0], acc[i >> 2][1][i & 3][1], q[i], tl);
    }
}
}
#define EPI_COMMON static constexpr bool PERM = true, AFTER_DRAIN = false; \
    __device__ __forceinline__ void operator()(const f32x4 (&acc)[2][2][4][2], const pg8::Unit& u, int wr, int wc, int fr, int fq) const { pg8::run_epi(*this, acc, u, wr, wc, fr, fq); } \
    template <bool META> __device__ __forceinline__ void frag1(int row, int pn, int colin, f32x4 a0, f32x4 a1, f32x4 b0, f32x4 b1) const { this->template frag<META>(row, pn, colin, a0, a1, b0, b1, pre(row, pn, colin), tile(pn, colin)); }
struct EpiNone {};
__device__ __forceinline__ void unpack8(u32x4 w, f32x4& lo, f32x4& hi) { lo = (f32x4){bflo(w.x), bfhi(w.x), bflo(w.y), bfhi(w.y)}; hi = (f32x4){bflo(w.z), bfhi(w.z), bflo(w.w), bfhi(w.w)}; }

struct EpiNull {
    typedef EpiNone Pre; typedef EpiNone Tile; static constexpr int DEPTH = 1;
    __device__ __forceinline__ Pre pre(int, int, int) const { return Pre{}; }
    __device__ __forceinline__ Tile tile(int, int) const { return Tile{}; }
    template <bool META> __device__ __forceinline__ void frag(int row, int pn, int colin, f32x4 a0, f32x4 a1, f32x4 b0, f32x4 b1, const Pre&, const Tile&) const { asm volatile("" :: "v"(a0), "v"(a1), "v"(b0), "v"(b1)); }
    EPI_COMMON
};
struct PreSsq { u64 v; };
struct EpiSwiGLU {
    bf16_t* HID; const u64* ssq;
    typedef PreSsq Pre; typedef EpiNone Tile; static constexpr int DEPTH = 8;
    __device__ __forceinline__ Pre pre(int row, int, int) const { return Pre{ssq[row]}; }
    __device__ __forceinline__ Tile tile(int, int) const { return Tile{}; }
    template <bool META> __device__ __forceinline__ void frag(int row, int pn, int colin, f32x4 a0, f32x4 a1, f32x4 b0, f32x4 b1, const Pre& p, const Tile&) const {
        const float rs = rstd_fx(p.v), c1 = rs * -1.4426950408889634f, rs2 = rs * rs;
        f32x4 t0 = a0 * c1, t1 = a1 * c1;
#pragma unroll
        for (int e = 0; e < 4; ++e) { t0[e] = __builtin_amdgcn_exp2f(t0[e]); t1[e] = __builtin_amdgcn_exp2f(t1[e]); }
        t0 = t0 + 1.0f; t1 = t1 + 1.0f;
#pragma unroll
        for (int e = 0; e < 4; ++e) { t0[e] = __builtin_amdgcn_rcpf(t0[e]); t1[e] = __builtin_amdgcn_rcpf(t1[e]); }
        const f32x4 o0 = (a0 * b0) * t0 * rs2, o1 = (a1 * b1) * t1 * rs2;
        *(u32x4*)(HID + (size_t)row * DFF + pn * 128 + colin) = pack8f(o0, o1);
    }
    EPI_COMMON
};
struct PreH { f32x4 h0, h1, h2, h3; };
struct PreHb { u32x4 lo, hi; };
struct EpiResid {
    float* Hf; bf16_t* HB; u64* ssqn; float alpha, ssw;
    typedef PreHb Pre; typedef EpiNone Tile; static constexpr int DEPTH = 4;
    __device__ __forceinline__ Pre pre(int row, int pn, int colin) const { const bf16_t* bp = HB + (size_t)row * DM + pn * 256 + colin; return Pre{*(const u32x4*)bp, *(const u32x4*)(bp + 128)}; }
    __device__ __forceinline__ Tile tile(int, int) const { return Tile{}; }
    template <bool META> __device__ __forceinline__ void frag(int row, int pn, int colin, f32x4 a0, f32x4 a1, f32x4 b0, f32x4 b1, const Pre& p, const Tile&) const {
        const int c0 = pn * 256 + colin;
        f32x4 h0, h1, h2, h3; unpack8(p.lo, h0, h1); unpack8(p.hi, h2, h3);
        h0 = h0 + alpha * a0; h1 = h1 + alpha * a1; h2 = h2 + alpha * b0; h3 = h3 + alpha * b1;
        bf16_t* bp = HB + (size_t)row * DM + c0;
        *(u32x4*)bp = pack8f(h0, h1); *(u32x4*)(bp + 128) = pack8f(h2, h3);
        if (Hf) { float* hp = Hf + (size_t)row * DM + c0; *(f32x4*)hp = h0; *(f32x4*)(hp + 4) = h1; *(f32x4*)(hp + 128) = h2; *(f32x4*)(hp + 132) = h3; }
        float ss = 0.f;
#pragma unroll
        for (int e = 0; e < 4; ++e) ss += h0[e] * h0[e] + h1[e] * h1[e] + h2[e] * h2[e] + h3[e] * h3[e];
        ss += __shfl_xor(ss, 16); ss += __shfl_xor(ss, 32);
        if ((threadIdx.x & 48) == 0) __hip_atomic_fetch_add(ssqn + row, ssq_fx(ss * ssw), __ATOMIC_RELAXED, __HIP_MEMORY_SCOPE_AGENT);
    }
    EPI_COMMON
};
struct PreWin { u64 v; f32x4 c, s; };
struct TileWin { f32x4 g0, g1, g2, g3; };
struct EpiWin {
    bf16_t *Q, *K, *V, *XR, *GY, *G, *QM; const float* bgate; const u64* ssq; const float* rc; const float* rsn;
    typedef PreWin Pre; typedef TileWin Tile; static constexpr int DEPTH = 3;
    __device__ __forceinline__ Pre pre(int row, int pn, int colin) const {
        Pre p; p.v = ssq[row]; p.c = (f32x4){0.f, 0.f, 0.f, 0.f}; p.s = p.c;
        if (pn < 16 && colin < 32) { const int pos = row >= MR ? row - MR : (row & 4095) + NMETA; p.c = *(const f32x4*)(rc + pos * 16 + (colin >> 1)); p.s = *(const f32x4*)(rsn + pos * 16 + (colin >> 1)); }
        return p; }
    __device__ __forceinline__ Tile tile(int pn, int colin) const {
        Tile t; t.g0 = (f32x4){0.f, 0.f, 0.f, 0.f}; t.g1 = t.g0; t.g2 = t.g0; t.g3 = t.g0;
        if (pn >= 44) { const float* bp = bgate + (pn - 44) * 256 + colin; t.g0 = *(const f32x4*)bp; t.g1 = *(const f32x4*)(bp + 4); t.g2 = *(const f32x4*)(bp + 128); t.g3 = *(const f32x4*)(bp + 132); }
        return t; }
    template <bool META> __device__ __forceinline__ void frag(int row, int pn, int colin, f32x4 a0, f32x4 a1, f32x4 b0, f32x4 b1, const Pre& pq, const Tile& tl) const {
        const float rs = rstd_fx(pq.v);
        a0 = a0 * rs; a1 = a1 * rs; b0 = b0 * rs; b1 = b1 * rs;
        const int mi = row - MR, b = row >> 12, t = row & 4095, pos = META ? mi : t + NMETA;
        if (pn < 24) {
            if (pn < 16 && colin < 32) {
                const f32x4 c = pq.c, s = pq.s;
                const f32x4 r1 = a0 * c - a1 * s, r2 = a1 * c + a0 * s, r3 = b0 * c - b1 * s, r4 = b1 * c + b0 * s;
                a0 = r1; a1 = r2; b0 = r3; b1 = r4;
            }
            const u32x4 wa = pack8f(a0, a1), wb = pack8f(b0, b1);
            const int h = pn & 7;
            if (pn < 8) {
                if (META) { bf16_t* p = QM + ((size_t)(2 * h) * NMETA + mi) * 128 + colin; *(u32x4*)p = wa; *(u32x4*)(p + NMETA * 128) = wb; }
                else { bf16_t* p = Q + ((size_t)(b * 16 + 2 * h) * SEQ + t) * 128 + colin; *(u32x4*)p = wa; *(u32x4*)(p + (size_t)SEQ * 128) = wb; }
            } else {
                bf16_t* base = pn < 16 ? K : V;
                if (META) {
#pragma unroll
                    for (int bb = 0; bb < NB; ++bb) { bf16_t* p = base + ((size_t)(bb * 16 + 2 * h) * KVLEN + mi) * 128 + colin; *(u32x4*)p = wa; *(u32x4*)(p + (size_t)KVLEN * 128) = wb; }
                } else { bf16_t* p = base + ((size_t)(b * 16 + 2 * h) * KVLEN + pos) * 128 + colin; *(u32x4*)p = wa; *(u32x4*)(p + (size_t)KVLEN * 128) = wb; }
            }
        } else if (pn < 34) {
            bf16_t* p = XR + (size_t)row * LW + (pn - 24) * 256 + colin; *(u32x4*)p = pack8f(a0, a1); *(u32x4*)(p + 128) = pack8f(b0, b1);
        } else if (pn < 44) {
            a0 = gelu_tanh4(a0); a1 = gelu_tanh4(a1); b0 = gelu_tanh4(b0); b1 = gelu_tanh4(b1);
            bf16_t* p = GY + (size_t)row * LW + (pn - 34) * 256 + colin; *(u32x4*)p = pack8f(a0, a1); *(u32x4*)(p + 128) = pack8f(b0, b1);
        } else {
            const int c0 = (pn - 44) * 256 + colin;
            a0 = sigmoid4(a0 + tl.g0); a1 = sigmoid4(a1 + tl.g1); b0 = sigmoid4(b0 + tl.g2); b1 = sigmoid4(b1 + tl.g3);
            bf16_t* p = G + (size_t)row * 4096 + c0; *(u32x4*)p = pack8f(a0, a1); *(u32x4*)(p + 128) = pack8f(b0, b1);
        }
    }
    EPI_COMMON
};
struct PreG { u32x4 g0, g1; };
struct EpiBa {
    bf16_t* TMP; const bf16_t* G;
    typedef PreG Pre; typedef EpiNone Tile; static constexpr int DEPTH = 4;
    __device__ __forceinline__ Pre pre(int row, int pn, int colin) const { const bf16_t* gp = G + (size_t)row * 4096 + pn * 256 + colin; return Pre{*(const u32x4*)gp, *(const u32x4*)(gp + 128)}; }
    __device__ __forceinline__ Tile tile(int, int) const { return Tile{}; }
    template <bool META> __device__ __forceinline__ void frag(int row, int pn, int colin, f32x4 a0, f32x4 a1, f32x4 b0, f32x4 b1, const Pre& p, const Tile&) const {
        const int c0 = pn * 256 + colin;
        f32x4 g0, g1, g2, g3; unpack8(p.g0, g0, g1); unpack8(p.g1, g2, g3);
        bf16_t* tp = TMP + (size_t)row * DM + c0;
        *(u32x4*)tp = pack8f(g0 * a0, g1 * a1); *(u32x4*)(tp + 128) = pack8f(g2 * b0, g3 * b1);
    }
    EPI_COMMON
};
struct PreTG { u32x4 t0, t1, g0, g1; };
struct EpiBl {
    const bf16_t* TMP; const bf16_t* G; bf16_t* MIX;
    typedef PreTG Pre; typedef EpiNone Tile; static constexpr int DEPTH = 2;
    __device__ __forceinline__ Pre pre(int row, int pn, int colin) const { const int c0 = pn * 256 + colin; const bf16_t* tp = TMP + (size_t)row * DM + c0; const bf16_t* gp = G + (size_t)row * 4096 + 2048 + c0;
        return Pre{*(const u32x4*)tp, *(const u32x4*)(tp + 128), *(const u32x4*)gp, *(const u32x4*)(gp + 128)}; }
    __device__ __forceinline__ Tile tile(int, int) const { return Tile{}; }
    template <bool META> __device__ __forceinline__ void frag(int row, int pn, int colin, f32x4 a0, f32x4 a1, f32x4 b0, f32x4 b1, const Pre& p, const Tile&) const {
        const int c0 = pn * 256 + colin;
        f32x4 g0, g1, g2, g3, t0, t1, t2, t3; unpack8(p.g0, g0, g1); unpack8(p.g1, g2, g3); unpack8(p.t0, t0, t1); unpack8(p.t1, t2, t3);
        t0 = t0 + g0 * a0; t1 = t1 + g1 * a1; t2 = t2 + g2 * b0; t3 = t3 + g3 * b1;
        bf16_t* mp = MIX + (size_t)row * DM + c0;
        *(u32x4*)mp = pack8f(t0, t1); *(u32x4*)(mp + 128) = pack8f(t2, t3);
    }
    EPI_COMMON
};

struct PreGG { u32x4 a0, a1, l0, l1; };
struct EpiDual {
    const bf16_t* G; bf16_t* MIX;
    typedef PreG Pre; typedef EpiNone Tile; static constexpr int DEPTH = 4;
    __device__ __forceinline__ Pre pre(int row, int pn, int colin) const { const bf16_t* gp = G + (size_t)row * 4096 + 2048 + pn * 256 + colin; return Pre{*(const u32x4*)gp, *(const u32x4*)(gp + 128)}; }
    __device__ __forceinline__ Tile tile(int, int) const { return Tile{}; }
    template <bool META> __device__ __forceinline__ void frag(int row, int pn, int colin, f32x4 a0, f32x4 a1, f32x4 b0, f32x4 b1, const Pre& p, const Tile&) const {
        f32x4 g0, g1, g2, g3; unpack8(p.g0, g0, g1); unpack8(p.g1, g2, g3);
#pragma unroll
        for (int e = 0; e < 4; ++e) { g0[e] = fmaxf(g0[e], 1e-20f); g1[e] = fmaxf(g1[e], 1e-20f); g2[e] = fmaxf(g2[e], 1e-20f); g3[e] = fmaxf(g3[e], 1e-20f); }
        bf16_t* mp = MIX + (size_t)row * DM + pn * 256 + colin;
        *(u32x4*)mp = pack8f(g0 * a0, g1 * a1); *(u32x4*)(mp + 128) = pack8f(g2 * b0, g3 * b1);
    }
    __device__ __forceinline__ PreGG pre2(int row, int pn, int colin) const { const bf16_t* gp = G + (size_t)row * 4096 + pn * 256 + colin;
        return PreGG{*(const u32x4*)gp, *(const u32x4*)(gp + 128), *(const u32x4*)(gp + 2048), *(const u32x4*)(gp + 2048 + 128)}; }
    static __device__ __forceinline__ f32x4 ratio4(f32x4 ga, f32x4 gl) { f32x4 r;
#pragma unroll
        for (int e = 0; e < 4; ++e) r[e] = ga[e] * __builtin_amdgcn_rcpf(fmaxf(gl[e], 1e-20f));
        return r; }
    __device__ __forceinline__ void mid(f32x4 (&acc)[2][2][4][2], const pg8::Unit& u, int wr, int wc, int fr, int fq) const {
        const int colin = wc * 32 + 8 * fq, row0 = u.pm * pg8::BM + wr * 64 + fr;
        PreGG q[8];
#pragma unroll
        for (int i = 0; i < 2; ++i) q[i] = pre2(row0 + (i >> 2) * pg8::HALF + (i & 3) * 16, u.pn, colin);
        asm volatile("" ::: "memory");
#pragma unroll
        for (int i = 0; i < 8; ++i) {
            if (i + 2 < 8) { q[i + 2] = pre2(row0 + ((i + 2) >> 2) * pg8::HALF + ((i + 2) & 3) * 16, u.pn, colin); asm volatile("" ::: "memory"); }
            f32x4 a0, a1, a2, a3, l0, l1, l2, l3; unpack8(q[i].a0, a0, a1); unpack8(q[i].a1, a2, a3); unpack8(q[i].l0, l0, l1); unpack8(q[i].l1, l2, l3);
            acc[i >> 2][0][i & 3][0] = acc[i >> 2][0][i & 3][0] * ratio4(a0, l0); acc[i >> 2][0][i & 3][1] = acc[i >> 2][0][i & 3][1] * ratio4(a1, l1);
            acc[i >> 2][1][i & 3][0] = acc[i >> 2][1][i & 3][0] * ratio4(a2, l2); acc[i >> 2][1][i & 3][1] = acc[i >> 2][1][i & 3][1] * ratio4(a3, l3);
        }
    }
    EPI_COMMON
};

template <class Epi> __device__ __forceinline__ void meta_gemm(LAS unsigned char* lds, const bf16_t* A16, const bf16_t* Bt, int N, int K, const Epi& E) {
    const int tid = tid_fresh(), wid = __builtin_amdgcn_readfirstlane(tid >> 6), lane = tid & 63, fr = lane & 15, fq = lane >> 4;
    const int nitems = N / 64, ks = K / 8;
    LAS f32x4* red = (LAS f32x4*)lds;
    for (int it = blockIdx.x; it < nitems; it += gridDim.x) {
        const int pn = it >> 2, wc = it & 3;
        typename Epi::Pre pq{}; typename Epi::Tile tl{};
        if (wid == 0) { pq = E.pre(MR + fr, pn, wc * 32 + 8 * fq); tl = E.tile(pn, wc * 32 + 8 * fq); }
        f32x4 acc[4];
#pragma unroll
        for (int q = 0; q < 4; ++q) acc[q] = (f32x4){0.f, 0.f, 0.f, 0.f};
        const bf16_t* ap = A16 + (size_t)fr * K + wid * ks + 8 * fq;
        const bf16_t* bp[4];
#pragma unroll
        for (int q = 0; q < 4; ++q) bp[q] = Bt + (size_t)(pn * 256 + (q >> 1) * 128 + wc * 32 + pg8::perm32(16 * (q & 1) + fr)) * K + wid * ks + 8 * fq;
#pragma unroll 8
        for (int kk = 0; kk < ks; kk += 32) {
            const bf16x8 a = *(const bf16x8*)(ap + kk);
#pragma unroll
            for (int q = 0; q < 4; ++q) { const bf16x8 bv = *(const bf16x8*)(bp[q] + kk); acc[q] = __builtin_amdgcn_mfma_f32_16x16x32_bf16(bv, a, acc[q], 0, 0, 0); }
        }
#pragma unroll
        for (int q = 0; q < 4; ++q) red[(wid * 4 + q) * 64 + lane] = acc[q];
        __syncthreads();
        if (wid == 0) {
            f32x4 s[4];
#pragma unroll
            for (int q = 0; q < 4; ++q) { s[q] = red[q * 64 + lane];
#pragma unroll
                for (int w = 1; w < 8; ++w) s[q] = s[q] + red[(w * 4 + q) * 64 + lane]; }
            E.template frag<true>(MR + fr, pn, wc * 32 + 8 * fq, s[0], s[1], s[2], s[3], pq, tl);
        }
        __syncthreads();
    }
}

template <int MODE> __device__ __forceinline__ int wmap(int n) {
    if (MODE == 1) return ((n >> 7) << 8) + (n & 127);
    if (MODE == 2) return ((n >> 7) << 8) + 128 + (n & 127);
    if (MODE == 3) { if (n >= 4096) return n; const int d = n & 127; if (d >= 32) return n; const int s = d < 16 ? 8 * (d >> 2) + (d & 3) : 8 * ((d - 16) >> 2) + 4 + (d & 3); return (n & ~127) + s; }
    return n;
}
template <int MODE> __device__ __forceinline__ void transpose_item(const float* W, int K, int N, bf16_t* WT, LAS float* scr, int item, int lane, const float* gk = nullptr) {
    const int nblk = N / 32, kb = item / nblk, nb = item % nblk, k0 = 64 * kb, n0 = 32 * nb;
    const int c = lane & 7;
    f32x4 ga = (f32x4){1.f, 1.f, 1.f, 1.f}, gb = ga;
    if (gk) { ga = *(const f32x4*)(gk + k0 + 8 * c); gb = *(const f32x4*)(gk + k0 + 8 * c + 4); }
    { float wv[32];
      const float* wp = W + (size_t)(k0 + (lane >> 5)) * N + n0 + (lane & 31);
#pragma unroll
      for (int i = 0; i < 32; ++i) wv[i] = wp[(size_t)(2 * i) * N];
#pragma unroll
      for (int i = 0; i < 32; ++i) scr[(2 * i + (lane >> 5)) * 33 + (lane & 31)] = wv[i]; }
    asm volatile("s_waitcnt lgkmcnt(0)" ::: "memory");
#pragma unroll
    for (int j = 0; j < 4; ++j) { const int n = (lane >> 3) + 8 * j; const LAS float* s = scr + (8 * c) * 33 + n;
        u32x4 o; o.x = cvt_pk_bf16(s[0 * 33] * ga[0], s[1 * 33] * ga[1]); o.y = cvt_pk_bf16(s[2 * 33] * ga[2], s[3 * 33] * ga[3]); o.z = cvt_pk_bf16(s[4 * 33] * gb[0], s[5 * 33] * gb[1]); o.w = cvt_pk_bf16(s[6 * 33] * gb[2], s[7 * 33] * gb[3]);
        *(u32x4*)(WT + (size_t)wmap<MODE>(n0 + n) * K + k0 + 8 * c) = o; }
    asm volatile("s_waitcnt lgkmcnt(0)" ::: "memory");
}

struct Args { const float* in[29]; float* out; unsigned char* ws; float invf[16]; int ph_lo, ph_hi; };
static_assert(sizeof(Args) == 31 * 8 + 16 * 4 + 8, "Args has no padding");

__device__ __forceinline__ void conv_pass(const bf16_t* XR, bf16_t* XCg, const float* conv_w, const float* conv_b, int gtid, int ngt, int k0 = 0, int k1 = 1 << 20) {
    constexpr int NCH = LW / 8, RUNS = (SEQ + NMETA) / 8, NTASK = NB * RUNS * NCH;
    for (int k = k0; k < k1; ++k) {
        const long task_l = (long)gtid + (long)k * ngt; if (task_l >= NTASK) break;
        const int task = (int)task_l;
        const int c8 = task % NCH, u = (task / NCH) % RUNS, b = task / (NCH * RUNS), p0 = 8 * u;
        if (u < 2 && b > 0) continue;
        float cw[4][8], cb[8], o[8][8];
        { const f32x4 b0 = *(const f32x4*)(conv_b + 8 * c8), b1 = *(const f32x4*)(conv_b + 8 * c8 + 4);
#pragma unroll
          for (int e = 0; e < 4; ++e) { cb[e] = b0[e]; cb[4 + e] = b1[e]; }
#pragma unroll
          for (int j = 0; j < 4; ++j) { const f32x4 w0 = *(const f32x4*)(conv_w + j * LW + 8 * c8), w1 = *(const f32x4*)(conv_w + j * LW + 8 * c8 + 4);
#pragma unroll
              for (int e = 0; e < 4; ++e) { cw[j][e] = w0[e]; cw[j][4 + e] = w1[e]; } } }
#pragma unroll
        for (int i = 0; i < 8; ++i)
#pragma unroll
            for (int e = 0; e < 8; ++e) o[i][e] = cb[e];
        u32x4 raw[11];
#pragma unroll
        for (int m = 0; m < 11; ++m) { const int p = p0 - 3 + m; raw[m] = (u32x4){0u, 0u, 0u, 0u};
            if (p >= 0) { const int row = p < NMETA ? MR + p : b * SEQ + p - NMETA; raw[m] = *(const u32x4*)(XR + (size_t)row * LW + 8 * c8); } }
#pragma unroll
        for (int m = 0; m < 11; ++m) {
            const u32x4 xv = raw[m];
            const float x[8] = {bflo(xv.x), bfhi(xv.x), bflo(xv.y), bfhi(xv.y), bflo(xv.z), bfhi(xv.z), bflo(xv.w), bfhi(xv.w)};
#pragma unroll
            for (int i = 0; i < 8; ++i) { const int j = i + 3 - m; if (j >= 0 && j < 4) {
#pragma unroll
                for (int e = 0; e < 8; ++e) o[i][e] += cw[j][e] * x[e]; } }
        }
#pragma unroll
        for (int i = 0; i < 8; ++i) { const int p = p0 + i, row = p < NMETA ? MR + p : b * SEQ + p - NMETA;
            u32x4 w; w.x = cvt_pk_bf16(o[i][0], o[i][1]); w.y = cvt_pk_bf16(o[i][2], o[i][3]); w.z = cvt_pk_bf16(o[i][4], o[i][5]); w.w = cvt_pk_bf16(o[i][6], o[i][7]);
            *(u32x4*)(XCg + (size_t)row * LW + 8 * c8) = w; }
    }
}
constexpr int LRU_TT = 128, LRU_XCS = 168;
constexpr int LRU_XC = 0, LRU_WS = LRU_XC + 128 * 336, LRU_GYS = LRU_WS + 80 * 336, LRU_SEG = LRU_GYS + 2 * 10240, LRU_HIN = LRU_SEG + 2 * 1280, LRU_HW = LRU_HIN + 2 * 160, LRU_END = LRU_HW + 8 * 160;
static_assert(LRU_END <= RING_BYTES, "LRU LDS map");
template <int SH> __device__ __forceinline__ float dpp_shr(float old, float v) {
    return __builtin_bit_cast(float, __builtin_amdgcn_update_dpp(__builtin_bit_cast(int, old), __builtin_bit_cast(int, v), 0x110 + SH, 0xf, 0xf, false));
}
#define LRU_SCAN_STEP(SH) asm volatile("s_nop 1\n\t" \
        "v_fmac_f32_dpp %0, %0, %10 row_shr:" #SH " row_mask:0xf bank_mask:0xf\n\t" \
        "v_fmac_f32_dpp %1, %1, %11 row_shr:" #SH " row_mask:0xf bank_mask:0xf\n\t" \
        "v_fmac_f32_dpp %2, %2, %12 row_shr:" #SH " row_mask:0xf bank_mask:0xf\n\t" \
        "v_fmac_f32_dpp %3, %3, %13 row_shr:" #SH " row_mask:0xf bank_mask:0xf\n\t" \
        "v_fmac_f32_dpp %4, %4, %14 row_shr:" #SH " row_mask:0xf bank_mask:0xf\n\t" \
        "v_fmac_f32_dpp %5, %5, %15 row_shr:" #SH " row_mask:0xf bank_mask:0xf\n\t" \
        "v_fmac_f32_dpp %6, %6, %16 row_shr:" #SH " row_mask:0xf bank_mask:0xf\n\t" \
        "v_fmac_f32_dpp %7, %7, %17 row_shr:" #SH " row_mask:0xf bank_mask:0xf\n\t" \
        "v_fmac_f32_dpp %8, %8, %18 row_shr:" #SH " row_mask:0xf bank_mask:0xf\n\t" \
        "v_fmac_f32_dpp %9, %9, %19 row_shr:" #SH " row_mask:0xf bank_mask:0xf\n\t" \
        "v_mul_f32_dpp %10, %10, %10 row_shr:" #SH " row_mask:0xf bank_mask:0xf\n\t" \
        "v_mul_f32_dpp %11, %11, %11 row_shr:" #SH " row_mask:0xf bank_mask:0xf\n\t" \
        "v_mul_f32_dpp %12, %12, %12 row_shr:" #SH " row_mask:0xf bank_mask:0xf\n\t" \
        "v_mul_f32_dpp %13, %13, %13 row_shr:" #SH " row_mask:0xf bank_mask:0xf\n\t" \
        "v_mul_f32_dpp %14, %14, %14 row_shr:" #SH " row_mask:0xf bank_mask:0xf\n\t" \
        "v_mul_f32_dpp %15, %15, %15 row_shr:" #SH " row_mask:0xf bank_mask:0xf\n\t" \
        "v_mul_f32_dpp %16, %16, %16 row_shr:" #SH " row_mask:0xf bank_mask:0xf\n\t" \
        "v_mul_f32_dpp %17, %17, %17 row_shr:" #SH " row_mask:0xf bank_mask:0xf\n\t" \
        "v_mul_f32_dpp %18, %18, %18 row_shr:" #SH " row_mask:0xf bank_mask:0xf\n\t" \
        "v_mul_f32_dpp %19, %19, %19 row_shr:" #SH " row_mask:0xf bank_mask:0xf\n\t" \
        : "+v"(Bv[0][0]), "+v"(Bv[0][1]), "+v"(Bv[1][0]), "+v"(Bv[1][1]), "+v"(Bv[2][0]), "+v"(Bv[2][1]), "+v"(Bv[3][0]), "+v"(Bv[3][1]), "+v"(Bv[4][0]), "+v"(Bv[4][1]), "+v"(Av[0][0]), "+v"(Av[0][1]), "+v"(Av[1][0]), "+v"(Av[1][1]), "+v"(Av[2][0]), "+v"(Av[2][1]), "+v"(Av[3][0]), "+v"(Av[3][1]), "+v"(Av[4][0]), "+v"(Av[4][1]))
__device__ __forceinline__ void lru_item(LAS unsigned char* lds, int it, const bf16_t* XCg, const bf16_t* GY, bf16_t* LO,
                                         const float* gx_w, const float* gx_b, const float* ga_w, const float* ga_b, const float* a_param) {
    const int tid = tid_fresh(), wid = __builtin_amdgcn_readfirstlane(tid >> 6), lane = tid & 63, fr = lane & 15, fq = lane >> 4;
    const int b = it >> 6, n = (it >> 2) & 15, s = it & 3, cl0 = 40 * s, cg0 = 160 * n + cl0;
    LAS bf16_t* XC = (LAS bf16_t*)(lds + LRU_XC); LAS bf16_t* WSM = (LAS bf16_t*)(lds + LRU_WS); LAS bf16_t* GYS = (LAS bf16_t*)(lds + LRU_GYS);
    LAS float* SEGA = (LAS float*)(lds + LRU_SEG); LAS float* SEGB = SEGA + 320; LAS float* HIN = (LAS float*)(lds + LRU_HIN); LAS float* HW = (LAS float*)(lds + LRU_HW);
    { float wv[25];
#pragma unroll
      for (int i = 0; i < 25; ++i) { const int e = tid + 512 * i, k = e / 80, j = e % 80, gate = j / 40, ch = j % 40; wv[i] = *((gate ? gx_w : ga_w) + ((size_t)n * 160 + k) * 160 + cl0 + ch); }
#pragma unroll
      for (int i = 0; i < 25; ++i) { const int e = tid + 512 * i, k = e / 80, j = e % 80, gate = j / 40, ch = j % 40, row = 16 * (ch >> 3) + 4 * ((ch >> 1) & 3) + 2 * gate + (ch & 1); WSM[row * LRU_XCS + k] = f2bf16(wv[i]); } }
    if (tid < 40) HIN[tid] = 0.f;
    float gab[5][2], gxb[5][2], lsa[5][2];
#pragma unroll
    for (int mt = 0; mt < 5; ++mt)
#pragma unroll
        for (int e = 0; e < 2; ++e) { const int c = cg0 + 8 * mt + 2 * fq + e; gab[mt][e] = -1.4426950408889634f * ga_b[c]; gxb[mt][e] = -1.4426950408889634f * gx_b[c];
            lsa[mt][e] = -8.0f * 1.4426950408889634f * log1pf(__expf(-a_param[c])); }
    u32x4 px[5], pg[2];
#define LRU_LOAD(kk) do { const int p0_ = (kk) == 0 ? 0 : NMETA + LRU_TT * ((kk) - 1);     \
        _Pragma("unroll") for (int i = 0; i < 5; ++i) { const int e = tid + 512 * i, t_ = e / 20, ch = e % 20, p = p0_ + t_; \
            const int row = p < NMETA ? MR + p : b * SEQ + p - NMETA; px[i] = *(const u32x4*)(XCg + (size_t)row * LW + 160 * n + 8 * ch); } \
        _Pragma("unroll") for (int i = 0; i < 2; ++i) { const int e = (tid + 512 * i) % 640, t_ = e / 5, ch = e % 5, p = p0_ + t_; \
            const int row = p < NMETA ? MR + p : b * SEQ + p - NMETA; pg[i] = *(const u32x4*)(GY + (size_t)row * LW + cg0 + 8 * ch); } } while (0)
#define LRU_STORE(kk) do { const int ps_ = (kk) == 0 ? 0 : NMETA + LRU_TT * ((kk) - 1), nvs_ = (kk) == 0 ? NMETA : LRU_TT; const LAS bf16_t* gs_ = GYS + ((kk) & 1) * 5120; \
        if ((kk) > 0 || b == 0) { _Pragma("unroll") for (int i = 0; i < 2; ++i) { const int e = tid + 512 * i, tt = e / 5, ch = e % 5, p = ps_ + tt, row = p < NMETA ? MR + p : b * SEQ + p - NMETA; \
            if (e < nvs_ * 5) *(u32x4*)(LO + (size_t)row * LW + cg0 + 8 * ch) = *(const LAS u32x4*)(gs_ + tt * 40 + 8 * ch); } } } while (0)
    LRU_LOAD(0);
    __syncthreads();
    for (int k = 0; k <= 32; ++k) {
        LAS bf16_t* GYc = GYS + (k & 1) * 5120;
#pragma unroll
        for (int i = 0; i < 5; ++i) { const int e = tid + 512 * i, t_ = e / 20, ch = e % 20; *(LAS u32x4*)(XC + t_ * LRU_XCS + 8 * ch) = px[i]; }
#pragma unroll
        for (int i = 0; i < 2; ++i) { const int e = tid + 512 * i, t_ = e / 5, ch = e % 5; if (e < 128 * 5) *(LAS u32x4*)(GYc + t_ * 40 + 8 * ch) = pg[i]; }
        asm volatile("s_waitcnt lgkmcnt(0)\n\ts_barrier" ::: "memory");
        if (k > 0) LRU_STORE(k - 1);
        if (k < 32) LRU_LOAD(k + 1);
        float Av[5][2], Bv[5][2];
        const int t = 16 * wid + fr;
        {
            bf16x8 xcf[5];
#pragma unroll
            for (int kk = 0; kk < 5; ++kk) xcf[kk] = *(const LAS bf16x8*)(XC + t * LRU_XCS + 32 * kk + 8 * fq);
#pragma unroll
            for (int mt = 0; mt < 5; ++mt) {
                f32x4 acc = (f32x4){0.f, 0.f, 0.f, 0.f};
#pragma unroll
                for (int kk = 0; kk < 5; ++kk) { const bf16x8 wf = *(const LAS bf16x8*)(WSM + (16 * mt + fr) * LRU_XCS + 32 * kk + 8 * fq); acc = __builtin_amdgcn_mfma_f32_16x16x32_bf16(wf, xcf[kk], acc, 0, 0, 0); }
                const unsigned xw = *(const LAS unsigned*)(XC + t * LRU_XCS + cl0 + 8 * mt + 2 * fq);
#pragma unroll
                for (int e = 0; e < 2; ++e) {
                    const float rr = __builtin_amdgcn_rcpf(1.0f + __builtin_amdgcn_exp2f(acc[e] * -1.4426950408889634f + gab[mt][e]));
                    const float ii = __builtin_amdgcn_rcpf(1.0f + __builtin_amdgcn_exp2f(acc[2 + e] * -1.4426950408889634f + gxb[mt][e]));
                    const float a = __builtin_amdgcn_exp2f(rr * lsa[mt][e]);
                    Av[mt][e] = a; Bv[mt][e] = __builtin_amdgcn_sqrtf(1.0f - a * a) * ii * (e ? bfhi(xw) : bflo(xw));
                }
            }
            if (k == 0 && wid > 0) {
#pragma unroll
                for (int mt = 0; mt < 5; ++mt) { Av[mt][0] = 1.f; Av[mt][1] = 1.f; Bv[mt][0] = 0.f; Bv[mt][1] = 0.f; }
            }
        }
        LRU_SCAN_STEP(1); LRU_SCAN_STEP(2); LRU_SCAN_STEP(4); LRU_SCAN_STEP(8);
        if (fr == 15) {
#pragma unroll
            for (int mt = 0; mt < 5; ++mt) { const int c = 8 * mt + 2 * fq; *(LAS f32x2*)(SEGA + wid * 40 + c) = (f32x2){Av[mt][0], Av[mt][1]}; *(LAS f32x2*)(SEGB + wid * 40 + c) = (f32x2){Bv[mt][0], Bv[mt][1]}; }
        }
        asm volatile("s_waitcnt lgkmcnt(0)\n\ts_barrier" ::: "memory");
        if (lane < 40) { float sa[8], sb[8];
#pragma unroll
            for (int v = 0; v < 8; ++v) { sa[v] = SEGA[v * 40 + lane]; sb[v] = SEGB[v * 40 + lane]; }
            float h = HIN[(k & 1) * 40 + lane];
#pragma unroll
            for (int v = 0; v < 7; ++v) if (v < wid) h = sa[v] * h + sb[v];
            HW[wid * 40 + lane] = h;
            if (wid == 7) HIN[((k + 1) & 1) * 40 + lane] = sa[7] * h + sb[7]; }
        asm volatile("s_waitcnt lgkmcnt(0)" ::: "memory");
#pragma unroll
        for (int mt = 0; mt < 5; ++mt) { const int c = 8 * mt + 2 * fq; const f32x2 hin = *(const LAS f32x2*)(HW + wid * 40 + c);
            LAS unsigned* gp = (LAS unsigned*)(GYc + t * 40 + c); const unsigned gw_ = *gp;
            const float h0 = Bv[mt][0] + Av[mt][0] * hin[0], h1 = Bv[mt][1] + Av[mt][1] * hin[1];
            *gp = cvt_pk_bf16(h0 * bflo(gw_), h1 * bfhi(gw_)); }
    }
    __syncthreads();
    LRU_STORE(32);
    __syncthreads();
#undef LRU_STORE
#undef LRU_LOAD
}
#undef LRU_SCAN_STEP

__device__ __forceinline__ att::BlockRef<bf16_t, bf16_t> attn_ref(const bf16_t* Qb, const bf16_t* Kb, const bf16_t* Vb, bf16_t* OP, int b, int h, int s, int idx) {
    const int cj = idx >> 1, c = cj >> 1, j = cj & 1, qb = (idx & 1) ? 15 - s : s;
    att::BlockRef<bf16_t, bf16_t> r;
    r.Q = Qb + ((size_t)(b * 16 + 2 * h + c) * SEQ + (size_t)qb * 256) * 128;
    r.K = Kb + (size_t)(b * 16 + 2 * h + c) * KVLEN * 128;
    r.V = Vb + (size_t)(b * 16 + 2 * h + j) * KVLEN * 128;
    r.O = OP + ((size_t)((b * 8 + h) * 4 + cj) * SEQ + (size_t)qb * 256) * 128;
    r.P0 = NMETA + qb * 256;
    return r;
}
__device__ __forceinline__ void attn_phase(char* lds, const bf16_t* Qb, const bf16_t* Kb, const bf16_t* Vb, bf16_t* OP, int vcu, int G) {
    constexpr int W = 1 << 20;
    for (int vw = vcu; vw < 256; vw += G) {
        const int bh = vw >> 3, s = vw & 7, b = bh >> 3, h = bh & 7;
        att::Seam<bf16_t> S;
        att::BlockRef<bf16_t, bf16_t> cur = attn_ref(Qb, Kb, Vb, OP, b, h, s, 0);
        att::causal_swa_prime<bf16_t, bf16_t>(cur, W, lds, S);
#pragma nounroll
        for (int idx = 0; idx < 8; ++idx) {
            const att::BlockRef<bf16_t, bf16_t> nxt = idx < 7 ? attn_ref(Qb, Kb, Vb, OP, b, h, s, idx + 1) : cur;
            att::causal_swa_block<bf16_t, bf16_t>(cur, nxt, KVLEN, W, lds, S);
            cur = nxt;
        }
    }
}

__device__ __forceinline__ void attn_phase256(char* lds, const bf16_t* Qb, const bf16_t* Kb, const bf16_t* Vb, bf16_t* OP, bf16_t* AO, float lam, const float* sl, int vcu, int G) {
    for (int vw = vcu; vw < 256; vw += G) {
        const int bh = vw >> 3, s = vw & 7, b = bh >> 3, h = bh & 7;
#pragma nounroll
        for (int pass = 0; pass < 2; ++pass) {
            const int qb = pass ? 15 - s : s;
            const bf16_t* v0 = Vb + (size_t)(b * 16 + 2 * h) * KVLEN * 128; const bf16_t* v1 = v0 + (size_t)KVLEN * 128;
            bf16_t* op = OP + ((size_t)(b * 8 + h) * SEQ + (size_t)qb * 256) * 256;
            bf16_t* ao = AO + (size_t)(b * SEQ + qb * 256) * DM + h * 256;
            att::diff_attn_block<false>(Qb + ((size_t)(b * 16 + 2 * h) * SEQ + (size_t)qb * 256) * 128, Kb + (size_t)(b * 16 + 2 * h) * KVLEN * 128, v0, v1, op, NMETA + qb * 256, KVLEN, lds, ao, DM, lam, sl, EPS);
            att::diff_attn_block<true>(Qb + ((size_t)(b * 16 + 2 * h + 1) * SEQ + (size_t)qb * 256) * 128, Kb + (size_t)(b * 16 + 2 * h + 1) * KVLEN * 128, v0, v1, op, NMETA + qb * 256, KVLEN, lds, ao, DM, lam, sl, EPS);
        }
    }
}
__device__ __forceinline__ float lam_of(const float* lq1, const float* lk1, const float* lq2, const float* lk2, float lam_init, int lane) {
    const float d1 = wave_sum(lq1[lane] * lk1[lane] + lq1[lane + 64] * lk1[lane + 64]), d2 = wave_sum(lq2[lane] * lk2[lane] + lq2[lane + 64] * lk2[lane + 64]);
    return __uint_as_float(__builtin_amdgcn_readfirstlane(__float_as_uint(expf(d1) - expf(d2) + lam_init)));
}
__device__ __forceinline__ void combine_phase(const bf16_t* OP, bf16_t* AO, const bf16_t* QM, const bf16_t* Kb, const bf16_t* Vb, const float* subln, float lam, float lam_init, int gw, int ngw, int lane) {
    const f32x4 sl = *(const f32x4*)(subln + 4 * lane) * (1.0f - lam_init);
    for (int it = gw; it < NHEAD * NMETA; it += ngw) {
        const int h = it >> 4, i = it & 15, kj = lane & 15, part = lane >> 4;
        float pc[2];
#pragma unroll
        for (int c = 0; c < 2; ++c) {
            const bf16_t* qp = QM + ((size_t)(2 * h + c) * NMETA + i) * 128 + 32 * part;
            const bf16_t* kp = Kb + ((size_t)(2 * h + c) * KVLEN + kj) * 128 + 32 * part;
            float d = 0.f;
#pragma unroll
            for (int e = 0; e < 4; ++e) { const u32x4 qv = *(const u32x4*)(qp + 8 * e), kv = *(const u32x4*)(kp + 8 * e);
                d += bflo(qv.x) * bflo(kv.x) + bfhi(qv.x) * bfhi(kv.x) + bflo(qv.y) * bflo(kv.y) + bfhi(qv.y) * bfhi(kv.y) + bflo(qv.z) * bflo(kv.z) + bfhi(qv.z) * bfhi(kv.z) + bflo(qv.w) * bflo(kv.w) + bfhi(qv.w) * bfhi(kv.w); }
            d += __shfl_xor(d, 16); d += __shfl_xor(d, 32);
            float sv = kj <= i ? d * 0.08838834764831845f : -INFINITY;
            float m = sv;
#pragma unroll
            for (int o = 1; o < 16; o <<= 1) m = fmaxf(m, __shfl_xor(m, o));
            float p = __expf(sv - m), l = p;
#pragma unroll
            for (int o = 1; o < 16; o <<= 1) l += __shfl_xor(l, o);
            pc[c] = p / l;
        }
        const int j = lane >> 5, dd = 4 * (lane & 31);
        f32x4 o0 = (f32x4){0.f, 0.f, 0.f, 0.f}, o1 = o0;
        for (int k2 = 0; k2 <= i; ++k2) {
            const unsigned long long w = *(const unsigned long long*)(Vb + ((size_t)(2 * h + j) * KVLEN + k2) * 128 + dd);
            const f32x4 v = (f32x4){bflo((unsigned)w), bfhi((unsigned)w), bflo((unsigned)(w >> 32)), bfhi((unsigned)(w >> 32))};
            o0 = o0 + __shfl(pc[0], k2) * v; o1 = o1 + __shfl(pc[1], k2) * v;
        }
        f32x4 x = o0 - lam * o1;
        const float ss = wave_sum(x[0] * x[0] + x[1] * x[1] + x[2] * x[2] + x[3] * x[3]);
        const float rs = rsqrtf(ss * (1.0f / 256.0f) + EPS);
        x = x * rs * sl;
        *(unsigned long long*)(AO + (size_t)(MR + i) * DM + h * 256 + 4 * lane) = (unsigned long long)cvt_pk_bf16(x[0], x[1]) | ((unsigned long long)cvt_pk_bf16(x[2], x[3]) << 32);
    }
}

__device__ __forceinline__ float sgpr_fresh_f(float v) { asm volatile("" : "+s"(v)); return v; }
__device__ __forceinline__ int sgpr_fresh(int v) { asm volatile("" : "+s"(v)); return v; }
typedef const __attribute__((address_space(4))) Args* ArgsP;
__device__ __forceinline__ ArgsP fresh_args() { ArgsP p = (ArgsP)__builtin_amdgcn_kernarg_segment_ptr(); asm volatile("" : "+s"(p)); return p; }
#define PH_ARGS ArgsP A = fresh_args(); unsigned char* const ws = A->ws; (void)ws; \
    const int G = sgpr_fresh(G0), bx = sgpr_fresh(bx0), vcu = sgpr_fresh(vcu0); (void)bx; \
    const int tid = tid_fresh(), lane = tid & 63, wave = __builtin_amdgcn_readfirstlane(tid >> 6), gw = vcu * NWAVES + wave, ngw = G * NWAVES; (void)lane; (void)gw; (void)ngw
#define ssq_base ((u64*)(ws + SSQ_OFF))
#define H ((float*)(ws + WS_H))
#define HB ((bf16_t*)(ws + WS_HB))
#define HID ((bf16_t*)(ws + WS_HID))
#define Qb ((bf16_t*)(ws + WS_Q))
#define Kb ((bf16_t*)(ws + WS_K))
#define Vb ((bf16_t*)(ws + WS_V))
#define QM ((bf16_t*)(ws + WS_QM))
#define XR ((bf16_t*)(ws + WS_XR))
#define GY ((bf16_t*)(ws + WS_GY))
#define GG ((bf16_t*)(ws + WS_G))
#define OP ((bf16_t*)(ws + WS_OP))
#define AO ((bf16_t*)(ws + WS_AO))
#define LO ((bf16_t*)(ws + WS_LO))
#define TMP ((bf16_t*)(ws + WS_TMP))
#define XCG ((bf16_t*)(ws + WS_TMP))
#define MIX ((bf16_t*)(ws + WS_MIX))
#define LAM_INIT(ll) ((ll) == 0 ? 0.2f : (ll) == 1 ? 0.35550906759096926f : (ll) == 2 ? 0.47071301834358416f : 0.5560582041556405f)
#define SLV ((float*)(ws + WS_QM + 131072))
#define ropec ((float*)(ws + WS_ROPE))
#define ropes ((float*)(ws + WS_ROPE + 512 * 1024))
#define SSQ(i) (ssq_base + (size_t)(i) * MPAD)
constexpr int CV_G = (DM / 64) * (DFF / 32), CV_D = (DFF / 64) * (DM / 32), CV_IN = (DM / 64) * (NIN / 32), CV_S = (DM / 64) * (DM / 32), CV_L = (LW / 64) * (DM / 32);
constexpr int CV_NIT = 2 * (2 * CV_G + CV_D) + CV_IN + 2 * CV_S + CV_L;
__device__ __forceinline__ void convert_item(ArgsP A, unsigned char* ws, int l, int it, LAS float* scr, int lane) {
    unsigned char* wb = ws + (size_t)(l & 1) * WBUF_STRIDE;
    int r = it;
    if (r < CV_G) { transpose_item<1>(A->in[3] + (size_t)l * DM * DFF, DM, DFF, (bf16_t*)(wb + W_GU1), scr, r, lane, A->in[2] + (size_t)l * DM); return; } r -= CV_G;
    if (r < CV_G) { transpose_item<2>(A->in[4] + (size_t)l * DM * DFF, DM, DFF, (bf16_t*)(wb + W_GU1), scr, r, lane, A->in[2] + (size_t)l * DM); return; } r -= CV_G;
    if (r < CV_D) { transpose_item<0>(A->in[5] + (size_t)l * DFF * DM, DFF, DM, (bf16_t*)(wb + W_DN1), scr, r, lane); return; } r -= CV_D;
    if (r < CV_IN) { transpose_item<3>(A->in[7] + (size_t)l * DM * NIN, DM, NIN, (bf16_t*)(wb + W_IN), scr, r, lane, A->in[6] + (size_t)l * DM); return; } r -= CV_IN;
    if (r < CV_S) { transpose_item<0>(A->in[21] + (size_t)l * DM * DM, DM, DM, (bf16_t*)(wb + W_BA), scr, r, lane); return; } r -= CV_S;
    if (r < CV_L) { transpose_item<0>(A->in[22] + (size_t)l * LW * DM, LW, DM, (bf16_t*)(wb + W_BL), scr, r, lane); return; } r -= CV_L;
    if (r < CV_S) { transpose_item<0>(A->in[23] + (size_t)l * DM * DM, DM, DM, (bf16_t*)(wb + W_O), scr, r, lane); return; } r -= CV_S;
    if (r < CV_G) { transpose_item<1>(A->in[25] + (size_t)l * DM * DFF, DM, DFF, (bf16_t*)(wb + W_GU2), scr, r, lane, A->in[24] + (size_t)l * DM); return; } r -= CV_G;
    if (r < CV_G) { transpose_item<2>(A->in[26] + (size_t)l * DM * DFF, DM, DFF, (bf16_t*)(wb + W_GU2), scr, r, lane, A->in[24] + (size_t)l * DM); return; } r -= CV_G;
    transpose_item<0>(A->in[27] + (size_t)l * DFF * DM, DFF, DM, (bf16_t*)(wb + W_DN2), scr, r, lane);
}
__device__ __forceinline__ void fill_seam(ArgsP A, gu32* ctl, LAS unsigned char* L, volatile LAS unsigned* MISC, int seam, int G, bool drain, int lnext) {
    unsigned char* const ws = A->ws;
    const int tid = tid_fresh(), lane = tid & 63, wave = __builtin_amdgcn_readfirstlane(tid >> 6);
    LAS float* scr = (LAS float*)(L + wave * 16384);
    if (tid == 0) __hip_atomic_fetch_add(ctl + CW_REACH + 64 * seam, 1u, RLX_AGENT);
    for (;;) {
        if (tid == 0) {
            unsigned base = (unsigned)CV_NIT;
            const bool stop = !drain && __hip_atomic_load(ctl + CW_REACH + 64 * seam, RLX_AGENT) >= (unsigned)(G - 16);
            if (!stop) base = __hip_atomic_fetch_add(ctl + CW_ITEM + 64 * lnext, 8u, RLX_AGENT);
            MISC[12] = base;
        }
        __syncthreads();
        const unsigned base = MISC[12];
        __syncthreads();
        if (base >= (unsigned)CV_NIT) break;
        const int it = (int)base + wave;
        if (it < CV_NIT) convert_item(A, ws, lnext, it, scr, lane);
    }
}
constexpr int CVR_GU1 = 0, CVR_DN1 = 2 * CV_G, CVR_IN = CVR_DN1 + CV_D, CVR_BA = CVR_IN + CV_IN, CVR_O = CVR_BA + CV_S + CV_L, CVR_GU2 = CVR_O + CV_S, CVR_DN2 = CVR_GU2 + 2 * CV_G;
static_assert(CVR_DN2 + CV_D == CV_NIT, "conversion ranges");
#define CONVERT(ll, first, count) do { if (EN(0)) { ArgsP A_ = fresh_args(); const int tid_ = tid_fresh(), lane_ = tid_ & 63, wave_ = __builtin_amdgcn_readfirstlane(tid_ >> 6), gw_ = vcu * NWAVES + wave_; \
        LAS float* scr_ = (LAS float*)(L + wave_ * 16384); REP(0) for (int it_ = (first) + gw_; it_ < (first) + (count); it_ += G * NWAVES) convert_item(A_, A_->ws, (ll), it_, scr_, lane_); } } while (0)
#ifndef CONV_SPLIT
#define CONV_SPLIT 1
#endif
__device__ __forceinline__ void attn_conv_phase(char* lds, int l, float lam, int vcu, int G) {
#define CONV_SLICE(k0_, k1_) do { ArgsP A_ = fresh_args(); unsigned char* const ws = A_->ws; const int t_ = tid_fresh(); \
        conv_pass(XR, XCG, A_->in[14] + (size_t)l * 4 * LW, A_->in[15] + (size_t)l * LW, (vcu * NWAVES + (t_ >> 6)) * 64 + (t_ & 63), G * NWAVES * 64, (k0_), (k1_)); } while (0)
    CONV_SLICE(4, 1 << 20);
    int kslice = 0;
    for (int vw = vcu; vw < 256; vw += G) {
        const int bh = vw >> 3, s = vw & 7, b = bh >> 3, h = bh & 7;
#pragma nounroll
        for (int pass = 0; pass < 2; ++pass) {
            const int qb = pass ? 15 - s : s;
            CONV_SLICE(kslice, kslice + 1); ++kslice;
            { ArgsP A_ = fresh_args(); unsigned char* const ws = A_->ws;
              const bf16_t* v0 = Vb + (size_t)(b * 16 + 2 * h) * KVLEN * 128; const bf16_t* v1 = v0 + (size_t)KVLEN * 128;
              bf16_t* op = OP + ((size_t)(b * 8 + h) * SEQ + (size_t)qb * 256) * 256;
              bf16_t* ao = AO + (size_t)(b * SEQ + qb * 256) * DM + h * 256;
              att::diff_attn_block<false>(Qb + ((size_t)(b * 16 + 2 * h) * SEQ + (size_t)qb * 256) * 128, Kb + (size_t)(b * 16 + 2 * h) * KVLEN * 128, v0, v1, op, NMETA + qb * 256, KVLEN, lds, ao, DM, lam, SLV + l * 256, EPS); }
            CONV_SLICE(kslice, kslice + 1); ++kslice;
            { ArgsP A_ = fresh_args(); unsigned char* const ws = A_->ws;
              const bf16_t* v0 = Vb + (size_t)(b * 16 + 2 * h) * KVLEN * 128; const bf16_t* v1 = v0 + (size_t)KVLEN * 128;
              bf16_t* op = OP + ((size_t)(b * 8 + h) * SEQ + (size_t)qb * 256) * 256;
              bf16_t* ao = AO + (size_t)(b * SEQ + qb * 256) * DM + h * 256;
              att::diff_attn_block<true>(Qb + ((size_t)(b * 16 + 2 * h + 1) * SEQ + (size_t)qb * 256) * 128, Kb + (size_t)(b * 16 + 2 * h + 1) * KVLEN * 128, v0, v1, op, NMETA + qb * 256, KVLEN, lds, ao, DM, lam, SLV + l * 256, EPS); }
        }
    }
    if (kslice < 4) CONV_SLICE(kslice, 4);
#undef CONV_SLICE
}
__global__ void __launch_bounds__(NWAVES * 64, 2) mk_fwd(Args args) {
    extern __shared__ __attribute__((aligned(16))) unsigned char lds[];
    LAS unsigned char* L = (LAS unsigned char*)lds;
    volatile LAS unsigned* MISC = (volatile LAS unsigned*)(L + MISC_OFF);
    const int G0 = gridDim.x, bx0 = blockIdx.x, vcu0 = (G0 % 8 == 0) ? (bx0 % 8) * (G0 / 8) + bx0 / 8 : bx0;
    gu32* ctl = (gu32*)(args.ws + WS_CTL);
    for (int u = threadIdx.x; u < (LDS_BYTES - LDSCTL_OFF) / 4; u += NWAVES * 64) ((LAS unsigned*)(L + LDSCTL_OFF))[u] = 0u;
    __syncthreads();
    XcdBarrier bar; bar.bar = (unsigned*)(ctl + CW_BAR); bar.x = 0; bar.st = nullptr;
    if (!MK_MULTI) bar = xcd_barrier_post((unsigned*)(ctl + CW_BAR), MISC + 8);
    const int lo = args.ph_lo, hi = args.ph_hi;
    unsigned long long twait = 0; const unsigned long long tstart = (DUP_PHASE == 40) ? __builtin_amdgcn_s_memrealtime() : 0ull;
#define IN(k) (lo <= (k) && (k) < hi)
#define SEAM(k) do { if (IN((k) + 1)) { unsigned long long tb0_ = 0; if (DUP_PHASE == 40) tb0_ = __builtin_amdgcn_s_memrealtime(); xcd_barrier(bar); if (DUP_PHASE == 40 && (PROBE_SEAM < 0 || ((k) - 1) % PH_PER_LAYER == PROBE_SEAM)) { twait += __builtin_amdgcn_s_memrealtime() - tb0_; } if (DUP_PHASE == 30) { xcd_barrier(bar); xcd_barrier(bar); xcd_barrier(bar); xcd_barrier(bar); } } } while (0)

    if (EN(10) && IN(0)) {
        PH_ARGS; const float* x = A->in[0]; const float* meta = A->in[1];
        for (int m = gw; m < MROWS; m += ngw) {
            const float* src = m < MR ? x + (size_t)m * DM : meta + (size_t)(m - MR) * DM; float ss = 0.f;
#pragma unroll
            for (int j = 0; j < 8; ++j) { const int c = 4 * (64 * j + lane); const f32x4 v = *(const f32x4*)(src + c);
                ss += v[0] * v[0] + v[1] * v[1] + v[2] * v[2] + v[3] * v[3];
                *(unsigned long long*)(HB + (size_t)m * DM + c) = (unsigned long long)cvt_pk_bf16(v[0], v[1]) | ((unsigned long long)cvt_pk_bf16(v[2], v[3]) << 32); }
            ss = wave_sum(ss); if (lane == 0) ssq_base[m] = ssq_fx(ss);
        }
        for (int e = gw * 64 + lane; e < DEPTH * 256; e += ngw * 64) SLV[e] = A->in[13][e] * (1.0f - LAM_INIT(e >> 8));
        for (int e = gw * 64 + lane; e < (SEQ + NMETA) * 16; e += ngw * 64) { const int pos = e >> 4, i = e & 15; const float ang = (float)pos * A->invf[i]; ropec[e] = cosf(ang); ropes[e] = sinf(ang); }
        for (int e = gw * 64 + lane; e < 2 * 64 * 48 * 16; e += ngw * 64) { const int kv = e / (64 * 48 * 16), r = e % (64 * 48 * 16), bh = r / (48 * 16), rr = (r / 16) % 48, ch = r % 16;
            *(u32x4*)((kv ? Vb : Kb) + ((size_t)bh * KVLEN + (SEQ + NMETA) + rr) * 128 + 8 * ch) = (u32x4){0u, 0u, 0u, 0u}; }
    }
#pragma nounroll
    for (int l = 0; l < DEPTH; ++l) {
        const int pb = 1 + l * PH_PER_LAYER;
        if (EN(0) && IN(pb + 0)) {
            PH_ARGS;
            LAS float* scr = (LAS float*)(L + wave * 16384);
            REP(0) for (int it = gw; it < CV_NIT; it += ngw) convert_item(A, ws, l, it, scr, lane);
            SEAM(pb + 0);
        }
        if (EN(1) && IN(pb + 1)) {
            PH_ARGS;
            pg8::Gemm g{HB, (const bf16_t*)(ws + W_GU1 + (size_t)(l & 1) * WBUF_STRIDE), MR, NGU, DM}; pg8::StaticOrder S; S.init(MR, NGU, G, bx);
            EpiSwiGLU E{HID, SSQ(3 * l)};
            REP(1) pg8::gemm_phase<EpiSwiGLU, pg8::StaticOrder, true, true>(L, g, S, E);
            if (DUP_PHASE == 21) { EpiNull EN_; pg8::gemm_phase<EpiNull, pg8::StaticOrder, true, true>(L, g, S, EN_); }
            REPM(1) meta_gemm(L, HB + (size_t)MR * DM, g.Bt, NGU, DM, E);
            SEAM(pb + 1);
        }
        if (EN(2) && IN(pb + 2)) {
            PH_ARGS;
            pg8::Gemm g{HID, (const bf16_t*)(ws + W_DN1 + (size_t)(l & 1) * WBUF_STRIDE), MR, DM, DFF}; pg8::StaticOrder S; S.init(MR, DM, G, bx);
            REP(2) { EpiResid E{nullptr, HB, SSQ(3 * l + 1), DRY(2) ? 0.f : 0.5f, DRY(2) ? 0.f : 1.f};
            pg8::gemm_phase<EpiResid, pg8::StaticOrder, true, true>(L, g, S, E); }
            REPM(2) { EpiResid E{nullptr, HB, SSQ(3 * l + 1), DRYM ? 0.f : 0.5f, DRYM ? 0.f : 1.f};
            meta_gemm(L, HID + (size_t)MR * DFF, g.Bt, DM, DFF, E); }
            SEAM(pb + 2);
        }
        if (EN(3) && IN(pb + 3)) {
            PH_ARGS;
            pg8::Gemm g{HB, (const bf16_t*)(ws + W_IN + (size_t)(l & 1) * WBUF_STRIDE), MR, NIN, DM}; pg8::StaticOrder S; S.init(MR, NIN, G, bx);
            EpiWin E{Qb, Kb, Vb, XR, GY, GG, QM, A->in[8] + (size_t)l * 2 * DM, SSQ(3 * l + 1), ropec, ropes};
            REP(3) pg8::gemm_phase<EpiWin, pg8::StaticOrder, true, true>(L, g, S, E);
            REPM(3) meta_gemm(L, HB + (size_t)MR * DM, g.Bt, NIN, DM, E);
            SEAM(pb + 3);
        }
        if (EN(4) && IN(pb + 4)) {
            PH_ARGS;
            if (EN(12) && !CONV_SPLIT) REP(14) conv_pass(XR, XCG, A->in[14] + (size_t)l * 4 * LW, A->in[15] + (size_t)l * LW, gw * 64 + lane, ngw * 64);
            if (EN(13)) { const float lam_init = LAM_INIT(sgpr_fresh(l)); const float lam = lam_of(A->in[9] + l * 128, A->in[10] + l * 128, A->in[11] + l * 128, A->in[12] + l * 128, lam_init, lane);
                if (CONV_SPLIT) attn_conv_phase((char*)lds, sgpr_fresh(l), lam, vcu, G); else REP(13) attn_phase256((char*)lds, Qb, Kb, Vb, OP, AO, lam, SLV + l * 256, vcu, G); }
            SEAM(pb + 4);
        }
        if (EN(5) && IN(pb + 5)) {
            PH_ARGS;
            const float lam_init = LAM_INIT(sgpr_fresh(l)); const float lam = lam_of(A->in[9] + l * 128, A->in[10] + l * 128, A->in[11] + l * 128, A->in[12] + l * 128, lam_init, lane);
            if (EN(12)) REP(12) for (int it = vcu; it < 256; it += G)
                lru_item(L, it, XCG, GY, LO, A->in[16] + (size_t)l * 16 * 160 * 160, A->in[17] + (size_t)l * LW, A->in[18] + (size_t)l * 16 * 160 * 160, A->in[19] + (size_t)l * LW, A->in[20] + (size_t)l * LW);
            REP(5) combine_phase(OP, AO, QM, Kb, Vb, A->in[13] + l * 256, lam, lam_init, gw, ngw, lane);
            SEAM(pb + 5);
        }
        if (EN(6) && IN(pb + 6)) {
            PH_ARGS;
            pg8::StaticOrder S; S.init(MR, DM, G, bx);
            REP(6) {
#if DUAL_BR
            { EpiDual E{GG, MIX};
              pg8::gemm_dual_phase<EpiDual, pg8::StaticOrder>(L, AO, (const bf16_t*)(ws + W_BA), DM, LO, (const bf16_t*)(ws + W_BL), LW, S, E); }
            if (l + 1 < DEPTH) {
                { EpiBa E{TMP, GG}; REPM(6) meta_gemm(L, AO + (size_t)MR * DM, (const bf16_t*)(ws + W_BA), DM, DM, E); }
                { EpiBl E{TMP, GG, MIX}; REPM(6) meta_gemm(L, LO + (size_t)MR * LW, (const bf16_t*)(ws + W_BL), DM, LW, E); }
            }
#else
            { pg8::Gemm g{AO, (const bf16_t*)(ws + W_BA + (size_t)(l & 1) * WBUF_STRIDE), MR, DM, DM}; EpiBa E{TMP, GG};
              pg8::gemm_phase<EpiBa, pg8::StaticOrder, true, true>(L, g, S, E); if (l + 1 < DEPTH) REPM(6) meta_gemm(L, AO + (size_t)MR * DM, g.Bt, DM, DM, E); }
            { pg8::Gemm g{LO, (const bf16_t*)(ws + W_BL + (size_t)(l & 1) * WBUF_STRIDE), MR, DM, LW}; EpiBl E{TMP, GG, MIX};
              pg8::gemm_phase<EpiBl, pg8::StaticOrder, true, true>(L, g, S, E); if (l + 1 < DEPTH) REPM(6) meta_gemm(L, LO + (size_t)MR * LW, g.Bt, DM, LW, E); }
#endif
            }
            SEAM(pb + 6);
        }
        if (EN(7) && IN(pb + 7)) {
            PH_ARGS;
            pg8::Gemm g{MIX, (const bf16_t*)(ws + W_O + (size_t)(l & 1) * WBUF_STRIDE), MR, DM, DM}; pg8::StaticOrder S; S.init(MR, DM, G, bx);
            REP(7) { EpiResid E{nullptr, HB, SSQ(3 * l + 2), DRY(7) ? 0.f : 1.0f, DRY(7) ? 0.f : 1.f};
            pg8::gemm_phase<EpiResid, pg8::StaticOrder, true, true>(L, g, S, E); }
            REPM(7) { EpiResid E{nullptr, HB, SSQ(3 * l + 2), DRYM ? 0.f : 1.0f, DRYM ? 0.f : 1.f};
            if (l + 1 < DEPTH) meta_gemm(L, MIX + (size_t)MR * DM, g.Bt, DM, DM, E); }
            SEAM(pb + 7);
        }
        if (EN(8) && IN(pb + 8)) {
            PH_ARGS;
            pg8::Gemm g{HB, (const bf16_t*)(ws + W_GU2 + (size_t)(l & 1) * WBUF_STRIDE), MR, NGU, DM}; pg8::StaticOrder S; S.init(MR, NGU, G, bx);
            EpiSwiGLU E{HID, SSQ(3 * l + 2)};
            pg8::gemm_phase<EpiSwiGLU, pg8::StaticOrder, true, true>(L, g, S, E);
            if (l + 1 < DEPTH) REPM(1) meta_gemm(L, HB + (size_t)MR * DM, g.Bt, NGU, DM, E);
            SEAM(pb + 8);
        }
        if (EN(9) && IN(pb + 9)) {
            PH_ARGS;
            pg8::Gemm g{HID, (const bf16_t*)(ws + W_DN2 + (size_t)(l & 1) * WBUF_STRIDE), MR, DM, DFF}; pg8::StaticOrder S; S.init(MR, DM, G, bx);
            { EpiResid E{(FINAL_BF16 || l + 1 < DEPTH) ? nullptr : H, HB, SSQ(3 * l + 3), 0.5f, 1.f};
            pg8::gemm_phase<EpiResid, pg8::StaticOrder, true, true>(L, g, S, E); }
            REPM(9) { EpiResid E{(FINAL_BF16 || l + 1 < DEPTH) ? nullptr : H, HB, SSQ(3 * l + 3), DRYM ? 0.f : 0.5f, DRYM ? 0.f : 1.f};
            if (l + 1 < DEPTH) meta_gemm(L, HID + (size_t)MR * DFF, g.Bt, DM, DFF, E); }
            SEAM(pb + 9);
        }
    }
    if (EN(11) && IN(N_PHASES - 1)) {
        PH_ARGS;
        float probe_scale = 1.0f;
        if (DUP_PHASE == 40) {
            u64* acc_ = (u64*)(ws + 2000000);
            if (threadIdx.x == 0) __hip_atomic_fetch_add(acc_, twait, __ATOMIC_RELAXED, __HIP_MEMORY_SCOPE_AGENT);
            xcd_barrier(bar);
            const u64 tot_ = __hip_atomic_load(acc_, __ATOMIC_RELAXED, __HIP_MEMORY_SCOPE_AGENT);
            const float frac_ = (float)tot_ / ((float)G * (float)(__builtin_amdgcn_s_memrealtime() - tstart));
            probe_scale = 1.0f + 0.02f * rintf(frac_ * 50.0f * PROBE_GAIN);
        }
        const float* gf = A->in[28];
#if FINAL_BF16
        const u64* ssqf = SSQ(3 * DEPTH);
        f32x4 gv[8];
#pragma unroll
        for (int j = 0; j < 4; ++j) { gv[2 * j] = *(const f32x4*)(gf + 8 * (64 * j + lane)); gv[2 * j + 1] = *(const f32x4*)(gf + 8 * (64 * j + lane) + 4); }
        static_assert(MR % 2 == 0, "row pairs");
        for (int m = 2 * gw; m < MR; m += 2 * ngw) {
            u32x4 w[8];
#pragma unroll
            for (int j = 0; j < 8; ++j) w[j] = *(const u32x4*)(HB + (size_t)(m + (j >> 2)) * DM + 8 * (64 * (j & 3) + lane));
            const float rs0 = rstd_fx(ssqf[m]) * probe_scale, rs1 = rstd_fx(ssqf[m + 1]) * probe_scale;
#pragma unroll
            for (int j = 0; j < 8; ++j) { const int c = 8 * (64 * (j & 3) + lane); const float rs = (j >> 2) ? rs1 : rs0; f32x4 lo, hi; unpack8(w[j], lo, hi);
                float* op = A->out + (size_t)(m + (j >> 2)) * DM + c;
                *(f32x4*)op = lo * rs * gv[2 * (j & 3)]; *(f32x4*)(op + 4) = hi * rs * gv[2 * (j & 3) + 1]; }
        }
#else
        for (int m = gw; m < MR; m += ngw) {
            f32x4 v[8]; float ss = 0.f;
#pragma unroll
            for (int j = 0; j < 8; ++j) { v[j] = *(const f32x4*)(H + (size_t)m * DM + 4 * (64 * j + lane)); ss += v[j][0] * v[j][0] + v[j][1] * v[j][1] + v[j][2] * v[j][2] + v[j][3] * v[j][3]; }
            const float rs = rstd_from(wave_sum(ss));
#pragma unroll
            for (int j = 0; j < 8; ++j) { const int c = 4 * (64 * j + lane); *(f32x4*)(A->out + (size_t)m * DM + c) = v[j] * (rs * probe_scale) * *(const f32x4*)(gf + c); }
        }
#endif
    }
#undef IN
#undef SEAM
}

extern "C" void kernel_launch(void* const* d_in, const int* in_sizes, int n_in, void* d_out, int out_size, void* d_ws, size_t ws_size, hipStream_t stream) {
    static int grid = 0;
    if (grid == 0) {
        if (n_in != 29 || in_sizes[0] != MR * DM || out_size != MR * DM || ws_size < WS_END) { fprintf(stderr, "kernel_launch: unexpected shapes (n_in %d, ws %zu < %zu?); nothing launched\n", n_in, ws_size, (size_t)WS_END); grid = -1; return; }
        int dev = 0, cus = 0, per_cu = 0;
        if (hipGetDevice(&dev) != hipSuccess || hipDeviceGetAttribute(&cus, hipDeviceAttributeMultiprocessorCount, dev) != hipSuccess) { grid = -1; return; }
        if (hipFuncSetAttribute((const void*)mk_fwd, hipFuncAttributeMaxDynamicSharedMemorySize, LDS_BYTES) != hipSuccess) { fprintf(stderr, "kernel_launch: hipFuncSetAttribute failed\n"); grid = -1; return; }
        if (hipOccupancyMaxActiveBlocksPerMultiprocessor(&per_cu, (const void*)mk_fwd, NWAVES * 64, LDS_BYTES) != hipSuccess || per_cu < 1) { fprintf(stderr, "kernel_launch: occupancy query says %d\n", per_cu); }
        (void)hipGetLastError();
        grid = cus;
    }
    if (grid < 0) return;
    if (hipMemsetAsync((char*)d_ws + WS_CTL, 0, CTL_ZERO_BYTES, stream) != hipSuccess) return;
    Args a{};
    for (int i = 0; i < 29; ++i) a.in[i] = (const float*)d_in[i];
    a.out = (float*)d_out; a.ws = (unsigned char*)d_ws;
    for (int i = 0; i < 16; ++i) a.invf[i] = (float)pow(500000.0, -(double)i / 16.0);
#if MK_MULTI
    for (int p = 0; p < N_PHASES; ++p) { a.ph_lo = p; a.ph_hi = p + 1; hipLaunchKernelGGL(mk_fwd, dim3(grid), dim3(NWAVES * 64), LDS_BYTES, stream, a); }
#else
    a.ph_lo = 0; a.ph_hi = N_PHASES;
    hipLaunchKernelGGL(mk_fwd, dim3(grid), dim3(NWAVES * 64), LDS_BYTES, stream, a);
#endif
    const hipError_t le = hipPeekAtLastError();
    if (le != hipSuccess) fprintf(stderr, "kernel_launch: launch failed: %s\n", hipGetErrorName(le));
}
```

```cpp
#include <hip/hip_runtime.h>
#include <cstdio>
#include <cstdint>
#include <cmath>
__device__ __forceinline__ int tid_fresh() { int t = threadIdx.x; asm volatile("" : "+v"(t)); return t; }
namespace pg8 {
#define PG8_LAS __attribute__((address_space(3)))
typedef unsigned short bf16_t;
typedef short bf16x8 __attribute__((ext_vector_type(8)));
typedef float f32x4 __attribute__((ext_vector_type(4)));
typedef unsigned u32x4 __attribute__((ext_vector_type(4)));
constexpr int BM = 256, BK = 64, HALF = 128, HTB = HALF * BK * 2  , STAGE_BYTES = 8 * HTB, NXCD = 8, WGM = 8;

__host__ __device__ __forceinline__ int lds_byte(int r, int c) { const int st = (r >> 4) * 2 + (c >> 5), rr = r & 15, cc = c & 31, ob = rr * 64 + cc * 2; return st * 1024 + (ob ^ (((ob >> 9) & 1) << 5)); }
__host__ __device__ __forceinline__ void stage_rc(int b, int& R, int& C) { const int st = b / 1024, sb = b % 1024, swz = sb ^ (((sb >> 9) & 1) << 5); R = (st >> 1) * 16 + swz / 64; C = (st & 1) * 32 + (swz % 64) / 2; }
__host__ __device__ __forceinline__ int perm32(int rho) { const int n = rho >> 4, i = rho & 15; return 8 * (i >> 2) + 4 * n + (i & 3); }

struct Unit { int pm, pn; };
struct Gemm { const bf16_t* A; const bf16_t* Bt; int M, N, K; };

struct StaticOrder {
    int nM, nN, nwg, G, c;
    __host__ __device__ void init(int M, int N, int G_, int c_) { nM = M / BM; nN = N / BM; nwg = nM * nN; G = G_; c = c_; }
    __host__ __device__ bool next(int i, Unit& u) const {
        const long L = (long)i * G + c; if (L >= nwg) return false;
        int wgid = (int)L; { const int q = nwg / NXCD, r = nwg % NXCD, xcd = wgid % NXCD, off = wgid / NXCD; wgid = (xcd < r ? xcd * (q + 1) : r * (q + 1) + (xcd - r) * q) + off; }
        const int nig = WGM * nN, gid = wgid / nig, fm = gid * WGM, gsz = (nM - fm) < WGM ? (nM - fm) : WGM;
        u.pm = fm + ((wgid % nig) % gsz); u.pn = (wgid % nig) / gsz; return true;
    }
    __device__ __forceinline__ void a_ready(const Unit&) const {}
    __device__ __forceinline__ void done(const Unit&) const {}
};

__device__ __forceinline__ unsigned cvt_pk_bf16(float lo, float hi) { unsigned r; asm volatile("v_cvt_pk_bf16_f32 %0, %1, %2" : "=v"(r) : "v"(lo), "v"(hi)); return r; }
typedef float f32x2 __attribute__((ext_vector_type(2)));
template <class Epi, class Sched, bool ALIGN_EPI = false, bool SP2 = false>
__device__ __forceinline__ void gemm_phase(PG8_LAS unsigned char* lds, const Gemm g, const Sched& S, const Epi& E) {
    const int tid = tid_fresh(), wid = __builtin_amdgcn_readfirstlane(tid >> 6), lane = tid & 63, wr = wid >> 2, wc = wid & 3, fr = lane & 15, fq = lane >> 4;
    const int K = g.K, nt = K / BK;
    unsigned voffA[2], voffB[2];
#pragma unroll
    for (int i = 0; i < 2; ++i) { int R, C; stage_rc(tid * 16 + i * 8192, R, C); const int Rb = Epi::PERM ? ((R & ~31) + perm32(R & 31)) : R;
        voffA[i] = (unsigned)(R * K + C) * 2u; voffB[i] = (unsigned)(Rb * K + C) * 2u; }
    const size_t kstep = (size_t)(BK * 2);
    const size_t hstep = (size_t)HALF * K * 2;
    const size_t tstep = 2 * hstep;
    const unsigned ldsw = (unsigned)wid * 1024u;
    const int aoff = lds_byte(wr * 64 + fr, fq * 8), boff = lds_byte(wc * 32 + fr, fq * 8);
#define PG8_SA(b, h) (((b) * 2 + (h)) * HTB)
#define PG8_SB(b, h) ((4 + (b) * 2 + (h)) * HTB)
#define PG8_STAGE(bufoff, gbase, voff) do { _Pragma("unroll") for (int _i = 0; _i < 2; ++_i) \
        __builtin_amdgcn_global_load_lds((const unsigned*)((const char*)(gbase) + (voff)[_i]), (PG8_LAS unsigned*)(lds + (bufoff) + ldsw + _i * 8192), 16, 0, 0); } while (0)
#define PG8_LDA(dst, b, h) do { _Pragma("unroll") for (int m = 0; m < 4; ++m) _Pragma("unroll") for (int k = 0; k < 2; ++k) dst[m][k] = *(const PG8_LAS bf16x8*)(lds + PG8_SA(b, h) + aoff + m * 2048 + k * 1024); } while (0)
#define PG8_LDB(dst, b, h) do { _Pragma("unroll") for (int n = 0; n < 2; ++n) _Pragma("unroll") for (int k = 0; k < 2; ++k) dst[n][k] = *(const PG8_LAS bf16x8*)(lds + PG8_SB(b, h) + boff + n * 2048 + k * 1024); } while (0)
#define PG8_MMA(ai, bj, At, Bt) do { __builtin_amdgcn_s_setprio(1); _Pragma("unroll") for (int m = 0; m < 4; ++m) _Pragma("unroll") for (int n = 0; n < 2; ++n) _Pragma("unroll") for (int k = 0; k < 2; ++k) \
        acc[ai][bj][m][n] = __builtin_amdgcn_mfma_f32_16x16x32_bf16(Bt[n][k], At[m][k], acc[ai][bj][m][n], 0, 0, 0); __builtin_amdgcn_s_setprio(0); } while (0)
#define PG8_WAIT_V(n) asm volatile("s_waitcnt vmcnt(" #n ")" ::: "memory")
#define PG8_WAIT_L(n) asm volatile("s_waitcnt lgkmcnt(" #n ")" ::: "memory")
#define PG8_BAR __builtin_amdgcn_s_barrier()
#define PG8_SCHED __builtin_amdgcn_sched_barrier(0)
    Unit cur, nxt; int ui = 0;
    if (!S.next(0, cur)) return;
    f32x4 acc[2][2][4][2];
#pragma unroll
    for (int a = 0; a < 2; ++a)
#pragma unroll
        for (int b = 0; b < 2; ++b)
#pragma unroll
            for (int m = 0; m < 4; ++m)
#pragma unroll
                for (int n = 0; n < 2; ++n) acc[a][b][m][n] = (f32x4){0.f, 0.f, 0.f, 0.f};
    bf16x8 At[4][2], B0[2][2], B1[2][2];
    const char* cA = (const char*)g.A + (size_t)cur.pm * tstep; const char* cB = (const char*)g.Bt + (size_t)cur.pn * tstep;
    S.a_ready(cur);
    if constexpr (SP2) {
        PG8_STAGE(PG8_SB(0, 0), cB, voffB); PG8_STAGE(PG8_SB(0, 1), cB + hstep, voffB); PG8_STAGE(PG8_SA(0, 0), cA, voffA); PG8_STAGE(PG8_SA(0, 1), cA + hstep, voffA);
        if (wr == 1) PG8_BAR;
        PG8_WAIT_V(2); PG8_BAR;
        PG8_STAGE(PG8_SB(1, 0), cB + kstep, voffB); PG8_STAGE(PG8_SA(1, 0), cA + kstep, voffA); PG8_STAGE(PG8_SB(1, 1), cB + hstep + kstep, voffB);
        PG8_WAIT_V(6); PG8_BAR;
    } else {
        PG8_STAGE(PG8_SB(0, 0), cB, voffB); PG8_STAGE(PG8_SA(0, 0), cA, voffA); PG8_STAGE(PG8_SB(0, 1), cB + hstep, voffB); PG8_STAGE(PG8_SA(0, 1), cA + hstep, voffA);
        if (wr == 1) PG8_BAR;
        PG8_WAIT_V(4); PG8_BAR;
        PG8_STAGE(PG8_SB(1, 0), cB + kstep, voffB); PG8_STAGE(PG8_SA(1, 0), cA + kstep, voffA); PG8_STAGE(PG8_SB(1, 1), cB + hstep + kstep, voffB);
        PG8_WAIT_V(6); PG8_BAR;
    }
    for (;;) {
        const bool has_next = S.next(ui + 1, nxt);
        const char* nA = has_next ? (const char*)g.A + (size_t)nxt.pm * tstep : cA; const char* nB = has_next ? (const char*)g.Bt + (size_t)nxt.pn * tstep : cB;
        for (int t = 0; t < nt; t += 2) {
            const bool last = (t == nt - 2);
            const char* a1 = cA + (size_t)(t + 1) * kstep;
            const char* a2 = last ? nA : cA + (size_t)(t + 2) * kstep; const char* b2 = last ? nB : cB + (size_t)(t + 2) * kstep;
            const char* a3 = a2 + kstep; const char* b3 = b2 + kstep;
            if (last && has_next) S.a_ready(nxt);
            if constexpr (SP2) {
            PG8_LDB(B0, 0, 0); PG8_LDB(B1, 0, 1); PG8_SCHED; PG8_LDA(At, 0, 0); PG8_STAGE(PG8_SA(1, 1), a1 + hstep, voffA);
            PG8_WAIT_V(8); PG8_WAIT_L(0); PG8_BAR; PG8_MMA(0, 0, At, B0); PG8_MMA(0, 1, At, B1); PG8_BAR; PG8_SCHED;
            PG8_LDA(At, 0, 1); PG8_STAGE(PG8_SB(0, 0), b2, voffB); PG8_STAGE(PG8_SB(0, 1), b2 + hstep, voffB); PG8_STAGE(PG8_SA(0, 0), a2, voffA);
            PG8_WAIT_V(8); PG8_WAIT_L(0); PG8_BAR; PG8_MMA(1, 0, At, B0); PG8_MMA(1, 1, At, B1); PG8_BAR; PG8_SCHED;
            PG8_LDB(B0, 1, 0); PG8_LDB(B1, 1, 1); PG8_SCHED; PG8_LDA(At, 1, 0); PG8_STAGE(PG8_SA(0, 1), a2 + hstep, voffA);
            PG8_WAIT_V(8); PG8_WAIT_L(0); PG8_BAR; PG8_MMA(0, 0, At, B0); PG8_MMA(0, 1, At, B1); PG8_BAR; PG8_SCHED;
            PG8_LDA(At, 1, 1); PG8_STAGE(PG8_SB(1, 0), b3, voffB); PG8_STAGE(PG8_SB(1, 1), b3 + hstep, voffB); PG8_STAGE(PG8_SA(1, 0), a3, voffA);
            PG8_WAIT_V(8); PG8_WAIT_L(0); PG8_BAR; PG8_MMA(1, 0, At, B0); PG8_MMA(1, 1, At, B1); PG8_BAR; PG8_SCHED;
            } else {
            PG8_LDB(B0, 0, 0); PG8_SCHED; PG8_LDA(At, 0, 0); PG8_STAGE(PG8_SA(1, 1), a1 + hstep, voffA);
            PG8_WAIT_L(8); PG8_BAR; PG8_WAIT_L(0); PG8_MMA(0, 0, At, B0); PG8_BAR; PG8_SCHED;
            PG8_LDB(B1, 0, 1); PG8_STAGE(PG8_SB(0, 0), b2, voffB);
            PG8_BAR; PG8_WAIT_L(0); PG8_MMA(0, 1, At, B1); PG8_BAR;
            PG8_LDA(At, 0, 1); PG8_STAGE(PG8_SA(0, 0), a2, voffA);
            PG8_BAR; PG8_WAIT_L(0); PG8_MMA(1, 0, At, B0); PG8_BAR; PG8_SCHED;
            PG8_STAGE(PG8_SB(0, 1), b2 + hstep, voffB);
            PG8_WAIT_V(6); PG8_BAR; PG8_MMA(1, 1, At, B1); PG8_BAR;
            PG8_LDB(B0, 1, 0); PG8_SCHED; PG8_LDA(At, 1, 0); PG8_STAGE(PG8_SA(0, 1), a2 + hstep, voffA);
            PG8_WAIT_L(8); PG8_BAR; PG8_WAIT_L(0); PG8_MMA(0, 0, At, B0); PG8_BAR; PG8_SCHED;
            PG8_LDB(B1, 1, 1); PG8_STAGE(PG8_SB(1, 0), b3, voffB);
            PG8_BAR; PG8_WAIT_L(0); PG8_MMA(0, 1, At, B1); PG8_BAR;
            PG8_LDA(At, 1, 1); PG8_STAGE(PG8_SA(1, 0), a3, voffA);
            PG8_BAR; PG8_WAIT_L(0); PG8_MMA(1, 0, At, B0); PG8_BAR; PG8_SCHED;
            PG8_STAGE(PG8_SB(1, 1), b3 + hstep, voffB);
            PG8_WAIT_V(6); PG8_BAR; PG8_MMA(1, 1, At, B1); PG8_BAR;
            }
        }
        if constexpr (ALIGN_EPI) { if (wr == 0) PG8_BAR; }
        if constexpr (!Epi::AFTER_DRAIN) { E(acc, cur, wr, wc, fr, fq); S.done(cur); }
        if (!has_next) break;
#pragma unroll
        for (int a = 0; a < 2; ++a)
#pragma unroll
            for (int b = 0; b < 2; ++b)
#pragma unroll
                for (int m = 0; m < 4; ++m)
#pragma unroll
                    for (int n = 0; n < 2; ++n) acc[a][b][m][n] = (f32x4){0.f, 0.f, 0.f, 0.f};
        cur = nxt; cA = nA; cB = nB; ++ui;
        if constexpr (ALIGN_EPI) { if (wr == 1) PG8_BAR; }
    }
    PG8_WAIT_V(0);
    if constexpr (!ALIGN_EPI) { if (wr == 0) PG8_BAR; }
    PG8_BAR;
    if constexpr (Epi::AFTER_DRAIN) { E.fused(acc, cur, wr, wc, fr, fq, lds, wid, lane); S.done(cur); }
#undef PG8_SA
#undef PG8_SB
#undef PG8_STAGE
#undef PG8_LDA
#undef PG8_LDB
#undef PG8_MMA
#undef PG8_WAIT_V
#undef PG8_WAIT_L
#undef PG8_BAR
#undef PG8_SCHED
}
}
namespace pg8 {
template <class Epi, class Sched>
__device__ __forceinline__ void gemm_dual_phase(PG8_LAS unsigned char* lds, const bf16_t* A0, const bf16_t* Bt0, int K0, const bf16_t* A1, const bf16_t* Bt1, int K1, const Sched& S, const Epi& E) {
    const int tid = tid_fresh(), wid = __builtin_amdgcn_readfirstlane(tid >> 6), lane = tid & 63, wr = wid >> 2, wc = wid & 3, fr = lane & 15, fq = lane >> 4;
    unsigned vA0_0, vA0_1, vB0_0, vB0_1, vA1_0, vA1_1, vB1_0, vB1_1;
    { int R, C; stage_rc(tid * 16, R, C); const int Rb = (R & ~31) + perm32(R & 31);
      vA0_0 = (unsigned)(R * K0 + C) * 2u; vB0_0 = (unsigned)(Rb * K0 + C) * 2u; vA1_0 = (unsigned)(R * K1 + C) * 2u; vB1_0 = (unsigned)(Rb * K1 + C) * 2u; }
    { int R, C; stage_rc(tid * 16 + 8192, R, C); const int Rb = (R & ~31) + perm32(R & 31);
      vA0_1 = (unsigned)(R * K0 + C) * 2u; vB0_1 = (unsigned)(Rb * K0 + C) * 2u; vA1_1 = (unsigned)(R * K1 + C) * 2u; vB1_1 = (unsigned)(Rb * K1 + C) * 2u; }
    const size_t kstep = (size_t)(BK * 2);
    const size_t hst0 = (size_t)HALF * K0 * 2, hst1 = (size_t)HALF * K1 * 2;
    const unsigned ldsw = (unsigned)wid * 1024u;
    const int aoff = lds_byte(wr * 64 + fr, fq * 8), boff = lds_byte(wc * 32 + fr, fq * 8);
#define PG8_SA(b, h) (((b) * 2 + (h)) * HTB)
#define PG8_SB(b, h) ((4 + (b) * 2 + (h)) * HTB)
#define PG8_STAGE2(bufoff, gbase, v0, v1) do { \
        __builtin_amdgcn_global_load_lds((const unsigned*)((const char*)(gbase) + (v0)), (PG8_LAS unsigned*)(lds + (bufoff) + ldsw), 16, 0, 0); \
        __builtin_amdgcn_global_load_lds((const unsigned*)((const char*)(gbase) + (v1)), (PG8_LAS unsigned*)(lds + (bufoff) + ldsw + 8192), 16, 0, 0); } while (0)
#define PG8_LDA(dst, b, h) do { _Pragma("unroll") for (int m = 0; m < 4; ++m) _Pragma("unroll") for (int k = 0; k < 2; ++k) dst[m][k] = *(const PG8_LAS bf16x8*)(lds + PG8_SA(b, h) + aoff + m * 2048 + k * 1024); } while (0)
#define PG8_LDB(dst, b, h) do { _Pragma("unroll") for (int n = 0; n < 2; ++n) _Pragma("unroll") for (int k = 0; k < 2; ++k) dst[n][k] = *(const PG8_LAS bf16x8*)(lds + PG8_SB(b, h) + boff + n * 2048 + k * 1024); } while (0)
#define PG8_MMA(ai, bj, At, Bt) do { __builtin_amdgcn_s_setprio(1); _Pragma("unroll") for (int m = 0; m < 4; ++m) _Pragma("unroll") for (int n = 0; n < 2; ++n) _Pragma("unroll") for (int k = 0; k < 2; ++k) \
        acc[ai][bj][m][n] = __builtin_amdgcn_mfma_f32_16x16x32_bf16(Bt[n][k], At[m][k], acc[ai][bj][m][n], 0, 0, 0); __builtin_amdgcn_s_setprio(0); } while (0)
#define PG8_WAIT_V(n) asm volatile("s_waitcnt vmcnt(" #n ")" ::: "memory")
#define PG8_WAIT_L(n) asm volatile("s_waitcnt lgkmcnt(" #n ")" ::: "memory")
#define PG8_BAR __builtin_amdgcn_s_barrier()
#define PG8_SCHED __builtin_amdgcn_sched_barrier(0)
    Unit cur, nxt; int ui = 0;
    if (!S.next(0, cur)) return;
    f32x4 acc[2][2][4][2];
#pragma unroll
    for (int a = 0; a < 2; ++a)
#pragma unroll
        for (int b = 0; b < 2; ++b)
#pragma unroll
            for (int m = 0; m < 4; ++m)
#pragma unroll
                for (int n = 0; n < 2; ++n) acc[a][b][m][n] = (f32x4){0.f, 0.f, 0.f, 0.f};
    bf16x8 At[4][2], B0[2][2], B1[2][2];
    int ty = 0;
    const char* cA = (const char*)A0 + (size_t)cur.pm * (2 * hst0); const char* cB = (const char*)Bt0 + (size_t)cur.pn * (2 * hst0);
    PG8_STAGE2(PG8_SB(0, 0), cB, vB0_0, vB0_1); PG8_STAGE2(PG8_SB(0, 1), cB + hst0, vB0_0, vB0_1); PG8_STAGE2(PG8_SA(0, 0), cA, vA0_0, vA0_1); PG8_STAGE2(PG8_SA(0, 1), cA + hst0, vA0_0, vA0_1);
    if (wr == 1) PG8_BAR;
    PG8_WAIT_V(2); PG8_BAR;
    PG8_STAGE2(PG8_SB(1, 0), cB + kstep, vB0_0, vB0_1); PG8_STAGE2(PG8_SA(1, 0), cA + kstep, vA0_0, vA0_1); PG8_STAGE2(PG8_SB(1, 1), cB + hst0 + kstep, vB0_0, vB0_1);
    PG8_WAIT_V(6); PG8_BAR;
    for (;;) {
        const bool has_next = (ty == 0) ? true : S.next(ui + 1, nxt);
        const int pty = has_next ? (ty ^ 1) : ty;
        const int npm = (ty == 0) ? cur.pm : nxt.pm, npn = (ty == 0) ? cur.pn : nxt.pn;
        const size_t hsc = ty ? hst1 : hst0, hsn = pty ? hst1 : hst0;
        const char* nA = has_next ? (const char*)(pty ? A1 : A0) + (size_t)npm * (2 * hsn) : cA;
        const char* nB = has_next ? (const char*)(pty ? Bt1 : Bt0) + (size_t)npn * (2 * hsn) : cB;
        const unsigned vAc0 = ty ? vA1_0 : vA0_0, vAc1 = ty ? vA1_1 : vA0_1, vBc0 = ty ? vB1_0 : vB0_0, vBc1 = ty ? vB1_1 : vB0_1;
        const unsigned vAn0 = pty ? vA1_0 : vA0_0, vAn1 = pty ? vA1_1 : vA0_1, vBn0 = pty ? vB1_0 : vB0_0, vBn1 = pty ? vB1_1 : vB0_1;
        const int nt = (ty ? K1 : K0) / BK;
        for (int t = 0; t < nt; t += 2) {
            const bool last = (t == nt - 2);
            const char* a1 = cA + (size_t)(t + 1) * kstep;
            const char* a2 = last ? nA : cA + (size_t)(t + 2) * kstep; const char* b2 = last ? nB : cB + (size_t)(t + 2) * kstep;
            const char* a3 = a2 + kstep; const char* b3 = b2 + kstep;
            const size_t hs2 = last ? hsn : hsc;
            const unsigned wA0 = last ? vAn0 : vAc0, wA1 = last ? vAn1 : vAc1, wB0 = last ? vBn0 : vBc0, wB1 = last ? vBn1 : vBc1;
            PG8_LDB(B0, 0, 0); PG8_LDB(B1, 0, 1); PG8_SCHED; PG8_LDA(At, 0, 0); PG8_STAGE2(PG8_SA(1, 1), a1 + hsc, vAc0, vAc1);
            PG8_WAIT_V(8); PG8_WAIT_L(0); PG8_BAR; PG8_MMA(0, 0, At, B0); PG8_MMA(0, 1, At, B1); PG8_BAR; PG8_SCHED;
            PG8_LDA(At, 0, 1); PG8_STAGE2(PG8_SB(0, 0), b2, wB0, wB1); PG8_STAGE2(PG8_SB(0, 1), b2 + hs2, wB0, wB1); PG8_STAGE2(PG8_SA(0, 0), a2, wA0, wA1);
            PG8_WAIT_V(8); PG8_WAIT_L(0); PG8_BAR; PG8_MMA(1, 0, At, B0); PG8_MMA(1, 1, At, B1); PG8_BAR; PG8_SCHED;
            PG8_LDB(B0, 1, 0); PG8_LDB(B1, 1, 1); PG8_SCHED; PG8_LDA(At, 1, 0); PG8_STAGE2(PG8_SA(0, 1), a2 + hs2, wA0, wA1);
            PG8_WAIT_V(8); PG8_WAIT_L(0); PG8_BAR; PG8_MMA(0, 0, At, B0); PG8_MMA(0, 1, At, B1); PG8_BAR; PG8_SCHED;
            PG8_LDA(At, 1, 1); PG8_STAGE2(PG8_SB(1, 0), b3, wB0, wB1); PG8_STAGE2(PG8_SB(1, 1), b3 + hs2, wB0, wB1); PG8_STAGE2(PG8_SA(1, 0), a3, wA0, wA1);
            PG8_WAIT_V(8); PG8_WAIT_L(0); PG8_BAR; PG8_MMA(1, 0, At, B0); PG8_MMA(1, 1, At, B1); PG8_BAR; PG8_SCHED;
        }
        if (wr == 0) PG8_BAR;
        if (ty == 0) E.mid(acc, cur, wr, wc, fr, fq); else E(acc, cur, wr, wc, fr, fq);
        if (!has_next) break;
        if (ty == 1) {
#pragma unroll
            for (int a = 0; a < 2; ++a)
#pragma unroll
                for (int b = 0; b < 2; ++b)
#pragma unroll
                    for (int m = 0; m < 4; ++m)
#pragma unroll
                        for (int n = 0; n < 2; ++n) acc[a][b][m][n] = (f32x4){0.f, 0.f, 0.f, 0.f};
            cur = nxt; ++ui;
        }
        ty ^= 1; cA = nA; cB = nB;
        if (wr == 1) PG8_BAR;
    }
    PG8_WAIT_V(0);
    PG8_BAR;
#undef PG8_SA
#undef PG8_SB
#undef PG8_STAGE2
#undef PG8_LDA
#undef PG8_LDB
#undef PG8_MMA
#undef PG8_WAIT_V
#undef PG8_WAIT_L
#undef PG8_BAR
#undef PG8_SCHED
}
}

#define GAS __attribute__((address_space(1)))
#define LAS __attribute__((address_space(3)))
typedef unsigned short bf16;
typedef unsigned v4u __attribute__((ext_vector_type(4)));
typedef float f32x4 __attribute__((ext_vector_type(4)));
typedef short bf16x8 __attribute__((ext_vector_type(8)));
typedef GAS unsigned gu32;
typedef GAS unsigned long long gu64;
#define RLX_AGENT __ATOMIC_RELAXED, __HIP_MEMORY_SCOPE_AGENT
#define LDS_WAIT() asm volatile("s_waitcnt lgkmcnt(0)" ::: "memory")
#define VM_WAIT() asm volatile("s_waitcnt vmcnt(0)" ::: "memory")
__device__ __forceinline__ unsigned long long rt() { return __builtin_amdgcn_s_memrealtime(); }
__device__ __forceinline__ unsigned f2bf(float f) { unsigned u = __builtin_bit_cast(unsigned, f); return (u + 0x7fffu + ((u >> 16) & 1u)) >> 16; }
__device__ __forceinline__ unsigned pk2(float lo, float hi) { return f2bf(lo) | (f2bf(hi) << 16); }

#define XB_TMO      128
#define XB_XCNT(j)  (256  + 64 * (j))
#define XB_XSUB(j)  (1280 + 64 * (j))
#define XB_XGEN(j)  (2304 + 64 * (j))
#define XB_TOP      3328
#define XB_TOPGEN   3392
#define XCD_BAR_WORDS 3456
#define XB_SPIN_CAP (1u << 18)

__device__ __forceinline__ unsigned xb_ld(unsigned* p)              { return __hip_atomic_load(p, __ATOMIC_RELAXED, __HIP_MEMORY_SCOPE_AGENT); }
__device__ __forceinline__ unsigned xb_add(unsigned* p, unsigned v) { return __hip_atomic_fetch_add(p, v, __ATOMIC_RELAXED, __HIP_MEMORY_SCOPE_AGENT); }
__device__ __forceinline__ unsigned xb_xcc_id() { return (unsigned)__builtin_amdgcn_s_getreg((3 << 11) | 20) & 0xFu; }
#define XB_SPIN(cond, bar) do { unsigned _sp = 0; while (cond) { __builtin_amdgcn_s_sleep(1); \
    if ((++_sp & 255u) == 0u) { if (xb_ld(&(bar)[XB_TMO])) break; if (_sp > XB_SPIN_CAP) { atomicAdd(&(bar)[XB_TMO], 1u); break; } } } } while (0)

struct XcdBarrier {
    unsigned* bar; unsigned x;
    volatile LAS unsigned* st;
};

__device__ __forceinline__ XcdBarrier xcd_barrier_post(unsigned* bar, volatile LAS unsigned* st) {
    XcdBarrier b; b.bar = bar; b.x = xb_xcc_id(); b.st = st;
    if (threadIdx.x == 0) (void)xb_add(&bar[XB_XCNT(b.x)], 1u);
    return b;
}
__device__ __forceinline__ void xcd_barrier_complete(unsigned* bar, unsigned x, unsigned& nloc, unsigned& nx) {
    const unsigned G = gridDim.x * gridDim.y * gridDim.z;
    unsigned sum, cnt, mine, sp = 0u;
    for (;;) {
        sum = 0u; cnt = 0u; mine = 0u;
#pragma unroll
        for (unsigned j = 0; j < 16; ++j) { const unsigned c = xb_ld(&bar[XB_XCNT(j)]); sum += c; cnt += (c > 0u) ? 1u : 0u; mine = (j == x) ? c : mine; }
        if (sum == G) break;
        __builtin_amdgcn_s_sleep(1);
        if ((++sp & 255u) == 0u) { if (xb_ld(&bar[XB_TMO])) break; if (sp > XB_SPIN_CAP) { atomicAdd(&bar[XB_TMO], 1u); break; } }
    }
    nloc = mine > 0u ? mine : 1u; nx = cnt > 0u ? cnt : 1u;
}

__device__ __forceinline__ void xcd_barrier(const XcdBarrier& b) {
    asm volatile("s_waitcnt vmcnt(0)" ::: "memory");
    __syncthreads();
    if (threadIdx.x == 0) {
        unsigned* bar = b.bar;
        __builtin_amdgcn_s_waitcnt(0);
        unsigned nloc = b.st[0], nx = b.st[1];
        if (nloc == 0u) { xcd_barrier_complete(bar, b.x, nloc, nx); b.st[0] = nloc; b.st[1] = nx; }
        const unsigned old = xb_add(&bar[XB_XSUB(b.x)], 1u);
        const unsigned gen = old / nloc;
        if (old + 1u == (gen + 1u) * nloc) {
            __builtin_amdgcn_fence(__ATOMIC_RELEASE, "agent");
            asm volatile("s_waitcnt vmcnt(0)" ::: "memory");
            const unsigned og = xb_add(&bar[XB_TOP], 1u);
            const unsigned tg = og / nx;
            if (og + 1u == (tg + 1u) * nx) xb_add(&bar[XB_TOPGEN], 1u);
            else XB_SPIN(xb_ld(&bar[XB_TOPGEN]) == tg, bar);
            __builtin_amdgcn_fence(__ATOMIC_ACQUIRE, "agent");
            xb_add(&bar[XB_XGEN(b.x)], 1u);
            asm volatile("s_waitcnt vmcnt(0)" ::: "memory");
        } else {
            XB_SPIN(xb_ld(&bar[XB_XGEN(b.x)]) == gen, bar);
            __builtin_amdgcn_fence(__ATOMIC_ACQUIRE, "agent");
            asm volatile("s_waitcnt vmcnt(0)" ::: "memory");
        }
    }
    __syncthreads();
}

namespace att {
constexpr int D = 128;
constexpr float THR = 8.f;
constexpr bool WSKIP = false;
constexpr float SCALE = 0.08838834764831845f;
constexpr int NW = 8, QBLK = 32, KVBLK = 64, QB = NW * QBLK;
constexpr int SHM_V = KVBLK * D * 2, SHM_K = KVBLK * D * 2;
constexpr int LDS_BYTES = 2 * SHM_V + 2 * SHM_K + NW * 64 * 4;
typedef short bf16x8 __attribute__((ext_vector_type(8)));
typedef short s16x4 __attribute__((ext_vector_type(4)));
typedef float f32x16 __attribute__((ext_vector_type(16)));
typedef float f32x4 __attribute__((ext_vector_type(4)));
typedef unsigned u32x4 __attribute__((ext_vector_type(4)));
template <class A, class Bt> struct same_t { static constexpr bool v = false; };
template <class A> struct same_t<A, A> { static constexpr bool v = true; };

#define KSWZ(row, colB) ((row) * 256 + ((colB) ^ (((row) & 7) << 4)))
#define SBAR() __builtin_amdgcn_sched_barrier(0)
__device__ __forceinline__ int v_st(int k, int c) { const int kk = (k & ~0xC) | ((k & 4) << 1) | ((k & 8) >> 1); return ((kk >> 3) * 4 + (c >> 5)) * 512 + ((kk & 7) * 32 + (c & 31)) * 2; }
__device__ __forceinline__ int v_rd_base(int lane) { return ((lane & 3) << 3) | (((lane >> 2) & 3) << 6) | (((lane >> 4) & 1) << 5) | (((lane >> 5) & 1) << 8); }
constexpr int v_rd_off(int d0, int ks, int half) { return d0 * 512 + ks * 4096 + half * 2048; }
__device__ __forceinline__ int crow(int r, int hi) { return (r & 3) + 8 * (r >> 2) + 4 * hi; }
__device__ __forceinline__ unsigned cvtpk(float lo, float hi) {
    unsigned r; asm volatile("v_cvt_pk_bf16_f32 %0, %1, %2" : "=v"(r) : "v"(lo), "v"(hi)); return r;
}
__device__ __forceinline__ bf16x8 pack8(f32x4 a, f32x4 b) {
    u32x4 w = {cvtpk(a[0], a[1]), cvtpk(a[2], a[3]), cvtpk(b[0], b[1]), cvtpk(b[2], b[3])};
    return *reinterpret_cast<bf16x8*>(&w);
}
template <class T> __device__ __forceinline__ bf16x8 load8(const T* p) {
    if constexpr (same_t<T, float>::v) { return pack8(*(const f32x4*)p, *(const f32x4*)(p + 4)); }
    else { return *reinterpret_cast<const bf16x8*>(p); }
}
__device__ __forceinline__ void mask_tile(f32x16& p0, f32x16& p1, int dq, unsigned W) {
    const float NEG = -__builtin_inff();
#pragma unroll
    for (int r = 0; r < 16; ++r) {
        const int c = (r & 3) + 8 * (r >> 2);
        if ((unsigned)(dq - c) >= W) p0[r] = NEG;
        if ((unsigned)(dq - c - 32) >= W) p1[r] = NEG;
    }
}
__device__ __forceinline__ void partialSM(f32x16& p0, f32x16& p1, float& m_reg, float& mn, float& alpha) {
    float pmax = p0[0]; for (int r = 1; r < 16; ++r) pmax = fmaxf(pmax, p0[r]); for (int r = 0; r < 16; ++r) pmax = fmaxf(pmax, p1[r]);
    { auto rr = __builtin_amdgcn_permlane32_swap(__float_as_uint(pmax), __float_as_uint(pmax), false, false);
      pmax = fmaxf(__uint_as_float(rr[0]), __uint_as_float(rr[1])); }
    constexpr float C2 = 1.4426950408889634f * SCALE;
    if (__builtin_expect(__all((pmax - m_reg) * SCALE <= THR), 1)) { mn = m_reg; alpha = 1.f; }
    else { mn = fmaxf(m_reg, pmax); alpha = __builtin_amdgcn_exp2f((m_reg - mn) * C2); m_reg = mn; }
    const float mnL = -mn * C2;
    for (int r = 0; r < 16; ++r) p0[r] = fmaf(p0[r], C2, mnL); for (int r = 0; r < 16; ++r) p1[r] = fmaf(p1[r], C2, mnL);
    for (int r = 0; r < 16; ++r) p0[r] = __builtin_amdgcn_exp2f(p0[r]);
}
__device__ __forceinline__ void finishSM(f32x16& p0, f32x16& p1, float alpha, float& l_reg, bf16x8& pa0, bf16x8& pa1, bf16x8& pa2, bf16x8& pa3) {
    for (int r = 0; r < 16; ++r) p1[r] = __builtin_amdgcn_exp2f(p1[r]);
    float ps = 0; for (int r = 0; r < 16; ++r) ps += p0[r]; for (int r = 0; r < 16; ++r) ps += p1[r];
    { auto rr = __builtin_amdgcn_permlane32_swap(__float_as_uint(ps), __float_as_uint(ps), false, false);
      ps = __uint_as_float(rr[0]) + __uint_as_float(rr[1]); }
    l_reg = l_reg * alpha + ps;
#define PK4(P, B_, OUT) do { unsigned a0 = cvtpk(P[B_+0], P[B_+1]), a1 = cvtpk(P[B_+2], P[B_+3]);                          \
        unsigned b0 = cvtpk(P[B_+4], P[B_+5]), b1 = cvtpk(P[B_+6], P[B_+7]);                                             \
        auto r0 = __builtin_amdgcn_permlane32_swap(a0, b0, false, false); auto r1 = __builtin_amdgcn_permlane32_swap(a1, b1, false, false); \
        u32x4 w = {r0[0], r1[0], r0[1], r1[1]}; OUT = *reinterpret_cast<bf16x8*>(&w); } while (0)
    PK4(p0, 0, pa0); PK4(p0, 8, pa1); PK4(p1, 0, pa2); PK4(p1, 8, pa3);
#undef PK4
}
template <int KB, bool SK>
__device__ __forceinline__ void qkt(f32x16& p0, f32x16& p1, const char* K_lds, int r32, int hi, const bf16x8* qr, bool act) {
    if (SK && !act) { const float NEG = -__builtin_inff();
#pragma unroll
        for (int r = 0; r < 16; ++r) { p0[r] = NEG; p1[r] = NEG; } return; }
    p0 = f32x16{}; p1 = f32x16{};
    const char* kb[4];
#pragma unroll
    for (int dd = 0; dd < 4; ++dd) kb[dd] = K_lds + KB * SHM_K + KSWZ(r32, (dd * 16 + hi * 8) * 2);
#pragma unroll
    for (int d0 = 0; d0 < 8; ++d0) { const char* a = kb[d0 & 3] + (d0 >> 2) * 128;
        bf16x8 b0 = *reinterpret_cast<const bf16x8*>(a);
        bf16x8 b1 = *reinterpret_cast<const bf16x8*>(a + 32 * 256);
        p0 = __builtin_amdgcn_mfma_f32_32x32x16_bf16(b0, qr[d0], p0, 0, 0, 0);
        p1 = __builtin_amdgcn_mfma_f32_32x32x16_bf16(b1, qr[d0], p1, 0, 0, 0); }
}
template <int VB, bool SK>
__device__ __forceinline__ void pv_tile(f32x16* o, int vb0, bf16x8 pa0, bf16x8 pa1, bf16x8 pa2, bf16x8 pa3, bool act) {
    if (SK && !act) return;
#define TRRD(dst, off) asm volatile("ds_read_b64_tr_b16 %0, %1 offset:%2" : "=&v"(dst) : "v"(vb0), "i"(off) : "memory")
#define PV_D0(d0) do { s16x4 l0, l1, l2, l3, h0, h1, h2, h3; constexpr int b_ = VB * SHM_V + v_rd_off(d0, 0, 0);     \
        TRRD(l0, b_); TRRD(h0, b_ + 2048); TRRD(l1, b_ + 4096); TRRD(h1, b_ + 6144); TRRD(l2, b_ + 8192); TRRD(h2, b_ + 10240); TRRD(l3, b_ + 12288); TRRD(h3, b_ + 14336); \
        asm volatile("s_waitcnt lgkmcnt(0)" ::: "memory"); SBAR();                 \
        o[d0] = __builtin_amdgcn_mfma_f32_32x32x16_bf16(pa0, (bf16x8){l0[0], l0[1], l0[2], l0[3], h0[0], h0[1], h0[2], h0[3]}, o[d0], 0, 0, 0);   \
        o[d0] = __builtin_amdgcn_mfma_f32_32x32x16_bf16(pa1, (bf16x8){l1[0], l1[1], l1[2], l1[3], h1[0], h1[1], h1[2], h1[3]}, o[d0], 0, 0, 0);   \
        o[d0] = __builtin_amdgcn_mfma_f32_32x32x16_bf16(pa2, (bf16x8){l2[0], l2[1], l2[2], l2[3], h2[0], h2[1], h2[2], h2[3]}, o[d0], 0, 0, 0);   \
        o[d0] = __builtin_amdgcn_mfma_f32_32x32x16_bf16(pa3, (bf16x8){l3[0], l3[1], l3[2], l3[3], h3[0], h3[1], h3[2], h3[3]}, o[d0], 0, 0, 0); } while (0)
    PV_D0(0); PV_D0(1); PV_D0(2); PV_D0(3);
#undef PV_D0
#undef TRRD
}

template <class TIn, class TOut> struct BlockRef { const TIn* Q; const TIn* K; const TIn* V; TOut* O; int P0; };
template <class TIn> struct Seam {
    bf16x8 qr[8];
    bf16x8 st_v0, st_v1, st_k0, st_k1; f32x4 sf0, sf1, sf2, sf3;
    f32x4 tq[16];
};
__device__ __forceinline__ int swa_jlo(int P0, int W) { const int lowk = P0 - W + 1; return lowk > 0 ? lowk / KVBLK : 0; }
#define ROW(p, k0, rr) ((p) + (size_t)((k0) + (rr)) * D + sc)
#define VMW() asm volatile("s_waitcnt vmcnt(0)" ::: "memory")
#define VMWN(n) asm volatile("s_waitcnt vmcnt(%0)" :: "i"(n) : "memory")
#define SLOAD_H(Kp, Vp, k0) do { S.st_v0 = load8<TIn>(ROW(Vp, k0, sr)); S.st_v1 = load8<TIn>(ROW(Vp, k0, 32 + sr));              \
                         S.st_k0 = load8<TIn>(ROW(Kp, k0, sr)); S.st_k1 = load8<TIn>(ROW(Kp, k0, 32 + sr)); } while (0)
#define SWRITE_HK(bf) do { *(bf16x8*)(K_lds + (bf) * SHM_K + kws) = S.st_k0; *(bf16x8*)(K_lds + (bf) * SHM_K + kws + 32 * 256) = S.st_k1; } while (0)
#define SWRITE_HV(bf) do { *(bf16x8*)(V_lds + (bf) * SHM_V + vst0) = S.st_v0; *(bf16x8*)(V_lds + (bf) * SHM_V + vst1) = S.st_v1; } while (0)
#define SWRITE_H(bf) do { SWRITE_HV(bf); SWRITE_HK(bf); } while (0)
#define SLOAD_F(p, k0) do { S.sf0 = *(const f32x4*)ROW(p, k0, sr); S.sf1 = *(const f32x4*)(ROW(p, k0, sr) + 4);                \
                            S.sf2 = *(const f32x4*)ROW(p, k0, 32 + sr); S.sf3 = *(const f32x4*)(ROW(p, k0, 32 + sr) + 4); } while (0)
#define SWRITE_KF(bf) do { *(bf16x8*)(K_lds + (bf) * SHM_K + kws) = pack8(S.sf0, S.sf1); *(bf16x8*)(K_lds + (bf) * SHM_K + kws + 32 * 256) = pack8(S.sf2, S.sf3); } while (0)
#define SWRITE_VF(bf) do { *(bf16x8*)(V_lds + (bf) * SHM_V + vst0) = pack8(S.sf0, S.sf1); *(bf16x8*)(V_lds + (bf) * SHM_V + vst1) = pack8(S.sf2, S.sf3); } while (0)
template <class TIn, class TOut>
__device__ __forceinline__ void causal_swa_prime(const BlockRef<TIn, TOut>& cur, int W, char* lds, Seam<TIn>& S) {
    constexpr bool F32 = same_t<TIn, float>::v;
    const int tid = tid_fresh(), wid = __builtin_amdgcn_readfirstlane(tid >> 6), lane = tid & 63, r32 = lane & 31, hi = lane >> 5;
    const int sr = tid >> 4, sc = (tid & 15) * 8, kws = KSWZ(sr, sc * 2); char* K_lds = lds + 2 * SHM_V;
    const int kb0 = swa_jlo(cur.P0, W) * KVBLK;
    for (int d0 = 0; d0 < 8; ++d0) S.qr[d0] = load8<TIn>(cur.Q + (size_t)(wid * QBLK + r32) * D + d0 * 16 + hi * 8);
    if constexpr (F32) { SLOAD_F((const float*)cur.K, kb0); VMW(); SWRITE_KF(0); SBAR(); SLOAD_F((const float*)cur.V, kb0); }
    else { SLOAD_H(cur.K, cur.V, kb0); VMW(); SWRITE_HK(0); }
    __syncthreads();
}
template <class TIn, class TOut>
__device__ __forceinline__ void causal_swa_block(const BlockRef<TIn, TOut>& cur, const BlockRef<TIn, TOut>& nxt, int skv, int W, char* lds, Seam<TIn>& S) {
    constexpr bool F32 = same_t<TIn, float>::v;
    const int tid = tid_fresh(), wid = __builtin_amdgcn_readfirstlane(tid >> 6), lane = tid & 63, r32 = lane & 31, hi = lane >> 5;
    const int j_lo = swa_jlo(cur.P0, W);
    int j_hi = (cur.P0 + QB - 1) / KVBLK + 1; if (j_hi > skv / KVBLK) j_hi = skv / KVBLK;
    const int NT = j_hi - j_lo;
    const int kbn = swa_jlo(nxt.P0, W) * KVBLK;
    const int qlo = cur.P0 + wid * QBLK, qm = qlo + r32 - 4 * hi;
    char* V_lds = lds; char* K_lds = lds + 2 * SHM_V;
    float* ws = (float*)(lds + 2 * SHM_V + 2 * SHM_K) + wid * 64; float* li_l = ws, * al_l = ws + 32;
    float m_reg = -1e30f, l_reg = 0; f32x16 o[4] = {};
    const int sr = tid >> 4, sc = (tid & 15) * 8, vst0 = v_st(sr, sc), vst1 = v_st(32 + sr, sc), kws = KSWZ(sr, sc * 2);
    const int vb0 = (int)(uintptr_t)V_lds + v_rd_base(lane);
    const TIn* Kh = cur.K; const TIn* Vh = cur.V;
#define RESC(a) do { if (__any((a) < 1.f)) { if (hi == 0) al_l[r32] = (a); asm volatile("s_waitcnt lgkmcnt(0)" ::: "memory");              \
                     for (int d_ = 0; d_ < 4; ++d_) for (int r = 0; r < 16; ++r) o[d_][r] *= al_l[crow(r, hi)]; } } while (0)
#define KBASE(t) ((j_lo + (t)) * KVBLK)
#define ACT(t) (KBASE(t) <= qlo + QBLK - 1 && KBASE(t) + KVBLK - 1 >= qlo - W + 1)
#define MASKT(P0_, P1_, t) do { const int kb_ = KBASE(t); if ((!SK || ACT(t)) && (kb_ + KVBLK - 1 > qlo || kb_ <= qlo + QBLK - 1 - W)) mask_tile(P0_, P1_, qm - kb_, (unsigned)W); } while (0)
    constexpr int NQL = F32 ? 16 : 8;
    constexpr bool SK = WSKIP && !F32;
#define SEAM_K0() do { VMWN(NQL); if constexpr (F32) { SWRITE_KF(0); SBAR(); SLOAD_F((const float*)nxt.V, kbn); } else { SWRITE_HK(0); } SBAR(); } while (0)
    f32x16 pA0, pA1, pB0, pB1; float mnA, mnB, alA, alB; bf16x8 pa0, pa1, pa2, pa3;
    if constexpr (F32) { VMW(); SWRITE_VF(0); SBAR(); } else { SWRITE_HV(0); SBAR(); }
    if (NT > 1) { if constexpr (F32) SLOAD_F((const float*)Kh, KBASE(1)); else SLOAD_H(Kh, Vh, KBASE(1)); }
    SBAR(); qkt<0, SK>(pA0, pA1, K_lds, r32, hi, S.qr, ACT(0));
    if constexpr (F32) { if (NT > 1) { VMW(); SWRITE_KF(1); SBAR(); SLOAD_F((const float*)Vh, KBASE(1)); } }
    MASKT(pA0, pA1, 0); partialSM(pA0, pA1, m_reg, mnA, alA);
    if (NT > 1) { VMW(); if constexpr (F32) { SWRITE_VF(1); SBAR(); if (NT > 2) SLOAD_F((const float*)Kh, KBASE(2)); } else SWRITE_H(1); }
    __syncthreads();
#define HALF_STEP(PX0, PX1, mnX, alX, PY0, PY1, alY, t, KB, VB, SB) do {                                                      \
        SBAR(); qkt<KB, SK>(PX0, PX1, K_lds, r32, hi, S.qr, ACT(t));                                             \
        finishSM(PY0, PY1, alY, l_reg, pa0, pa1, pa2, pa3); SBAR();                                                           \
        if ((t) + 1 < NT) { if constexpr (F32) { VMW(); SWRITE_KF(SB); SBAR(); SLOAD_F((const float*)Vh, KBASE((t) + 1)); }  \
                            else { SLOAD_H(Kh, Vh, KBASE((t) + 1)); } SBAR(); }                                               \
        pv_tile<VB, SK>(o, vb0, pa0, pa1, pa2, pa3, ACT((t) - 1)); MASKT(PX0, PX1, (t)); partialSM(PX0, PX1, m_reg, mnX, alX);                                        \
        __syncthreads();                                                                                                      \
        if ((t) + 1 < NT) { VMW(); if constexpr (F32) { SWRITE_VF(SB); SBAR(); if ((t) + 2 < NT) SLOAD_F((const float*)Kh, KBASE((t) + 2)); } \
                            else { SWRITE_H(SB); } }                                                                          \
        RESC(alX); __syncthreads(); } while (0)
    for (int t = 1; t + 1 < NT; t += 2) {
        HALF_STEP(pB0, pB1, mnB, alB, pA0, pA1, alA, t, 1, 0, 0);
        HALF_STEP(pA0, pA1, mnA, alA, pB0, pB1, alB, t + 1, 0, 1, 1);
    }
    const bool even = (NT & 1) == 0;
    if (even) { SBAR(); qkt<1, SK>(pB0, pB1, K_lds, r32, hi, S.qr, ACT(NT - 1)); SBAR(); }
#define QROW(e) (nxt.Q + (size_t)(wid * QBLK + r32) * D + ((e) >> 1) * 16 + hi * 8 + ((e) & 1) * 4)
    if constexpr (F32) { SLOAD_F((const float*)nxt.K, kbn); SBAR();
#pragma unroll
        for (int e = 0; e < 8; ++e) S.tq[e] = *(const f32x4*)QROW(e); }
    else { SLOAD_H(nxt.K, nxt.V, kbn); SBAR();
#pragma unroll
        for (int d0 = 0; d0 < 8; ++d0) S.qr[d0] = load8<TIn>(nxt.Q + (size_t)(wid * QBLK + r32) * D + d0 * 16 + hi * 8); }
    SBAR();
    finishSM(pA0, pA1, alA, l_reg, pa0, pa1, pa2, pa3); SBAR();
    if constexpr (F32) {
#pragma unroll
        for (int e = 8; e < 16; ++e) S.tq[e] = *(const f32x4*)QROW(e); SBAR(); }
#undef QROW
    pv_tile<0, SK>(o, vb0, pa0, pa1, pa2, pa3, ACT(even ? NT - 2 : NT - 1));
    if (even) { MASKT(pB0, pB1, NT - 1); partialSM(pB0, pB1, m_reg, mnB, alB); __syncthreads(); RESC(alB);
        finishSM(pB0, pB1, alB, l_reg, pa0, pa1, pa2, pa3); SBAR(); pv_tile<1, SK>(o, vb0, pa0, pa1, pa2, pa3, ACT(NT - 1)); }
    SBAR(); SEAM_K0();
    if (hi == 0) li_l[r32] = l_reg; asm volatile("s_waitcnt lgkmcnt(0)" ::: "memory");
    float rli[16];
#pragma unroll
    for (int r = 0; r < 16; ++r) rli[r] = __builtin_amdgcn_rcpf(li_l[crow(r, hi)]);
    TOut* Ow = cur.O + (size_t)(wid * QBLK) * D;
#pragma unroll
    for (int r = 0; r < 16; ++r) { const int orow = crow(r, hi);
#pragma unroll
        for (int d0 = 0; d0 < 4; ++d0) { const float v = o[d0][r] * rli[r];
            if constexpr (same_t<TOut, float>::v) { Ow[(size_t)orow * D + d0 * 32 + r32] = v; }
            else { const float vn = __shfl_xor(v, 1);
                   if ((r32 & 1) == 0) *(unsigned*)(Ow + (size_t)orow * D + d0 * 32 + r32) = cvtpk(v, vn); } } }
    if constexpr (F32) {
#pragma unroll
        for (int d0 = 0; d0 < 8; ++d0) S.qr[d0] = pack8(S.tq[2 * d0], S.tq[2 * d0 + 1]); }
    __syncthreads();
#undef RESC
#undef KBASE
#undef ACT
#undef MASKT
#undef SEAM_K0
#undef HALF_STEP
}
#undef ROW
#undef VMW
#undef VMWN
#undef SLOAD_H
#undef SWRITE_HK
#undef SWRITE_HV
#undef SWRITE_H
#undef SLOAD_F
#undef SWRITE_KF
#undef SWRITE_VF
constexpr int LDS256_V = 0, LDS256_K = 4 * SHM_V, LDS256_WS = LDS256_K + 2 * SHM_K, LDS256_BYTES = LDS256_WS + NW * 64 * 4;
template <bool COMB>
__device__ __forceinline__ void diff_attn_block(const unsigned short* Q, const unsigned short* K, const unsigned short* V0, const unsigned short* V1, unsigned short* O, int P0, int skv, char* lds,
                                                unsigned short* AOut, int AOP, float lam, const float* sl, float eps) {
    const int tid = tid_fresh(), wid = __builtin_amdgcn_readfirstlane(tid >> 6), lane = tid & 63, r32 = lane & 31, hi = lane >> 5;
    int NT = (P0 + QB - 1) / KVBLK + 1; if (NT > skv / KVBLK) NT = skv / KVBLK;
    const int qlo = P0 + wid * QBLK, qm = qlo + r32 - 4 * hi;
    char* V_lds = lds + LDS256_V; char* K_lds = lds + LDS256_K;
    float* ws = (float*)(lds + LDS256_WS) + wid * 64; float* li_l = ws, * al_l = ws + 32;
    float m_reg = -1e30f, l_reg = 0; f32x16 o[8] = {};
    const int vb0 = (int)(uintptr_t)V_lds + v_rd_base(lane);
    bf16x8 qr[8];
#pragma unroll
    for (int d0 = 0; d0 < 8; ++d0) qr[d0] = *reinterpret_cast<const bf16x8*>(Q + (size_t)(wid * QBLK + r32) * D + d0 * 16 + hi * 8);
    typedef __attribute__((address_space(3))) unsigned* ldsu_t;
    unsigned koff[2], voff[2];
#pragma unroll
    for (int i = 0; i < 2; ++i) { const int q = (2 * wid + i) * 64 + lane;
        { const int row = q >> 4, cs = q & 15; koff[i] = (unsigned)(row * 256 + ((cs ^ (row & 7)) << 4)); }
        { const int st = q >> 5, kk = 8 * (st >> 2) + ((q & 31) >> 2), k = (kk & ~0xC) | ((kk & 4) << 1) | ((kk & 8) >> 1), c = 32 * (st & 3) + 8 * (q & 3); voff[i] = (unsigned)(k * 256 + c * 2); } }
    const unsigned ldsw = (unsigned)wid * 2048u;
#define A256_DMA(t, bf) do { const size_t tb_ = (size_t)(t) * (KVBLK * D * 2); \
        _Pragma("unroll") for (int i = 0; i < 2; ++i) { \
            __builtin_amdgcn_global_load_lds((const unsigned*)((const char*)K + tb_ + koff[i]), (ldsu_t)(K_lds + (bf) * SHM_K + ldsw + i * 1024), 16, 0, 0); \
            __builtin_amdgcn_global_load_lds((const unsigned*)((const char*)V0 + tb_ + voff[i]), (ldsu_t)(V_lds + (2 * (bf)) * SHM_V + ldsw + i * 1024), 16, 0, 0); \
            __builtin_amdgcn_global_load_lds((const unsigned*)((const char*)V1 + tb_ + voff[i]), (ldsu_t)(V_lds + (2 * (bf) + 1) * SHM_V + ldsw + i * 1024), 16, 0, 0); } } while (0)
#define A256_RESC(a) do { if (__any((a) < 1.f)) { if (hi == 0) al_l[r32] = (a); asm volatile("s_waitcnt lgkmcnt(0)" ::: "memory"); \
        _Pragma("unroll") for (int d_ = 0; d_ < 8; ++d_) _Pragma("unroll") for (int r = 0; r < 16; ++r) o[d_][r] *= al_l[crow(r, hi)]; } } while (0)
#define A256_STEP(BUF, tt) do { \
        if ((tt) + 1 < NT) A256_DMA((tt) + 1, 1 - BUF); \
        f32x16 p0, p1; float mn, alpha; bf16x8 pa0, pa1, pa2, pa3; \
        SBAR(); qkt<BUF, false>(p0, p1, K_lds, r32, hi, qr, true); \
        { const int kb_ = (tt) * KVBLK; if (kb_ + KVBLK - 1 > qlo) mask_tile(p0, p1, qm - kb_, 1u << 30); } \
        partialSM(p0, p1, m_reg, mn, alpha); \
        finishSM(p0, p1, alpha, l_reg, pa0, pa1, pa2, pa3); SBAR(); \
        A256_RESC(alpha); \
        pv_tile<2 * BUF, false>(o, vb0, pa0, pa1, pa2, pa3, true); pv_tile<2 * BUF + 1, false>(o + 4, vb0, pa0, pa1, pa2, pa3, true); \
        __syncthreads(); } while (0)
    A256_DMA(0, 0);
    __syncthreads();
    if (wid >= 4) __builtin_amdgcn_s_setprio(1);
    for (int t = 0; t < NT; t += 2) {
        A256_STEP(0, t);
        if (t + 1 < NT) A256_STEP(1, t + 1);
    }
    if (wid >= 4) __builtin_amdgcn_s_setprio(0);
    if (hi == 0) li_l[r32] = l_reg; asm volatile("s_waitcnt lgkmcnt(0)" ::: "memory");
    float rli[16];
#pragma unroll
    for (int r = 0; r < 16; ++r) rli[r] = __builtin_amdgcn_rcpf(li_l[crow(r, hi)]);
#define A256_DPP(v_, ctrl_) __builtin_bit_cast(float, __builtin_amdgcn_update_dpp(0, __builtin_bit_cast(int, (float)(v_)), (ctrl_), 0xf, 0xf, true))
#define A256_SHX(v_, m_) __builtin_bit_cast(float, __builtin_amdgcn_ds_bpermute((lane ^ (m_)) << 2, __builtin_bit_cast(int, (float)(v_))))
    unsigned short* Ow = O + (size_t)(wid * QBLK) * 256;
    if constexpr (!COMB) {
#pragma unroll
        for (int j = 0; j < 16; ++j) { const int d0 = j >> 1, rb = (j & 1) * 8;
            u32x4 w; w.x = cvtpk(o[d0][rb] * rli[rb], o[d0][rb + 1] * rli[rb + 1]); w.y = cvtpk(o[d0][rb + 2] * rli[rb + 2], o[d0][rb + 3] * rli[rb + 3]);
            w.z = cvtpk(o[d0][rb + 4] * rli[rb + 4], o[d0][rb + 5] * rli[rb + 5]); w.w = cvtpk(o[d0][rb + 6] * rli[rb + 6], o[d0][rb + 7] * rli[rb + 7]);
            *(u32x4*)(Ow + (size_t)(j * 64 + lane) * 8) = w; }
    } else {
        float slv[8];
#pragma unroll
        for (int d0 = 0; d0 < 8; ++d0) slv[d0] = sl[d0 * 32 + r32];
        u32x4 pw[16];
#pragma unroll
        for (int j = 0; j < 16; ++j) pw[j] = *(const u32x4*)(Ow + (size_t)(j * 64 + lane) * 8);
#pragma unroll
        for (int r = 0; r < 16; ++r) { const int orow = crow(r, hi); float ss = 0.f;
#pragma unroll
            for (int d0 = 0; d0 < 8; ++d0) { const unsigned wv = pw[2 * d0 + (r >> 3)][(r & 7) >> 1]; const float o0 = (r & 1) ? __uint_as_float(wv & 0xffff0000u) : __uint_as_float(wv << 16);
                const float x = o0 - lam * (o[d0][r] * rli[r]); o[d0][r] = x; ss += x * x; }
            ss += A256_DPP(ss, 0xB1); ss += A256_DPP(ss, 0x4E); ss += A256_DPP(ss, 0x141); ss += A256_DPP(ss, 0x140); ss += A256_SHX(ss, 16);
            const float rs = rsqrtf(ss * (1.0f / 256.0f) + eps);
            unsigned short* ao = AOut + (size_t)(wid * QBLK + orow) * AOP;
#pragma unroll
            for (int d0 = 0; d0 < 8; ++d0) { const float v = o[d0][r] * rs * slv[d0]; const float vn = A256_DPP(v, 0xB1);
                if ((r32 & 1) == 0) *(unsigned*)(ao + d0 * 32 + r32) = cvtpk(v, vn); } }
    }
    asm volatile("s_waitcnt lgkmcnt(0)\n\ts_barrier" ::: "memory");
#undef A256_SHX
#undef A256_DPP
#undef A256_DMA
#undef A256_RESC
#undef A256_STEP
}
#undef KSWZ
#undef SBAR
}
constexpr int DM = 2048, NB = 4, SEQ = 4096, NMETA = 16, MR = NB * SEQ  , MROWS = MR + NMETA, MPAD = MR + 256;
constexpr int DFF = 5632, NGU = 2 * DFF, NIN = 15360, LW = 2560, NHEAD = 8, KVLEN = 4160, DEPTH = 4;
constexpr float EPS = 1e-6f;
constexpr int NWAVES = 8;
#ifndef MK_MULTI
#define MK_MULTI 0
#endif
#ifndef DUAL_BR
#define DUAL_BR 1
#endif
#ifndef FINAL_BF16
#define FINAL_BF16 1
#endif
#ifndef EN_MASK
#define EN_MASK 0xFFFF
#endif
#define EN(k) (((EN_MASK) >> (k)) & 1)
#ifndef PROBE_SEAM
#define PROBE_SEAM -1
#endif
#ifndef PROBE_GAIN
#define PROBE_GAIN 1.0f
#endif
#ifndef DUP_PHASE
#define DUP_PHASE -1
#endif
#define DRY(k) ((k) == (DUP_PHASE) && rep_ == 0)
#define REPM(k) for (int rep_ = 0; rep_ < ((DUP_PHASE) == 20 ? 2 : 1); ++rep_)
#define DRYM ((DUP_PHASE) == 20 && rep_ == 0)
#define REP(k) for (int rep_ = 0; rep_ < ((k) == (DUP_PHASE) ? 2 : 1); ++rep_)
#ifndef NO_META
#define NO_META 0
#endif
constexpr int PH_PER_LAYER = 10, N_PHASES = 2 + DEPTH * PH_PER_LAYER;

constexpr size_t MiB = 1u << 20;
constexpr size_t WS_CTL = 0, CTL_ZERO_BYTES = 2 * MiB;
constexpr size_t WS_ROPE = 2 * MiB;
constexpr size_t WS_QM = 3 * MiB + 512 * 1024;
constexpr size_t WS_W = 4 * MiB, WBUF_STRIDE = 0 * MiB;
constexpr size_t W_GU1 = WS_W, W_DN1 = W_GU1 + 44 * MiB, W_IN = W_DN1 + 22 * MiB, W_BA = W_IN + 60 * MiB, W_BL = W_BA + 8 * MiB, W_O = W_BL + 10 * MiB,
                 W_GU2 = W_O + 8 * MiB, W_DN2 = W_GU2 + 44 * MiB;
constexpr size_t WS_H = 224 * MiB;
constexpr size_t WS_HB = 354 * MiB;
constexpr size_t WS_HID = 420 * MiB;
constexpr size_t WS_Q = 600 * MiB;
constexpr size_t WS_K = 664 * MiB;
constexpr size_t WS_V = 729 * MiB;
constexpr size_t WS_XR = 794 * MiB;
constexpr size_t WS_GY = 876 * MiB;
constexpr size_t WS_G = 958 * MiB;
constexpr size_t WS_OP = 1088 * MiB;
constexpr size_t WS_AO = 1216 * MiB;
constexpr size_t WS_LO = 1281 * MiB;
constexpr size_t WS_TMP = 1363 * MiB;
constexpr size_t WS_MIX = 1493 * MiB;
constexpr size_t WS_END = 1558 * MiB;
static_assert(W_DN2 + 22 * MiB <= WS_H && WS_H + (size_t)MPAD * DM * 4 <= WS_HB && WS_HB + (size_t)MPAD * DM * 2 <= WS_HID && WS_HID + (size_t)MPAD * DFF * 2 <= WS_Q, "ws map 1");
static_assert(WS_K + (size_t)64 * KVLEN * 256 <= WS_V && WS_V + (size_t)64 * KVLEN * 256 <= WS_XR && WS_XR + (size_t)MPAD * LW * 2 <= WS_GY && WS_GY + (size_t)MPAD * LW * 2 <= WS_G, "ws map 2");
static_assert(WS_LO + (size_t)MPAD * LW * 2 <= WS_TMP && WS_TMP + (size_t)MPAD * DM * 4 <= WS_MIX && WS_MIX + (size_t)MPAD * DM * 2 <= WS_END, "ws map 3");
constexpr int CW_TMO = 0, CW_CODE = 1, CW_BAR = 4096, CW_REACH = 8192  , CW_ITEM = 12288  ;
constexpr size_t SSQ_OFF = 65536;
constexpr int N_SSQ = 13;
static_assert(SSQ_OFF + (size_t)N_SSQ * MPAD * 8 <= CTL_ZERO_BYTES, "ssq inside the memset region");

constexpr int RING_BYTES = 143360, LDSCTL_OFF = RING_BYTES, MISC_OFF = LDSCTL_OFF + 320, LDS_BYTES = 147456;

using pg8::bf16_t; using pg8::bf16x8; using pg8::f32x4; using pg8::u32x4; using pg8::cvt_pk_bf16;

__device__ __forceinline__ float wave_sum(float v) {
#pragma unroll
    for (int o = 1; o < 64; o <<= 1) v += __shfl_xor(v, o);
    return v;
}
__device__ __forceinline__ float bf2f(unsigned short u) { return __uint_as_float((unsigned)u << 16); }
__device__ __forceinline__ float bflo(unsigned u) { return __uint_as_float(u << 16); }
__device__ __forceinline__ float bfhi(unsigned u) { return __uint_as_float(u & 0xffff0000u); }
__device__ __forceinline__ unsigned short f2bf16(float f) { return (unsigned short)(cvt_pk_bf16(f, 0.f) & 0xffffu); }
typedef unsigned long long u64;
typedef float f32x2 __attribute__((ext_vector_type(2)));
__device__ __forceinline__ float rstd_from(float ssq) { return rsqrtf(ssq * (1.0f / 2048.0f) + EPS); }
__device__ __forceinline__ float rstd_fx(u64 v) { return rsqrtf((float)v * (1.0f / 4294967296.0f / 2048.0f) + EPS); }
__device__ __forceinline__ u64 ssq_fx(float ss) { return (u64)(ss * 4294967296.0f); }
__device__ __forceinline__ float sigmoid_f(float x) { return __builtin_amdgcn_rcpf(1.0f + __expf(-x)); }
__device__ __forceinline__ float gelu_tanh_f(float y) { const float u = 1.5957691216057308f * (y + 0.044715f * y * y * y); return y * __builtin_amdgcn_rcpf(1.0f + __expf(-u)); }
__device__ __forceinline__ f32x4 sigmoid4(f32x4 x) { f32x4 t = x * -1.4426950408889634f;
#pragma unroll
    for (int e = 0; e < 4; ++e) t[e] = __builtin_amdgcn_exp2f(t[e]);
    t = t + 1.0f;
#pragma unroll
    for (int e = 0; e < 4; ++e) t[e] = __builtin_amdgcn_rcpf(t[e]);
    return t; }
__device__ __forceinline__ f32x4 gelu_tanh4(f32x4 y) { return y * sigmoid4(y * ((y * y) * (0.044715f * 1.5957691216057308f) + 1.5957691216057308f)); }
__device__ __forceinline__ u32x4 pack8f(f32x4 a, f32x4 b) { u32x4 w; w.x = cvt_pk_bf16(a[0], a[1]); w.y = cvt_pk_bf16(a[2], a[3]); w.z = cvt_pk_bf16(b[0], b[1]); w.w = cvt_pk_bf16(b[2], b[3]); return w; }

namespace pg8 {
template <class E> __device__ __forceinline__ void run_epi(const E& e, const f32x4 (&acc)[2][2][4][2], const Unit& u, int wr, int wc, int fr, int fq) {
    const int colin = wc * 32 + 8 * fq, row0 = u.pm * BM + wr * 64 + fr;
    const typename E::Tile tl = e.tile(u.pn, colin);
    typename E::Pre q[8];
#pragma unroll
    for (int i = 0; i < 8; ++i) if (i < E::DEPTH) q[i] = e.pre(row0 + (i >> 2) * HALF + (i & 3) * 16, u.pn, colin);
    asm volatile("" ::: "memory");
#pragma unroll
    for (int i = 0; i < 8; ++i) {
        if (i + E::DEPTH < 8) { q[i + E::DEPTH] = e.pre(row0 + ((i + E::DEPTH) >> 2) * HALF + ((i + E::DEPTH) & 3) * 16, u.pn, colin); asm volatile("" ::: "memory"); }
        e.template frag<false>(row0 + (i >> 2) * HALF + (i & 3) * 16, u.pn, colin, acc[i >> 2][0][i & 3][0], acc[i >> 2][0][i & 3][1], acc[i >> 2][1][i & 3][0], acc[i >> 2][1][i & 3][1], q[i], tl);
    }
}
}
#define EPI_COMMON static constexpr bool PERM = true, AFTER_DRAIN = false; \
    __device__ __forceinline__ void operator()(const f32x4 (&acc)[2][2][4][2], const pg8::Unit& u, int wr, int wc, int fr, int fq) const { pg8::run_epi(*this, acc, u, wr, wc, fr, fq); } \
    template <bool META> __device__ __forceinline__ void frag1(int row, int pn, int colin, f32x4 a0, f32x4 a1, f32x4 b0, f32x4 b1) const { this->template frag<META>(row, pn, colin, a0, a1, b0, b1, pre(row, pn, colin), tile(pn, colin)); }
struct EpiNone {};
__device__ __forceinline__ void unpack8(u32x4 w, f32x4& lo, f32x4& hi) { lo = (f32x4){bflo(w.x), bfhi(w.x), bflo(w.y), bfhi(w.y)}; hi = (f32x4){bflo(w.z), bfhi(w.z), bflo(w.w), bfhi(w.w)}; }

struct EpiNull {
    typedef EpiNone Pre; typedef EpiNone Tile; static constexpr int DEPTH = 1;
    __device__ __forceinline__ Pre pre(int, int, int) const { return Pre{}; }
    __device__ __forceinline__ Tile tile(int, int) const { return Tile{}; }
    template <bool META> __device__ __forceinline__ void frag(int row, int pn, int colin, f32x4 a0, f32x4 a1, f32x4 b0, f32x4 b1, const Pre&, const Tile&) const { asm volatile("" :: "v"(a0), "v"(a1), "v"(b0), "v"(b1)); }
    EPI_COMMON
};
struct PreSsq { u64 v; };
struct EpiSwiGLU {
    bf16_t* HID; const u64* ssq;
    typedef PreSsq Pre; typedef EpiNone Tile; static constexpr int DEPTH = 8;
    __device__ __forceinline__ Pre pre(int row, int, int) const { return Pre{ssq[row]}; }
    __device__ __forceinline__ Tile tile(int, int) const { return Tile{}; }
    template <bool META> __device__ __forceinline__ void frag(int row, int pn, int colin, f32x4 a0, f32x4 a1, f32x4 b0, f32x4 b1, const Pre& p, const Tile&) const {
        const float rs = rstd_fx(p.v), c1 = rs * -1.4426950408889634f, rs2 = rs * rs;
        f32x4 t0 = a0 * c1, t1 = a1 * c1;
#pragma unroll
        for (int e = 0; e < 4; ++e) { t0[e] = __builtin_amdgcn_exp2f(t0[e]); t1[e] = __builtin_amdgcn_exp2f(t1[e]); }
        t0 = t0 + 1.0f; t1 = t1 + 1.0f;
#pragma unroll
        for (int e = 0; e < 4; ++e) { t0[e] = __builtin_amdgcn_rcpf(t0[e]); t1[e] = __builtin_amdgcn_rcpf(t1[e]); }
        const f32x4 o0 = (a0 * b0) * t0 * rs2, o1 = (a1 * b1) * t1 * rs2;
        *(u32x4*)(HID + (size_t)row * DFF + pn * 128 + colin) = pack8f(o0, o1);
    }
    EPI_COMMON
};
struct PreH { f32x4 h0, h1, h2, h3; };
struct PreHb { u32x4 lo, hi; };
struct EpiResid {
    float* Hf; bf16_t* HB; u64* ssqn; float alpha, ssw;
    typedef PreHb Pre; typedef EpiNone Tile; static constexpr int DEPTH = 4;
    __device__ __forceinline__ Pre pre(int row, int pn, int colin) const { const bf16_t* bp = HB + (size_t)row * DM + pn * 256 + colin; return Pre{*(const u32x4*)bp, *(const u32x4*)(bp + 128)}; }
    __device__ __forceinline__ Tile tile(int, int) const { return Tile{}; }
    template <bool META> __device__ __forceinline__ void frag(int row, int pn, int colin, f32x4 a0, f32x4 a1, f32x4 b0, f32x4 b1, const Pre& p, const Tile&) const {
        const int c0 = pn * 256 + colin;
        f32x4 h0, h1, h2, h3; unpack8(p.lo, h0, h1); unpack8(p.hi, h2, h3);
        h0 = h0 + alpha * a0; h1 = h1 + alpha * a1; h2 = h2 + alpha * b0; h3 = h3 + alpha * b1;
        bf16_t* bp = HB + (size_t)row * DM + c0;
        *(u32x4*)bp = pack8f(h0, h1); *(u32x4*)(bp + 128) = pack8f(h2, h3);
        if (Hf) { float* hp = Hf + (size_t)row * DM + c0; *(f32x4*)hp = h0; *(f32x4*)(hp + 4) = h1; *(f32x4*)(hp + 128) = h2; *(f32x4*)(hp + 132) = h3; }
        float ss = 0.f;
#pragma unroll
        for (int e = 0; e < 4; ++e) ss += h0[e] * h0[e] + h1[e] * h1[e] + h2[e] * h2[e] + h3[e] * h3[e];
        ss += __shfl_xor(ss, 16); ss += __shfl_xor(ss, 32);
        if ((threadIdx.x & 48) == 0) __hip_atomic_fetch_add(ssqn + row, ssq_fx(ss * ssw), __ATOMIC_RELAXED, __HIP_MEMORY_SCOPE_AGENT);
    }
    EPI_COMMON
};
struct PreWin { u64 v; f32x4 c, s; };
struct TileWin { f32x4 g0, g1, g2, g3; };
struct EpiWin {
    bf16_t *Q, *K, *V, *XR, *GY, *G, *QM; const float* bgate; const u64* ssq; const float* rc; const float* rsn;
    typedef PreWin Pre; typedef TileWin Tile; static constexpr int DEPTH = 3;
    __device__ __forceinline__ Pre pre(int row, int pn, int colin) const {
        Pre p; p.v = ssq[row]; p.c = (f32x4){0.f, 0.f, 0.f, 0.f}; p.s = p.c;
        if (pn < 16 && colin < 32) { const int pos = row >= MR ? row - MR : (row & 4095) + NMETA; p.c = *(const f32x4*)(rc + pos * 16 + (colin >> 1)); p.s = *(const f32x4*)(rsn + pos * 16 + (colin >> 1)); }
        return p; }
    __device__ __forceinline__ Tile tile(int pn, int colin) const {
        Tile t; t.g0 = (f32x4){0.f, 0.f, 0.f, 0.f}; t.g1 = t.g0; t.g2 = t.g0; t.g3 = t.g0;
        if (pn >= 44) { const float* bp = bgate + (pn - 44) * 256 + colin; t.g0 = *(const f32x4*)bp; t.g1 = *(const f32x4*)(bp + 4); t.g2 = *(const f32x4*)(bp + 128); t.g3 = *(const f32x4*)(bp + 132); }
        return t; }
    template <bool META> __device__ __forceinline__ void frag(int row, int pn, int colin, f32x4 a0, f32x4 a1, f32x4 b0, f32x4 b1, const Pre& pq, const Tile& tl) const {
        const float rs = rstd_fx(pq.v);
        a0 = a0 * rs; a1 = a1 * rs; b0 = b0 * rs; b1 = b1 * rs;
        const int mi = row - MR, b = row >> 12, t = row & 4095, pos = META ? mi : t + NMETA;
        if (pn < 24) {
            if (pn < 16 && colin < 32) {
                const f32x4 c = pq.c, s = pq.s;
                const f32x4 r1 = a0 * c - a1 * s, r2 = a1 * c + a0 * s, r3 = b0 * c - b1 * s, r4 = b1 * c + b0 * s;
                a0 = r1; a1 = r2; b0 = r3; b1 = r4;
            }
            const u32x4 wa = pack8f(a0, a1), wb = pack8f(b0, b1);
            const int h = pn & 7;
            if (pn < 8) {
                if (META) { bf16_t* p = QM + ((size_t)(2 * h) * NMETA + mi) * 128 + colin; *(u32x4*)p = wa; *(u32x4*)(p + NMETA * 128) = wb; }
                else { bf16_t* p = Q + ((size_t)(b * 16 + 2 * h) * SEQ + t) * 128 + colin; *(u32x4*)p = wa; *(u32x4*)(p + (size_t)SEQ * 128) = wb; }
            } else {
                bf16_t* base = pn < 16 ? K : V;
                if (META) {
#pragma unroll
                    for (int bb = 0; bb < NB; ++bb) { bf16_t* p = base + ((size_t)(bb * 16 + 2 * h) * KVLEN + mi) * 128 + colin; *(u32x4*)p = wa; *(u32x4*)(p + (size_t)KVLEN * 128) = wb; }
                } else { bf16_t* p = base + ((size_t)(b * 16 + 2 * h) * KVLEN + pos) * 128 + colin; *(u32x4*)p = wa; *(u32x4*)(p + (size_t)KVLEN * 128) = wb; }
            }
        } else if (pn < 34) {
            bf16_t* p = XR + (size_t)row * LW + (pn - 24) * 256 + colin; *(u32x4*)p = pack8f(a0, a1); *(u32x4*)(p + 128) = pack8f(b0, b1);
        } else if (pn < 44) {
            a0 = gelu_tanh4(a0); a1 = gelu_tanh4(a1); b0 = gelu_tanh4(b0); b1 = gelu_tanh4(b1);
            bf16_t* p = GY + (size_t)row * LW + (pn - 34) * 256 + colin; *(u32x4*)p = pack8f(a0, a1); *(u32x4*)(p + 128) = pack8f(b0, b1);
        } else {
            const int c0 = (pn - 44) * 256 + colin;
            a0 = sigmoid4(a0 + tl.g0); a1 = sigmoid4(a1 + tl.g1); b0 = sigmoid4(b0 + tl.g2); b1 = sigmoid4(b1 + tl.g3);
            bf16_t* p = G + (size_t)row * 4096 + c0; *(u32x4*)p = pack8f(a0, a1); *(u32x4*)(p + 128) = pack8f(b0, b1);
        }
    }
    EPI_COMMON
};
struct PreG { u32x4 g0, g1; };
struct EpiBa {
    bf16_t* TMP; const bf16_t* G;
    typedef PreG Pre; typedef EpiNone Tile; static constexpr int DEPTH = 4;
    __device__ __forceinline__ Pre pre(int row, int pn, int colin) const { const bf16_t* gp = G + (size_t)row * 4096 + pn * 256 + colin; return Pre{*(const u32x4*)gp, *(const u32x4*)(gp + 128)}; }
    __device__ __forceinline__ Tile tile(int, int) const { return Tile{}; }
    template <bool META> __device__ __forceinline__ void frag(int row, int pn, int colin, f32x4 a0, f32x4 a1, f32x4 b0, f32x4 b1, const Pre& p, const Tile&) const {
        const int c0 = pn * 256 + colin;
        f32x4 g0, g1, g2, g3; unpack8(p.g0, g0, g1); unpack8(p.g1, g2, g3);
        bf16_t* tp = TMP + (size_t)row * DM + c0;
        *(u32x4*)tp = pack8f(g0 * a0, g1 * a1); *(u32x4*)(tp + 128) = pack8f(g2 * b0, g3 * b1);
    }
    EPI_COMMON
};
struct PreTG { u32x4 t0, t1, g0, g1; };
struct EpiBl {
    const bf16_t* TMP; const bf16_t* G; bf16_t* MIX;
    typedef PreTG Pre; typedef EpiNone Tile; static constexpr int DEPTH = 2;
    __device__ __forceinline__ Pre pre(int row, int pn, int colin) const { const int c0 = pn * 256 + colin; const bf16_t* tp = TMP + (size_t)row * DM + c0; const bf16_t* gp = G + (size_t)row * 4096 + 2048 + c0;
        return Pre{*(const u32x4*)tp, *(const u32x4*)(tp + 128), *(const u32x4*)gp, *(const u32x4*)(gp + 128)}; }
    __device__ __forceinline__ Tile tile(int, int) const { return Tile{}; }
    template <bool META> __device__ __forceinline__ void frag(int row, int pn, int colin, f32x4 a0, f32x4 a1, f32x4 b0, f32x4 b1, const Pre& p, const Tile&) const {
        const int c0 = pn * 256 + colin;
        f32x4 g0, g1, g2, g3, t0, t1, t2, t3; unpack8(p.g0, g0, g1); unpack8(p.g1, g2, g3); unpack8(p.t0, t0, t1); unpack8(p.t1, t2, t3);
        t0 = t0 + g0 * a0; t1 = t1 + g1 * a1; t2 = t2 + g2 * b0; t3 = t3 + g3 * b1;
        bf16_t* mp = MIX + (size_t)row * DM + c0;
        *(u32x4*)mp = pack8f(t0, t1); *(u32x4*)(mp + 128) = pack8f(t2, t3);
    }
    EPI_COMMON
};

struct PreGG { u32x4 a0, a1, l0, l1; };
struct EpiDual {
    const bf16_t* G; bf16_t* MIX;
    typedef PreG Pre; typedef EpiNone Tile; static constexpr int DEPTH = 4;
    __device__ __forceinline__ Pre pre(int row, int pn, int colin) const { const bf16_t* gp = G + (size_t)row * 4096 + 2048 + pn * 256 + colin; return Pre{*(const u32x4*)gp, *(const u32x4*)(gp + 128)}; }
    __device__ __forceinline__ Tile tile(int, int) const { return Tile{}; }
    template <bool META> __device__ __forceinline__ void frag(int row, int pn, int colin, f32x4 a0, f32x4 a1, f32x4 b0, f32x4 b1, const Pre& p, const Tile&) const {
        f32x4 g0, g1, g2, g3; unpack8(p.g0, g0, g1); unpack8(p.g1, g2, g3);
#pragma unroll
        for (int e = 0; e < 4; ++e) { g0[e] = fmaxf(g0[e], 1e-20f); g1[e] = fmaxf(g1[e], 1e-20f); g2[e] = fmaxf(g2[e], 1e-20f); g3[e] = fmaxf(g3[e], 1e-20f); }
        bf16_t* mp = MIX + (size_t)row * DM + pn * 256 + colin;
        *(u32x4*)mp = pack8f(g0 * a0, g1 * a1); *(u32x4*)(mp + 128) = pack8f(g2 * b0, g3 * b1);
    }
    __device__ __forceinline__ PreGG pre2(int row, int pn, int colin) const { const bf16_t* gp = G + (size_t)row * 4096 + pn * 256 + colin;
        return PreGG{*(const u32x4*)gp, *(const u32x4*)(gp + 128), *(const u32x4*)(gp + 2048), *(const u32x4*)(gp + 2048 + 128)}; }
    static __device__ __forceinline__ f32x4 ratio4(f32x4 ga, f32x4 gl) { f32x4 r;
#pragma unroll
        for (int e = 0; e < 4; ++e) r[e] = ga[e] * __builtin_amdgcn_rcpf(fmaxf(gl[e], 1e-20f));
        return r; }
    __device__ __forceinline__ void mid(f32x4 (&acc)[2][2][4][2], const pg8::Unit& u, int wr, int wc, int fr, int fq) const {
        const int colin = wc * 32 + 8 * fq, row0 = u.pm * pg8::BM + wr * 64 + fr;
        PreGG q[8];
#pragma unroll
        for (int i = 0; i < 2; ++i) q[i] = pre2(row0 + (i >> 2) * pg8::HALF + (i & 3) * 16, u.pn, colin);
        asm volatile("" ::: "memory");
#pragma unroll
        for (int i = 0; i < 8; ++i) {
            if (i + 2 < 8) { q[i + 2] = pre2(row0 + ((i + 2) >> 2) * pg8::HALF + ((i + 2) & 3) * 16, u.pn, colin); asm volatile("" ::: "memory"); }
            f32x4 a0, a1, a2, a3, l0, l1, l2, l3; unpack8(q[i].a0, a0, a1); unpack8(q[i].a1, a2, a3); unpack8(q[i].l0, l0, l1); unpack8(q[i].l1, l2, l3);
            acc[i >> 2][0][i & 3][0] = acc[i >> 2][0][i & 3][0] * ratio4(a0, l0); acc[i >> 2][0][i & 3][1] = acc[i >> 2][0][i & 3][1] * ratio4(a1, l1);
            acc[i >> 2][1][i & 3][0] = acc[i >> 2][1][i & 3][0] * ratio4(a2, l2); acc[i >> 2][1][i & 3][1] = acc[i >> 2][1][i & 3][1] * ratio4(a3, l3);
        }
    }
    EPI_COMMON
};

template <class Epi> __device__ __forceinline__ void meta_gemm(LAS unsigned char* lds, const bf16_t* A16, const bf16_t* Bt, int N, int K, const Epi& E) {
    const int tid = tid_fresh(), wid = __builtin_amdgcn_readfirstlane(tid >> 6), lane = tid & 63, fr = lane & 15, fq = lane >> 4;
    const int nitems = N / 64, ks = K / 8;
    LAS f32x4* red = (LAS f32x4*)lds;
    for (int it = blockIdx.x; it < nitems; it += gridDim.x) {
        const int pn = it >> 2, wc = it & 3;
        typename Epi::Pre pq{}; typename Epi::Tile tl{};
        if (wid == 0) { pq = E.pre(MR + fr, pn, wc * 32 + 8 * fq); tl = E.tile(pn, wc * 32 + 8 * fq); }
        f32x4 acc[4];
#pragma unroll
        for (int q = 0; q < 4; ++q) acc[q] = (f32x4){0.f, 0.f, 0.f, 0.f};
        const bf16_t* ap = A16 + (size_t)fr * K + wid * ks + 8 * fq;
        const bf16_t* bp[4];
#pragma unroll
        for (int q = 0; q < 4; ++q) bp[q] = Bt + (size_t)(pn * 256 + (q >> 1) * 128 + wc * 32 + pg8::perm32(16 * (q & 1) + fr)) * K + wid * ks + 8 * fq;
#pragma unroll 8
        for (int kk = 0; kk < ks; kk += 32) {
            const bf16x8 a = *(const bf16x8*)(ap + kk);
#pragma unroll
            for (int q = 0; q < 4; ++q) { const bf16x8 bv = *(const bf16x8*)(bp[q] + kk); acc[q] = __builtin_amdgcn_mfma_f32_16x16x32_bf16(bv, a, acc[q], 0, 0, 0); }
        }
#pragma unroll
        for (int q = 0; q < 4; ++q) red[(wid * 4 + q) * 64 + lane] = acc[q];
        __syncthreads();
        if (wid == 0) {
            f32x4 s[4];
#pragma unroll
            for (int q = 0; q < 4; ++q) { s[q] = red[q * 64 + lane];
#pragma unroll
                for (int w = 1; w < 8; ++w) s[q] = s[q] + red[(w * 4 + q) * 64 + lane]; }
            E.template frag<true>(MR + fr, pn, wc * 32 + 8 * fq, s[0], s[1], s[2], s[3], pq, tl);
        }
        __syncthreads();
    }
}

__device__ __forceinline__ void meta_dual(LAS unsigned char* lds, const bf16_t* A0, const bf16_t* Bt0, int K0, const bf16_t* A1, const bf16_t* Bt1, int K1, const bf16_t* G, bf16_t* MIXo) {
    const int tid = tid_fresh(), wid = __builtin_amdgcn_readfirstlane(tid >> 6), lane = tid & 63, fr = lane & 15, fq = lane >> 4;
    LAS f32x4* red = (LAS f32x4*)lds;
    for (int it = blockIdx.x; it < DM / 64; it += gridDim.x) {
        const int pn = it >> 2, wc = it & 3, colin = wc * 32 + 8 * fq, c0 = pn * 256 + colin;
        u32x4 ga0{}, ga1{}, gl0{}, gl1{};
        if (wid == 0) { const bf16_t* gp = G + (size_t)(MR + fr) * 4096 + c0; ga0 = *(const u32x4*)gp; ga1 = *(const u32x4*)(gp + 128); gl0 = *(const u32x4*)(gp + 2048); gl1 = *(const u32x4*)(gp + 2048 + 128); }
        f32x4 acc[8];
#pragma unroll
        for (int q = 0; q < 8; ++q) acc[q] = (f32x4){0.f, 0.f, 0.f, 0.f};
#pragma unroll
        for (int h = 0; h < 2; ++h) {
            const bf16_t* Ah = h ? A1 : A0; const bf16_t* Bh = h ? Bt1 : Bt0; const int K = h ? K1 : K0, ks = K / 8;
            const bf16_t* ap = Ah + (size_t)fr * K + wid * ks + 8 * fq;
            const bf16_t* bp[4];
#pragma unroll
            for (int q = 0; q < 4; ++q) bp[q] = Bh + (size_t)(pn * 256 + (q >> 1) * 128 + wc * 32 + pg8::perm32(16 * (q & 1) + fr)) * K + wid * ks + 8 * fq;
#pragma unroll 8
            for (int kk = 0; kk < ks; kk += 32) {
                const bf16x8 a = *(const bf16x8*)(ap + kk);
#pragma unroll
                for (int q = 0; q < 4; ++q) { const bf16x8 bv = *(const bf16x8*)(bp[q] + kk); acc[4 * h + q] = __builtin_amdgcn_mfma_f32_16x16x32_bf16(bv, a, acc[4 * h + q], 0, 0, 0); }
            }
        }
#pragma unroll
        for (int q = 0; q < 8; ++q) red[(wid * 8 + q) * 64 + lane] = acc[q];
        __syncthreads();
        if (wid == 0) {
            f32x4 sm[8];
#pragma unroll
            for (int q = 0; q < 8; ++q) { sm[q] = red[q * 64 + lane];
#pragma unroll
                for (int w = 1; w < 8; ++w) sm[q] = sm[q] + red[(w * 8 + q) * 64 + lane]; }
            f32x4 a0, a1, a2, a3, l0, l1, l2, l3; unpack8(ga0, a0, a1); unpack8(ga1, a2, a3); unpack8(gl0, l0, l1); unpack8(gl1, l2, l3);
            bf16_t* mp = MIXo + (size_t)(MR + fr) * DM + c0;
            *(u32x4*)mp = pack8f(a0 * sm[0] + l0 * sm[4], a1 * sm[1] + l1 * sm[5]); *(u32x4*)(mp + 128) = pack8f(a2 * sm[2] + l2 * sm[6], a3 * sm[3] + l3 * sm[7]);
        }
        __syncthreads();
    }
}

template <int MODE> __device__ __forceinline__ int wmap(int n) {
    if (MODE == 1) return ((n >> 7) << 8) + (n & 127);
    if (MODE == 2) return ((n >> 7) << 8) + 128 + (n & 127);
    if (MODE == 3) { if (n >= 4096) return n; const int d = n & 127; if (d >= 32) return n; const int s = d < 16 ? 8 * (d >> 2) + (d & 3) : 8 * ((d - 16) >> 2) + 4 + (d & 3); return (n & ~127) + s; }
    return n;
}
template <int MODE> __device__ __forceinline__ void transpose_item(const float* W, int K, int N, bf16_t* WT, LAS float* scr, int item, int lane, const float* gk = nullptr) {
    const int nblk = N / 32, kb = item / nblk, nb = item % nblk, k0 = 64 * kb, n0 = 32 * nb;
    const int c = lane & 7;
    f32x4 ga = (f32x4){1.f, 1.f, 1.f, 1.f}, gb = ga;
    if (gk) { ga = *(const f32x4*)(gk + k0 + 8 * c); gb = *(const f32x4*)(gk + k0 + 8 * c + 4); }
    { float wv[32];
      const float* wp = W + (size_t)(k0 + (lane >> 5)) * N + n0 + (lane & 31);
#pragma unroll
      for (int i = 0; i < 32; ++i) wv[i] = wp[(size_t)(2 * i) * N];
#pragma unroll
      for (int i = 0; i < 32; ++i) scr[(2 * i + (lane >> 5)) * 33 + (lane & 31)] = wv[i]; }
    asm volatile("s_waitcnt lgkmcnt(0)" ::: "memory");
#pragma unroll
    for (int j = 0; j < 4; ++j) { const int n = (lane >> 3) + 8 * j; const LAS float* s = scr + (8 * c) * 33 + n;
        u32x4 o; o.x = cvt_pk_bf16(s[0 * 33] * ga[0], s[1 * 33] * ga[1]); o.y = cvt_pk_bf16(s[2 * 33] * ga[2], s[3 * 33] * ga[3]); o.z = cvt_pk_bf16(s[4 * 33] * gb[0], s[5 * 33] * gb[1]); o.w = cvt_pk_bf16(s[6 * 33] * gb[2], s[7 * 33] * gb[3]);
        *(u32x4*)(WT + (size_t)wmap<MODE>(n0 + n) * K + k0 + 8 * c) = o; }
    asm volatile("s_waitcnt lgkmcnt(0)" ::: "memory");
}

struct Args { const float* in[29]; float* out; unsigned char* ws; float invf[16]; int ph_lo, ph_hi; };
static_assert(sizeof(Args) == 31 * 8 + 16 * 4 + 8, "Args has no padding");

__device__ __forceinline__ void conv_pass(const bf16_t* XR, bf16_t* XCg, const float* conv_w, const float* conv_b, int gtid, int ngt) {
    constexpr int NCH = LW / 8, RUNS = (SEQ + NMETA) / 8, NTASK = NB * RUNS * NCH;
    for (int task = gtid; task < NTASK; task += ngt) {
        const int c8 = task % NCH, u = (task / NCH) % RUNS, b = task / (NCH * RUNS), p0 = 8 * u;
        if (u < 2 && b > 0) continue;
        float cw[4][8], cb[8], o[8][8];
        { const f32x4 b0 = *(const f32x4*)(conv_b + 8 * c8), b1 = *(const f32x4*)(conv_b + 8 * c8 + 4);
#pragma unroll
          for (int e = 0; e < 4; ++e) { cb[e] = b0[e]; cb[4 + e] = b1[e]; }
#pragma unroll
          for (int j = 0; j < 4; ++j) { const f32x4 w0 = *(const f32x4*)(conv_w + j * LW + 8 * c8), w1 = *(const f32x4*)(conv_w + j * LW + 8 * c8 + 4);
#pragma unroll
              for (int e = 0; e < 4; ++e) { cw[j][e] = w0[e]; cw[j][4 + e] = w1[e]; } } }
#pragma unroll
        for (int i = 0; i < 8; ++i)
#pragma unroll
            for (int e = 0; e < 8; ++e) o[i][e] = cb[e];
        u32x4 raw[11];
#pragma unroll
        for (int m = 0; m < 11; ++m) { const int p = p0 - 3 + m; raw[m] = (u32x4){0u, 0u, 0u, 0u};
            if (p >= 0) { const int row = p < NMETA ? MR + p : b * SEQ + p - NMETA; raw[m] = *(const u32x4*)(XR + (size_t)row * LW + 8 * c8); } }
#pragma unroll
        for (int m = 0; m < 11; ++m) {
            const u32x4 xv = raw[m];
            const float x[8] = {bflo(xv.x), bfhi(xv.x), bflo(xv.y), bfhi(xv.y), bflo(xv.z), bfhi(xv.z), bflo(xv.w), bfhi(xv.w)};
#pragma unroll
            for (int i = 0; i < 8; ++i) { const int j = i + 3 - m; if (j >= 0 && j < 4) {
#pragma unroll
                for (int e = 0; e < 8; ++e) o[i][e] += cw[j][e] * x[e]; } }
        }
#pragma unroll
        for (int i = 0; i < 8; ++i) { const int p = p0 + i, row = p < NMETA ? MR + p : b * SEQ + p - NMETA;
            u32x4 w; w.x = cvt_pk_bf16(o[i][0], o[i][1]); w.y = cvt_pk_bf16(o[i][2], o[i][3]); w.z = cvt_pk_bf16(o[i][4], o[i][5]); w.w = cvt_pk_bf16(o[i][6], o[i][7]);
            *(u32x4*)(XCg + (size_t)row * LW + 8 * c8) = w; }
    }
}
constexpr int LRU_TT = 128, LRU_XCS = 168;
constexpr int LRU_XC = 0, LRU_WS = LRU_XC + 128 * 336, LRU_GYS = LRU_WS + 80 * 336, LRU_SEG = LRU_GYS + 2 * 10240, LRU_HIN = LRU_SEG + 2 * 1280, LRU_HW = LRU_HIN + 2 * 160, LRU_END = LRU_HW + 8 * 160;
static_assert(LRU_END <= RING_BYTES, "LRU LDS map");
template <int SH> __device__ __forceinline__ float dpp_shr(float old, float v) {
    return __builtin_bit_cast(float, __builtin_amdgcn_update_dpp(__builtin_bit_cast(int, old), __builtin_bit_cast(int, v), 0x110 + SH, 0xf, 0xf, false));
}
#define LRU_SCAN_STEP(SH) asm volatile("s_nop 1\n\t" \
        "v_fmac_f32_dpp %0, %0, %10 row_shr:" #SH " row_mask:0xf bank_mask:0xf\n\t" \
        "v_fmac_f32_dpp %1, %1, %11 row_shr:" #SH " row_mask:0xf bank_mask:0xf\n\t" \
        "v_fmac_f32_dpp %2, %2, %12 row_shr:" #SH " row_mask:0xf bank_mask:0xf\n\t" \
        "v_fmac_f32_dpp %3, %3, %13 row_shr:" #SH " row_mask:0xf bank_mask:0xf\n\t" \
        "v_fmac_f32_dpp %4, %4, %14 row_shr:" #SH " row_mask:0xf bank_mask:0xf\n\t" \
        "v_fmac_f32_dpp %5, %5, %15 row_shr:" #SH " row_mask:0xf bank_mask:0xf\n\t" \
        "v_fmac_f32_dpp %6, %6, %16 row_shr:" #SH " row_mask:0xf bank_mask:0xf\n\t" \
        "v_fmac_f32_dpp %7, %7, %17 row_shr:" #SH " row_mask:0xf bank_mask:0xf\n\t" \
        "v_fmac_f32_dpp %8, %8, %18 row_shr:" #SH " row_mask:0xf bank_mask:0xf\n\t" \
        "v_fmac_f32_dpp %9, %9, %19 row_shr:" #SH " row_mask:0xf bank_mask:0xf\n\t" \
        "v_mul_f32_dpp %10, %10, %10 row_shr:" #SH " row_mask:0xf bank_mask:0xf\n\t" \
        "v_mul_f32_dpp %11, %11, %11 row_shr:" #SH " row_mask:0xf bank_mask:0xf\n\t" \
        "v_mul_f32_dpp %12, %12, %12 row_shr:" #SH " row_mask:0xf bank_mask:0xf\n\t" \
        "v_mul_f32_dpp %13, %13, %13 row_shr:" #SH " row_mask:0xf bank_mask:0xf\n\t" \
        "v_mul_f32_dpp %14, %14, %14 row_shr:" #SH " row_mask:0xf bank_mask:0xf\n\t" \
        "v_mul_f32_dpp %15, %15, %15 row_shr:" #SH " row_mask:0xf bank_mask:0xf\n\t" \
        "v_mul_f32_dpp %16, %16, %16 row_shr:" #SH " row_mask:0xf bank_mask:0xf\n\t" \
        "v_mul_f32_dpp %17, %17, %17 row_shr:" #SH " row_mask:0xf bank_mask:0xf\n\t" \
        "v_mul_f32_dpp %18, %18, %18 row_shr:" #SH " row_mask:0xf bank_mask:0xf\n\t" \
        "v_mul_f32_dpp %19, %19, %19 row_shr:" #SH " row_mask:0xf bank_mask:0xf\n\t" \
        : "+v"(Bv[0][0]), "+v"(Bv[0][1]), "+v"(Bv[1][0]), "+v"(Bv[1][1]), "+v"(Bv[2][0]), "+v"(Bv[2][1]), "+v"(Bv[3][0]), "+v"(Bv[3][1]), "+v"(Bv[4][0]), "+v"(Bv[4][1]), "+v"(Av[0][0]), "+v"(Av[0][1]), "+v"(Av[1][0]), "+v"(Av[1][1]), "+v"(Av[2][0]), "+v"(Av[2][1]), "+v"(Av[3][0]), "+v"(Av[3][1]), "+v"(Av[4][0]), "+v"(Av[4][1]))
__device__ __forceinline__ void lru_item(LAS unsigned char* lds, int it, const bf16_t* XCg, const bf16_t* GY, bf16_t* LO,
                                         const float* gx_w, const float* gx_b, const float* ga_w, const float* ga_b, const float* a_param) {
    const int tid = tid_fresh(), wid = __builtin_amdgcn_readfirstlane(tid >> 6), lane = tid & 63, fr = lane & 15, fq = lane >> 4;
    const int b = it >> 6, n = (it >> 2) & 15, s = it & 3, cl0 = 40 * s, cg0 = 160 * n + cl0;
    LAS bf16_t* XC = (LAS bf16_t*)(lds + LRU_XC); LAS bf16_t* WSM = (LAS bf16_t*)(lds + LRU_WS); LAS bf16_t* GYS = (LAS bf16_t*)(lds + LRU_GYS);
    LAS float* SEGA = (LAS float*)(lds + LRU_SEG); LAS float* SEGB = SEGA + 320; LAS float* HIN = (LAS float*)(lds + LRU_HIN); LAS float* HW = (LAS float*)(lds + LRU_HW);
    { float wv[25];
#pragma unroll
      for (int i = 0; i < 25; ++i) { const int e = tid + 512 * i, k = e / 80, j = e % 80, gate = j / 40, ch = j % 40; wv[i] = *((gate ? gx_w : ga_w) + ((size_t)n * 160 + k) * 160 + cl0 + ch); }
#pragma unroll
      for (int i = 0; i < 25; ++i) { const int e = tid + 512 * i, k = e / 80, j = e % 80, gate = j / 40, ch = j % 40, row = 16 * (ch >> 3) + 4 * ((ch >> 1) & 3) + 2 * gate + (ch & 1); WSM[row * LRU_XCS + k] = f2bf16(wv[i]); } }
    if (tid < 40) HIN[tid] = 0.f;
    float gab[5][2], gxb[5][2], lsa[5][2];
#pragma unroll
    for (int mt = 0; mt < 5; ++mt)
#pragma unroll
        for (int e = 0; e < 2; ++e) { const int c = cg0 + 8 * mt + 2 * fq + e; gab[mt][e] = -1.4426950408889634f * ga_b[c]; gxb[mt][e] = -1.4426950408889634f * gx_b[c];
            lsa[mt][e] = -8.0f * 1.4426950408889634f * log1pf(__expf(-a_param[c])); }
    u32x4 px[5], pg[2];
#define LRU_LOAD(kk) do { const int p0_ = (kk) == 0 ? 0 : NMETA + LRU_TT * ((kk) - 1);     \
        _Pragma("unroll") for (int i = 0; i < 5; ++i) { const int e = tid + 512 * i, t_ = e / 20, ch = e % 20, p = p0_ + t_; \
            const int row = p < NMETA ? MR + p : b * SEQ + p - NMETA; px[i] = *(const u32x4*)(XCg + (size_t)row * LW + 160 * n + 8 * ch); } \
        _Pragma("unroll") for (int i = 0; i < 2; ++i) { const int e = (tid + 512 * i) % 640, t_ = e / 5, ch = e % 5, p = p0_ + t_; \
            const int row = p < NMETA ? MR + p : b * SEQ + p - NMETA; pg[i] = *(const u32x4*)(GY + (size_t)row * LW + cg0 + 8 * ch); } } while (0)
#define LRU_STORE(kk) do { const int ps_ = (kk) == 0 ? 0 : NMETA + LRU_TT * ((kk) - 1), nvs_ = (kk) == 0 ? NMETA : LRU_TT; const LAS bf16_t* gs_ = GYS + ((kk) & 1) * 5120; \
        if ((kk) > 0 || b == 0) { _Pragma("unroll") for (int i = 0; i < 2; ++i) { const int e = tid + 512 * i, tt = e / 5, ch = e % 5, p = ps_ + tt, row = p < NMETA ? MR + p : b * SEQ + p - NMETA; \
            if (e < nvs_ * 5) *(u32x4*)(LO + (size_t)row * LW + cg0 + 8 * ch) = *(const LAS u32x4*)(gs_ + tt * 40 + 8 * ch); } } } while (0)
    LRU_LOAD(0);
    __syncthreads();
    for (int k = 0; k <= 32; ++k) {
        LAS bf16_t* GYc = GYS + (k & 1) * 5120;
#pragma unroll
        for (int i = 0; i < 5; ++i) { const int e = tid + 512 * i, t_ = e / 20, ch = e % 20; *(LAS u32x4*)(XC + t_ * LRU_XCS + 8 * ch) = px[i]; }
#pragma unroll
        for (int i = 0; i < 2; ++i) { const int e = tid + 512 * i, t_ = e / 5, ch = e % 5; if (e < 128 * 5) *(LAS u32x4*)(GYc + t_ * 40 + 8 * ch) = pg[i]; }
        asm volatile("s_waitcnt lgkmcnt(0)\n\ts_barrier" ::: "memory");
        if (k > 0) LRU_STORE(k - 1);
        if (k < 32) LRU_LOAD(k + 1);
        float Av[5][2], Bv[5][2];
        const int t = 16 * wid + fr;
        {
            bf16x8 xcf[5];
#pragma unroll
            for (int kk = 0; kk < 5; ++kk) xcf[kk] = *(const LAS bf16x8*)(XC + t * LRU_XCS + 32 * kk + 8 * fq);
#pragma unroll
            for (int mt = 0; mt < 5; ++mt) {
                f32x4 acc = (f32x4){0.f, 0.f, 0.f, 0.f};
#pragma unroll
                for (int kk = 0; kk < 5; ++kk) { const bf16x8 wf = *(const LAS bf16x8*)(WSM + (16 * mt + fr) * LRU_XCS + 32 * kk + 8 * fq); acc = __builtin_amdgcn_mfma_f32_16x16x32_bf16(wf, xcf[kk], acc, 0, 0, 0); }
                const unsigned xw = *(const LAS unsigned*)(XC + t * LRU_XCS + cl0 + 8 * mt + 2 * fq);
#pragma unroll
                for (int e = 0; e < 2; ++e) {
                    const float rr = __builtin_amdgcn_rcpf(1.0f + __builtin_amdgcn_exp2f(acc[e] * -1.4426950408889634f + gab[mt][e]));
                    const float ii = __builtin_amdgcn_rcpf(1.0f + __builtin_amdgcn_exp2f(acc[2 + e] * -1.4426950408889634f + gxb[mt][e]));
                    const float a = __builtin_amdgcn_exp2f(rr * lsa[mt][e]);
                    Av[mt][e] = a; Bv[mt][e] = __builtin_amdgcn_sqrtf(1.0f - a * a) * ii * (e ? bfhi(xw) : bflo(xw));
                }
            }
            if (k == 0 && wid > 0) {
#pragma unroll
                for (int mt = 0; mt < 5; ++mt) { Av[mt][0] = 1.f; Av[mt][1] = 1.f; Bv[mt][0] = 0.f; Bv[mt][1] = 0.f; }
            }
        }
        LRU_SCAN_STEP(1); LRU_SCAN_STEP(2); LRU_SCAN_STEP(4); LRU_SCAN_STEP(8);
        if (fr == 15) {
#pragma unroll
            for (int mt = 0; mt < 5; ++mt) { const int c = 8 * mt + 2 * fq; *(LAS f32x2*)(SEGA + wid * 40 + c) = (f32x2){Av[mt][0], Av[mt][1]}; *(LAS f32x2*)(SEGB + wid * 40 + c) = (f32x2){Bv[mt][0], Bv[mt][1]}; }
        }
        asm volatile("s_waitcnt lgkmcnt(0)\n\ts_barrier" ::: "memory");
        if (lane < 40) { float sa[8], sb[8];
#pragma unroll
            for (int v = 0; v < 8; ++v) { sa[v] = SEGA[v * 40 + lane]; sb[v] = SEGB[v * 40 + lane]; }
            float h = HIN[(k & 1) * 40 + lane];
#pragma unroll
            for (int v = 0; v < 7; ++v) if (v < wid) h = sa[v] * h + sb[v];
            HW[wid * 40 + lane] = h;
            if (wid == 7) HIN[((k + 1) & 1) * 40 + lane] = sa[7] * h + sb[7]; }
        asm volatile("s_waitcnt lgkmcnt(0)" ::: "memory");
#pragma unroll
        for (int mt = 0; mt < 5; ++mt) { const int c = 8 * mt + 2 * fq; const f32x2 hin = *(const LAS f32x2*)(HW + wid * 40 + c);
            LAS unsigned* gp = (LAS unsigned*)(GYc + t * 40 + c); const unsigned gw_ = *gp;
            const float h0 = Bv[mt][0] + Av[mt][0] * hin[0], h1 = Bv[mt][1] + Av[mt][1] * hin[1];
            *gp = cvt_pk_bf16(h0 * bflo(gw_), h1 * bfhi(gw_)); }
    }
    __syncthreads();
    LRU_STORE(32);
    __syncthreads();
#undef LRU_STORE
#undef LRU_LOAD
}
#undef LRU_SCAN_STEP

__device__ __forceinline__ att::BlockRef<bf16_t, bf16_t> attn_ref(const bf16_t* Qb, const bf16_t* Kb, const bf16_t* Vb, bf16_t* OP, int b, int h, int s, int idx) {
    const int cj = idx >> 1, c = cj >> 1, j = cj & 1, qb = (idx & 1) ? 15 - s : s;
    att::BlockRef<bf16_t, bf16_t> r;
    r.Q = Qb + ((size_t)(b * 16 + 2 * h + c) * SEQ + (size_t)qb * 256) * 128;
    r.K = Kb + (size_t)(b * 16 + 2 * h + c) * KVLEN * 128;
    r.V = Vb + (size_t)(b * 16 + 2 * h + j) * KVLEN * 128;
    r.O = OP + ((size_t)((b * 8 + h) * 4 + cj) * SEQ + (size_t)qb * 256) * 128;
    r.P0 = NMETA + qb * 256;
    return r;
}
__device__ __forceinline__ void attn_phase(char* lds, const bf16_t* Qb, const bf16_t* Kb, const bf16_t* Vb, bf16_t* OP, int vcu, int G) {
    constexpr int W = 1 << 20;
    for (int vw = vcu; vw < 256; vw += G) {
        const int bh = vw >> 3, s = vw & 7, b = bh >> 3, h = bh & 7;
        att::Seam<bf16_t> S;
        att::BlockRef<bf16_t, bf16_t> cur = attn_ref(Qb, Kb, Vb, OP, b, h, s, 0);
        att::causal_swa_prime<bf16_t, bf16_t>(cur, W, lds, S);
#pragma nounroll
        for (int idx = 0; idx < 8; ++idx) {
            const att::BlockRef<bf16_t, bf16_t> nxt = idx < 7 ? attn_ref(Qb, Kb, Vb, OP, b, h, s, idx + 1) : cur;
            att::causal_swa_block<bf16_t, bf16_t>(cur, nxt, KVLEN, W, lds, S);
            cur = nxt;
        }
    }
}

__device__ __forceinline__ void attn_phase256(char* lds, const bf16_t* Qb, const bf16_t* Kb, const bf16_t* Vb, bf16_t* OP, bf16_t* AO, float lam, const float* sl, int vcu, int G) {
    for (int vw = vcu; vw < 256; vw += G) {
        const int bh = vw >> 3, s = vw & 7, b = bh >> 3, h = bh & 7;
#pragma nounroll
        for (int pass = 0; pass < 2; ++pass) {
            const int qb = pass ? 15 - s : s;
            const bf16_t* v0 = Vb + (size_t)(b * 16 + 2 * h) * KVLEN * 128; const bf16_t* v1 = v0 + (size_t)KVLEN * 128;
            bf16_t* op = OP + ((size_t)(b * 8 + h) * SEQ + (size_t)qb * 256) * 256;
            bf16_t* ao = AO + (size_t)(b * SEQ + qb * 256) * DM + h * 256;
            att::diff_attn_block<false>(Qb + ((size_t)(b * 16 + 2 * h) * SEQ + (size_t)qb * 256) * 128, Kb + (size_t)(b * 16 + 2 * h) * KVLEN * 128, v0, v1, op, NMETA + qb * 256, KVLEN, lds, ao, DM, lam, sl, EPS);
            att::diff_attn_block<true>(Qb + ((size_t)(b * 16 + 2 * h + 1) * SEQ + (size_t)qb * 256) * 128, Kb + (size_t)(b * 16 + 2 * h + 1) * KVLEN * 128, v0, v1, op, NMETA + qb * 256, KVLEN, lds, ao, DM, lam, sl, EPS);
        }
    }
}
__device__ __forceinline__ float lam_of(const float* lq1, const float* lk1, const float* lq2, const float* lk2, float lam_init, int lane) {
    const float d1 = wave_sum(lq1[lane] * lk1[lane] + lq1[lane + 64] * lk1[lane + 64]), d2 = wave_sum(lq2[lane] * lk2[lane] + lq2[lane + 64] * lk2[lane + 64]);
    return __uint_as_float(__builtin_amdgcn_readfirstlane(__float_as_uint(expf(d1) - expf(d2) + lam_init)));
}
__device__ __forceinline__ void combine_phase(const bf16_t* OP, bf16_t* AO, const bf16_t* QM, const bf16_t* Kb, const bf16_t* Vb, const float* subln, float lam, float lam_init, int gw, int ngw, int lane) {
    const f32x4 sl = *(const f32x4*)(subln + 4 * lane) * (1.0f - lam_init);
    for (int it = gw; it < NHEAD * NMETA; it += ngw) {
        const int h = it >> 4, i = it & 15, kj = lane & 15, part = lane >> 4;
        float pc[2];
#pragma unroll
        for (int c = 0; c < 2; ++c) {
            const bf16_t* qp = QM + ((size_t)(2 * h + c) * NMETA + i) * 128 + 32 * part;
            const bf16_t* kp = Kb + ((size_t)(2 * h + c) * KVLEN + kj) * 128 + 32 * part;
            float d = 0.f;
#pragma unroll
            for (int e = 0; e < 4; ++e) { const u32x4 qv = *(const u32x4*)(qp + 8 * e), kv = *(const u32x4*)(kp + 8 * e);
                d += bflo(qv.x) * bflo(kv.x) + bfhi(qv.x) * bfhi(kv.x) + bflo(qv.y) * bflo(kv.y) + bfhi(qv.y) * bfhi(kv.y) + bflo(qv.z) * bflo(kv.z) + bfhi(qv.z) * bfhi(kv.z) + bflo(qv.w) * bflo(kv.w) + bfhi(qv.w) * bfhi(kv.w); }
            d += __shfl_xor(d, 16); d += __shfl_xor(d, 32);
            float sv = kj <= i ? d * 0.08838834764831845f : -INFINITY;
            float m = sv;
#pragma unroll
            for (int o = 1; o < 16; o <<= 1) m = fmaxf(m, __shfl_xor(m, o));
            float p = __expf(sv - m), l = p;
#pragma unroll
            for (int o = 1; o < 16; o <<= 1) l += __shfl_xor(l, o);
            pc[c] = p / l;
        }
        const int j = lane >> 5, dd = 4 * (lane & 31);
        f32x4 o0 = (f32x4){0.f, 0.f, 0.f, 0.f}, o1 = o0;
        for (int k2 = 0; k2 <= i; ++k2) {
            const unsigned long long w = *(const unsigned long long*)(Vb + ((size_t)(2 * h + j) * KVLEN + k2) * 128 + dd);
            const f32x4 v = (f32x4){bflo((unsigned)w), bfhi((unsigned)w), bflo((unsigned)(w >> 32)), bfhi((unsigned)(w >> 32))};
            o0 = o0 + __shfl(pc[0], k2) * v; o1 = o1 + __shfl(pc[1], k2) * v;
        }
        f32x4 x = o0 - lam * o1;
        const float ss = wave_sum(x[0] * x[0] + x[1] * x[1] + x[2] * x[2] + x[3] * x[3]);
        const float rs = rsqrtf(ss * (1.0f / 256.0f) + EPS);
        x = x * rs * sl;
        *(unsigned long long*)(AO + (size_t)(MR + i) * DM + h * 256 + 4 * lane) = (unsigned long long)cvt_pk_bf16(x[0], x[1]) | ((unsigned long long)cvt_pk_bf16(x[2], x[3]) << 32);
    }
}

__device__ __forceinline__ float sgpr_fresh_f(float v) { asm volatile("" : "+s"(v)); return v; }
__device__ __forceinline__ int sgpr_fresh(int v) { asm volatile("" : "+s"(v)); return v; }
typedef const __attribute__((address_space(4))) Args* ArgsP;
__device__ __forceinline__ ArgsP fresh_args() { ArgsP p = (ArgsP)__builtin_amdgcn_kernarg_segment_ptr(); asm volatile("" : "+s"(p)); return p; }
#define PH_ARGS ArgsP A = fresh_args(); unsigned char* const ws = A->ws; (void)ws; \
    const int G = sgpr_fresh(G0), bx = sgpr_fresh(bx0), vcu = sgpr_fresh(vcu0); (void)bx; \
    const int tid = tid_fresh(), lane = tid & 63, wave = __builtin_amdgcn_readfirstlane(tid >> 6), gw = vcu * NWAVES + wave, ngw = G * NWAVES; (void)lane; (void)gw; (void)ngw
#define ssq_base ((u64*)(ws + SSQ_OFF))
#define H ((float*)(ws + WS_H))
#define HB ((bf16_t*)(ws + WS_HB))
#define HID ((bf16_t*)(ws + WS_HID))
#define Qb ((bf16_t*)(ws + WS_Q))
#define Kb ((bf16_t*)(ws + WS_K))
#define Vb ((bf16_t*)(ws + WS_V))
#define QM ((bf16_t*)(ws + WS_QM))
#define XR ((bf16_t*)(ws + WS_XR))
#define GY ((bf16_t*)(ws + WS_GY))
#define GG ((bf16_t*)(ws + WS_G))
#define OP ((bf16_t*)(ws + WS_OP))
#define AO ((bf16_t*)(ws + WS_AO))
#define LO ((bf16_t*)(ws + WS_LO))
#define TMP ((bf16_t*)(ws + WS_TMP))
#define XCG ((bf16_t*)(ws + WS_TMP))
#define MIX ((bf16_t*)(ws + WS_MIX))
#define LAM_INIT(ll) ((ll) == 0 ? 0.2f : (ll) == 1 ? 0.35550906759096926f : (ll) == 2 ? 0.47071301834358416f : 0.5560582041556405f)
#define SLV ((float*)(ws + WS_QM + 131072))
#define ropec ((float*)(ws + WS_ROPE))
#define ropes ((float*)(ws + WS_ROPE + 512 * 1024))
#define SSQ(i) (ssq_base + (size_t)(i) * MPAD)
constexpr int CV_G = (DM / 64) * (DFF / 32), CV_D = (DFF / 64) * (DM / 32), CV_IN = (DM / 64) * (NIN / 32), CV_S = (DM / 64) * (DM / 32), CV_L = (LW / 64) * (DM / 32);
constexpr int CV_NIT = 2 * (2 * CV_G + CV_D) + CV_IN + 2 * CV_S + CV_L;
__device__ __forceinline__ void convert_item(ArgsP A, unsigned char* ws, int l, int it, LAS float* scr, int lane) {
    unsigned char* wb = ws + (size_t)(l & 1) * WBUF_STRIDE;
    int r = it;
    if (r < CV_G) { transpose_item<1>(A->in[3] + (size_t)l * DM * DFF, DM, DFF, (bf16_t*)(wb + W_GU1), scr, r, lane, A->in[2] + (size_t)l * DM); return; } r -= CV_G;
    if (r < CV_G) { transpose_item<2>(A->in[4] + (size_t)l * DM * DFF, DM, DFF, (bf16_t*)(wb + W_GU1), scr, r, lane, A->in[2] + (size_t)l * DM); return; } r -= CV_G;
    if (r < CV_D) { transpose_item<0>(A->in[5] + (size_t)l * DFF * DM, DFF, DM, (bf16_t*)(wb + W_DN1), scr, r, lane); return; } r -= CV_D;
    if (r < CV_IN) { transpose_item<3>(A->in[7] + (size_t)l * DM * NIN, DM, NIN, (bf16_t*)(wb + W_IN), scr, r, lane, A->in[6] + (size_t)l * DM); return; } r -= CV_IN;
    if (r < CV_S) { transpose_item<0>(A->in[21] + (size_t)l * DM * DM, DM, DM, (bf16_t*)(wb + W_BA), scr, r, lane); return; } r -= CV_S;
    if (r < CV_L) { transpose_item<0>(A->in[22] + (size_t)l * LW * DM, LW, DM, (bf16_t*)(wb + W_BL), scr, r, lane); return; } r -= CV_L;
    if (r < CV_S) { transpose_item<0>(A->in[23] + (size_t)l * DM * DM, DM, DM, (bf16_t*)(wb + W_O), scr, r, lane); return; } r -= CV_S;
    if (r < CV_G) { transpose_item<1>(A->in[25] + (size_t)l * DM * DFF, DM, DFF, (bf16_t*)(wb + W_GU2), scr, r, lane, A->in[24] + (size_t)l * DM); return; } r -= CV_G;
    if (r < CV_G) { transpose_item<2>(A->in[26] + (size_t)l * DM * DFF, DM, DFF, (bf16_t*)(wb + W_GU2), scr, r, lane, A->in[24] + (size_t)l * DM); return; } r -= CV_G;
    transpose_item<0>(A->in[27] + (size_t)l * DFF * DM, DFF, DM, (bf16_t*)(wb + W_DN2), scr, r, lane);
}
__device__ __forceinline__ void fill_seam(ArgsP A, gu32* ctl, LAS unsigned char* L, volatile LAS unsigned* MISC, int seam, int G, bool drain, int lnext) {
    unsigned char* const ws = A->ws;
    const int tid = tid_fresh(), lane = tid & 63, wave = __builtin_amdgcn_readfirstlane(tid >> 6);
    LAS float* scr = (LAS float*)(L + wave * 16384);
    if (tid == 0) __hip_atomic_fetch_add(ctl + CW_REACH + 64 * seam, 1u, RLX_AGENT);
    for (;;) {
        if (tid == 0) {
            unsigned base = (unsigned)CV_NIT;
            const bool stop = !drain && __hip_atomic_load(ctl + CW_REACH + 64 * seam, RLX_AGENT) >= (unsigned)(G - 16);
            if (!stop) base = __hip_atomic_fetch_add(ctl + CW_ITEM + 64 * lnext, 8u, RLX_AGENT);
            MISC[12] = base;
        }
        __syncthreads();
        const unsigned base = MISC[12];
        __syncthreads();
        if (base >= (unsigned)CV_NIT) break;
        const int it = (int)base + wave;
        if (it < CV_NIT) convert_item(A, ws, lnext, it, scr, lane);
    }
}
constexpr int CVR_GU1 = 0, CVR_DN1 = 2 * CV_G, CVR_IN = CVR_DN1 + CV_D, CVR_BA = CVR_IN + CV_IN, CVR_O = CVR_BA + CV_S + CV_L, CVR_GU2 = CVR_O + CV_S, CVR_DN2 = CVR_GU2 + 2 * CV_G;
static_assert(CVR_DN2 + CV_D == CV_NIT, "conversion ranges");
#define CONVERT(ll, first, count) do { if (EN(0)) { ArgsP A_ = fresh_args(); const int tid_ = tid_fresh(), lane_ = tid_ & 63, wave_ = __builtin_amdgcn_readfirstlane(tid_ >> 6), gw_ = vcu * NWAVES + wave_; \
        LAS float* scr_ = (LAS float*)(L + wave_ * 16384); REP(0) for (int it_ = (first) + gw_; it_ < (first) + (count); it_ += G * NWAVES) convert_item(A_, A_->ws, (ll), it_, scr_, lane_); } } while (0)
__global__ void __launch_bounds__(NWAVES * 64, 2) mk_fwd(Args args) {
    extern __shared__ __attribute__((aligned(16))) unsigned char lds[];
    LAS unsigned char* L = (LAS unsigned char*)lds;
    volatile LAS unsigned* MISC = (volatile LAS unsigned*)(L + MISC_OFF);
    const int G0 = gridDim.x, bx0 = blockIdx.x, vcu0 = (G0 % 8 == 0) ? (bx0 % 8) * (G0 / 8) + bx0 / 8 : bx0;
    gu32* ctl = (gu32*)(args.ws + WS_CTL);
    for (int u = threadIdx.x; u < (LDS_BYTES - LDSCTL_OFF) / 4; u += NWAVES * 64) ((LAS unsigned*)(L + LDSCTL_OFF))[u] = 0u;
    __syncthreads();
    XcdBarrier bar; bar.bar = (unsigned*)(ctl + CW_BAR); bar.x = 0; bar.st = nullptr;
    if (!MK_MULTI) bar = xcd_barrier_post((unsigned*)(ctl + CW_BAR), MISC + 8);
    const int lo = args.ph_lo, hi = args.ph_hi;
    unsigned long long twait = 0; const unsigned long long tstart = (DUP_PHASE == 40) ? __builtin_amdgcn_s_memrealtime() : 0ull;
#define IN(k) (lo <= (k) && (k) < hi)
#define SEAM(k) do { if (IN((k) + 1)) { unsigned long long tb0_ = 0; if (DUP_PHASE == 40) tb0_ = __builtin_amdgcn_s_memrealtime(); xcd_barrier(bar); if (DUP_PHASE == 40 && (PROBE_SEAM < 0 || ((k) - 1) % PH_PER_LAYER == PROBE_SEAM)) { twait += __builtin_amdgcn_s_memrealtime() - tb0_; } if (DUP_PHASE == 30) { xcd_barrier(bar); xcd_barrier(bar); xcd_barrier(bar); xcd_barrier(bar); } } } while (0)

    if (EN(10) && IN(0)) {
        PH_ARGS; const float* x = A->in[0]; const float* meta = A->in[1];
        for (int m = gw; m < MROWS; m += ngw) {
            const float* src = m < MR ? x + (size_t)m * DM : meta + (size_t)(m - MR) * DM; float ss = 0.f;
#pragma unroll
            for (int j = 0; j < 8; ++j) { const int c = 4 * (64 * j + lane); const f32x4 v = *(const f32x4*)(src + c);
                ss += v[0] * v[0] + v[1] * v[1] + v[2] * v[2] + v[3] * v[3];
                *(unsigned long long*)(HB + (size_t)m * DM + c) = (unsigned long long)cvt_pk_bf16(v[0], v[1]) | ((unsigned long long)cvt_pk_bf16(v[2], v[3]) << 32); }
            ss = wave_sum(ss); if (lane == 0) ssq_base[m] = ssq_fx(ss);
        }
        for (int e = gw * 64 + lane; e < DEPTH * 256; e += ngw * 64) SLV[e] = A->in[13][e] * (1.0f - LAM_INIT(e >> 8));
        for (int e = gw * 64 + lane; e < (SEQ + NMETA) * 16; e += ngw * 64) { const int pos = e >> 4, i = e & 15; const float ang = (float)pos * A->invf[i]; ropec[e] = cosf(ang); ropes[e] = sinf(ang); }
        for (int e = gw * 64 + lane; e < 2 * 64 * 48 * 16; e += ngw * 64) { const int kv = e / (64 * 48 * 16), r = e % (64 * 48 * 16), bh = r / (48 * 16), rr = (r / 16) % 48, ch = r % 16;
            *(u32x4*)((kv ? Vb : Kb) + ((size_t)bh * KVLEN + (SEQ + NMETA) + rr) * 128 + 8 * ch) = (u32x4){0u, 0u, 0u, 0u}; }
    }
#pragma nounroll
    for (int l = 0; l < DEPTH; ++l) {
        const int pb = 1 + l * PH_PER_LAYER;
        if (EN(0) && IN(pb + 0)) {
            PH_ARGS;
            LAS float* scr = (LAS float*)(L + wave * 16384);
            REP(0) for (int it = gw; it < CV_NIT; it += ngw) convert_item(A, ws, l, it, scr, lane);
            SEAM(pb + 0);
        }
        if (EN(1) && IN(pb + 1)) {
            PH_ARGS;
            pg8::Gemm g{HB, (const bf16_t*)(ws + W_GU1 + (size_t)(l & 1) * WBUF_STRIDE), MR, NGU, DM}; pg8::StaticOrder S; S.init(MR, NGU, G, bx);
            EpiSwiGLU E{HID, SSQ(3 * l)};
            REP(1) pg8::gemm_phase<EpiSwiGLU, pg8::StaticOrder, true, true>(L, g, S, E);
            if (DUP_PHASE == 21) { EpiNull EN_; pg8::gemm_phase<EpiNull, pg8::StaticOrder, true, true>(L, g, S, EN_); }
            REPM(1) meta_gemm(L, HB + (size_t)MR * DM, g.Bt, NGU, DM, E);
            SEAM(pb + 1);
        }
        if (EN(2) && IN(pb + 2)) {
            PH_ARGS;
            pg8::Gemm g{HID, (const bf16_t*)(ws + W_DN1 + (size_t)(l & 1) * WBUF_STRIDE), MR, DM, DFF}; pg8::StaticOrder S; S.init(MR, DM, G, bx);
            REP(2) { EpiResid E{nullptr, HB, SSQ(3 * l + 1), DRY(2) ? 0.f : 0.5f, DRY(2) ? 0.f : 1.f};
            pg8::gemm_phase<EpiResid, pg8::StaticOrder, true, true>(L, g, S, E); }
            REPM(2) { EpiResid E{nullptr, HB, SSQ(3 * l + 1), DRYM ? 0.f : 0.5f, DRYM ? 0.f : 1.f};
            meta_gemm(L, HID + (size_t)MR * DFF, g.Bt, DM, DFF, E); }
            SEAM(pb + 2);
        }
        if (EN(3) && IN(pb + 3)) {
            PH_ARGS;
            pg8::Gemm g{HB, (const bf16_t*)(ws + W_IN + (size_t)(l & 1) * WBUF_STRIDE), MR, NIN, DM}; pg8::StaticOrder S; S.init(MR, NIN, G, bx);
            EpiWin E{Qb, Kb, Vb, XR, GY, GG, QM, A->in[8] + (size_t)l * 2 * DM, SSQ(3 * l + 1), ropec, ropes};
            REP(3) pg8::gemm_phase<EpiWin, pg8::StaticOrder, true, true>(L, g, S, E);
            REPM(3) meta_gemm(L, HB + (size_t)MR * DM, g.Bt, NIN, DM, E);
            SEAM(pb + 3);
        }
        if (EN(4) && IN(pb + 4)) {
            PH_ARGS;
            if (EN(12)) REP(14) conv_pass(XR, XCG, A->in[14] + (size_t)l * 4 * LW, A->in[15] + (size_t)l * LW, gw * 64 + lane, ngw * 64);
            if (EN(13)) { const float lam_init = LAM_INIT(sgpr_fresh(l)); const float lam = lam_of(A->in[9] + l * 128, A->in[10] + l * 128, A->in[11] + l * 128, A->in[12] + l * 128, lam_init, lane);
                REP(13) attn_phase256((char*)lds, Qb, Kb, Vb, OP, AO, lam, SLV + l * 256, vcu, G); }
            SEAM(pb + 4);
        }
        if (EN(5) && IN(pb + 5)) {
            PH_ARGS;
            const float lam_init = LAM_INIT(sgpr_fresh(l)); const float lam = lam_of(A->in[9] + l * 128, A->in[10] + l * 128, A->in[11] + l * 128, A->in[12] + l * 128, lam_init, lane);
            if (EN(12)) REP(12) for (int it = vcu; it < 256; it += G)
                lru_item(L, it, XCG, GY, LO, A->in[16] + (size_t)l * 16 * 160 * 160, A->in[17] + (size_t)l * LW, A->in[18] + (size_t)l * 16 * 160 * 160, A->in[19] + (size_t)l * LW, A->in[20] + (size_t)l * LW);
            REP(5) combine_phase(OP, AO, QM, Kb, Vb, A->in[13] + l * 256, lam, lam_init, gw, ngw, lane);
            SEAM(pb + 5);
        }
        if (EN(6) && IN(pb + 6)) {
            PH_ARGS;
            pg8::StaticOrder S; S.init(MR, DM, G, bx);
            REP(6) {
#if DUAL_BR
            { EpiDual E{GG, MIX};
              pg8::gemm_dual_phase<EpiDual, pg8::StaticOrder>(L, AO, (const bf16_t*)(ws + W_BA), DM, LO, (const bf16_t*)(ws + W_BL), LW, S, E); }
            if (l + 1 < DEPTH) {
                REPM(6) meta_dual(L, AO + (size_t)MR * DM, (const bf16_t*)(ws + W_BA), DM, LO + (size_t)MR * LW, (const bf16_t*)(ws + W_BL), LW, GG, MIX);
            }
#else
            { pg8::Gemm g{AO, (const bf16_t*)(ws + W_BA + (size_t)(l & 1) * WBUF_STRIDE), MR, DM, DM}; EpiBa E{TMP, GG};
              pg8::gemm_phase<EpiBa, pg8::StaticOrder, true, true>(L, g, S, E); if (l + 1 < DEPTH) REPM(6) meta_gemm(L, AO + (size_t)MR * DM, g.Bt, DM, DM, E); }
            { pg8::Gemm g{LO, (const bf16_t*)(ws + W_BL + (size_t)(l & 1) * WBUF_STRIDE), MR, DM, LW}; EpiBl E{TMP, GG, MIX};
              pg8::gemm_phase<EpiBl, pg8::StaticOrder, true, true>(L, g, S, E); if (l + 1 < DEPTH) REPM(6) meta_gemm(L, LO + (size_t)MR * LW, g.Bt, DM, LW, E); }
#endif
            }
            SEAM(pb + 6);
        }
        if (EN(7) && IN(pb + 7)) {
            PH_ARGS;
            pg8::Gemm g{MIX, (const bf16_t*)(ws + W_O + (size_t)(l & 1) * WBUF_STRIDE), MR, DM, DM}; pg8::StaticOrder S; S.init(MR, DM, G, bx);
            REP(7) { EpiResid E{nullptr, HB, SSQ(3 * l + 2), DRY(7) ? 0.f : 1.0f, DRY(7) ? 0.f : 1.f};
            pg8::gemm_phase<EpiResid, pg8::StaticOrder, true, true>(L, g, S, E); }
            REPM(7) { EpiResid E{nullptr, HB, SSQ(3 * l + 2), DRYM ? 0.f : 1.0f, DRYM ? 0.f : 1.f};
            if (l + 1 < DEPTH) meta_gemm(L, MIX + (size_t)MR * DM, g.Bt, DM, DM, E); }
            SEAM(pb + 7);
        }
        if (EN(8) && IN(pb + 8)) {
            PH_ARGS;
            pg8::Gemm g{HB, (const bf16_t*)(ws + W_GU2 + (size_t)(l & 1) * WBUF_STRIDE), MR, NGU, DM}; pg8::StaticOrder S; S.init(MR, NGU, G, bx);
            EpiSwiGLU E{HID, SSQ(3 * l + 2)};
            pg8::gemm_phase<EpiSwiGLU, pg8::StaticOrder, true, true>(L, g, S, E);
            if (l + 1 < DEPTH) REPM(1) meta_gemm(L, HB + (size_t)MR * DM, g.Bt, NGU, DM, E);
            SEAM(pb + 8);
        }
        if (EN(9) && IN(pb + 9)) {
            PH_ARGS;
            pg8::Gemm g{HID, (const bf16_t*)(ws + W_DN2 + (size_t)(l & 1) * WBUF_STRIDE), MR, DM, DFF}; pg8::StaticOrder S; S.init(MR, DM, G, bx);
            { EpiResid E{(FINAL_BF16 || l + 1 < DEPTH) ? nullptr : H, HB, SSQ(3 * l + 3), 0.5f, 1.f};
            pg8::gemm_phase<EpiResid, pg8::StaticOrder, true, true>(L, g, S, E); }
            REPM(9) { EpiResid E{(FINAL_BF16 || l + 1 < DEPTH) ? nullptr : H, HB, SSQ(3 * l + 3), DRYM ? 0.f : 0.5f, DRYM ? 0.f : 1.f};
            if (l + 1 < DEPTH) meta_gemm(L, HID + (size_t)MR * DFF, g.Bt, DM, DFF, E); }
            SEAM(pb + 9);
        }
    }
    if (EN(11) && IN(N_PHASES - 1)) {
        PH_ARGS;
        float probe_scale = 1.0f;
        if (DUP_PHASE == 40) {
            u64* acc_ = (u64*)(ws + 2000000);
            if (threadIdx.x == 0) __hip_atomic_fetch_add(acc_, twait, __ATOMIC_RELAXED, __HIP_MEMORY_SCOPE_AGENT);
            xcd_barrier(bar);
            const u64 tot_ = __hip_atomic_load(acc_, __ATOMIC_RELAXED, __HIP_MEMORY_SCOPE_AGENT);
            const float frac_ = (float)tot_ / ((float)G * (float)(__builtin_amdgcn_s_memrealtime() - tstart));
            probe_scale = 1.0f + 0.02f * rintf(frac_ * 50.0f * PROBE_GAIN);
        }
        const float* gf = A->in[28];
#if FINAL_BF16
        const u64* ssqf = SSQ(3 * DEPTH);
        f32x4 gv[8];
#pragma unroll
        for (int j = 0; j < 4; ++j) { gv[2 * j] = *(const f32x4*)(gf + 8 * (64 * j + lane)); gv[2 * j + 1] = *(const f32x4*)(gf + 8 * (64 * j + lane) + 4); }
        static_assert(MR % 2 == 0, "row pairs");
        for (int m = 2 * gw; m < MR; m += 2 * ngw) {
            u32x4 w[8];
#pragma unroll
            for (int j = 0; j < 8; ++j) w[j] = *(const u32x4*)(HB + (size_t)(m + (j >> 2)) * DM + 8 * (64 * (j & 3) + lane));
            const float rs0 = rstd_fx(ssqf[m]) * probe_scale, rs1 = rstd_fx(ssqf[m + 1]) * probe_scale;
#pragma unroll
            for (int j = 0; j < 8; ++j) { const int c = 8 * (64 * (j & 3) + lane); const float rs = (j >> 2) ? rs1 : rs0; f32x4 lo, hi; unpack8(w[j], lo, hi);
                float* op = A->out + (size_t)(m + (j >> 2)) * DM + c;
                *(f32x4*)op = lo * rs * gv[2 * (j & 3)]; *(f32x4*)(op + 4) = hi * rs * gv[2 * (j & 3) + 1]; }
        }
#else
        for (int m = gw; m < MR; m += ngw) {
            f32x4 v[8]; float ss = 0.f;
#pragma unroll
            for (int j = 0; j < 8; ++j) { v[j] = *(const f32x4*)(H + (size_t)m * DM + 4 * (64 * j + lane)); ss += v[j][0] * v[j][0] + v[j][1] * v[j][1] + v[j][2] * v[j][2] + v[j][3] * v[j][3]; }
            const float rs = rstd_from(wave_sum(ss));
#pragma unroll
            for (int j = 0; j < 8; ++j) { const int c = 4 * (64 * j + lane); *(f32x4*)(A->out + (size_t)m * DM + c) = v[j] * (rs * probe_scale) * *(const f32x4*)(gf + c); }
        }
#endif
    }
#undef IN
#undef SEAM
}

extern "C" void kernel_launch(void* const* d_in, const int* in_sizes, int n_in, void* d_out, int out_size, void* d_ws, size_t ws_size, hipStream_t stream) {
    static int grid = 0;
    if (grid == 0) {
        if (n_in != 29 || in_sizes[0] != MR * DM || out_size != MR * DM || ws_size < WS_END) { fprintf(stderr, "kernel_launch: unexpected shapes (n_in %d, ws %zu < %zu?); nothing launched\n", n_in, ws_size, (size_t)WS_END); grid = -1; return; }
        int dev = 0, cus = 0, per_cu = 0;
        if (hipGetDevice(&dev) != hipSuccess || hipDeviceGetAttribute(&cus, hipDeviceAttributeMultiprocessorCount, dev) != hipSuccess) { grid = -1; return; }
        if (hipFuncSetAttribute((const void*)mk_fwd, hipFuncAttributeMaxDynamicSharedMemorySize, LDS_BYTES) != hipSuccess) { fprintf(stderr, "kernel_launch: hipFuncSetAttribute failed\n"); grid = -1; return; }
        if (hipOccupancyMaxActiveBlocksPerMultiprocessor(&per_cu, (const void*)mk_fwd, NWAVES * 64, LDS_BYTES) != hipSuccess || per_cu < 1) { fprintf(stderr, "kernel_launch: occupancy query says %d\n", per_cu); }
        (void)hipGetLastError();
        grid = cus;
    }
    if (grid < 0) return;
    if (hipMemsetAsync((char*)d_ws + WS_CTL, 0, CTL_ZERO_BYTES, stream) != hipSuccess) return;
    Args a{};
    for (int i = 0; i < 29; ++i) a.in[i] = (const float*)d_in[i];
    a.out = (float*)d_out; a.ws = (unsigned char*)d_ws;
    for (int i = 0; i < 16; ++i) a.invf[i] = (float)pow(500000.0, -(double)i / 16.0);
#if MK_MULTI
    for (int p = 0; p < N_PHASES; ++p) { a.ph_lo = p; a.ph_hi = p + 1; hipLaunchKernelGGL(mk_fwd, dim3(grid), dim3(NWAVES * 64), LDS_BYTES, stream, a); }
#else
    a.ph_lo = 0; a.ph_hi = N_PHASES;
    hipLaunchKernelGGL(mk_fwd, dim3(grid), dim3(NWAVES * 64), LDS_BYTES, stream, a);
#endif
    const hipError_t le = hipPeekAtLastError();
    if (le != hipSuccess) fprintf(stderr, "kernel_launch: launch failed: %s\n", hipGetErrorName(le));
}
```

```cpp
#include <hip/hip_runtime.h>
#include <cstdio>
#include <cstdint>
#include <cmath>
__device__ __forceinline__ int tid_fresh() { int t = threadIdx.x; asm volatile("" : "+v"(t)); return t; }
namespace pg8 {
#define PG8_LAS __attribute__((address_space(3)))
typedef unsigned short bf16_t;
typedef short bf16x8 __attribute__((ext_vector_type(8)));
typedef float f32x4 __attribute__((ext_vector_type(4)));
typedef unsigned u32x4 __attribute__((ext_vector_type(4)));
constexpr int BM = 256, BK = 64, HALF = 128, HTB = HALF * BK * 2  , STAGE_BYTES = 8 * HTB, NXCD = 8, WGM = 8;

__host__ __device__ __forceinline__ int lds_byte(int r, int c) { const int st = (r >> 4) * 2 + (c >> 5), rr = r & 15, cc = c & 31, ob = rr * 64 + cc * 2; return st * 1024 + (ob ^ (((ob >> 9) & 1) << 5)); }
__host__ __device__ __forceinline__ void stage_rc(int b, int& R, int& C) { const int st = b / 1024, sb = b % 1024, swz = sb ^ (((sb >> 9) & 1) << 5); R = (st >> 1) * 16 + swz / 64; C = (st & 1) * 32 + (swz % 64) / 2; }
__host__ __device__ __forceinline__ int perm32(int rho) { const int n = rho >> 4, i = rho & 15; return 8 * (i >> 2) + 4 * n + (i & 3); }

struct Unit { int pm, pn; };
struct Gemm { const bf16_t* A; const bf16_t* Bt; int M, N, K; };

struct StaticOrder {
    int nM, nN, nwg, G, c;
    __host__ __device__ void init(int M, int N, int G_, int c_) { nM = M / BM; nN = N / BM; nwg = nM * nN; G = G_; c = c_; }
    __host__ __device__ bool next(int i, Unit& u) const {
        const long L = (long)i * G + c; if (L >= nwg) return false;
        int wgid = (int)L; { const int q = nwg / NXCD, r = nwg % NXCD, xcd = wgid % NXCD, off = wgid / NXCD; wgid = (xcd < r ? xcd * (q + 1) : r * (q + 1) + (xcd - r) * q) + off; }
        const int nig = WGM * nN, gid = wgid / nig, fm = gid * WGM, gsz = (nM - fm) < WGM ? (nM - fm) : WGM;
        u.pm = fm + ((wgid % nig) % gsz); u.pn = (wgid % nig) / gsz; return true;
    }
    __device__ __forceinline__ void a_ready(const Unit&) const {}
    __device__ __forceinline__ void done(const Unit&) const {}
};

__device__ __forceinline__ unsigned cvt_pk_bf16(float lo, float hi) { unsigned r; asm volatile("v_cvt_pk_bf16_f32 %0, %1, %2" : "=v"(r) : "v"(lo), "v"(hi)); return r; }
typedef float f32x2 __attribute__((ext_vector_type(2)));
template <class Epi, class Sched, bool ALIGN_EPI = false, bool SP2 = false>
__device__ __forceinline__ void gemm_phase(PG8_LAS unsigned char* lds, const Gemm g, const Sched& S, const Epi& E) {
    const int tid = tid_fresh(), wid = __builtin_amdgcn_readfirstlane(tid >> 6), lane = tid & 63, wr = wid >> 2, wc = wid & 3, fr = lane & 15, fq = lane >> 4;
    const int K = g.K, nt = K / BK;
    unsigned voffA[2], voffB[2];
#pragma unroll
    for (int i = 0; i < 2; ++i) { int R, C; stage_rc(tid * 16 + i * 8192, R, C); const int Rb = Epi::PERM ? ((R & ~31) + perm32(R & 31)) : R;
        voffA[i] = (unsigned)(R * K + C) * 2u; voffB[i] = (unsigned)(Rb * K + C) * 2u; }
    const size_t kstep = (size_t)(BK * 2);
    const size_t hstep = (size_t)HALF * K * 2;
    const size_t tstep = 2 * hstep;
    const unsigned ldsw = (unsigned)wid * 1024u;
    const int aoff = lds_byte(wr * 64 + fr, fq * 8), boff = lds_byte(wc * 32 + fr, fq * 8);
#define PG8_SA(b, h) (((b) * 2 + (h)) * HTB)
#define PG8_SB(b, h) ((4 + (b) * 2 + (h)) * HTB)
#define PG8_STAGE(bufoff, gbase, voff) do { _Pragma("unroll") for (int _i = 0; _i < 2; ++_i) \
        __builtin_amdgcn_global_load_lds((const unsigned*)((const char*)(gbase) + (voff)[_i]), (PG8_LAS unsigned*)(lds + (bufoff) + ldsw + _i * 8192), 16, 0, 0); } while (0)
#define PG8_LDA(dst, b, h) do { _Pragma("unroll") for (int m = 0; m < 4; ++m) _Pragma("unroll") for (int k = 0; k < 2; ++k) dst[m][k] = *(const PG8_LAS bf16x8*)(lds + PG8_SA(b, h) + aoff + m * 2048 + k * 1024); } while (0)
#define PG8_LDB(dst, b, h) do { _Pragma("unroll") for (int n = 0; n < 2; ++n) _Pragma("unroll") for (int k = 0; k < 2; ++k) dst[n][k] = *(const PG8_LAS bf16x8*)(lds + PG8_SB(b, h) + boff + n * 2048 + k * 1024); } while (0)
#define PG8_MMA(ai, bj, At, Bt) do { __builtin_amdgcn_s_setprio(1); _Pragma("unroll") for (int m = 0; m < 4; ++m) _Pragma("unroll") for (int n = 0; n < 2; ++n) _Pragma("unroll") for (int k = 0; k < 2; ++k) \
        acc[ai][bj][m][n] = __builtin_amdgcn_mfma_f32_16x16x32_bf16(Bt[n][k], At[m][k], acc[ai][bj][m][n], 0, 0, 0); __builtin_amdgcn_s_setprio(0); } while (0)
#define PG8_WAIT_V(n) asm volatile("s_waitcnt vmcnt(" #n ")" ::: "memory")
#define PG8_WAIT_L(n) asm volatile("s_waitcnt lgkmcnt(" #n ")" ::: "memory")
#define PG8_BAR __builtin_amdgcn_s_barrier()
#define PG8_SCHED __builtin_amdgcn_sched_barrier(0)
    Unit cur, nxt; int ui = 0;
    if (!S.next(0, cur)) return;
    f32x4 acc[2][2][4][2];
#pragma unroll
    for (int a = 0; a < 2; ++a)
#pragma unroll
        for (int b = 0; b < 2; ++b)
#pragma unroll
            for (int m = 0; m < 4; ++m)
#pragma unroll
                for (int n = 0; n < 2; ++n) acc[a][b][m][n] = (f32x4){0.f, 0.f, 0.f, 0.f};
    bf16x8 At[4][2], B0[2][2], B1[2][2];
    const char* cA = (const char*)g.A + (size_t)cur.pm * tstep; const char* cB = (const char*)g.Bt + (size_t)cur.pn * tstep;
    S.a_ready(cur);
    if constexpr (SP2) {
        PG8_STAGE(PG8_SB(0, 0), cB, voffB); PG8_STAGE(PG8_SB(0, 1), cB + hstep, voffB); PG8_STAGE(PG8_SA(0, 0), cA, voffA); PG8_STAGE(PG8_SA(0, 1), cA + hstep, voffA);
        if (wr == 1) PG8_BAR;
        PG8_WAIT_V(2); PG8_BAR;
        PG8_STAGE(PG8_SB(1, 0), cB + kstep, voffB); PG8_STAGE(PG8_SA(1, 0), cA + kstep, voffA); PG8_STAGE(PG8_SB(1, 1), cB + hstep + kstep, voffB);
        PG8_WAIT_V(6); PG8_BAR;
    } else {
        PG8_STAGE(PG8_SB(0, 0), cB, voffB); PG8_STAGE(PG8_SA(0, 0), cA, voffA); PG8_STAGE(PG8_SB(0, 1), cB + hstep, voffB); PG8_STAGE(PG8_SA(0, 1), cA + hstep, voffA);
        if (wr == 1) PG8_BAR;
        PG8_WAIT_V(4); PG8_BAR;
        PG8_STAGE(PG8_SB(1, 0), cB + kstep, voffB); PG8_STAGE(PG8_SA(1, 0), cA + kstep, voffA); PG8_STAGE(PG8_SB(1, 1), cB + hstep + kstep, voffB);
        PG8_WAIT_V(6); PG8_BAR;
    }
    for (;;) {
        const bool has_next = S.next(ui + 1, nxt);
        const char* nA = has_next ? (const char*)g.A + (size_t)nxt.pm * tstep : cA; const char* nB = has_next ? (const char*)g.Bt + (size_t)nxt.pn * tstep : cB;
        for (int t = 0; t < nt; t += 2) {
            const bool last = (t == nt - 2);
            const char* a1 = cA + (size_t)(t + 1) * kstep;
            const char* a2 = last ? nA : cA + (size_t)(t + 2) * kstep; const char* b2 = last ? nB : cB + (size_t)(t + 2) * kstep;
            const char* a3 = a2 + kstep; const char* b3 = b2 + kstep;
            if (last && has_next) S.a_ready(nxt);
            if constexpr (SP2) {
            PG8_LDB(B0, 0, 0); PG8_LDB(B1, 0, 1); PG8_SCHED; PG8_LDA(At, 0, 0); PG8_STAGE(PG8_SA(1, 1), a1 + hstep, voffA);
            PG8_WAIT_V(8); PG8_WAIT_L(0); PG8_BAR; PG8_MMA(0, 0, At, B0); PG8_MMA(0, 1, At, B1); PG8_BAR; PG8_SCHED;
            PG8_LDA(At, 0, 1); PG8_STAGE(PG8_SB(0, 0), b2, voffB); PG8_STAGE(PG8_SB(0, 1), b2 + hstep, voffB); PG8_STAGE(PG8_SA(0, 0), a2, voffA);
            PG8_WAIT_V(8); PG8_WAIT_L(0); PG8_BAR; PG8_MMA(1, 0, At, B0); PG8_MMA(1, 1, At, B1); PG8_BAR; PG8_SCHED;
            PG8_LDB(B0, 1, 0); PG8_LDB(B1, 1, 1); PG8_SCHED; PG8_LDA(At, 1, 0); PG8_STAGE(PG8_SA(0, 1), a2 + hstep, voffA);
            PG8_WAIT_V(8); PG8_WAIT_L(0); PG8_BAR; PG8_MMA(0, 0, At, B0); PG8_MMA(0, 1, At, B1); PG8_BAR; PG8_SCHED;
            PG8_LDA(At, 1, 1); PG8_STAGE(PG8_SB(1, 0), b3, voffB); PG8_STAGE(PG8_SB(1, 1), b3 + hstep, voffB); PG8_STAGE(PG8_SA(1, 0), a3, voffA);
            PG8_WAIT_V(8); PG8_WAIT_L(0); PG8_BAR; PG8_MMA(1, 0, At, B0); PG8_MMA(1, 1, At, B1); PG8_BAR; PG8_SCHED;
            } else {
            PG8_LDB(B0, 0, 0); PG8_SCHED; PG8_LDA(At, 0, 0); PG8_STAGE(PG8_SA(1, 1), a1 + hstep, voffA);
            PG8_WAIT_L(8); PG8_BAR; PG8_WAIT_L(0); PG8_MMA(0, 0, At, B0); PG8_BAR; PG8_SCHED;
            PG8_LDB(B1, 0, 1); PG8_STAGE(PG8_SB(0, 0), b2, voffB);
            PG8_BAR; PG8_WAIT_L(0); PG8_MMA(0, 1, At, B1); PG8_BAR;
            PG8_LDA(At, 0, 1); PG8_STAGE(PG8_SA(0, 0), a2, voffA);
            PG8_BAR; PG8_WAIT_L(0); PG8_MMA(1, 0, At, B0); PG8_BAR; PG8_SCHED;
            PG8_STAGE(PG8_SB(0, 1), b2 + hstep, voffB);
            PG8_WAIT_V(6); PG8_BAR; PG8_MMA(1, 1, At, B1); PG8_BAR;
            PG8_LDB(B0, 1, 0); PG8_SCHED; PG8_LDA(At, 1, 0); PG8_STAGE(PG8_SA(0, 1), a2 + hstep, voffA);
            PG8_WAIT_L(8); PG8_BAR; PG8_WAIT_L(0); PG8_MMA(0, 0, At, B0); PG8_BAR; PG8_SCHED;
            PG8_LDB(B1, 1, 1); PG8_STAGE(PG8_SB(1, 0), b3, voffB);
            PG8_BAR; PG8_WAIT_L(0); PG8_MMA(0, 1, At, B1); PG8_BAR;
            PG8_LDA(At, 1, 1); PG8_STAGE(PG8_SA(1, 0), a3, voffA);
            PG8_BAR; PG8_WAIT_L(0); PG8_MMA(1, 0, At, B0); PG8_BAR; PG8_SCHED;
            PG8_STAGE(PG8_SB(1, 1), b3 + hstep, voffB);
            PG8_WAIT_V(6); PG8_BAR; PG8_MMA(1, 1, At, B1); PG8_BAR;
            }
        }
        if constexpr (ALIGN_EPI) { if (wr == 0) PG8_BAR; }
        if constexpr (!Epi::AFTER_DRAIN) { E(acc, cur, wr, wc, fr, fq); S.done(cur); }
        if (!has_next) break;
#pragma unroll
        for (int a = 0; a < 2; ++a)
#pragma unroll
            for (int b = 0; b < 2; ++b)
#pragma unroll
                for (int m = 0; m < 4; ++m)
#pragma unroll
                    for (int n = 0; n < 2; ++n) acc[a][b][m][n] = (f32x4){0.f, 0.f, 0.f, 0.f};
        cur = nxt; cA = nA; cB = nB; ++ui;
        if constexpr (ALIGN_EPI) { if (wr == 1) PG8_BAR; }
    }
    PG8_WAIT_V(0);
    if constexpr (!ALIGN_EPI) { if (wr == 0) PG8_BAR; }
    PG8_BAR;
    if constexpr (Epi::AFTER_DRAIN) { E.fused(acc, cur, wr, wc, fr, fq, lds, wid, lane); S.done(cur); }
#undef PG8_SA
#undef PG8_SB
#undef PG8_STAGE
#undef PG8_LDA
#undef PG8_LDB
#undef PG8_MMA
#undef PG8_WAIT_V
#undef PG8_WAIT_L
#undef PG8_BAR
#undef PG8_SCHED
}
}
namespace pg8 {
template <class Epi, class Sched>
__device__ __forceinline__ void gemm_dual_phase(PG8_LAS unsigned char* lds, const bf16_t* A0, const bf16_t* Bt0, int K0, const bf16_t* A1, const bf16_t* Bt1, int K1, const Sched& S, const Epi& E) {
    const int tid = tid_fresh(), wid = __builtin_amdgcn_readfirstlane(tid >> 6), lane = tid & 63, wr = wid >> 2, wc = wid & 3, fr = lane & 15, fq = lane >> 4;
    unsigned vA0_0, vA0_1, vB0_0, vB0_1, vA1_0, vA1_1, vB1_0, vB1_1;
    { int R, C; stage_rc(tid * 16, R, C); const int Rb = (R & ~31) + perm32(R & 31);
      vA0_0 = (unsigned)(R * K0 + C) * 2u; vB0_0 = (unsigned)(Rb * K0 + C) * 2u; vA1_0 = (unsigned)(R * K1 + C) * 2u; vB1_0 = (unsigned)(Rb * K1 + C) * 2u; }
    { int R, C; stage_rc(tid * 16 + 8192, R, C); const int Rb = (R & ~31) + perm32(R & 31);
      vA0_1 = (unsigned)(R * K0 + C) * 2u; vB0_1 = (unsigned)(Rb * K0 + C) * 2u; vA1_1 = (unsigned)(R * K1 + C) * 2u; vB1_1 = (unsigned)(Rb * K1 + C) * 2u; }
    const size_t kstep = (size_t)(BK * 2);
    const size_t hst0 = (size_t)HALF * K0 * 2, hst1 = (size_t)HALF * K1 * 2;
    const unsigned ldsw = (unsigned)wid * 1024u;
    const int aoff = lds_byte(wr * 64 + fr, fq * 8), boff = lds_byte(wc * 32 + fr, fq * 8);
#define PG8_SA(b, h) (((b) * 2 + (h)) * HTB)
#define PG8_SB(b, h) ((4 + (b) * 2 + (h)) * HTB)
#define PG8_STAGE2(bufoff, gbase, v0, v1) do { \
        __builtin_amdgcn_global_load_lds((const unsigned*)((const char*)(gbase) + (v0)), (PG8_LAS unsigned*)(lds + (bufoff) + ldsw), 16, 0, 0); \
        __builtin_amdgcn_global_load_lds((const unsigned*)((const char*)(gbase) + (v1)), (PG8_LAS unsigned*)(lds + (bufoff) + ldsw + 8192), 16, 0, 0); } while (0)
#define PG8_LDA(dst, b, h) do { _Pragma("unroll") for (int m = 0; m < 4; ++m) _Pragma("unroll") for (int k = 0; k < 2; ++k) dst[m][k] = *(const PG8_LAS bf16x8*)(lds + PG8_SA(b, h) + aoff + m * 2048 + k * 1024); } while (0)
#define PG8_LDB(dst, b, h) do { _Pragma("unroll") for (int n = 0; n < 2; ++n) _Pragma("unroll") for (int k = 0; k < 2; ++k) dst[n][k] = *(const PG8_LAS bf16x8*)(lds + PG8_SB(b, h) + boff + n * 2048 + k * 1024); } while (0)
#define PG8_MMA(ai, bj, At, Bt) do { __builtin_amdgcn_s_setprio(1); _Pragma("unroll") for (int m = 0; m < 4; ++m) _Pragma("unroll") for (int n = 0; n < 2; ++n) _Pragma("unroll") for (int k = 0; k < 2; ++k) \
        acc[ai][bj][m][n] = __builtin_amdgcn_mfma_f32_16x16x32_bf16(Bt[n][k], At[m][k], acc[ai][bj][m][n], 0, 0, 0); __builtin_amdgcn_s_setprio(0); } while (0)
#define PG8_WAIT_V(n) asm volatile("s_waitcnt vmcnt(" #n ")" ::: "memory")
#define PG8_WAIT_L(n) asm volatile("s_waitcnt lgkmcnt(" #n ")" ::: "memory")
#define PG8_BAR __builtin_amdgcn_s_barrier()
#define PG8_SCHED __builtin_amdgcn_sched_barrier(0)
    Unit cur, nxt; int ui = 0;
    if (!S.next(0, cur)) return;
    f32x4 acc[2][2][4][2];
#pragma unroll
    for (int a = 0; a < 2; ++a)
#pragma unroll
        for (int b = 0; b < 2; ++b)
#pragma unroll
            for (int m = 0; m < 4; ++m)
#pragma unroll
                for (int n = 0; n < 2; ++n) acc[a][b][m][n] = (f32x4){0.f, 0.f, 0.f, 0.f};
    bf16x8 At[4][2], B0[2][2], B1[2][2];
    int ty = 0;
    const char* cA = (const char*)A0 + (size_t)cur.pm * (2 * hst0); const char* cB = (const char*)Bt0 + (size_t)cur.pn * (2 * hst0);
    PG8_STAGE2(PG8_SB(0, 0), cB, vB0_0, vB0_1); PG8_STAGE2(PG8_SB(0, 1), cB + hst0, vB0_0, vB0_1); PG8_STAGE2(PG8_SA(0, 0), cA, vA0_0, vA0_1); PG8_STAGE2(PG8_SA(0, 1), cA + hst0, vA0_0, vA0_1);
    if (wr == 1) PG8_BAR;
    PG8_WAIT_V(2); PG8_BAR;
    PG8_STAGE2(PG8_SB(1, 0), cB + kstep, vB0_0, vB0_1); PG8_STAGE2(PG8_SA(1, 0), cA + kstep, vA0_0, vA0_1); PG8_STAGE2(PG8_SB(1, 1), cB + hst0 + kstep, vB0_0, vB0_1);
    PG8_WAIT_V(6); PG8_BAR;
    for (;;) {
        const bool has_next = (ty == 0) ? true : S.next(ui + 1, nxt);
        const int pty = has_next ? (ty ^ 1) : ty;
        const int npm = (ty == 0) ? cur.pm : nxt.pm, npn = (ty == 0) ? cur.pn : nxt.pn;
        const size_t hsc = ty ? hst1 : hst0, hsn = pty ? hst1 : hst0;
        const char* nA = has_next ? (const char*)(pty ? A1 : A0) + (size_t)npm * (2 * hsn) : cA;
        const char* nB = has_next ? (const char*)(pty ? Bt1 : Bt0) + (size_t)npn * (2 * hsn) : cB;
        const unsigned vAc0 = ty ? vA1_0 : vA0_0, vAc1 = ty ? vA1_1 : vA0_1, vBc0 = ty ? vB1_0 : vB0_0, vBc1 = ty ? vB1_1 : vB0_1;
        const unsigned vAn0 = pty ? vA1_0 : vA0_0, vAn1 = pty ? vA1_1 : vA0_1, vBn0 = pty ? vB1_0 : vB0_0, vBn1 = pty ? vB1_1 : vB0_1;
        const int nt = (ty ? K1 : K0) / BK;
        for (int t = 0; t < nt; t += 2) {
            const bool last = (t == nt - 2);
            const char* a1 = cA + (size_t)(t + 1) * kstep;
            const char* a2 = last ? nA : cA + (size_t)(t + 2) * kstep; const char* b2 = last ? nB : cB + (size_t)(t + 2) * kstep;
            const char* a3 = a2 + kstep; const char* b3 = b2 + kstep;
            const size_t hs2 = last ? hsn : hsc;
            const unsigned wA0 = last ? vAn0 : vAc0, wA1 = last ? vAn1 : vAc1, wB0 = last ? vBn0 : vBc0, wB1 = last ? vBn1 : vBc1;
            PG8_LDB(B0, 0, 0); PG8_LDB(B1, 0, 1); PG8_SCHED; PG8_LDA(At, 0, 0); PG8_STAGE2(PG8_SA(1, 1), a1 + hsc, vAc0, vAc1);
            PG8_WAIT_V(8); PG8_WAIT_L(0); PG8_BAR; PG8_MMA(0, 0, At, B0); PG8_MMA(0, 1, At, B1); PG8_BAR; PG8_SCHED;
            PG8_LDA(At, 0, 1); PG8_STAGE2(PG8_SB(0, 0), b2, wB0, wB1); PG8_STAGE2(PG8_SB(0, 1), b2 + hs2, wB0, wB1); PG8_STAGE2(PG8_SA(0, 0), a2, wA0, wA1);
            PG8_WAIT_V(8); PG8_WAIT_L(0); PG8_BAR; PG8_MMA(1, 0, At, B0); PG8_MMA(1, 1, At, B1); PG8_BAR; PG8_SCHED;
            PG8_LDB(B0, 1, 0); PG8_LDB(B1, 1, 1); PG8_SCHED; PG8_LDA(At, 1, 0); PG8_STAGE2(PG8_SA(0, 1), a2 + hs2, wA0, wA1);
            PG8_WAIT_V(8); PG8_WAIT_L(0); PG8_BAR; PG8_MMA(0, 0, At, B0); PG8_MMA(0, 1, At, B1); PG8_BAR; PG8_SCHED;
            PG8_LDA(At, 1, 1); PG8_STAGE2(PG8_SB(1, 0), b3, wB0, wB1); PG8_STAGE2(PG8_SB(1, 1), b3 + hs2, wB0, wB1); PG8_STAGE2(PG8_SA(1, 0), a3, wA0, wA1);
            PG8_WAIT_V(8); PG8_WAIT_L(0); PG8_BAR; PG8_MMA(1, 0, At, B0); PG8_MMA(1, 1, At, B1); PG8_BAR; PG8_SCHED;
        }
        if (wr == 0) PG8_BAR;
        if (ty == 0) E.mid(acc, cur, wr, wc, fr, fq); else E(acc, cur, wr, wc, fr, fq);
        if (!has_next) break;
        if (ty == 1) {
#pragma unroll
            for (int a = 0; a < 2; ++a)
#pragma unroll
                for (int b = 0; b < 2; ++b)
#pragma unroll
                    for (int m = 0; m < 4; ++m)
#pragma unroll
                        for (int n = 0; n < 2; ++n) acc[a][b][m][n] = (f32x4){0.f, 0.f, 0.f, 0.f};
            cur = nxt; ++ui;
        }
        ty ^= 1; cA = nA; cB = nB;
        if (wr == 1) PG8_BAR;
    }
    PG8_WAIT_V(0);
    PG8_BAR;
#undef PG8_SA
#undef PG8_SB
#undef PG8_STAGE2
#undef PG8_LDA
#undef PG8_LDB
#undef PG8_MMA
#undef PG8_WAIT_V
#undef PG8_WAIT_L
#undef PG8_BAR
#undef PG8_SCHED
}
}

#define GAS __attribute__((address_space(1)))
#define LAS __attribute__((address_space(3)))
typedef unsigned short bf16;
typedef unsigned v4u __attribute__((ext_vector_type(4)));
typedef float f32x4 __attribute__((ext_vector_type(4)));
typedef short bf16x8 __attribute__((ext_vector_type(8)));
typedef GAS unsigned gu32;
typedef GAS unsigned long long gu64;
#define RLX_AGENT __ATOMIC_RELAXED, __HIP_MEMORY_SCOPE_AGENT
#define LDS_WAIT() asm volatile("s_waitcnt lgkmcnt(0)" ::: "memory")
#define VM_WAIT() asm volatile("s_waitcnt vmcnt(0)" ::: "memory")
__device__ __forceinline__ unsigned long long rt() { return __builtin_amdgcn_s_memrealtime(); }
__device__ __forceinline__ unsigned f2bf(float f) { unsigned u = __builtin_bit_cast(unsigned, f); return (u + 0x7fffu + ((u >> 16) & 1u)) >> 16; }
__device__ __forceinline__ unsigned pk2(float lo, float hi) { return f2bf(lo) | (f2bf(hi) << 16); }

#define XB_TMO      128
#define XB_XCNT(j)  (256  + 64 * (j))
#define XB_XSUB(j)  (1280 + 64 * (j))
#define XB_XGEN(j)  (2304 + 64 * (j))
#define XB_TOP      3328
#define XB_TOPGEN   3392
#define XCD_BAR_WORDS 3456
#define XB_SPIN_CAP (1u << 18)

__device__ __forceinline__ unsigned xb_ld(unsigned* p)              { return __hip_atomic_load(p, __ATOMIC_RELAXED, __HIP_MEMORY_SCOPE_AGENT); }
__device__ __forceinline__ unsigned xb_add(unsigned* p, unsigned v) { return __hip_atomic_fetch_add(p, v, __ATOMIC_RELAXED, __HIP_MEMORY_SCOPE_AGENT); }
__device__ __forceinline__ unsigned xb_xcc_id() { return (unsigned)__builtin_amdgcn_s_getreg((3 << 11) | 20) & 0xFu; }
#define XB_SPIN(cond, bar) do { unsigned _sp = 0; while (cond) { __builtin_amdgcn_s_sleep(1); \
    if ((++_sp & 255u) == 0u) { if (xb_ld(&(bar)[XB_TMO])) break; if (_sp > XB_SPIN_CAP) { atomicAdd(&(bar)[XB_TMO], 1u); break; } } } } while (0)

struct XcdBarrier {
    unsigned* bar; unsigned x;
    volatile LAS unsigned* st;
};

__device__ __forceinline__ XcdBarrier xcd_barrier_post(unsigned* bar, volatile LAS unsigned* st) {
    XcdBarrier b; b.bar = bar; b.x = xb_xcc_id(); b.st = st;
    if (threadIdx.x == 0) (void)xb_add(&bar[XB_XCNT(b.x)], 1u);
    return b;
}
__device__ __forceinline__ void xcd_barrier_complete(unsigned* bar, unsigned x, unsigned& nloc, unsigned& nx) {
    const unsigned G = gridDim.x * gridDim.y * gridDim.z;
    unsigned sum, cnt, mine, sp = 0u;
    for (;;) {
        sum = 0u; cnt = 0u; mine = 0u;
#pragma unroll
        for (unsigned j = 0; j < 16; ++j) { const unsigned c = xb_ld(&bar[XB_XCNT(j)]); sum += c; cnt += (c > 0u) ? 1u : 0u; mine = (j == x) ? c : mine; }
        if (sum == G) break;
        __builtin_amdgcn_s_sleep(1);
        if ((++sp & 255u) == 0u) { if (xb_ld(&bar[XB_TMO])) break; if (sp > XB_SPIN_CAP) { atomicAdd(&bar[XB_TMO], 1u); break; } }
    }
    nloc = mine > 0u ? mine : 1u; nx = cnt > 0u ? cnt : 1u;
}

__device__ __forceinline__ void xcd_barrier(const XcdBarrier& b) {
    asm volatile("s_waitcnt vmcnt(0)" ::: "memory");
    __syncthreads();
    if (threadIdx.x == 0) {
        unsigned* bar = b.bar;
        __builtin_amdgcn_s_waitcnt(0);
        unsigned nloc = b.st[0], nx = b.st[1];
        if (nloc == 0u) { xcd_barrier_complete(bar, b.x, nloc, nx); b.st[0] = nloc; b.st[1] = nx; }
        const unsigned old = xb_add(&bar[XB_XSUB(b.x)], 1u);
        const unsigned gen = old / nloc;
        if (old + 1u == (gen + 1u) * nloc) {
            __builtin_amdgcn_fence(__ATOMIC_RELEASE, "agent");
            asm volatile("s_waitcnt vmcnt(0)" ::: "memory");
            const unsigned og = xb_add(&bar[XB_TOP], 1u);
            const unsigned tg = og / nx;
            if (og + 1u == (tg + 1u) * nx) xb_add(&bar[XB_TOPGEN], 1u);
            else XB_SPIN(xb_ld(&bar[XB_TOPGEN]) == tg, bar);
            __builtin_amdgcn_fence(__ATOMIC_ACQUIRE, "agent");
            xb_add(&bar[XB_XGEN(b.x)], 1u);
            asm volatile("s_waitcnt vmcnt(0)" ::: "memory");
        } else {
            XB_SPIN(xb_ld(&bar[XB_XGEN(b.x)]) == gen, bar);
            __builtin_amdgcn_fence(__ATOMIC_ACQUIRE, "agent");
            asm volatile("s_waitcnt vmcnt(0)" ::: "memory");
        }
    }
    __syncthreads();
}

namespace att {
constexpr int D = 128;
constexpr float THR = 8.f;
constexpr bool WSKIP = false;
constexpr float SCALE = 0.08838834764831845f;
constexpr int NW = 8, QBLK = 32, KVBLK = 64, QB = NW * QBLK;
constexpr int SHM_V = KVBLK * D * 2, SHM_K = KVBLK * D * 2;
constexpr int LDS_BYTES = 2 * SHM_V + 2 * SHM_K + NW * 64 * 4;
typedef short bf16x8 __attribute__((ext_vector_type(8)));
typedef short s16x4 __attribute__((ext_vector_type(4)));
typedef float f32x16 __attribute__((ext_vector_type(16)));
typedef float f32x4 __attribute__((ext_vector_type(4)));
typedef unsigned u32x4 __attribute__((ext_vector_type(4)));
template <class A, class Bt> struct same_t { static constexpr bool v = false; };
template <class A> struct same_t<A, A> { static constexpr bool v = true; };

#define KSWZ(row, colB) ((row) * 256 + ((colB) ^ (((row) & 7) << 4)))
#define SBAR() __builtin_amdgcn_sched_barrier(0)
__device__ __forceinline__ int v_st(int k, int c) { const int kk = (k & ~0xC) | ((k & 4) << 1) | ((k & 8) >> 1); return ((kk >> 3) * 4 + (c >> 5)) * 512 + ((kk & 7) * 32 + (c & 31)) * 2; }
__device__ __forceinline__ int v_rd_base(int lane) { return ((lane & 3) << 3) | (((lane >> 2) & 3) << 6) | (((lane >> 4) & 1) << 5) | (((lane >> 5) & 1) << 8); }
constexpr int v_rd_off(int d0, int ks, int half) { return d0 * 512 + ks * 4096 + half * 2048; }
__device__ __forceinline__ int crow(int r, int hi) { return (r & 3) + 8 * (r >> 2) + 4 * hi; }
__device__ __forceinline__ unsigned cvtpk(float lo, float hi) {
    unsigned r; asm volatile("v_cvt_pk_bf16_f32 %0, %1, %2" : "=v"(r) : "v"(lo), "v"(hi)); return r;
}
__device__ __forceinline__ bf16x8 pack8(f32x4 a, f32x4 b) {
    u32x4 w = {cvtpk(a[0], a[1]), cvtpk(a[2], a[3]), cvtpk(b[0], b[1]), cvtpk(b[2], b[3])};
    return *reinterpret_cast<bf16x8*>(&w);
}
template <class T> __device__ __forceinline__ bf16x8 load8(const T* p) {
    if constexpr (same_t<T, float>::v) { return pack8(*(const f32x4*)p, *(const f32x4*)(p + 4)); }
    else { return *reinterpret_cast<const bf16x8*>(p); }
}
__device__ __forceinline__ void mask_tile(f32x16& p0, f32x16& p1, int dq, unsigned W) {
    const float NEG = -__builtin_inff();
#pragma unroll
    for (int r = 0; r < 16; ++r) {
        const int c = (r & 3) + 8 * (r >> 2);
        if ((unsigned)(dq - c) >= W) p0[r] = NEG;
        if ((unsigned)(dq - c - 32) >= W) p1[r] = NEG;
    }
}
__device__ __forceinline__ void partialSM(f32x16& p0, f32x16& p1, float& m_reg, float& mn, float& alpha) {
    float pmax = p0[0]; for (int r = 1; r < 16; ++r) pmax = fmaxf(pmax, p0[r]); for (int r = 0; r < 16; ++r) pmax = fmaxf(pmax, p1[r]);
    { auto rr = __builtin_amdgcn_permlane32_swap(__float_as_uint(pmax), __float_as_uint(pmax), false, false);
      pmax = fmaxf(__uint_as_float(rr[0]), __uint_as_float(rr[1])); }
    constexpr float C2 = 1.4426950408889634f * SCALE;
    if (__builtin_expect(__all((pmax - m_reg) * SCALE <= THR), 1)) { mn = m_reg; alpha = 1.f; }
    else { mn = fmaxf(m_reg, pmax); alpha = __builtin_amdgcn_exp2f((m_reg - mn) * C2); m_reg = mn; }
    const float mnL = -mn * C2;
    for (int r = 0; r < 16; ++r) p0[r] = fmaf(p0[r], C2, mnL); for (int r = 0; r < 16; ++r) p1[r] = fmaf(p1[r], C2, mnL);
    for (int r = 0; r < 16; ++r) p0[r] = __builtin_amdgcn_exp2f(p0[r]);
}
__device__ __forceinline__ void finishSM(f32x16& p0, f32x16& p1, float alpha, float& l_reg, bf16x8& pa0, bf16x8& pa1, bf16x8& pa2, bf16x8& pa3) {
    for (int r = 0; r < 16; ++r) p1[r] = __builtin_amdgcn_exp2f(p1[r]);
    float ps = 0; for (int r = 0; r < 16; ++r) ps += p0[r]; for (int r = 0; r < 16; ++r) ps += p1[r];
    { auto rr = __builtin_amdgcn_permlane32_swap(__float_as_uint(ps), __float_as_uint(ps), false, false);
      ps = __uint_as_float(rr[0]) + __uint_as_float(rr[1]); }
    l_reg = l_reg * alpha + ps;
#define PK4(P, B_, OUT) do { unsigned a0 = cvtpk(P[B_+0], P[B_+1]), a1 = cvtpk(P[B_+2], P[B_+3]);                          \
        unsigned b0 = cvtpk(P[B_+4], P[B_+5]), b1 = cvtpk(P[B_+6], P[B_+7]);                                             \
        auto r0 = __builtin_amdgcn_permlane32_swap(a0, b0, false, false); auto r1 = __builtin_amdgcn_permlane32_swap(a1, b1, false, false); \
        u32x4 w = {r0[0], r1[0], r0[1], r1[1]}; OUT = *reinterpret_cast<bf16x8*>(&w); } while (0)
    PK4(p0, 0, pa0); PK4(p0, 8, pa1); PK4(p1, 0, pa2); PK4(p1, 8, pa3);
#undef PK4
}
template <int KB, bool SK>
__device__ __forceinline__ void qkt(f32x16& p0, f32x16& p1, const char* K_lds, int r32, int hi, const bf16x8* qr, bool act) {
    if (SK && !act) { const float NEG = -__builtin_inff();
#pragma unroll
        for (int r = 0; r < 16; ++r) { p0[r] = NEG; p1[r] = NEG; } return; }
    p0 = f32x16{}; p1 = f32x16{};
    const char* kb[4];
#pragma unroll
    for (int dd = 0; dd < 4; ++dd) kb[dd] = K_lds + KB * SHM_K + KSWZ(r32, (dd * 16 + hi * 8) * 2);
#pragma unroll
    for (int d0 = 0; d0 < 8; ++d0) { const char* a = kb[d0 & 3] + (d0 >> 2) * 128;
        bf16x8 b0 = *reinterpret_cast<const bf16x8*>(a);
        bf16x8 b1 = *reinterpret_cast<const bf16x8*>(a + 32 * 256);
        p0 = __builtin_amdgcn_mfma_f32_32x32x16_bf16(b0, qr[d0], p0, 0, 0, 0);
        p1 = __builtin_amdgcn_mfma_f32_32x32x16_bf16(b1, qr[d0], p1, 0, 0, 0); }
}
template <int VB, bool SK>
__device__ __forceinline__ void pv_tile(f32x16* o, int vb0, bf16x8 pa0, bf16x8 pa1, bf16x8 pa2, bf16x8 pa3, bool act) {
    if (SK && !act) return;
#define TRRD(dst, off) asm volatile("ds_read_b64_tr_b16 %0, %1 offset:%2" : "=&v"(dst) : "v"(vb0), "i"(off) : "memory")
#define PV_D0(d0) do { s16x4 l0, l1, l2, l3, h0, h1, h2, h3; constexpr int b_ = VB * SHM_V + v_rd_off(d0, 0, 0);     \
        TRRD(l0, b_); TRRD(h0, b_ + 2048); TRRD(l1, b_ + 4096); TRRD(h1, b_ + 6144); TRRD(l2, b_ + 8192); TRRD(h2, b_ + 10240); TRRD(l3, b_ + 12288); TRRD(h3, b_ + 14336); \
        asm volatile("s_waitcnt lgkmcnt(0)" ::: "memory"); SBAR();                 \
        o[d0] = __builtin_amdgcn_mfma_f32_32x32x16_bf16(pa0, (bf16x8){l0[0], l0[1], l0[2], l0[3], h0[0], h0[1], h0[2], h0[3]}, o[d0], 0, 0, 0);   \
        o[d0] = __builtin_amdgcn_mfma_f32_32x32x16_bf16(pa1, (bf16x8){l1[0], l1[1], l1[2], l1[3], h1[0], h1[1], h1[2], h1[3]}, o[d0], 0, 0, 0);   \
        o[d0] = __builtin_amdgcn_mfma_f32_32x32x16_bf16(pa2, (bf16x8){l2[0], l2[1], l2[2], l2[3], h2[0], h2[1], h2[2], h2[3]}, o[d0], 0, 0, 0);   \
        o[d0] = __builtin_amdgcn_mfma_f32_32x32x16_bf16(pa3, (bf16x8){l3[0], l3[1], l3[2], l3[3], h3[0], h3[1], h3[2], h3[3]}, o[d0], 0, 0, 0); } while (0)
    PV_D0(0); PV_D0(1); PV_D0(2); PV_D0(3);
#undef PV_D0
#undef TRRD
}

template <class TIn, class TOut> struct BlockRef { const TIn* Q; const TIn* K; const TIn* V; TOut* O; int P0; };
template <class TIn> struct Seam {
    bf16x8 qr[8];
    bf16x8 st_v0, st_v1, st_k0, st_k1; f32x4 sf0, sf1, sf2, sf3;
    f32x4 tq[16];
};
__device__ __forceinline__ int swa_jlo(int P0, int W) { const int lowk = P0 - W + 1; return lowk > 0 ? lowk / KVBLK : 0; }
#define ROW(p, k0, rr) ((p) + (size_t)((k0) + (rr)) * D + sc)
#define VMW() asm volatile("s_waitcnt vmcnt(0)" ::: "memory")
#define VMWN(n) asm volatile("s_waitcnt vmcnt(%0)" :: "i"(n) : "memory")
#define SLOAD_H(Kp, Vp, k0) do { S.st_v0 = load8<TIn>(ROW(Vp, k0, sr)); S.st_v1 = load8<TIn>(ROW(Vp, k0, 32 + sr));              \
                         S.st_k0 = load8<TIn>(ROW(Kp, k0, sr)); S.st_k1 = load8<TIn>(ROW(Kp, k0, 32 + sr)); } while (0)
#define SWRITE_HK(bf) do { *(bf16x8*)(K_lds + (bf) * SHM_K + kws) = S.st_k0; *(bf16x8*)(K_lds + (bf) * SHM_K + kws + 32 * 256) = S.st_k1; } while (0)
#define SWRITE_HV(bf) do { *(bf16x8*)(V_lds + (bf) * SHM_V + vst0) = S.st_v0; *(bf16x8*)(V_lds + (bf) * SHM_V + vst1) = S.st_v1; } while (0)
#define SWRITE_H(bf) do { SWRITE_HV(bf); SWRITE_HK(bf); } while (0)
#define SLOAD_F(p, k0) do { S.sf0 = *(const f32x4*)ROW(p, k0, sr); S.sf1 = *(const f32x4*)(ROW(p, k0, sr) + 4);                \
                            S.sf2 = *(const f32x4*)ROW(p, k0, 32 + sr); S.sf3 = *(const f32x4*)(ROW(p, k0, 32 + sr) + 4); } while (0)
#define SWRITE_KF(bf) do { *(bf16x8*)(K_lds + (bf) * SHM_K + kws) = pack8(S.sf0, S.sf1); *(bf16x8*)(K_lds + (bf) * SHM_K + kws + 32 * 256) = pack8(S.sf2, S.sf3); } while (0)
#define SWRITE_VF(bf) do { *(bf16x8*)(V_lds + (bf) * SHM_V + vst0) = pack8(S.sf0, S.sf1); *(bf16x8*)(V_lds + (bf) * SHM_V + vst1) = pack8(S.sf2, S.sf3); } while (0)
template <class TIn, class TOut>
__device__ __forceinline__ void causal_swa_prime(const BlockRef<TIn, TOut>& cur, int W, char* lds, Seam<TIn>& S) {
    constexpr bool F32 = same_t<TIn, float>::v;
    const int tid = tid_fresh(), wid = __builtin_amdgcn_readfirstlane(tid >> 6), lane = tid & 63, r32 = lane & 31, hi = lane >> 5;
    const int sr = tid >> 4, sc = (tid & 15) * 8, kws = KSWZ(sr, sc * 2); char* K_lds = lds + 2 * SHM_V;
    const int kb0 = swa_jlo(cur.P0, W) * KVBLK;
    for (int d0 = 0; d0 < 8; ++d0) S.qr[d0] = load8<TIn>(cur.Q + (size_t)(wid * QBLK + r32) * D + d0 * 16 + hi * 8);
    if constexpr (F32) { SLOAD_F((const float*)cur.K, kb0); VMW(); SWRITE_KF(0); SBAR(); SLOAD_F((const float*)cur.V, kb0); }
    else { SLOAD_H(cur.K, cur.V, kb0); VMW(); SWRITE_HK(0); }
    __syncthreads();
}
template <class TIn, class TOut>
__device__ __forceinline__ void causal_swa_block(const BlockRef<TIn, TOut>& cur, const BlockRef<TIn, TOut>& nxt, int skv, int W, char* lds, Seam<TIn>& S) {
    constexpr bool F32 = same_t<TIn, float>::v;
    const int tid = tid_fresh(), wid = __builtin_amdgcn_readfirstlane(tid >> 6), lane = tid & 63, r32 = lane & 31, hi = lane >> 5;
    const int j_lo = swa_jlo(cur.P0, W);
    int j_hi = (cur.P0 + QB - 1) / KVBLK + 1; if (j_hi > skv / KVBLK) j_hi = skv / KVBLK;
    const int NT = j_hi - j_lo;
    const int kbn = swa_jlo(nxt.P0, W) * KVBLK;
    const int qlo = cur.P0 + wid * QBLK, qm = qlo + r32 - 4 * hi;
    char* V_lds = lds; char* K_lds = lds + 2 * SHM_V;
    float* ws = (float*)(lds + 2 * SHM_V + 2 * SHM_K) + wid * 64; float* li_l = ws, * al_l = ws + 32;
    float m_reg = -1e30f, l_reg = 0; f32x16 o[4] = {};
    const int sr = tid >> 4, sc = (tid & 15) * 8, vst0 = v_st(sr, sc), vst1 = v_st(32 + sr, sc), kws = KSWZ(sr, sc * 2);
    const int vb0 = (int)(uintptr_t)V_lds + v_rd_base(lane);
    const TIn* Kh = cur.K; const TIn* Vh = cur.V;
#define RESC(a) do { if (__any((a) < 1.f)) { if (hi == 0) al_l[r32] = (a); asm volatile("s_waitcnt lgkmcnt(0)" ::: "memory");              \
                     for (int d_ = 0; d_ < 4; ++d_) for (int r = 0; r < 16; ++r) o[d_][r] *= al_l[crow(r, hi)]; } } while (0)
#define KBASE(t) ((j_lo + (t)) * KVBLK)
#define ACT(t) (KBASE(t) <= qlo + QBLK - 1 && KBASE(t) + KVBLK - 1 >= qlo - W + 1)
#define MASKT(P0_, P1_, t) do { const int kb_ = KBASE(t); if ((!SK || ACT(t)) && (kb_ + KVBLK - 1 > qlo || kb_ <= qlo + QBLK - 1 - W)) mask_tile(P0_, P1_, qm - kb_, (unsigned)W); } while (0)
    constexpr int NQL = F32 ? 16 : 8;
    constexpr bool SK = WSKIP && !F32;
#define SEAM_K0() do { VMWN(NQL); if constexpr (F32) { SWRITE_KF(0); SBAR(); SLOAD_F((const float*)nxt.V, kbn); } else { SWRITE_HK(0); } SBAR(); } while (0)
    f32x16 pA0, pA1, pB0, pB1; float mnA, mnB, alA, alB; bf16x8 pa0, pa1, pa2, pa3;
    if constexpr (F32) { VMW(); SWRITE_VF(0); SBAR(); } else { SWRITE_HV(0); SBAR(); }
    if (NT > 1) { if constexpr (F32) SLOAD_F((const float*)Kh, KBASE(1)); else SLOAD_H(Kh, Vh, KBASE(1)); }
    SBAR(); qkt<0, SK>(pA0, pA1, K_lds, r32, hi, S.qr, ACT(0));
    if constexpr (F32) { if (NT > 1) { VMW(); SWRITE_KF(1); SBAR(); SLOAD_F((const float*)Vh, KBASE(1)); } }
    MASKT(pA0, pA1, 0); partialSM(pA0, pA1, m_reg, mnA, alA);
    if (NT > 1) { VMW(); if constexpr (F32) { SWRITE_VF(1); SBAR(); if (NT > 2) SLOAD_F((const float*)Kh, KBASE(2)); } else SWRITE_H(1); }
    __syncthreads();
#define HALF_STEP(PX0, PX1, mnX, alX, PY0, PY1, alY, t, KB, VB, SB) do {                                                      \
        SBAR(); qkt<KB, SK>(PX0, PX1, K_lds, r32, hi, S.qr, ACT(t));                                             \
        finishSM(PY0, PY1, alY, l_reg, pa0, pa1, pa2, pa3); SBAR();                                                           \
        if ((t) + 1 < NT) { if constexpr (F32) { VMW(); SWRITE_KF(SB); SBAR(); SLOAD_F((const float*)Vh, KBASE((t) + 1)); }  \
                            else { SLOAD_H(Kh, Vh, KBASE((t) + 1)); } SBAR(); }                                               \
        pv_tile<VB, SK>(o, vb0, pa0, pa1, pa2, pa3, ACT((t) - 1)); MASKT(PX0, PX1, (t)); partialSM(PX0, PX1, m_reg, mnX, alX);                                        \
        __syncthreads();                                                                                                      \
        if ((t) + 1 < NT) { VMW(); if constexpr (F32) { SWRITE_VF(SB); SBAR(); if ((t) + 2 < NT) SLOAD_F((const float*)Kh, KBASE((t) + 2)); } \
                            else { SWRITE_H(SB); } }                                                                          \
        RESC(alX); __syncthreads(); } while (0)
    for (int t = 1; t + 1 < NT; t += 2) {
        HALF_STEP(pB0, pB1, mnB, alB, pA0, pA1, alA, t, 1, 0, 0);
        HALF_STEP(pA0, pA1, mnA, alA, pB0, pB1, alB, t + 1, 0, 1, 1);
    }
    const bool even = (NT & 1) == 0;
    if (even) { SBAR(); qkt<1, SK>(pB0, pB1, K_lds, r32, hi, S.qr, ACT(NT - 1)); SBAR(); }
#define QROW(e) (nxt.Q + (size_t)(wid * QBLK + r32) * D + ((e) >> 1) * 16 + hi * 8 + ((e) & 1) * 4)
    if constexpr (F32) { SLOAD_F((const float*)nxt.K, kbn); SBAR();
#pragma unroll
        for (int e = 0; e < 8; ++e) S.tq[e] = *(const f32x4*)QROW(e); }
    else { SLOAD_H(nxt.K, nxt.V, kbn); SBAR();
#pragma unroll
        for (int d0 = 0; d0 < 8; ++d0) S.qr[d0] = load8<TIn>(nxt.Q + (size_t)(wid * QBLK + r32) * D + d0 * 16 + hi * 8); }
    SBAR();
    finishSM(pA0, pA1, alA, l_reg, pa0, pa1, pa2, pa3); SBAR();
    if constexpr (F32) {
#pragma unroll
        for (int e = 8; e < 16; ++e) S.tq[e] = *(const f32x4*)QROW(e); SBAR(); }
#undef QROW
    pv_tile<0, SK>(o, vb0, pa0, pa1, pa2, pa3, ACT(even ? NT - 2 : NT - 1));
    if (even) { MASKT(pB0, pB1, NT - 1); partialSM(pB0, pB1, m_reg, mnB, alB); __syncthreads(); RESC(alB);
        finishSM(pB0, pB1, alB, l_reg, pa0, pa1, pa2, pa3); SBAR(); pv_tile<1, SK>(o, vb0, pa0, pa1, pa2, pa3, ACT(NT - 1)); }
    SBAR(); SEAM_K0();
    if (hi == 0) li_l[r32] = l_reg; asm volatile("s_waitcnt lgkmcnt(0)" ::: "memory");
    float rli[16];
#pragma unroll
    for (int r = 0; r < 16; ++r) rli[r] = __builtin_amdgcn_rcpf(li_l[crow(r, hi)]);
    TOut* Ow = cur.O + (size_t)(wid * QBLK) * D;
#pragma unroll
    for (int r = 0; r < 16; ++r) { const int orow = crow(r, hi);
#pragma unroll
        for (int d0 = 0; d0 < 4; ++d0) { const float v = o[d0][r] * rli[r];
            if constexpr (same_t<TOut, float>::v) { Ow[(size_t)orow * D + d0 * 32 + r32] = v; }
            else { const float vn = __shfl_xor(v, 1);
                   if ((r32 & 1) == 0) *(unsigned*)(Ow + (size_t)orow * D + d0 * 32 + r32) = cvtpk(v, vn); } } }
    if constexpr (F32) {
#pragma unroll
        for (int d0 = 0; d0 < 8; ++d0) S.qr[d0] = pack8(S.tq[2 * d0], S.tq[2 * d0 + 1]); }
    __syncthreads();
#undef RESC
#undef KBASE
#undef ACT
#undef MASKT
#undef SEAM_K0
#undef HALF_STEP
}
#undef ROW
#undef VMW
#undef VMWN
#undef SLOAD_H
#undef SWRITE_HK
#undef SWRITE_HV
#undef SWRITE_H
#undef SLOAD_F
#undef SWRITE_KF
#undef SWRITE_VF
constexpr int LDS256_V = 0, LDS256_K = 4 * SHM_V, LDS256_WS = LDS256_K + 2 * SHM_K, LDS256_BYTES = LDS256_WS + NW * 64 * 4;
template <bool COMB>
__device__ __forceinline__ void diff_attn_block(const unsigned short* Q, const unsigned short* K, const unsigned short* V0, const unsigned short* V1, unsigned short* O, int P0, int skv, char* lds,
                                                unsigned short* AOut, int AOP, float lam, const float* sl, float eps) {
    const int tid = tid_fresh(), wid = __builtin_amdgcn_readfirstlane(tid >> 6), lane = tid & 63, r32 = lane & 31, hi = lane >> 5;
    int NT = (P0 + QB - 1) / KVBLK + 1; if (NT > skv / KVBLK) NT = skv / KVBLK;
    const int qlo = P0 + wid * QBLK, qm = qlo + r32 - 4 * hi;
    char* V_lds = lds + LDS256_V; char* K_lds = lds + LDS256_K;
    float* ws = (float*)(lds + LDS256_WS) + wid * 64; float* li_l = ws, * al_l = ws + 32;
    float m_reg = -1e30f, l_reg = 0; f32x16 o[8] = {};
    const int vb0 = (int)(uintptr_t)V_lds + v_rd_base(lane);
    bf16x8 qr[8];
#pragma unroll
    for (int d0 = 0; d0 < 8; ++d0) qr[d0] = *reinterpret_cast<const bf16x8*>(Q + (size_t)(wid * QBLK + r32) * D + d0 * 16 + hi * 8);
    typedef __attribute__((address_space(3))) unsigned* ldsu_t;
    unsigned koff[2], voff[2];
#pragma unroll
    for (int i = 0; i < 2; ++i) { const int q = (2 * wid + i) * 64 + lane;
        { const int row = q >> 4, cs = q & 15; koff[i] = (unsigned)(row * 256 + ((cs ^ (row & 7)) << 4)); }
        { const int st = q >> 5, kk = 8 * (st >> 2) + ((q & 31) >> 2), k = (kk & ~0xC) | ((kk & 4) << 1) | ((kk & 8) >> 1), c = 32 * (st & 3) + 8 * (q & 3); voff[i] = (unsigned)(k * 256 + c * 2); } }
    const unsigned ldsw = (unsigned)wid * 2048u;
#define A256_DMA(t, bf) do { const size_t tb_ = (size_t)(t) * (KVBLK * D * 2); \
        _Pragma("unroll") for (int i = 0; i < 2; ++i) { \
            __builtin_amdgcn_global_load_lds((const unsigned*)((const char*)K + tb_ + koff[i]), (ldsu_t)(K_lds + (bf) * SHM_K + ldsw + i * 1024), 16, 0, 0); \
            __builtin_amdgcn_global_load_lds((const unsigned*)((const char*)V0 + tb_ + voff[i]), (ldsu_t)(V_lds + (2 * (bf)) * SHM_V + ldsw + i * 1024), 16, 0, 0); \
            __builtin_amdgcn_global_load_lds((const unsigned*)((const char*)V1 + tb_ + voff[i]), (ldsu_t)(V_lds + (2 * (bf) + 1) * SHM_V + ldsw + i * 1024), 16, 0, 0); } } while (0)
#define A256_RESC(a) do { if (__any((a) < 1.f)) { if (hi == 0) al_l[r32] = (a); asm volatile("s_waitcnt lgkmcnt(0)" ::: "memory"); \
        _Pragma("unroll") for (int d_ = 0; d_ < 8; ++d_) _Pragma("unroll") for (int r = 0; r < 16; ++r) o[d_][r] *= al_l[crow(r, hi)]; } } while (0)
#define A256_STEP(BUF, tt) do { \
        if ((tt) + 1 < NT) A256_DMA((tt) + 1, 1 - BUF); \
        f32x16 p0, p1; float mn, alpha; bf16x8 pa0, pa1, pa2, pa3; \
        SBAR(); qkt<BUF, false>(p0, p1, K_lds, r32, hi, qr, true); \
        { const int kb_ = (tt) * KVBLK; if (kb_ + KVBLK - 1 > qlo) mask_tile(p0, p1, qm - kb_, 1u << 30); } \
        partialSM(p0, p1, m_reg, mn, alpha); \
        finishSM(p0, p1, alpha, l_reg, pa0, pa1, pa2, pa3); SBAR(); \
        A256_RESC(alpha); \
        pv_tile<2 * BUF, false>(o, vb0, pa0, pa1, pa2, pa3, true); pv_tile<2 * BUF + 1, false>(o + 4, vb0, pa0, pa1, pa2, pa3, true); \
        __syncthreads(); } while (0)
    A256_DMA(0, 0);
    __syncthreads();
    if (wid >= 4) __builtin_amdgcn_s_setprio(1);
    for (int t = 0; t < NT; t += 2) {
        A256_STEP(0, t);
        if (t + 1 < NT) A256_STEP(1, t + 1);
    }
    if (wid >= 4) __builtin_amdgcn_s_setprio(0);
    if (hi == 0) li_l[r32] = l_reg; asm volatile("s_waitcnt lgkmcnt(0)" ::: "memory");
    float rli[16];
#pragma unroll
    for (int r = 0; r < 16; ++r) rli[r] = __builtin_amdgcn_rcpf(li_l[crow(r, hi)]);
#define A256_DPP(v_, ctrl_) __builtin_bit_cast(float, __builtin_amdgcn_update_dpp(0, __builtin_bit_cast(int, (float)(v_)), (ctrl_), 0xf, 0xf, true))
#define A256_SHX(v_, m_) __builtin_bit_cast(float, __builtin_amdgcn_ds_bpermute((lane ^ (m_)) << 2, __builtin_bit_cast(int, (float)(v_))))
    unsigned short* Ow = O + (size_t)(wid * QBLK) * 256;
    if constexpr (!COMB) {
#pragma unroll
        for (int j = 0; j < 16; ++j) { const int d0 = j >> 1, rb = (j & 1) * 8;
            u32x4 w; w.x = cvtpk(o[d0][rb] * rli[rb], o[d0][rb + 1] * rli[rb + 1]); w.y = cvtpk(o[d0][rb + 2] * rli[rb + 2], o[d0][rb + 3] * rli[rb + 3]);
            w.z = cvtpk(o[d0][rb + 4] * rli[rb + 4], o[d0][rb + 5] * rli[rb + 5]); w.w = cvtpk(o[d0][rb + 6] * rli[rb + 6], o[d0][rb + 7] * rli[rb + 7]);
            *(u32x4*)(Ow + (size_t)(j * 64 + lane) * 8) = w; }
    } else {
        float slv[8];
#pragma unroll
        for (int d0 = 0; d0 < 8; ++d0) slv[d0] = sl[d0 * 32 + r32];
        u32x4 pw[16];
#pragma unroll
        for (int j = 0; j < 16; ++j) pw[j] = *(const u32x4*)(Ow + (size_t)(j * 64 + lane) * 8);
#pragma unroll
        for (int r = 0; r < 16; ++r) { const int orow = crow(r, hi); float ss = 0.f;
#pragma unroll
            for (int d0 = 0; d0 < 8; ++d0) { const unsigned wv = pw[2 * d0 + (r >> 3)][(r & 7) >> 1]; const float o0 = (r & 1) ? __uint_as_float(wv & 0xffff0000u) : __uint_as_float(wv << 16);
                const float x = o0 - lam * (o[d0][r] * rli[r]); o[d0][r] = x; ss += x * x; }
            ss += A256_DPP(ss, 0xB1); ss += A256_DPP(ss, 0x4E); ss += A256_DPP(ss, 0x141); ss += A256_DPP(ss, 0x140); ss += A256_SHX(ss, 16);
            const float rs = rsqrtf(ss * (1.0f / 256.0f) + eps);
            unsigned short* ao = AOut + (size_t)(wid * QBLK + orow) * AOP;
#pragma unroll
            for (int d0 = 0; d0 < 8; ++d0) { const float v = o[d0][r] * rs * slv[d0]; const float vn = A256_DPP(v, 0xB1);
                if ((r32 & 1) == 0) *(unsigned*)(ao + d0 * 32 + r32) = cvtpk(v, vn); } }
    }
    asm volatile("s_waitcnt lgkmcnt(0)\n\ts_barrier" ::: "memory");
#undef A256_SHX
#undef A256_DPP
#undef A256_DMA
#undef A256_RESC
#undef A256_STEP
}
#undef KSWZ
#undef SBAR
}
constexpr int DM = 2048, NB = 4, SEQ = 4096, NMETA = 16, MR = NB * SEQ  , MROWS = MR + NMETA, MPAD = MR + 256;
constexpr int DFF = 5632, NGU = 2 * DFF, NIN = 15360, LW = 2560, NHEAD = 8, KVLEN = 4160, DEPTH = 4;
constexpr float EPS = 1e-6f;
constexpr int NWAVES = 8;
#ifndef MK_MULTI
#define MK_MULTI 0
#endif
#ifndef DUAL_BR
#define DUAL_BR 1
#endif
#ifndef FINAL_BF16
#define FINAL_BF16 1
#endif
#ifndef EN_MASK
#define EN_MASK 0xFFFF
#endif
#define EN(k) (((EN_MASK) >> (k)) & 1)
#ifndef PROBE_SEAM
#define PROBE_SEAM -1
#endif
#ifndef PROBE_GAIN
#define PROBE_GAIN 1.0f
#endif
#ifndef DUP_PHASE
#define DUP_PHASE -1
#endif
#define DRY(k) ((k) == (DUP_PHASE) && rep_ == 0)
#define REPM(k) for (int rep_ = 0; rep_ < ((DUP_PHASE) == 20 ? 2 : 1); ++rep_)
#define DRYM ((DUP_PHASE) == 20 && rep_ == 0)
#define REP(k) for (int rep_ = 0; rep_ < ((k) == (DUP_PHASE) ? 2 : 1); ++rep_)
#ifndef NO_META
#define NO_META 0
#endif
constexpr int PH_PER_LAYER = 10, N_PHASES = 2 + DEPTH * PH_PER_LAYER;

constexpr size_t MiB = 1u << 20;
constexpr size_t WS_CTL = 0, CTL_ZERO_BYTES = 2 * MiB;
constexpr size_t WS_ROPE = 2 * MiB;
constexpr size_t WS_QM = 3 * MiB + 512 * 1024;
constexpr size_t WS_W = 4 * MiB, WBUF_STRIDE = 0 * MiB;
constexpr size_t W_GU1 = WS_W, W_DN1 = W_GU1 + 44 * MiB, W_IN = W_DN1 + 22 * MiB, W_BA = W_IN + 60 * MiB, W_BL = W_BA + 8 * MiB, W_O = W_BL + 10 * MiB,
                 W_GU2 = W_O + 8 * MiB, W_DN2 = W_GU2 + 44 * MiB;
constexpr size_t WS_H = 224 * MiB;
constexpr size_t WS_HB = 354 * MiB;
constexpr size_t WS_HID = 420 * MiB;
constexpr size_t WS_Q = 600 * MiB;
constexpr size_t WS_K = 664 * MiB;
constexpr size_t WS_V = 729 * MiB;
constexpr size_t WS_XR = 794 * MiB;
constexpr size_t WS_GY = 876 * MiB;
constexpr size_t WS_G = 958 * MiB;
constexpr size_t WS_OP = 1088 * MiB;
constexpr size_t WS_AO = 1216 * MiB;
constexpr size_t WS_LO = 1281 * MiB;
constexpr size_t WS_TMP = 1363 * MiB;
constexpr size_t WS_MIX = 1493 * MiB;
constexpr size_t WS_END = 1558 * MiB;
static_assert(W_DN2 + 22 * MiB <= WS_H && WS_H + (size_t)MPAD * DM * 4 <= WS_HB && WS_HB + (size_t)MPAD * DM * 2 <= WS_HID && WS_HID + (size_t)MPAD * DFF * 2 <= WS_Q, "ws map 1");
static_assert(WS_K + (size_t)64 * KVLEN * 256 <= WS_V && WS_V + (size_t)64 * KVLEN * 256 <= WS_XR && WS_XR + (size_t)MPAD * LW * 2 <= WS_GY && WS_GY + (size_t)MPAD * LW * 2 <= WS_G, "ws map 2");
static_assert(WS_LO + (size_t)MPAD * LW * 2 <= WS_TMP && WS_TMP + (size_t)MPAD * DM * 4 <= WS_MIX && WS_MIX + (size_t)MPAD * DM * 2 <= WS_END, "ws map 3");
constexpr int CW_TMO = 0, CW_CODE = 1, CW_BAR = 4096, CW_REACH = 8192  , CW_ITEM = 12288  ;
constexpr size_t SSQ_OFF = 65536;
constexpr int N_SSQ = 13;
static_assert(SSQ_OFF + (size_t)N_SSQ * MPAD * 8 <= CTL_ZERO_BYTES, "ssq inside the memset region");

constexpr int RING_BYTES = 143360, LDSCTL_OFF = RING_BYTES, MISC_OFF = LDSCTL_OFF + 320, LDS_BYTES = 147456;

using pg8::bf16_t; using pg8::bf16x8; using pg8::f32x4; using pg8::u32x4; using pg8::cvt_pk_bf16;

__device__ __forceinline__ float wave_sum(float v) {
#pragma unroll
    for (int o = 1; o < 64; o <<= 1) v += __shfl_xor(v, o);
    return v;
}
__device__ __forceinline__ float bf2f(unsigned short u) { return __uint_as_float((unsigned)u << 16); }
__device__ __forceinline__ float bflo(unsigned u) { return __uint_as_float(u << 16); }
__device__ __forceinline__ float bfhi(unsigned u) { return __uint_as_float(u & 0xffff0000u); }
__device__ __forceinline__ unsigned short f2bf16(float f) { return (unsigned short)(cvt_pk_bf16(f, 0.f) & 0xffffu); }
typedef unsigned long long u64;
typedef float f32x2 __attribute__((ext_vector_type(2)));
__device__ __forceinline__ float rstd_from(float ssq) { return rsqrtf(ssq * (1.0f / 2048.0f) + EPS); }
__device__ __forceinline__ float rstd_fx(u64 v) { return rsqrtf((float)v * (1.0f / 4294967296.0f / 2048.0f) + EPS); }
__device__ __forceinline__ u64 ssq_fx(float ss) { return (u64)(ss * 4294967296.0f); }
__device__ __forceinline__ float sigmoid_f(float x) { return __builtin_amdgcn_rcpf(1.0f + __expf(-x)); }
__device__ __forceinline__ float gelu_tanh_f(float y) { const float u = 1.5957691216057308f * (y + 0.044715f * y * y * y); return y * __builtin_amdgcn_rcpf(1.0f + __expf(-u)); }
__device__ __forceinline__ f32x4 sigmoid4(f32x4 x) { f32x4 t = x * -1.4426950408889634f;
#pragma unroll
    for (int e = 0; e < 4; ++e) t[e] = __builtin_amdgcn_exp2f(t[e]);
    t = t + 1.0f;
#pragma unroll
    for (int e = 0; e < 4; ++e) t[e] = __builtin_amdgcn_rcpf(t[e]);
    return t; }
__device__ __forceinline__ f32x4 gelu_tanh4(f32x4 y) { return y * sigmoid4(y * ((y * y) * (0.044715f * 1.5957691216057308f) + 1.5957691216057308f)); }
__device__ __forceinline__ u32x4 pack8f(f32x4 a, f32x4 b) { u32x4 w; w.x = cvt_pk_bf16(a[0], a[1]); w.y = cvt_pk_bf16(a[2], a[3]); w.z = cvt_pk_bf16(b[0], b[1]); w.w = cvt_pk_bf16(b[2], b[3]); return w; }

namespace pg8 {
template <class E> __device__ __forceinline__ void run_epi(const E& e, const f32x4 (&acc)[2][2][4][2], const Unit& u, int wr, int wc, int fr, int fq) {
    const int colin = wc * 32 + 8 * fq, row0 = u.pm * BM + wr * 64 + fr;
    const typename E::Tile tl = e.tile(u.pn, colin);
    typename E::Pre q[8];
#pragma unroll
    for (int i = 0; i < 8; ++i) if (i < E::DEPTH) q[i] = e.pre(row0 + (i >> 2) * HALF + (i & 3) * 16, u.pn, colin);
    asm volatile("" ::: "memory");
#pragma unroll
    for (int i = 0; i < 8; ++i) {
        if (i + E::DEPTH < 8) { q[i + E::DEPTH] = e.pre(row0 + ((i + E::DEPTH) >> 2) * HALF + ((i + E::DEPTH) & 3) * 16, u.pn, colin); asm volatile("" ::: "memory"); }
        e.template frag<false>(row0 + (i >> 2) * HALF + (i & 3) * 16, u.pn, colin, acc[i >> 2][0][i & 3][0], acc[i >> 2][0][i & 3][1], acc[i >> 2][1][i & 3][0], acc[i >> 2][1][i & 3][1], q[i], tl);
    }
}
}
#define EPI_COMMON static constexpr bool PERM = true, AFTER_DRAIN = false; \
    __device__ __forceinline__ void operator()(const f32x4 (&acc)[2][2][4][2], const pg8::Unit& u, int wr, int wc, int fr, int fq) const { pg8::run_epi(*this, acc, u, wr, wc, fr, fq); } \
    template <bool META> __device__ __forceinline__ void frag1(int row, int pn, int colin, f32x4 a0, f32x4 a1, f32x4 b0, f32x4 b1) const { this->template frag<META>(row, pn, colin, a0, a1, b0, b1, pre(row, pn, colin), tile(pn, colin)); }
struct EpiNone {};
__device__ __forceinline__ void unpack8(u32x4 w, f32x4& lo, f32x4& hi) { lo = (f32x4){bflo(w.x), bfhi(w.x), bflo(w.y), bfhi(w.y)}; hi = (f32x4){bflo(w.z), bfhi(w.z), bflo(w.w), bfhi(w.w)}; }

struct EpiNull {
    typedef EpiNone Pre; typedef EpiNone Tile; static constexpr int DEPTH = 1;
    __device__ __forceinline__ Pre pre(int, int, int) const { return Pre{}; }
    __device__ __forceinline__ Tile tile(int, int) const { return Tile{}; }
    template <bool META> __device__ __forceinline__ void frag(int row, int pn, int colin, f32x4 a0, f32x4 a1, f32x4 b0, f32x4 b1, const Pre&, const Tile&) const { asm volatile("" :: "v"(a0), "v"(a1), "v"(b0), "v"(b1)); }
    EPI_COMMON
};
struct PreSsq { u64 v; };
struct EpiSwiGLU {
    bf16_t* HID; const u64* ssq;
    typedef PreSsq Pre; typedef EpiNone Tile; static constexpr int DEPTH = 8;
    __device__ __forceinline__ Pre pre(int row, int, int) const { return Pre{ssq[row]}; }
    __device__ __forceinline__ Tile tile(int, int) const { return Tile{}; }
    template <bool META> __device__ __forceinline__ void frag(int row, int pn, int colin, f32x4 a0, f32x4 a1, f32x4 b0, f32x4 b1, const Pre& p, const Tile&) const {
        const float rs = rstd_fx(p.v), c1 = rs * -1.4426950408889634f, rs2 = rs * rs;
        f32x4 t0 = a0 * c1, t1 = a1 * c1;
#pragma unroll
        for (int e = 0; e < 4; ++e) { t0[e] = __builtin_amdgcn_exp2f(t0[e]); t1[e] = __builtin_amdgcn_exp2f(t1[e]); }
        t0 = t0 + 1.0f; t1 = t1 + 1.0f;
#pragma unroll
        for (int e = 0; e < 4; ++e) { t0[e] = __builtin_amdgcn_rcpf(t0[e]); t1[e] = __builtin_amdgcn_rcpf(t1[e]); }
        const f32x4 o0 = (a0 * b0) * t0 * rs2, o1 = (a1 * b1) * t1 * rs2;
        *(u32x4*)(HID + (size_t)row * DFF + pn * 128 + colin) = pack8f(o0, o1);
    }
    EPI_COMMON
};
struct PreH { f32x4 h0, h1, h2, h3; };
struct PreHb { u32x4 lo, hi; };
struct EpiResid {
    float* Hf; bf16_t* HB; u64* ssqn; float alpha, ssw;
    typedef PreHb Pre; typedef EpiNone Tile; static constexpr int DEPTH = 4;
    __device__ __forceinline__ Pre pre(int row, int pn, int colin) const { const bf16_t* bp = HB + (size_t)row * DM + pn * 256 + colin; return Pre{*(const u32x4*)bp, *(const u32x4*)(bp + 128)}; }
    __device__ __forceinline__ Tile tile(int, int) const { return Tile{}; }
    template <bool META> __device__ __forceinline__ void frag(int row, int pn, int colin, f32x4 a0, f32x4 a1, f32x4 b0, f32x4 b1, const Pre& p, const Tile&) const {
        const int c0 = pn * 256 + colin;
        f32x4 h0, h1, h2, h3; unpack8(p.lo, h0, h1); unpack8(p.hi, h2, h3);
        h0 = h0 + alpha * a0; h1 = h1 + alpha * a1; h2 = h2 + alpha * b0; h3 = h3 + alpha * b1;
        bf16_t* bp = HB + (size_t)row * DM + c0;
        *(u32x4*)bp = pack8f(h0, h1); *(u32x4*)(bp + 128) = pack8f(h2, h3);
        if (Hf) { float* hp = Hf + (size_t)row * DM + c0; *(f32x4*)hp = h0; *(f32x4*)(hp + 4) = h1; *(f32x4*)(hp + 128) = h2; *(f32x4*)(hp + 132) = h3; }
        float ss = 0.f;
#pragma unroll
        for (int e = 0; e < 4; ++e) ss += h0[e] * h0[e] + h1[e] * h1[e] + h2[e] * h2[e] + h3[e] * h3[e];
        ss += __shfl_xor(ss, 16); ss += __shfl_xor(ss, 32);
        if ((threadIdx.x & 48) == 0) __hip_atomic_fetch_add(ssqn + row, ssq_fx(ss * ssw), __ATOMIC_RELAXED, __HIP_MEMORY_SCOPE_AGENT);
    }
    EPI_COMMON
};
struct PreWin { u64 v; f32x4 c, s; };
struct TileWin { f32x4 g0, g1, g2, g3; };
struct EpiWin {
    bf16_t *Q, *K, *V, *XR, *GY, *G, *QM; const float* bgate; const u64* ssq; const float* rc; const float* rsn;
    typedef PreWin Pre; typedef TileWin Tile; static constexpr int DEPTH = 3;
    __device__ __forceinline__ Pre pre(int row, int pn, int colin) const {
        Pre p; p.v = ssq[row]; p.c = (f32x4){0.f, 0.f, 0.f, 0.f}; p.s = p.c;
        if (pn < 16 && colin < 32) { const int pos = row >= MR ? row - MR : (row & 4095) + NMETA; p.c = *(const f32x4*)(rc + pos * 16 + (colin >> 1)); p.s = *(const f32x4*)(rsn + pos * 16 + (colin >> 1)); }
        return p; }
    __device__ __forceinline__ Tile tile(int pn, int colin) const {
        Tile t; t.g0 = (f32x4){0.f, 0.f, 0.f, 0.f}; t.g1 = t.g0; t.g2 = t.g0; t.g3 = t.g0;
        if (pn >= 44) { const float* bp = bgate + (pn - 44) * 256 + colin; t.g0 = *(const f32x4*)bp; t.g1 = *(const f32x4*)(bp + 4); t.g2 = *(const f32x4*)(bp + 128); t.g3 = *(const f32x4*)(bp + 132); }
        return t; }
    template <bool META> __device__ __forceinline__ void frag(int row, int pn, int colin, f32x4 a0, f32x4 a1, f32x4 b0, f32x4 b1, const Pre& pq, const Tile& tl) const {
        const float rs = rstd_fx(pq.v);
        a0 = a0 * rs; a1 = a1 * rs; b0 = b0 * rs; b1 = b1 * rs;
        const int mi = row - MR, b = row >> 12, t = row & 4095, pos = META ? mi : t + NMETA;
        if (pn < 24) {
            if (pn < 16 && colin < 32) {
                const f32x4 c = pq.c, s = pq.s;
                const f32x4 r1 = a0 * c - a1 * s, r2 = a1 * c + a0 * s, r3 = b0 * c - b1 * s, r4 = b1 * c + b0 * s;
                a0 = r1; a1 = r2; b0 = r3; b1 = r4;
            }
            const u32x4 wa = pack8f(a0, a1), wb = pack8f(b0, b1);
            const int h = pn & 7;
            if (pn < 8) {
                if (META) { bf16_t* p = QM + ((size_t)(2 * h) * NMETA + mi) * 128 + colin; *(u32x4*)p = wa; *(u32x4*)(p + NMETA * 128) = wb; }
                else { bf16_t* p = Q + ((size_t)(b * 16 + 2 * h) * SEQ + t) * 128 + colin; *(u32x4*)p = wa; *(u32x4*)(p + (size_t)SEQ * 128) = wb; }
            } else {
                bf16_t* base = pn < 16 ? K : V;
                if (META) {
#pragma unroll
                    for (int bb = 0; bb < NB; ++bb) { bf16_t* p = base + ((size_t)(bb * 16 + 2 * h) * KVLEN + mi) * 128 + colin; *(u32x4*)p = wa; *(u32x4*)(p + (size_t)KVLEN * 128) = wb; }
                } else { bf16_t* p = base + ((size_t)(b * 16 + 2 * h) * KVLEN + pos) * 128 + colin; *(u32x4*)p = wa; *(u32x4*)(p + (size_t)KVLEN * 128) = wb; }
            }
        } else if (pn < 34) {
            bf16_t* p = XR + (size_t)row * LW + (pn - 24) * 256 + colin; *(u32x4*)p = pack8f(a0, a1); *(u32x4*)(p + 128) = pack8f(b0, b1);
        } else if (pn < 44) {
            a0 = gelu_tanh4(a0); a1 = gelu_tanh4(a1); b0 = gelu_tanh4(b0); b1 = gelu_tanh4(b1);
            bf16_t* p = GY + (size_t)row * LW + (pn - 34) * 256 + colin; *(u32x4*)p = pack8f(a0, a1); *(u32x4*)(p + 128) = pack8f(b0, b1);
        } else {
            const int c0 = (pn - 44) * 256 + colin;
            a0 = sigmoid4(a0 + tl.g0); a1 = sigmoid4(a1 + tl.g1); b0 = sigmoid4(b0 + tl.g2); b1 = sigmoid4(b1 + tl.g3);
            bf16_t* p = G + (size_t)row * 4096 + c0; *(u32x4*)p = pack8f(a0, a1); *(u32x4*)(p + 128) = pack8f(b0, b1);
        }
    }
    EPI_COMMON
};
struct PreG { u32x4 g0, g1; };
struct EpiBa {
    bf16_t* TMP; const bf16_t* G;
    typedef PreG Pre; typedef EpiNone Tile; static constexpr int DEPTH = 4;
    __device__ __forceinline__ Pre pre(int row, int pn, int colin) const { const bf16_t* gp = G + (size_t)row * 4096 + pn * 256 + colin; return Pre{*(const u32x4*)gp, *(const u32x4*)(gp + 128)}; }
    __device__ __forceinline__ Tile tile(int, int) const { return Tile{}; }
    template <bool META> __device__ __forceinline__ void frag(int row, int pn, int colin, f32x4 a0, f32x4 a1, f32x4 b0, f32x4 b1, const Pre& p, const Tile&) const {
        const int c0 = pn * 256 + colin;
        f32x4 g0, g1, g2, g3; unpack8(p.g0, g0, g1); unpack8(p.g1, g2, g3);
        bf16_t* tp = TMP + (size_t)row * DM + c0;
        *(u32x4*)tp = pack8f(g0 * a0, g1 * a1); *(u32x4*)(tp + 128) = pack8f(g2 * b0, g3 * b1);
    }
    EPI_COMMON
};
struct PreTG { u32x4 t0, t1, g0, g1; };
struct EpiBl {
    const bf16_t* TMP; const bf16_t* G; bf16_t* MIX;
    typedef PreTG Pre; typedef EpiNone Tile; static constexpr int DEPTH = 2;
    __device__ __forceinline__ Pre pre(int row, int pn, int colin) const { const int c0 = pn * 256 + colin; const bf16_t* tp = TMP + (size_t)row * DM + c0; const bf16_t* gp = G + (size_t)row * 4096 + 2048 + c0;
        return Pre{*(const u32x4*)tp, *(const u32x4*)(tp + 128), *(const u32x4*)gp, *(const u32x4*)(gp + 128)}; }
    __device__ __forceinline__ Tile tile(int, int) const { return Tile{}; }
    template <bool META> __device__ __forceinline__ void frag(int row, int pn, int colin, f32x4 a0, f32x4 a1, f32x4 b0, f32x4 b1, const Pre& p, const Tile&) const {
        const int c0 = pn * 256 + colin;
        f32x4 g0, g1, g2, g3, t0, t1, t2, t3; unpack8(p.g0, g0, g1); unpack8(p.g1, g2, g3); unpack8(p.t0, t0, t1); unpack8(p.t1, t2, t3);
        t0 = t0 + g0 * a0; t1 = t1 + g1 * a1; t2 = t2 + g2 * b0; t3 = t3 + g3 * b1;
        bf16_t* mp = MIX + (size_t)row * DM + c0;
        *(u32x4*)mp = pack8f(t0, t1); *(u32x4*)(mp + 128) = pack8f(t2, t3);
    }
    EPI_COMMON
};

struct PreGG { u32x4 a0, a1, l0, l1; };
struct EpiDual {
    const bf16_t* G; bf16_t* MIX;
    typedef PreG Pre; typedef EpiNone Tile; static constexpr int DEPTH = 4;
    __device__ __forceinline__ Pre pre(int row, int pn, int colin) const { const bf16_t* gp = G + (size_t)row * 4096 + 2048 + pn * 256 + colin; return Pre{*(const u32x4*)gp, *(const u32x4*)(gp + 128)}; }
    __device__ __forceinline__ Tile tile(int, int) const { return Tile{}; }
    template <bool META> __device__ __forceinline__ void frag(int row, int pn, int colin, f32x4 a0, f32x4 a1, f32x4 b0, f32x4 b1, const Pre& p, const Tile&) const {
        f32x4 g0, g1, g2, g3; unpack8(p.g0, g0, g1); unpack8(p.g1, g2, g3);
#pragma unroll
        for (int e = 0; e < 4; ++e) { g0[e] = fmaxf(g0[e], 1e-20f); g1[e] = fmaxf(g1[e], 1e-20f); g2[e] = fmaxf(g2[e], 1e-20f); g3[e] = fmaxf(g3[e], 1e-20f); }
        bf16_t* mp = MIX + (size_t)row * DM + pn * 256 + colin;
        *(u32x4*)mp = pack8f(g0 * a0, g1 * a1); *(u32x4*)(mp + 128) = pack8f(g2 * b0, g3 * b1);
    }
    __device__ __forceinline__ PreGG pre2(int row, int pn, int colin) const { const bf16_t* gp = G + (size_t)row * 4096 + pn * 256 + colin;
        return PreGG{*(const u32x4*)gp, *(const u32x4*)(gp + 128), *(const u32x4*)(gp + 2048), *(const u32x4*)(gp + 2048 + 128)}; }
    static __device__ __forceinline__ f32x4 ratio4(f32x4 ga, f32x4 gl) { f32x4 r;
#pragma unroll
        for (int e = 0; e < 4; ++e) r[e] = ga[e] * __builtin_amdgcn_rcpf(fmaxf(gl[e], 1e-20f));
        return r; }
    __device__ __forceinline__ void mid(f32x4 (&acc)[2][2][4][2], const pg8::Unit& u, int wr, int wc, int fr, int fq) const {
        const int colin = wc * 32 + 8 * fq, row0 = u.pm * pg8::BM + wr * 64 + fr;
        PreGG q[8];
#pragma unroll
        for (int i = 0; i < 2; ++i) q[i] = pre2(row0 + (i >> 2) * pg8::HALF + (i & 3) * 16, u.pn, colin);
        asm volatile("" ::: "memory");
#pragma unroll
        for (int i = 0; i < 8; ++i) {
            if (i + 2 < 8) { q[i + 2] = pre2(row0 + ((i + 2) >> 2) * pg8::HALF + ((i + 2) & 3) * 16, u.pn, colin); asm volatile("" ::: "memory"); }
            f32x4 a0, a1, a2, a3, l0, l1, l2, l3; unpack8(q[i].a0, a0, a1); unpack8(q[i].a1, a2, a3); unpack8(q[i].l0, l0, l1); unpack8(q[i].l1, l2, l3);
            acc[i >> 2][0][i & 3][0] = acc[i >> 2][0][i & 3][0] * ratio4(a0, l0); acc[i >> 2][0][i & 3][1] = acc[i >> 2][0][i & 3][1] * ratio4(a1, l1);
            acc[i >> 2][1][i & 3][0] = acc[i >> 2][1][i & 3][0] * ratio4(a2, l2); acc[i >> 2][1][i & 3][1] = acc[i >> 2][1][i & 3][1] * ratio4(a3, l3);
        }
    }
    EPI_COMMON
};

template <class Epi> __device__ __forceinline__ void meta_gemm(LAS unsigned char* lds, const bf16_t* A16, const bf16_t* Bt, int N, int K, const Epi& E) {
    const int tid = tid_fresh(), wid = __builtin_amdgcn_readfirstlane(tid >> 6), lane = tid & 63, fr = lane & 15, fq = lane >> 4;
    const int nitems = N / 64, ks = K / 8;
    LAS f32x4* red = (LAS f32x4*)lds;
    for (int it = blockIdx.x; it < nitems; it += gridDim.x) {
        const int pn = it >> 2, wc = it & 3;
        typename Epi::Pre pq{}; typename Epi::Tile tl{};
        if (wid == 0) { pq = E.pre(MR + fr, pn, wc * 32 + 8 * fq); tl = E.tile(pn, wc * 32 + 8 * fq); }
        f32x4 acc[4];
#pragma unroll
        for (int q = 0; q < 4; ++q) acc[q] = (f32x4){0.f, 0.f, 0.f, 0.f};
        const bf16_t* ap = A16 + (size_t)fr * K + wid * ks + 8 * fq;
        const bf16_t* bp[4];
#pragma unroll
        for (int q = 0; q < 4; ++q) bp[q] = Bt + (size_t)(pn * 256 + (q >> 1) * 128 + wc * 32 + pg8::perm32(16 * (q & 1) + fr)) * K + wid * ks + 8 * fq;
#pragma unroll 8
        for (int kk = 0; kk < ks; kk += 32) {
            const bf16x8 a = *(const bf16x8*)(ap + kk);
#pragma unroll
            for (int q = 0; q < 4; ++q) { const bf16x8 bv = *(const bf16x8*)(bp[q] + kk); acc[q] = __builtin_amdgcn_mfma_f32_16x16x32_bf16(bv, a, acc[q], 0, 0, 0); }
        }
#pragma unroll
        for (int q = 0; q < 4; ++q) red[(wid * 4 + q) * 64 + lane] = acc[q];
        __syncthreads();
        if (wid == 0) {
            f32x4 s[4];
#pragma unroll
            for (int q = 0; q < 4; ++q) { s[q] = red[q * 64 + lane];
#pragma unroll
                for (int w = 1; w < 8; ++w) s[q] = s[q] + red[(w * 4 + q) * 64 + lane]; }
            E.template frag<true>(MR + fr, pn, wc * 32 + 8 * fq, s[0], s[1], s[2], s[3], pq, tl);
        }
        __syncthreads();
    }
}

template <int K> __device__ __forceinline__ void meta_resid(LAS unsigned char* lds, const bf16_t* A16, const bf16_t* Bt, bf16_t* HBo, u64* ssqn, float alpha) {
    const int tid = tid_fresh(), wid = __builtin_amdgcn_readfirstlane(tid >> 6), lane = tid & 63, fr = lane & 15, fq = lane >> 4;
    constexpr int ks = K / 8, NST = ks / 32;
    LAS f32x4* red = (LAS f32x4*)lds;
    for (int it = blockIdx.x; it < DM / 16; it += gridDim.x) {
        const int pn = it >> 4, bj = (it >> 3) & 1, wc = (it >> 1) & 3, n = it & 1;
        const int c0 = pn * 256 + bj * 128 + wc * 32 + 8 * fq + 4 * n;
        bf16_t* hp = HBo + (size_t)(MR + fr) * DM + c0;
        unsigned long long hw = 0ull;
        if (wid == 0) hw = *(const unsigned long long*)hp;
        const bf16_t* ap = A16 + (size_t)fr * K + wid * ks + 8 * fq;
        const bf16_t* bp = Bt + (size_t)(pn * 256 + bj * 128 + wc * 32 + pg8::perm32(16 * n + fr)) * K + wid * ks + 8 * fq;
        bf16x8 av[NST], bv[NST];
#pragma unroll
        for (int i = 0; i < NST; ++i) { av[i] = *(const bf16x8*)(ap + 32 * i); bv[i] = *(const bf16x8*)(bp + 32 * i); }
        f32x4 acc = (f32x4){0.f, 0.f, 0.f, 0.f};
#pragma unroll
        for (int i = 0; i < NST; ++i) acc = __builtin_amdgcn_mfma_f32_16x16x32_bf16(bv[i], av[i], acc, 0, 0, 0);
        red[wid * 64 + lane] = acc;
        __syncthreads();
        if (wid == 0) {
            f32x4 sm = red[lane];
#pragma unroll
            for (int w = 1; w < 8; ++w) sm = sm + red[w * 64 + lane];
            const unsigned w0 = (unsigned)hw, w1 = (unsigned)(hw >> 32);
            const f32x4 h = (f32x4){bflo(w0), bfhi(w0), bflo(w1), bfhi(w1)} + alpha * sm;
            *(unsigned long long*)hp = (unsigned long long)cvt_pk_bf16(h[0], h[1]) | ((unsigned long long)cvt_pk_bf16(h[2], h[3]) << 32);
            float ss = h[0] * h[0] + h[1] * h[1] + h[2] * h[2] + h[3] * h[3];
            ss += __shfl_xor(ss, 16); ss += __shfl_xor(ss, 32);
            if (fq == 0) __hip_atomic_fetch_add(ssqn + MR + fr, ssq_fx(ss), __ATOMIC_RELAXED, __HIP_MEMORY_SCOPE_AGENT);
        }
        __syncthreads();
    }
}
__device__ __forceinline__ void meta_dual(LAS unsigned char* lds, const bf16_t* A0, const bf16_t* Bt0, int K0, const bf16_t* A1, const bf16_t* Bt1, int K1, const bf16_t* G, bf16_t* MIXo) {
    const int tid = tid_fresh(), wid = __builtin_amdgcn_readfirstlane(tid >> 6), lane = tid & 63, fr = lane & 15, fq = lane >> 4;
    LAS f32x4* red = (LAS f32x4*)lds;
    for (int it = blockIdx.x; it < DM / 64; it += gridDim.x) {
        const int pn = it >> 2, wc = it & 3, colin = wc * 32 + 8 * fq, c0 = pn * 256 + colin;
        u32x4 ga0{}, ga1{}, gl0{}, gl1{};
        if (wid == 0) { const bf16_t* gp = G + (size_t)(MR + fr) * 4096 + c0; ga0 = *(const u32x4*)gp; ga1 = *(const u32x4*)(gp + 128); gl0 = *(const u32x4*)(gp + 2048); gl1 = *(const u32x4*)(gp + 2048 + 128); }
        f32x4 acc[8];
#pragma unroll
        for (int q = 0; q < 8; ++q) acc[q] = (f32x4){0.f, 0.f, 0.f, 0.f};
#pragma unroll
        for (int h = 0; h < 2; ++h) {
            const bf16_t* Ah = h ? A1 : A0; const bf16_t* Bh = h ? Bt1 : Bt0; const int K = h ? K1 : K0, ks = K / 8;
            const bf16_t* ap = Ah + (size_t)fr * K + wid * ks + 8 * fq;
            const bf16_t* bp[4];
#pragma unroll
            for (int q = 0; q < 4; ++q) bp[q] = Bh + (size_t)(pn * 256 + (q >> 1) * 128 + wc * 32 + pg8::perm32(16 * (q & 1) + fr)) * K + wid * ks + 8 * fq;
#pragma unroll 8
            for (int kk = 0; kk < ks; kk += 32) {
                const bf16x8 a = *(const bf16x8*)(ap + kk);
#pragma unroll
                for (int q = 0; q < 4; ++q) { const bf16x8 bv = *(const bf16x8*)(bp[q] + kk); acc[4 * h + q] = __builtin_amdgcn_mfma_f32_16x16x32_bf16(bv, a, acc[4 * h + q], 0, 0, 0); }
            }
        }
#pragma unroll
        for (int q = 0; q < 8; ++q) red[(wid * 8 + q) * 64 + lane] = acc[q];
        __syncthreads();
        if (wid == 0) {
            f32x4 sm[8];
#pragma unroll
            for (int q = 0; q < 8; ++q) { sm[q] = red[q * 64 + lane];
#pragma unroll
                for (int w = 1; w < 8; ++w) sm[q] = sm[q] + red[(w * 8 + q) * 64 + lane]; }
            f32x4 a0, a1, a2, a3, l0, l1, l2, l3; unpack8(ga0, a0, a1); unpack8(ga1, a2, a3); unpack8(gl0, l0, l1); unpack8(gl1, l2, l3);
            bf16_t* mp = MIXo + (size_t)(MR + fr) * DM + c0;
            *(u32x4*)mp = pack8f(a0 * sm[0] + l0 * sm[4], a1 * sm[1] + l1 * sm[5]); *(u32x4*)(mp + 128) = pack8f(a2 * sm[2] + l2 * sm[6], a3 * sm[3] + l3 * sm[7]);
        }
        __syncthreads();
    }
}

template <int MODE> __device__ __forceinline__ int wmap(int n) {
    if (MODE == 1) return ((n >> 7) << 8) + (n & 127);
    if (MODE == 2) return ((n >> 7) << 8) + 128 + (n & 127);
    if (MODE == 3) { if (n >= 4096) return n; const int d = n & 127; if (d >= 32) return n; const int s = d < 16 ? 8 * (d >> 2) + (d & 3) : 8 * ((d - 16) >> 2) + 4 + (d & 3); return (n & ~127) + s; }
    return n;
}
template <int MODE> __device__ __forceinline__ void transpose_item(const float* W, int K, int N, bf16_t* WT, LAS float* scr, int item, int lane, const float* gk = nullptr) {
    const int nblk = N / 32, kb = item / nblk, nb = item % nblk, k0 = 64 * kb, n0 = 32 * nb;
    const int c = lane & 7;
    f32x4 ga = (f32x4){1.f, 1.f, 1.f, 1.f}, gb = ga;
    if (gk) { ga = *(const f32x4*)(gk + k0 + 8 * c); gb = *(const f32x4*)(gk + k0 + 8 * c + 4); }
    { float wv[32];
      const float* wp = W + (size_t)(k0 + (lane >> 5)) * N + n0 + (lane & 31);
#pragma unroll
      for (int i = 0; i < 32; ++i) wv[i] = wp[(size_t)(2 * i) * N];
#pragma unroll
      for (int i = 0; i < 32; ++i) scr[(2 * i + (lane >> 5)) * 33 + (lane & 31)] = wv[i]; }
    asm volatile("s_waitcnt lgkmcnt(0)" ::: "memory");
#pragma unroll
    for (int j = 0; j < 4; ++j) { const int n = (lane >> 3) + 8 * j; const LAS float* s = scr + (8 * c) * 33 + n;
        u32x4 o; o.x = cvt_pk_bf16(s[0 * 33] * ga[0], s[1 * 33] * ga[1]); o.y = cvt_pk_bf16(s[2 * 33] * ga[2], s[3 * 33] * ga[3]); o.z = cvt_pk_bf16(s[4 * 33] * gb[0], s[5 * 33] * gb[1]); o.w = cvt_pk_bf16(s[6 * 33] * gb[2], s[7 * 33] * gb[3]);
        *(u32x4*)(WT + (size_t)wmap<MODE>(n0 + n) * K + k0 + 8 * c) = o; }
    asm volatile("s_waitcnt lgkmcnt(0)" ::: "memory");
}

struct Args { const float* in[29]; float* out; unsigned char* ws; float invf[16]; int ph_lo, ph_hi; };
static_assert(sizeof(Args) == 31 * 8 + 16 * 4 + 8, "Args has no padding");

__device__ __forceinline__ void conv_pass(const bf16_t* XR, bf16_t* XCg, const float* conv_w, const float* conv_b, int gtid, int ngt) {
    constexpr int NCH = LW / 8, RUNS = (SEQ + NMETA) / 8, NTASK = NB * RUNS * NCH;
    for (int task = gtid; task < NTASK; task += ngt) {
        const int c8 = task % NCH, u = (task / NCH) % RUNS, b = task / (NCH * RUNS), p0 = 8 * u;
        if (u < 2 && b > 0) continue;
        float cw[4][8], cb[8], o[8][8];
        { const f32x4 b0 = *(const f32x4*)(conv_b + 8 * c8), b1 = *(const f32x4*)(conv_b + 8 * c8 + 4);
#pragma unroll
          for (int e = 0; e < 4; ++e) { cb[e] = b0[e]; cb[4 + e] = b1[e]; }
#pragma unroll
          for (int j = 0; j < 4; ++j) { const f32x4 w0 = *(const f32x4*)(conv_w + j * LW + 8 * c8), w1 = *(const f32x4*)(conv_w + j * LW + 8 * c8 + 4);
#pragma unroll
              for (int e = 0; e < 4; ++e) { cw[j][e] = w0[e]; cw[j][4 + e] = w1[e]; } } }
#pragma unroll
        for (int i = 0; i < 8; ++i)
#pragma unroll
            for (int e = 0; e < 8; ++e) o[i][e] = cb[e];
        u32x4 raw[11];
#pragma unroll
        for (int m = 0; m < 11; ++m) { const int p = p0 - 3 + m; raw[m] = (u32x4){0u, 0u, 0u, 0u};
            if (p >= 0) { const int row = p < NMETA ? MR + p : b * SEQ + p - NMETA; raw[m] = *(const u32x4*)(XR + (size_t)row * LW + 8 * c8); } }
#pragma unroll
        for (int m = 0; m < 11; ++m) {
            const u32x4 xv = raw[m];
            const float x[8] = {bflo(xv.x), bfhi(xv.x), bflo(xv.y), bfhi(xv.y), bflo(xv.z), bfhi(xv.z), bflo(xv.w), bfhi(xv.w)};
#pragma unroll
            for (int i = 0; i < 8; ++i) { const int j = i + 3 - m; if (j >= 0 && j < 4) {
#pragma unroll
                for (int e = 0; e < 8; ++e) o[i][e] += cw[j][e] * x[e]; } }
        }
#pragma unroll
        for (int i = 0; i < 8; ++i) { const int p = p0 + i, row = p < NMETA ? MR + p : b * SEQ + p - NMETA;
            u32x4 w; w.x = cvt_pk_bf16(o[i][0], o[i][1]); w.y = cvt_pk_bf16(o[i][2], o[i][3]); w.z = cvt_pk_bf16(o[i][4], o[i][5]); w.w = cvt_pk_bf16(o[i][6], o[i][7]);
            *(u32x4*)(XCg + (size_t)row * LW + 8 * c8) = w; }
    }
}
constexpr int LRU_TT = 128, LRU_XCS = 168;
constexpr int LRU_XC = 0, LRU_WS = LRU_XC + 128 * 336, LRU_GYS = LRU_WS + 80 * 336, LRU_SEG = LRU_GYS + 2 * 10240, LRU_HIN = LRU_SEG + 2 * 1280, LRU_HW = LRU_HIN + 2 * 160, LRU_END = LRU_HW + 8 * 160;
static_assert(LRU_END <= RING_BYTES, "LRU LDS map");
template <int SH> __device__ __forceinline__ float dpp_shr(float old, float v) {
    return __builtin_bit_cast(float, __builtin_amdgcn_update_dpp(__builtin_bit_cast(int, old), __builtin_bit_cast(int, v), 0x110 + SH, 0xf, 0xf, false));
}
#define LRU_SCAN_STEP(SH) asm volatile("s_nop 1\n\t" \
        "v_fmac_f32_dpp %0, %0, %10 row_shr:" #SH " row_mask:0xf bank_mask:0xf\n\t" \
        "v_fmac_f32_dpp %1, %1, %11 row_shr:" #SH " row_mask:0xf bank_mask:0xf\n\t" \
        "v_fmac_f32_dpp %2, %2, %12 row_shr:" #SH " row_mask:0xf bank_mask:0xf\n\t" \
        "v_fmac_f32_dpp %3, %3, %13 row_shr:" #SH " row_mask:0xf bank_mask:0xf\n\t" \
        "v_fmac_f32_dpp %4, %4, %14 row_shr:" #SH " row_mask:0xf bank_mask:0xf\n\t" \
        "v_fmac_f32_dpp %5, %5, %15 row_shr:" #SH " row_mask:0xf bank_mask:0xf\n\t" \
        "v_fmac_f32_dpp %6, %6, %16 row_shr:" #SH " row_mask:0xf bank_mask:0xf\n\t" \
        "v_fmac_f32_dpp %7, %7, %17 row_shr:" #SH " row_mask:0xf bank_mask:0xf\n\t" \
        "v_fmac_f32_dpp %8, %8, %18 row_shr:" #SH " row_mask:0xf bank_mask:0xf\n\t" \
        "v_fmac_f32_dpp %9, %9, %19 row_shr:" #SH " row_mask:0xf bank_mask:0xf\n\t" \
        "v_mul_f32_dpp %10, %10, %10 row_shr:" #SH " row_mask:0xf bank_mask:0xf\n\t" \
        "v_mul_f32_dpp %11, %11, %11 row_shr:" #SH " row_mask:0xf bank_mask:0xf\n\t" \
        "v_mul_f32_dpp %12, %12, %12 row_shr:" #SH " row_mask:0xf bank_mask:0xf\n\t" \
        "v_mul_f32_dpp %13, %13, %13 row_shr:" #SH " row_mask:0xf bank_mask:0xf\n\t" \
        "v_mul_f32_dpp %14, %14, %14 row_shr:" #SH " row_mask:0xf bank_mask:0xf\n\t" \
        "v_mul_f32_dpp %15, %15, %15 row_shr:" #SH " row_mask:0xf bank_mask:0xf\n\t" \
        "v_mul_f32_dpp %16, %16, %16 row_shr:" #SH " row_mask:0xf bank_mask:0xf\n\t" \
        "v_mul_f32_dpp %17, %17, %17 row_shr:" #SH " row_mask:0xf bank_mask:0xf\n\t" \
        "v_mul_f32_dpp %18, %18, %18 row_shr:" #SH " row_mask:0xf bank_mask:0xf\n\t" \
        "v_mul_f32_dpp %19, %19, %19 row_shr:" #SH " row_mask:0xf bank_mask:0xf\n\t" \
        : "+v"(Bv[0][0]), "+v"(Bv[0][1]), "+v"(Bv[1][0]), "+v"(Bv[1][1]), "+v"(Bv[2][0]), "+v"(Bv[2][1]), "+v"(Bv[3][0]), "+v"(Bv[3][1]), "+v"(Bv[4][0]), "+v"(Bv[4][1]), "+v"(Av[0][0]), "+v"(Av[0][1]), "+v"(Av[1][0]), "+v"(Av[1][1]), "+v"(Av[2][0]), "+v"(Av[2][1]), "+v"(Av[3][0]), "+v"(Av[3][1]), "+v"(Av[4][0]), "+v"(Av[4][1]))
__device__ __forceinline__ void lru_item(LAS unsigned char* lds, int it, const bf16_t* XCg, const bf16_t* GY, bf16_t* LO,
                                         const float* gx_w, const float* gx_b, const float* ga_w, const float* ga_b, const float* a_param) {
    const int tid = tid_fresh(), wid = __builtin_amdgcn_readfirstlane(tid >> 6), lane = tid & 63, fr = lane & 15, fq = lane >> 4;
    const int b = it >> 6, n = (it >> 2) & 15, s = it & 3, cl0 = 40 * s, cg0 = 160 * n + cl0;
    LAS bf16_t* XC = (LAS bf16_t*)(lds + LRU_XC); LAS bf16_t* WSM = (LAS bf16_t*)(lds + LRU_WS); LAS bf16_t* GYS = (LAS bf16_t*)(lds + LRU_GYS);
    LAS float* SEGA = (LAS float*)(lds + LRU_SEG); LAS float* SEGB = SEGA + 320; LAS float* HIN = (LAS float*)(lds + LRU_HIN); LAS float* HW = (LAS float*)(lds + LRU_HW);
    { float wv[25];
#pragma unroll
      for (int i = 0; i < 25; ++i) { const int e = tid + 512 * i, k = e / 80, j = e % 80, gate = j / 40, ch = j % 40; wv[i] = *((gate ? gx_w : ga_w) + ((size_t)n * 160 + k) * 160 + cl0 + ch); }
#pragma unroll
      for (int i = 0; i < 25; ++i) { const int e = tid + 512 * i, k = e / 80, j = e % 80, gate = j / 40, ch = j % 40, row = 16 * (ch >> 3) + 4 * ((ch >> 1) & 3) + 2 * gate + (ch & 1); WSM[row * LRU_XCS + k] = f2bf16(wv[i]); } }
    if (tid < 40) HIN[tid] = 0.f;
    float gab[5][2], gxb[5][2], lsa[5][2];
#pragma unroll
    for (int mt = 0; mt < 5; ++mt)
#pragma unroll
        for (int e = 0; e < 2; ++e) { const int c = cg0 + 8 * mt + 2 * fq + e; gab[mt][e] = -1.4426950408889634f * ga_b[c]; gxb[mt][e] = -1.4426950408889634f * gx_b[c];
            lsa[mt][e] = -8.0f * 1.4426950408889634f * log1pf(__expf(-a_param[c])); }
    u32x4 px[5], pg[2];
#define LRU_LOAD(kk) do { const int p0_ = (kk) == 0 ? 0 : NMETA + LRU_TT * ((kk) - 1);     \
        _Pragma("unroll") for (int i = 0; i < 5; ++i) { const int e = tid + 512 * i, t_ = e / 20, ch = e % 20, p = p0_ + t_; \
            const int row = p < NMETA ? MR + p : b * SEQ + p - NMETA; px[i] = *(const u32x4*)(XCg + (size_t)row * LW + 160 * n + 8 * ch); } \
        _Pragma("unroll") for (int i = 0; i < 2; ++i) { const int e = (tid + 512 * i) % 640, t_ = e / 5, ch = e % 5, p = p0_ + t_; \
            const int row = p < NMETA ? MR + p : b * SEQ + p - NMETA; pg[i] = *(const u32x4*)(GY + (size_t)row * LW + cg0 + 8 * ch); } } while (0)
#define LRU_STORE(kk) do { const int ps_ = (kk) == 0 ? 0 : NMETA + LRU_TT * ((kk) - 1), nvs_ = (kk) == 0 ? NMETA : LRU_TT; const LAS bf16_t* gs_ = GYS + ((kk) & 1) * 5120; \
        if ((kk) > 0 || b == 0) { _Pragma("unroll") for (int i = 0; i < 2; ++i) { const int e = tid + 512 * i, tt = e / 5, ch = e % 5, p = ps_ + tt, row = p < NMETA ? MR + p : b * SEQ + p - NMETA; \
            if (e < nvs_ * 5) *(u32x4*)(LO + (size_t)row * LW + cg0 + 8 * ch) = *(const LAS u32x4*)(gs_ + tt * 40 + 8 * ch); } } } while (0)
    LRU_LOAD(0);
    __syncthreads();
    for (int k = 0; k <= 32; ++k) {
        LAS bf16_t* GYc = GYS + (k & 1) * 5120;
#pragma unroll
        for (int i = 0; i < 5; ++i) { const int e = tid + 512 * i, t_ = e / 20, ch = e % 20; *(LAS u32x4*)(XC + t_ * LRU_XCS + 8 * ch) = px[i]; }
#pragma unroll
        for (int i = 0; i < 2; ++i) { const int e = tid + 512 * i, t_ = e / 5, ch = e % 5; if (e < 128 * 5) *(LAS u32x4*)(GYc + t_ * 40 + 8 * ch) = pg[i]; }
        asm volatile("s_waitcnt lgkmcnt(0)\n\ts_barrier" ::: "memory");
        if (k > 0) LRU_STORE(k - 1);
        if (k < 32) LRU_LOAD(k + 1);
        float Av[5][2], Bv[5][2];
        const int t = 16 * wid + fr;
        {
            bf16x8 xcf[5];
#pragma unroll
            for (int kk = 0; kk < 5; ++kk) xcf[kk] = *(const LAS bf16x8*)(XC + t * LRU_XCS + 32 * kk + 8 * fq);
#pragma unroll
            for (int mt = 0; mt < 5; ++mt) {
                f32x4 acc = (f32x4){0.f, 0.f, 0.f, 0.f};
#pragma unroll
                for (int kk = 0; kk < 5; ++kk) { const bf16x8 wf = *(const LAS bf16x8*)(WSM + (16 * mt + fr) * LRU_XCS + 32 * kk + 8 * fq); acc = __builtin_amdgcn_mfma_f32_16x16x32_bf16(wf, xcf[kk], acc, 0, 0, 0); }
                const unsigned xw = *(const LAS unsigned*)(XC + t * LRU_XCS + cl0 + 8 * mt + 2 * fq);
#pragma unroll
                for (int e = 0; e < 2; ++e) {
                    const float rr = __builtin_amdgcn_rcpf(1.0f + __builtin_amdgcn_exp2f(acc[e] * -1.4426950408889634f + gab[mt][e]));
                    const float ii = __builtin_amdgcn_rcpf(1.0f + __builtin_amdgcn_exp2f(acc[2 + e] * -1.4426950408889634f + gxb[mt][e]));
                    const float a = __builtin_amdgcn_exp2f(rr * lsa[mt][e]);
                    Av[mt][e] = a; Bv[mt][e] = __builtin_amdgcn_sqrtf(1.0f - a * a) * ii * (e ? bfhi(xw) : bflo(xw));
                }
            }
            if (k == 0 && wid > 0) {
#pragma unroll
                for (int mt = 0; mt < 5; ++mt) { Av[mt][0] = 1.f; Av[mt][1] = 1.f; Bv[mt][0] = 0.f; Bv[mt][1] = 0.f; }
            }
        }
        LRU_SCAN_STEP(1); LRU_SCAN_STEP(2); LRU_SCAN_STEP(4); LRU_SCAN_STEP(8);
        if (fr == 15) {
#pragma unroll
            for (int mt = 0; mt < 5; ++mt) { const int c = 8 * mt + 2 * fq; *(LAS f32x2*)(SEGA + wid * 40 + c) = (f32x2){Av[mt][0], Av[mt][1]}; *(LAS f32x2*)(SEGB + wid * 40 + c) = (f32x2){Bv[mt][0], Bv[mt][1]}; }
        }
        asm volatile("s_waitcnt lgkmcnt(0)\n\ts_barrier" ::: "memory");
        if (lane < 40) { float sa[8], sb[8];
#pragma unroll
            for (int v = 0; v < 8; ++v) { sa[v] = SEGA[v * 40 + lane]; sb[v] = SEGB[v * 40 + lane]; }
            float h = HIN[(k & 1) * 40 + lane];
#pragma unroll
            for (int v = 0; v < 7; ++v) if (v < wid) h = sa[v] * h + sb[v];
            HW[wid * 40 + lane] = h;
            if (wid == 7) HIN[((k + 1) & 1) * 40 + lane] = sa[7] * h + sb[7]; }
        asm volatile("s_waitcnt lgkmcnt(0)" ::: "memory");
#pragma unroll
        for (int mt = 0; mt < 5; ++mt) { const int c = 8 * mt + 2 * fq; const f32x2 hin = *(const LAS f32x2*)(HW + wid * 40 + c);
            LAS unsigned* gp = (LAS unsigned*)(GYc + t * 40 + c); const unsigned gw_ = *gp;
            const float h0 = Bv[mt][0] + Av[mt][0] * hin[0], h1 = Bv[mt][1] + Av[mt][1] * hin[1];
            *gp = cvt_pk_bf16(h0 * bflo(gw_), h1 * bfhi(gw_)); }
    }
    __syncthreads();
    LRU_STORE(32);
    __syncthreads();
#undef LRU_STORE
#undef LRU_LOAD
}
#undef LRU_SCAN_STEP

__device__ __forceinline__ att::BlockRef<bf16_t, bf16_t> attn_ref(const bf16_t* Qb, const bf16_t* Kb, const bf16_t* Vb, bf16_t* OP, int b, int h, int s, int idx) {
    const int cj = idx >> 1, c = cj >> 1, j = cj & 1, qb = (idx & 1) ? 15 - s : s;
    att::BlockRef<bf16_t, bf16_t> r;
    r.Q = Qb + ((size_t)(b * 16 + 2 * h + c) * SEQ + (size_t)qb * 256) * 128;
    r.K = Kb + (size_t)(b * 16 + 2 * h + c) * KVLEN * 128;
    r.V = Vb + (size_t)(b * 16 + 2 * h + j) * KVLEN * 128;
    r.O = OP + ((size_t)((b * 8 + h) * 4 + cj) * SEQ + (size_t)qb * 256) * 128;
    r.P0 = NMETA + qb * 256;
    return r;
}
__device__ __forceinline__ void attn_phase(char* lds, const bf16_t* Qb, const bf16_t* Kb, const bf16_t* Vb, bf16_t* OP, int vcu, int G) {
    constexpr int W = 1 << 20;
    for (int vw = vcu; vw < 256; vw += G) {
        const int bh = vw >> 3, s = vw & 7, b = bh >> 3, h = bh & 7;
        att::Seam<bf16_t> S;
        att::BlockRef<bf16_t, bf16_t> cur = attn_ref(Qb, Kb, Vb, OP, b, h, s, 0);
        att::causal_swa_prime<bf16_t, bf16_t>(cur, W, lds, S);
#pragma nounroll
        for (int idx = 0; idx < 8; ++idx) {
            const att::BlockRef<bf16_t, bf16_t> nxt = idx < 7 ? attn_ref(Qb, Kb, Vb, OP, b, h, s, idx + 1) : cur;
            att::causal_swa_block<bf16_t, bf16_t>(cur, nxt, KVLEN, W, lds, S);
            cur = nxt;
        }
    }
}

__device__ __forceinline__ void attn_phase256(char* lds, const bf16_t* Qb, const bf16_t* Kb, const bf16_t* Vb, bf16_t* OP, bf16_t* AO, float lam, const float* sl, int vcu, int G) {
    for (int vw = vcu; vw < 256; vw += G) {
        const int bh = vw >> 3, s = vw & 7, b = bh >> 3, h = bh & 7;
#pragma nounroll
        for (int pass = 0; pass < 2; ++pass) {
            const int qb = pass ? 15 - s : s;
            const bf16_t* v0 = Vb + (size_t)(b * 16 + 2 * h) * KVLEN * 128; const bf16_t* v1 = v0 + (size_t)KVLEN * 128;
            bf16_t* op = OP + ((size_t)(b * 8 + h) * SEQ + (size_t)qb * 256) * 256;
            bf16_t* ao = AO + (size_t)(b * SEQ + qb * 256) * DM + h * 256;
            att::diff_attn_block<false>(Qb + ((size_t)(b * 16 + 2 * h) * SEQ + (size_t)qb * 256) * 128, Kb + (size_t)(b * 16 + 2 * h) * KVLEN * 128, v0, v1, op, NMETA + qb * 256, KVLEN, lds, ao, DM, lam, sl, EPS);
            att::diff_attn_block<true>(Qb + ((size_t)(b * 16 + 2 * h + 1) * SEQ + (size_t)qb * 256) * 128, Kb + (size_t)(b * 16 + 2 * h + 1) * KVLEN * 128, v0, v1, op, NMETA + qb * 256, KVLEN, lds, ao, DM, lam, sl, EPS);
        }
    }
}
__device__ __forceinline__ float lam_of(const float* lq1, const float* lk1, const float* lq2, const float* lk2, float lam_init, int lane) {
    const float d1 = wave_sum(lq1[lane] * lk1[lane] + lq1[lane + 64] * lk1[lane + 64]), d2 = wave_sum(lq2[lane] * lk2[lane] + lq2[lane + 64] * lk2[lane + 64]);
    return __uint_as_float(__builtin_amdgcn_readfirstlane(__float_as_uint(expf(d1) - expf(d2) + lam_init)));
}
__device__ __forceinline__ void combine_phase(const bf16_t* OP, bf16_t* AO, const bf16_t* QM, const bf16_t* Kb, const bf16_t* Vb, const float* subln, float lam, float lam_init, int gw, int ngw, int lane) {
    const f32x4 sl = *(const f32x4*)(subln + 4 * lane) * (1.0f - lam_init);
    for (int it = gw; it < NHEAD * NMETA; it += ngw) {
        const int h = it >> 4, i = it & 15, kj = lane & 15, part = lane >> 4;
        float pc[2];
#pragma unroll
        for (int c = 0; c < 2; ++c) {
            const bf16_t* qp = QM + ((size_t)(2 * h + c) * NMETA + i) * 128 + 32 * part;
            const bf16_t* kp = Kb + ((size_t)(2 * h + c) * KVLEN + kj) * 128 + 32 * part;
            float d = 0.f;
#pragma unroll
            for (int e = 0; e < 4; ++e) { const u32x4 qv = *(const u32x4*)(qp + 8 * e), kv = *(const u32x4*)(kp + 8 * e);
                d += bflo(qv.x) * bflo(kv.x) + bfhi(qv.x) * bfhi(kv.x) + bflo(qv.y) * bflo(kv.y) + bfhi(qv.y) * bfhi(kv.y) + bflo(qv.z) * bflo(kv.z) + bfhi(qv.z) * bfhi(kv.z) + bflo(qv.w) * bflo(kv.w) + bfhi(qv.w) * bfhi(kv.w); }
            d += __shfl_xor(d, 16); d += __shfl_xor(d, 32);
            float sv = kj <= i ? d * 0.08838834764831845f : -INFINITY;
            float m = sv;
#pragma unroll
            for (int o = 1; o < 16; o <<= 1) m = fmaxf(m, __shfl_xor(m, o));
            float p = __expf(sv - m), l = p;
#pragma unroll
            for (int o = 1; o < 16; o <<= 1) l += __shfl_xor(l, o);
            pc[c] = p / l;
        }
        const int j = lane >> 5, dd = 4 * (lane & 31);
        f32x4 o0 = (f32x4){0.f, 0.f, 0.f, 0.f}, o1 = o0;
        for (int k2 = 0; k2 <= i; ++k2) {
            const unsigned long long w = *(const unsigned long long*)(Vb + ((size_t)(2 * h + j) * KVLEN + k2) * 128 + dd);
            const f32x4 v = (f32x4){bflo((unsigned)w), bfhi((unsigned)w), bflo((unsigned)(w >> 32)), bfhi((unsigned)(w >> 32))};
            o0 = o0 + __shfl(pc[0], k2) * v; o1 = o1 + __shfl(pc[1], k2) * v;
        }
        f32x4 x = o0 - lam * o1;
        const float ss = wave_sum(x[0] * x[0] + x[1] * x[1] + x[2] * x[2] + x[3] * x[3]);
        const float rs = rsqrtf(ss * (1.0f / 256.0f) + EPS);
        x = x * rs * sl;
        *(unsigned long long*)(AO + (size_t)(MR + i) * DM + h * 256 + 4 * lane) = (unsigned long long)cvt_pk_bf16(x[0], x[1]) | ((unsigned long long)cvt_pk_bf16(x[2], x[3]) << 32);
    }
}

__device__ __forceinline__ float sgpr_fresh_f(float v) { asm volatile("" : "+s"(v)); return v; }
__device__ __forceinline__ int sgpr_fresh(int v) { asm volatile("" : "+s"(v)); return v; }
typedef const __attribute__((address_space(4))) Args* ArgsP;
__device__ __forceinline__ ArgsP fresh_args() { ArgsP p = (ArgsP)__builtin_amdgcn_kernarg_segment_ptr(); asm volatile("" : "+s"(p)); return p; }
#define PH_ARGS ArgsP A = fresh_args(); unsigned char* const ws = A->ws; (void)ws; \
    const int G = sgpr_fresh(G0), bx = sgpr_fresh(bx0), vcu = sgpr_fresh(vcu0); (void)bx; \
    const int tid = tid_fresh(), lane = tid & 63, wave = __builtin_amdgcn_readfirstlane(tid >> 6), gw = vcu * NWAVES + wave, ngw = G * NWAVES; (void)lane; (void)gw; (void)ngw
#define ssq_base ((u64*)(ws + SSQ_OFF))
#define H ((float*)(ws + WS_H))
#define HB ((bf16_t*)(ws + WS_HB))
#define HID ((bf16_t*)(ws + WS_HID))
#define Qb ((bf16_t*)(ws + WS_Q))
#define Kb ((bf16_t*)(ws + WS_K))
#define Vb ((bf16_t*)(ws + WS_V))
#define QM ((bf16_t*)(ws + WS_QM))
#define XR ((bf16_t*)(ws + WS_XR))
#define GY ((bf16_t*)(ws + WS_GY))
#define GG ((bf16_t*)(ws + WS_G))
#define OP ((bf16_t*)(ws + WS_OP))
#define AO ((bf16_t*)(ws + WS_AO))
#define LO ((bf16_t*)(ws + WS_LO))
#define TMP ((bf16_t*)(ws + WS_TMP))
#define XCG ((bf16_t*)(ws + WS_TMP))
#define MIX ((bf16_t*)(ws + WS_MIX))
#define LAM_INIT(ll) ((ll) == 0 ? 0.2f : (ll) == 1 ? 0.35550906759096926f : (ll) == 2 ? 0.47071301834358416f : 0.5560582041556405f)
#define SLV ((float*)(ws + WS_QM + 131072))
#define ropec ((float*)(ws + WS_ROPE))
#define ropes ((float*)(ws + WS_ROPE + 512 * 1024))
#define SSQ(i) (ssq_base + (size_t)(i) * MPAD)
constexpr int CV_G = (DM / 64) * (DFF / 32), CV_D = (DFF / 64) * (DM / 32), CV_IN = (DM / 64) * (NIN / 32), CV_S = (DM / 64) * (DM / 32), CV_L = (LW / 64) * (DM / 32);
constexpr int CV_NIT = 2 * (2 * CV_G + CV_D) + CV_IN + 2 * CV_S + CV_L;
__device__ __forceinline__ void convert_item(ArgsP A, unsigned char* ws, int l, int it, LAS float* scr, int lane) {
    unsigned char* wb = ws + (size_t)(l & 1) * WBUF_STRIDE;
    int r = it;
    if (r < CV_G) { transpose_item<1>(A->in[3] + (size_t)l * DM * DFF, DM, DFF, (bf16_t*)(wb + W_GU1), scr, r, lane, A->in[2] + (size_t)l * DM); return; } r -= CV_G;
    if (r < CV_G) { transpose_item<2>(A->in[4] + (size_t)l * DM * DFF, DM, DFF, (bf16_t*)(wb + W_GU1), scr, r, lane, A->in[2] + (size_t)l * DM); return; } r -= CV_G;
    if (r < CV_D) { transpose_item<0>(A->in[5] + (size_t)l * DFF * DM, DFF, DM, (bf16_t*)(wb + W_DN1), scr, r, lane); return; } r -= CV_D;
    if (r < CV_IN) { transpose_item<3>(A->in[7] + (size_t)l * DM * NIN, DM, NIN, (bf16_t*)(wb + W_IN), scr, r, lane, A->in[6] + (size_t)l * DM); return; } r -= CV_IN;
    if (r < CV_S) { transpose_item<0>(A->in[21] + (size_t)l * DM * DM, DM, DM, (bf16_t*)(wb + W_BA), scr, r, lane); return; } r -= CV_S;
    if (r < CV_L) { transpose_item<0>(A->in[22] + (size_t)l * LW * DM, LW, DM, (bf16_t*)(wb + W_BL), scr, r, lane); return; } r -= CV_L;
    if (r < CV_S) { transpose_item<0>(A->in[23] + (size_t)l * DM * DM, DM, DM, (bf16_t*)(wb + W_O), scr, r, lane); return; } r -= CV_S;
    if (r < CV_G) { transpose_item<1>(A->in[25] + (size_t)l * DM * DFF, DM, DFF, (bf16_t*)(wb + W_GU2), scr, r, lane, A->in[24] + (size_t)l * DM); return; } r -= CV_G;
    if (r < CV_G) { transpose_item<2>(A->in[26] + (size_t)l * DM * DFF, DM, DFF, (bf16_t*)(wb + W_GU2), scr, r, lane, A->in[24] + (size_t)l * DM); return; } r -= CV_G;
    transpose_item<0>(A->in[27] + (size_t)l * DFF * DM, DFF, DM, (bf16_t*)(wb + W_DN2), scr, r, lane);
}
__device__ __forceinline__ void fill_seam(ArgsP A, gu32* ctl, LAS unsigned char* L, volatile LAS unsigned* MISC, int seam, int G, bool drain, int lnext) {
    unsigned char* const ws = A->ws;
    const int tid = tid_fresh(), lane = tid & 63, wave = __builtin_amdgcn_readfirstlane(tid >> 6);
    LAS float* scr = (LAS float*)(L + wave * 16384);
    if (tid == 0) __hip_atomic_fetch_add(ctl + CW_REACH + 64 * seam, 1u, RLX_AGENT);
    for (;;) {
        if (tid == 0) {
            unsigned base = (unsigned)CV_NIT;
            const bool stop = !drain && __hip_atomic_load(ctl + CW_REACH + 64 * seam, RLX_AGENT) >= (unsigned)(G - 16);
            if (!stop) base = __hip_atomic_fetch_add(ctl + CW_ITEM + 64 * lnext, 8u, RLX_AGENT);
            MISC[12] = base;
        }
        __syncthreads();
        const unsigned base = MISC[12];
        __syncthreads();
        if (base >= (unsigned)CV_NIT) break;
        const int it = (int)base + wave;
        if (it < CV_NIT) convert_item(A, ws, lnext, it, scr, lane);
    }
}
constexpr int CVR_GU1 = 0, CVR_DN1 = 2 * CV_G, CVR_IN = CVR_DN1 + CV_D, CVR_BA = CVR_IN + CV_IN, CVR_O = CVR_BA + CV_S + CV_L, CVR_GU2 = CVR_O + CV_S, CVR_DN2 = CVR_GU2 + 2 * CV_G;
static_assert(CVR_DN2 + CV_D == CV_NIT, "conversion ranges");
#define CONVERT(ll, first, count) do { if (EN(0)) { ArgsP A_ = fresh_args(); const int tid_ = tid_fresh(), lane_ = tid_ & 63, wave_ = __builtin_amdgcn_readfirstlane(tid_ >> 6), gw_ = vcu * NWAVES + wave_; \
        LAS float* scr_ = (LAS float*)(L + wave_ * 16384); REP(0) for (int it_ = (first) + gw_; it_ < (first) + (count); it_ += G * NWAVES) convert_item(A_, A_->ws, (ll), it_, scr_, lane_); } } while (0)
__global__ void __launch_bounds__(NWAVES * 64, 2) mk_fwd(Args args) {
    extern __shared__ __attribute__((aligned(16))) unsigned char lds[];
    LAS unsigned char* L = (LAS unsigned char*)lds;
    volatile LAS unsigned* MISC = (volatile LAS unsigned*)(L + MISC_OFF);
    const int G0 = gridDim.x, bx0 = blockIdx.x, vcu0 = (G0 % 8 == 0) ? (bx0 % 8) * (G0 / 8) + bx0 / 8 : bx0;
    gu32* ctl = (gu32*)(args.ws + WS_CTL);
    for (int u = threadIdx.x; u < (LDS_BYTES - LDSCTL_OFF) / 4; u += NWAVES * 64) ((LAS unsigned*)(L + LDSCTL_OFF))[u] = 0u;
    __syncthreads();
    XcdBarrier bar; bar.bar = (unsigned*)(ctl + CW_BAR); bar.x = 0; bar.st = nullptr;
    if (!MK_MULTI) bar = xcd_barrier_post((unsigned*)(ctl + CW_BAR), MISC + 8);
    const int lo = args.ph_lo, hi = args.ph_hi;
    unsigned long long twait = 0; const unsigned long long tstart = (DUP_PHASE == 40) ? __builtin_amdgcn_s_memrealtime() : 0ull;
#define IN(k) (lo <= (k) && (k) < hi)
#define SEAM(k) do { if (IN((k) + 1)) { unsigned long long tb0_ = 0; if (DUP_PHASE == 40) tb0_ = __builtin_amdgcn_s_memrealtime(); xcd_barrier(bar); if (DUP_PHASE == 40 && (PROBE_SEAM < 0 || ((k) - 1) % PH_PER_LAYER == PROBE_SEAM)) { twait += __builtin_amdgcn_s_memrealtime() - tb0_; } if (DUP_PHASE == 30) { xcd_barrier(bar); xcd_barrier(bar); xcd_barrier(bar); xcd_barrier(bar); } } } while (0)

    if (EN(10) && IN(0)) {
        PH_ARGS; const float* x = A->in[0]; const float* meta = A->in[1];
        for (int m = gw; m < MROWS; m += ngw) {
            const float* src = m < MR ? x + (size_t)m * DM : meta + (size_t)(m - MR) * DM; float ss = 0.f;
#pragma unroll
            for (int j = 0; j < 8; ++j) { const int c = 4 * (64 * j + lane); const f32x4 v = *(const f32x4*)(src + c);
                ss += v[0] * v[0] + v[1] * v[1] + v[2] * v[2] + v[3] * v[3];
                *(unsigned long long*)(HB + (size_t)m * DM + c) = (unsigned long long)cvt_pk_bf16(v[0], v[1]) | ((unsigned long long)cvt_pk_bf16(v[2], v[3]) << 32); }
            ss = wave_sum(ss); if (lane == 0) ssq_base[m] = ssq_fx(ss);
        }
        for (int e = gw * 64 + lane; e < DEPTH * 256; e += ngw * 64) SLV[e] = A->in[13][e] * (1.0f - LAM_INIT(e >> 8));
        for (int e = gw * 64 + lane; e < (SEQ + NMETA) * 16; e += ngw * 64) { const int pos = e >> 4, i = e & 15; const float ang = (float)pos * A->invf[i]; ropec[e] = cosf(ang); ropes[e] = sinf(ang); }
        for (int e = gw * 64 + lane; e < 2 * 64 * 48 * 16; e += ngw * 64) { const int kv = e / (64 * 48 * 16), r = e % (64 * 48 * 16), bh = r / (48 * 16), rr = (r / 16) % 48, ch = r % 16;
            *(u32x4*)((kv ? Vb : Kb) + ((size_t)bh * KVLEN + (SEQ + NMETA) + rr) * 128 + 8 * ch) = (u32x4){0u, 0u, 0u, 0u}; }
    }
#pragma nounroll
    for (int l = 0; l < DEPTH; ++l) {
        const int pb = 1 + l * PH_PER_LAYER;
        if (EN(0) && IN(pb + 0)) {
            PH_ARGS;
            LAS float* scr = (LAS float*)(L + wave * 16384);
            REP(0) for (int it = gw; it < CV_NIT; it += ngw) convert_item(A, ws, l, it, scr, lane);
            SEAM(pb + 0);
        }
        if (EN(1) && IN(pb + 1)) {
            PH_ARGS;
            pg8::Gemm g{HB, (const bf16_t*)(ws + W_GU1 + (size_t)(l & 1) * WBUF_STRIDE), MR, NGU, DM}; pg8::StaticOrder S; S.init(MR, NGU, G, bx);
            EpiSwiGLU E{HID, SSQ(3 * l)};
            REP(1) pg8::gemm_phase<EpiSwiGLU, pg8::StaticOrder, true, true>(L, g, S, E);
            if (DUP_PHASE == 21) { EpiNull EN_; pg8::gemm_phase<EpiNull, pg8::StaticOrder, true, true>(L, g, S, EN_); }
            REPM(1) meta_gemm(L, HB + (size_t)MR * DM, g.Bt, NGU, DM, E);
            SEAM(pb + 1);
        }
        if (EN(2) && IN(pb + 2)) {
            PH_ARGS;
            pg8::Gemm g{HID, (const bf16_t*)(ws + W_DN1 + (size_t)(l & 1) * WBUF_STRIDE), MR, DM, DFF}; pg8::StaticOrder S; S.init(MR, DM, G, bx);
            REP(2) { EpiResid E{nullptr, HB, SSQ(3 * l + 1), DRY(2) ? 0.f : 0.5f, DRY(2) ? 0.f : 1.f};
            pg8::gemm_phase<EpiResid, pg8::StaticOrder, true, true>(L, g, S, E); }
            meta_resid<DFF>(L, HID + (size_t)MR * DFF, g.Bt, HB, SSQ(3 * l + 1), 0.5f);
            SEAM(pb + 2);
        }
        if (EN(3) && IN(pb + 3)) {
            PH_ARGS;
            pg8::Gemm g{HB, (const bf16_t*)(ws + W_IN + (size_t)(l & 1) * WBUF_STRIDE), MR, NIN, DM}; pg8::StaticOrder S; S.init(MR, NIN, G, bx);
            EpiWin E{Qb, Kb, Vb, XR, GY, GG, QM, A->in[8] + (size_t)l * 2 * DM, SSQ(3 * l + 1), ropec, ropes};
            REP(3) pg8::gemm_phase<EpiWin, pg8::StaticOrder, true, true>(L, g, S, E);
            REPM(3) meta_gemm(L, HB + (size_t)MR * DM, g.Bt, NIN, DM, E);
            SEAM(pb + 3);
        }
        if (EN(4) && IN(pb + 4)) {
            PH_ARGS;
            if (EN(12)) REP(14) conv_pass(XR, XCG, A->in[14] + (size_t)l * 4 * LW, A->in[15] + (size_t)l * LW, gw * 64 + lane, ngw * 64);
            if (EN(13)) { const float lam_init = LAM_INIT(sgpr_fresh(l)); const float lam = lam_of(A->in[9] + l * 128, A->in[10] + l * 128, A->in[11] + l * 128, A->in[12] + l * 128, lam_init, lane);
                REP(13) attn_phase256((char*)lds, Qb, Kb, Vb, OP, AO, lam, SLV + l * 256, vcu, G); }
            SEAM(pb + 4);
        }
        if (EN(5) && IN(pb + 5)) {
            PH_ARGS;
            const float lam_init = LAM_INIT(sgpr_fresh(l)); const float lam = lam_of(A->in[9] + l * 128, A->in[10] + l * 128, A->in[11] + l * 128, A->in[12] + l * 128, lam_init, lane);
            if (EN(12)) REP(12) for (int it = vcu; it < 256; it += G)
                lru_item(L, it, XCG, GY, LO, A->in[16] + (size_t)l * 16 * 160 * 160, A->in[17] + (size_t)l * LW, A->in[18] + (size_t)l * 16 * 160 * 160, A->in[19] + (size_t)l * LW, A->in[20] + (size_t)l * LW);
            REP(5) combine_phase(OP, AO, QM, Kb, Vb, A->in[13] + l * 256, lam, lam_init, gw, ngw, lane);
            SEAM(pb + 5);
        }
        if (EN(6) && IN(pb + 6)) {
            PH_ARGS;
            pg8::StaticOrder S; S.init(MR, DM, G, bx);
            REP(6) {
#if DUAL_BR
            { EpiDual E{GG, MIX};
              pg8::gemm_dual_phase<EpiDual, pg8::StaticOrder>(L, AO, (const bf16_t*)(ws + W_BA), DM, LO, (const bf16_t*)(ws + W_BL), LW, S, E); }
            if (l + 1 < DEPTH) {
                REPM(6) meta_dual(L, AO + (size_t)MR * DM, (const bf16_t*)(ws + W_BA), DM, LO + (size_t)MR * LW, (const bf16_t*)(ws + W_BL), LW, GG, MIX);
            }
#else
            { pg8::Gemm g{AO, (const bf16_t*)(ws + W_BA + (size_t)(l & 1) * WBUF_STRIDE), MR, DM, DM}; EpiBa E{TMP, GG};
              pg8::gemm_phase<EpiBa, pg8::StaticOrder, true, true>(L, g, S, E); if (l + 1 < DEPTH) REPM(6) meta_gemm(L, AO + (size_t)MR * DM, g.Bt, DM, DM, E); }
            { pg8::Gemm g{LO, (const bf16_t*)(ws + W_BL + (size_t)(l & 1) * WBUF_STRIDE), MR, DM, LW}; EpiBl E{TMP, GG, MIX};
              pg8::gemm_phase<EpiBl, pg8::StaticOrder, true, true>(L, g, S, E); if (l + 1 < DEPTH) REPM(6) meta_gemm(L, LO + (size_t)MR * LW, g.Bt, DM, LW, E); }
#endif
            }
            SEAM(pb + 6);
        }
        if (EN(7) && IN(pb + 7)) {
            PH_ARGS;
            pg8::Gemm g{MIX, (const bf16_t*)(ws + W_O + (size_t)(l & 1) * WBUF_STRIDE), MR, DM, DM}; pg8::StaticOrder S; S.init(MR, DM, G, bx);
            REP(7) { EpiResid E{nullptr, HB, SSQ(3 * l + 2), DRY(7) ? 0.f : 1.0f, DRY(7) ? 0.f : 1.f};
            pg8::gemm_phase<EpiResid, pg8::StaticOrder, true, true>(L, g, S, E); }
            if (l + 1 < DEPTH) meta_resid<DM>(L, MIX + (size_t)MR * DM, g.Bt, HB, SSQ(3 * l + 2), 1.0f);
            SEAM(pb + 7);
        }
        if (EN(8) && IN(pb + 8)) {
            PH_ARGS;
            pg8::Gemm g{HB, (const bf16_t*)(ws + W_GU2 + (size_t)(l & 1) * WBUF_STRIDE), MR, NGU, DM}; pg8::StaticOrder S; S.init(MR, NGU, G, bx);
            EpiSwiGLU E{HID, SSQ(3 * l + 2)};
            pg8::gemm_phase<EpiSwiGLU, pg8::StaticOrder, true, true>(L, g, S, E);
            if (l + 1 < DEPTH) REPM(1) meta_gemm(L, HB + (size_t)MR * DM, g.Bt, NGU, DM, E);
            SEAM(pb + 8);
        }
        if (EN(9) && IN(pb + 9)) {
            PH_ARGS;
            pg8::Gemm g{HID, (const bf16_t*)(ws + W_DN2 + (size_t)(l & 1) * WBUF_STRIDE), MR, DM, DFF}; pg8::StaticOrder S; S.init(MR, DM, G, bx);
            { EpiResid E{(FINAL_BF16 || l + 1 < DEPTH) ? nullptr : H, HB, SSQ(3 * l + 3), 0.5f, 1.f};
            pg8::gemm_phase<EpiResid, pg8::StaticOrder, true, true>(L, g, S, E); }
            if (l + 1 < DEPTH) meta_resid<DFF>(L, HID + (size_t)MR * DFF, g.Bt, HB, SSQ(3 * l + 3), 0.5f);
            SEAM(pb + 9);
        }
    }
    if (EN(11) && IN(N_PHASES - 1)) {
        PH_ARGS;
        float probe_scale = 1.0f;
        if (DUP_PHASE == 40) {
            u64* acc_ = (u64*)(ws + 2000000);
            if (threadIdx.x == 0) __hip_atomic_fetch_add(acc_, twait, __ATOMIC_RELAXED, __HIP_MEMORY_SCOPE_AGENT);
            xcd_barrier(bar);
            const u64 tot_ = __hip_atomic_load(acc_, __ATOMIC_RELAXED, __HIP_MEMORY_SCOPE_AGENT);
            const float frac_ = (float)tot_ / ((float)G * (float)(__builtin_amdgcn_s_memrealtime() - tstart));
            probe_scale = 1.0f + 0.02f * rintf(frac_ * 50.0f * PROBE_GAIN);
        }
        const float* gf = A->in[28];
#if FINAL_BF16
        const u64* ssqf = SSQ(3 * DEPTH);
        f32x4 gv[8];
#pragma unroll
        for (int j = 0; j < 4; ++j) { gv[2 * j] = *(const f32x4*)(gf + 8 * (64 * j + lane)); gv[2 * j + 1] = *(const f32x4*)(gf + 8 * (64 * j + lane) + 4); }
        static_assert(MR % 2 == 0, "row pairs");
        for (int m = 2 * gw; m < MR; m += 2 * ngw) {
            u32x4 w[8];
#pragma unroll
            for (int j = 0; j < 8; ++j) w[j] = *(const u32x4*)(HB + (size_t)(m + (j >> 2)) * DM + 8 * (64 * (j & 3) + lane));
            const float rs0 = rstd_fx(ssqf[m]) * probe_scale, rs1 = rstd_fx(ssqf[m + 1]) * probe_scale;
#pragma unroll
            for (int j = 0; j < 8; ++j) { const int c = 8 * (64 * (j & 3) + lane); const float rs = (j >> 2) ? rs1 : rs0; f32x4 lo, hi; unpack8(w[j], lo, hi);
                float* op = A->out + (size_t)(m + (j >> 2)) * DM + c;
                *(f32x4*)op = lo * rs * gv[2 * (j & 3)]; *(f32x4*)(op + 4) = hi * rs * gv[2 * (j & 3) + 1]; }
        }
#else
        for (int m = gw; m < MR; m += ngw) {
            f32x4 v[8]; float ss = 0.f;
#pragma unroll
            for (int j = 0; j < 8; ++j) { v[j] = *(const f32x4*)(H + (size_t)m * DM + 4 * (64 * j + lane)); ss += v[j][0] * v[j][0] + v[j][1] * v[j][1] + v[j][2] * v[j][2] + v[j][3] * v[j][3]; }
            const float rs = rstd_from(wave_sum(ss));
#pragma unroll
            for (int j = 0; j < 8; ++j) { const int c = 4 * (64 * j + lane); *(f32x4*)(A->out + (size_t)m * DM + c) = v[j] * (rs * probe_scale) * *(const f32x4*)(gf + c); }
        }
#endif
    }
#undef IN
#undef SEAM
}

extern "C" void kernel_launch(void* const* d_in, const int* in_sizes, int n_in, void* d_out, int out_size, void* d_ws, size_t ws_size, hipStream_t stream) {
    static int grid = 0;
    if (grid == 0) {
        if (n_in != 29 || in_sizes[0] != MR * DM || out_size != MR * DM || ws_size < WS_END) { fprintf(stderr, "kernel_launch: unexpected shapes (n_in %d, ws %zu < %zu?); nothing launched\n", n_in, ws_size, (size_t)WS_END); grid = -1; return; }
        int dev = 0, cus = 0, per_cu = 0;
        if (hipGetDevice(&dev) != hipSuccess || hipDeviceGetAttribute(&cus, hipDeviceAttributeMultiprocessorCount, dev) != hipSuccess) { grid = -1; return; }
        if (hipFuncSetAttribute((const void*)mk_fwd, hipFuncAttributeMaxDynamicSharedMemorySize, LDS_BYTES) != hipSuccess) { fprintf(stderr, "kernel_launch: hipFuncSetAttribute failed\n"); grid = -1; return; }
        if (hipOccupancyMaxActiveBlocksPerMultiprocessor(&per_cu, (const void*)mk_fwd, NWAVES * 64, LDS_BYTES) != hipSuccess || per_cu < 1) { fprintf(stderr, "kernel_launch: occupancy query says %d\n", per_cu); }
        (void)hipGetLastError();
        grid = cus;
    }
    if (grid < 0) return;
    if (hipMemsetAsync((char*)d_ws + WS_CTL, 0, CTL_ZERO_BYTES, stream) != hipSuccess) return;
    Args a{};
    for (int i = 0; i < 29; ++i) a.in[i] = (const float*)d_in[i];
    a.out = (float*)d_out; a.ws = (unsigned char*)d_ws;
    for (int i = 0; i < 16; ++i) a.invf[i] = (float)pow(500000.0, -(double)i / 16.0);
#if MK_MULTI
    for (int p = 0; p < N_PHASES; ++p) { a.ph_lo = p; a.ph_hi = p + 1; hipLaunchKernelGGL(mk_fwd, dim3(grid), dim3(NWAVES * 64), LDS_BYTES, stream, a); }
#else
    a.ph_lo = 0; a.ph_hi = N_PHASES;
    hipLaunchKernelGGL(mk_fwd, dim3(grid), dim3(NWAVES * 64), LDS_BYTES, stream, a);
#endif
    const hipError_t le = hipPeekAtLastError();
    if (le != hipSuccess) fprintf(stderr, "kernel_launch: launch failed: %s\n", hipGetErrorName(le));
}
```

```cpp
#include <hip/hip_runtime.h>
#include <cstdio>
#include <cstdint>
#include <cmath>
__device__ __forceinline__ int tid_fresh() { int t = threadIdx.x; asm volatile("" : "+v"(t)); return t; }
namespace pg8 {
#define PG8_LAS __attribute__((address_space(3)))
typedef unsigned short bf16_t;
typedef short bf16x8 __attribute__((ext_vector_type(8)));
typedef float f32x4 __attribute__((ext_vector_type(4)));
typedef unsigned u32x4 __attribute__((ext_vector_type(4)));
constexpr int BM = 256, BK = 64, HALF = 128, HTB = HALF * BK * 2  , STAGE_BYTES = 8 * HTB, NXCD = 8, WGM = 8;

__host__ __device__ __forceinline__ int lds_byte(int r, int c) { const int st = (r >> 4) * 2 + (c >> 5), rr = r & 15, cc = c & 31, ob = rr * 64 + cc * 2; return st * 1024 + (ob ^ (((ob >> 9) & 1) << 5)); }
__host__ __device__ __forceinline__ void stage_rc(int b, int& R, int& C) { const int st = b / 1024, sb = b % 1024, swz = sb ^ (((sb >> 9) & 1) << 5); R = (st >> 1) * 16 + swz / 64; C = (st & 1) * 32 + (swz % 64) / 2; }
__host__ __device__ __forceinline__ int perm32(int rho) { const int n = rho >> 4, i = rho & 15; return 8 * (i >> 2) + 4 * n + (i & 3); }

struct Unit { int pm, pn; };
struct Gemm { const bf16_t* A; const bf16_t* Bt; int M, N, K; };

struct StaticOrder {
    int nM, nN, nwg, G, c;
    __host__ __device__ void init(int M, int N, int G_, int c_) { nM = M / BM; nN = N / BM; nwg = nM * nN; G = G_; c = c_; }
    __host__ __device__ bool next(int i, Unit& u) const {
        const long L = (long)i * G + c; if (L >= nwg) return false;
        int wgid = (int)L; { const int q = nwg / NXCD, r = nwg % NXCD, xcd = wgid % NXCD, off = wgid / NXCD; wgid = (xcd < r ? xcd * (q + 1) : r * (q + 1) + (xcd - r) * q) + off; }
        const int nig = WGM * nN, gid = wgid / nig, fm = gid * WGM, gsz = (nM - fm) < WGM ? (nM - fm) : WGM;
        u.pm = fm + ((wgid % nig) % gsz); u.pn = (wgid % nig) / gsz; return true;
    }
    __device__ __forceinline__ void a_ready(const Unit&) const {}
    __device__ __forceinline__ void done(const Unit&) const {}
};

__device__ __forceinline__ unsigned cvt_pk_bf16(float lo, float hi) { unsigned r; asm volatile("v_cvt_pk_bf16_f32 %0, %1, %2" : "=v"(r) : "v"(lo), "v"(hi)); return r; }
typedef float f32x2 __attribute__((ext_vector_type(2)));
template <class Epi, class Sched, bool ALIGN_EPI = false, bool SP2 = false>
__device__ __forceinline__ void gemm_phase(PG8_LAS unsigned char* lds, const Gemm g, const Sched& S, const Epi& E) {
    const int tid = tid_fresh(), wid = __builtin_amdgcn_readfirstlane(tid >> 6), lane = tid & 63, wr = wid >> 2, wc = wid & 3, fr = lane & 15, fq = lane >> 4;
    const int K = g.K, nt = K / BK;
    unsigned voffA[2], voffB[2];
#pragma unroll
    for (int i = 0; i < 2; ++i) { int R, C; stage_rc(tid * 16 + i * 8192, R, C); const int Rb = Epi::PERM ? ((R & ~31) + perm32(R & 31)) : R;
        voffA[i] = (unsigned)(R * K + C) * 2u; voffB[i] = (unsigned)(Rb * K + C) * 2u; }
    const size_t kstep = (size_t)(BK * 2);
    const size_t hstep = (size_t)HALF * K * 2;
    const size_t tstep = 2 * hstep;
    const unsigned ldsw = (unsigned)wid * 1024u;
    const int aoff = lds_byte(wr * 64 + fr, fq * 8), boff = lds_byte(wc * 32 + fr, fq * 8);
#define PG8_SA(b, h) (((b) * 2 + (h)) * HTB)
#define PG8_SB(b, h) ((4 + (b) * 2 + (h)) * HTB)
#define PG8_STAGE(bufoff, gbase, voff) do { _Pragma("unroll") for (int _i = 0; _i < 2; ++_i) \
        __builtin_amdgcn_global_load_lds((const unsigned*)((const char*)(gbase) + (voff)[_i]), (PG8_LAS unsigned*)(lds + (bufoff) + ldsw + _i * 8192), 16, 0, 0); } while (0)
#define PG8_LDA(dst, b, h) do { _Pragma("unroll") for (int m = 0; m < 4; ++m) _Pragma("unroll") for (int k = 0; k < 2; ++k) dst[m][k] = *(const PG8_LAS bf16x8*)(lds + PG8_SA(b, h) + aoff + m * 2048 + k * 1024); } while (0)
#define PG8_LDB(dst, b, h) do { _Pragma("unroll") for (int n = 0; n < 2; ++n) _Pragma("unroll") for (int k = 0; k < 2; ++k) dst[n][k] = *(const PG8_LAS bf16x8*)(lds + PG8_SB(b, h) + boff + n * 2048 + k * 1024); } while (0)
#define PG8_MMA(ai, bj, At, Bt) do { __builtin_amdgcn_s_setprio(1); _Pragma("unroll") for (int m = 0; m < 4; ++m) _Pragma("unroll") for (int n = 0; n < 2; ++n) _Pragma("unroll") for (int k = 0; k < 2; ++k) \
        acc[ai][bj][m][n] = __builtin_amdgcn_mfma_f32_16x16x32_bf16(Bt[n][k], At[m][k], acc[ai][bj][m][n], 0, 0, 0); __builtin_amdgcn_s_setprio(0); } while (0)
#define PG8_WAIT_V(n) asm volatile("s_waitcnt vmcnt(" #n ")" ::: "memory")
#define PG8_WAIT_L(n) asm volatile("s_waitcnt lgkmcnt(" #n ")" ::: "memory")
#define PG8_BAR __builtin_amdgcn_s_barrier()
#define PG8_SCHED __builtin_amdgcn_sched_barrier(0)
    Unit cur, nxt; int ui = 0;
    if (!S.next(0, cur)) return;
    f32x4 acc[2][2][4][2];
#pragma unroll
    for (int a = 0; a < 2; ++a)
#pragma unroll
        for (int b = 0; b < 2; ++b)
#pragma unroll
            for (int m = 0; m < 4; ++m)
#pragma unroll
                for (int n = 0; n < 2; ++n) acc[a][b][m][n] = (f32x4){0.f, 0.f, 0.f, 0.f};
    bf16x8 At[4][2], B0[2][2], B1[2][2];
    const char* cA = (const char*)g.A + (size_t)cur.pm * tstep; const char* cB = (const char*)g.Bt + (size_t)cur.pn * tstep;
    S.a_ready(cur);
    if constexpr (SP2) {
        PG8_STAGE(PG8_SB(0, 0), cB, voffB); PG8_STAGE(PG8_SB(0, 1), cB + hstep, voffB); PG8_STAGE(PG8_SA(0, 0), cA, voffA); PG8_STAGE(PG8_SA(0, 1), cA + hstep, voffA);
        if (wr == 1) PG8_BAR;
        PG8_WAIT_V(2); PG8_BAR;
        PG8_STAGE(PG8_SB(1, 0), cB + kstep, voffB); PG8_STAGE(PG8_SA(1, 0), cA + kstep, voffA); PG8_STAGE(PG8_SB(1, 1), cB + hstep + kstep, voffB);
        PG8_WAIT_V(6); PG8_BAR;
    } else {
        PG8_STAGE(PG8_SB(0, 0), cB, voffB); PG8_STAGE(PG8_SA(0, 0), cA, voffA); PG8_STAGE(PG8_SB(0, 1), cB + hstep, voffB); PG8_STAGE(PG8_SA(0, 1), cA + hstep, voffA);
        if (wr == 1) PG8_BAR;
        PG8_WAIT_V(4); PG8_BAR;
        PG8_STAGE(PG8_SB(1, 0), cB + kstep, voffB); PG8_STAGE(PG8_SA(1, 0), cA + kstep, voffA); PG8_STAGE(PG8_SB(1, 1), cB + hstep + kstep, voffB);
        PG8_WAIT_V(6); PG8_BAR;
    }
    for (;;) {
        const bool has_next = S.next(ui + 1, nxt);
        const char* nA = has_next ? (const char*)g.A + (size_t)nxt.pm * tstep : cA; const char* nB = has_next ? (const char*)g.Bt + (size_t)nxt.pn * tstep : cB;
        for (int t = 0; t < nt; t += 2) {
            const bool last = (t == nt - 2);
            const char* a1 = cA + (size_t)(t + 1) * kstep;
            const char* a2 = last ? nA : cA + (size_t)(t + 2) * kstep; const char* b2 = last ? nB : cB + (size_t)(t + 2) * kstep;
            const char* a3 = a2 + kstep; const char* b3 = b2 + kstep;
            if (last && has_next) S.a_ready(nxt);
            if constexpr (SP2) {
            PG8_LDB(B0, 0, 0); PG8_LDB(B1, 0, 1); PG8_SCHED; PG8_LDA(At, 0, 0); PG8_STAGE(PG8_SA(1, 1), a1 + hstep, voffA);
            PG8_WAIT_V(8); PG8_WAIT_L(0); PG8_BAR; PG8_MMA(0, 0, At, B0); PG8_MMA(0, 1, At, B1); PG8_BAR; PG8_SCHED;
            PG8_LDA(At, 0, 1); PG8_STAGE(PG8_SB(0, 0), b2, voffB); PG8_STAGE(PG8_SB(0, 1), b2 + hstep, voffB); PG8_STAGE(PG8_SA(0, 0), a2, voffA);
            PG8_WAIT_V(8); PG8_WAIT_L(0); PG8_BAR; PG8_MMA(1, 0, At, B0); PG8_MMA(1, 1, At, B1); PG8_BAR; PG8_SCHED;
            PG8_LDB(B0, 1, 0); PG8_LDB(B1, 1, 1); PG8_SCHED; PG8_LDA(At, 1, 0); PG8_STAGE(PG8_SA(0, 1), a2 + hstep, voffA);
            PG8_WAIT_V(8); PG8_WAIT_L(0); PG8_BAR; PG8_MMA(0, 0, At, B0); PG8_MMA(0, 1, At, B1); PG8_BAR; PG8_SCHED;
            PG8_LDA(At, 1, 1); PG8_STAGE(PG8_SB(1, 0), b3, voffB); PG8_STAGE(PG8_SB(1, 1), b3 + hstep, voffB); PG8_STAGE(PG8_SA(1, 0), a3, voffA);
            PG8_WAIT_V(8); PG8_WAIT_L(0); PG8_BAR; PG8_MMA(1, 0, At, B0); PG8_MMA(1, 1, At, B1); PG8_BAR; PG8_SCHED;
            } else {
            PG8_LDB(B0, 0, 0); PG8_SCHED; PG8_LDA(At, 0, 0); PG8_STAGE(PG8_SA(1, 1), a1 + hstep, voffA);
            PG8_WAIT_L(8); PG8_BAR; PG8_WAIT_L(0); PG8_MMA(0, 0, At, B0); PG8_BAR; PG8_SCHED;
            PG8_LDB(B1, 0, 1); PG8_STAGE(PG8_SB(0, 0), b2, voffB);
            PG8_BAR; PG8_WAIT_L(0); PG8_MMA(0, 1, At, B1); PG8_BAR;
            PG8_LDA(At, 0, 1); PG8_STAGE(PG8_SA(0, 0), a2, voffA);
            PG8_BAR; PG8_WAIT_L(0); PG8_MMA(1, 0, At, B0); PG8_BAR; PG8_SCHED;
            PG8_STAGE(PG8_SB(0, 1), b2 + hstep, voffB);
            PG8_WAIT_V(6); PG8_BAR; PG8_MMA(1, 1, At, B1); PG8_BAR;
            PG8_LDB(B0, 1, 0); PG8_SCHED; PG8_LDA(At, 1, 0); PG8_STAGE(PG8_SA(0, 1), a2 + hstep, voffA);
            PG8_WAIT_L(8); PG8_BAR; PG8_WAIT_L(0); PG8_MMA(0, 0, At, B0); PG8_BAR; PG8_SCHED;
            PG8_LDB(B1, 1, 1); PG8_STAGE(PG8_SB(1, 0), b3, voffB);
            PG8_BAR; PG8_WAIT_L(0); PG8_MMA(0, 1, At, B1); PG8_BAR;
            PG8_LDA(At, 1, 1); PG8_STAGE(PG8_SA(1, 0), a3, voffA);
            PG8_BAR; PG8_WAIT_L(0); PG8_MMA(1, 0, At, B0); PG8_BAR; PG8_SCHED;
            PG8_STAGE(PG8_SB(1, 1), b3 + hstep, voffB);
            PG8_WAIT_V(6); PG8_BAR; PG8_MMA(1, 1, At, B1); PG8_BAR;
            }
        }
        if constexpr (ALIGN_EPI) { if (wr == 0) PG8_BAR; }
        if constexpr (!Epi::AFTER_DRAIN) { E(acc, cur, wr, wc, fr, fq); S.done(cur); }
        if (!has_next) break;
#pragma unroll
        for (int a = 0; a < 2; ++a)
#pragma unroll
            for (int b = 0; b < 2; ++b)
#pragma unroll
                for (int m = 0; m < 4; ++m)
#pragma unroll
                    for (int n = 0; n < 2; ++n) acc[a][b][m][n] = (f32x4){0.f, 0.f, 0.f, 0.f};
        cur = nxt; cA = nA; cB = nB; ++ui;
        if constexpr (ALIGN_EPI) { if (wr == 1) PG8_BAR; }
    }
    PG8_WAIT_V(0);
    if constexpr (!ALIGN_EPI) { if (wr == 0) PG8_BAR; }
    PG8_BAR;
    if constexpr (Epi::AFTER_DRAIN) { E.fused(acc, cur, wr, wc, fr, fq, lds, wid, lane); S.done(cur); }
#undef PG8_SA
#undef PG8_SB
#undef PG8_STAGE
#undef PG8_LDA
#undef PG8_LDB
#undef PG8_MMA
#undef PG8_WAIT_V
#undef PG8_WAIT_L
#undef PG8_BAR
#undef PG8_SCHED
}
}
namespace pg8 {
template <class Epi, class Sched>
__device__ __forceinline__ void gemm_dual_phase(PG8_LAS unsigned char* lds, const bf16_t* A0, const bf16_t* Bt0, int K0, const bf16_t* A1, const bf16_t* Bt1, int K1, const Sched& S, const Epi& E) {
    const int tid = tid_fresh(), wid = __builtin_amdgcn_readfirstlane(tid >> 6), lane = tid & 63, wr = wid >> 2, wc = wid & 3, fr = lane & 15, fq = lane >> 4;
    unsigned vA0_0, vA0_1, vB0_0, vB0_1, vA1_0, vA1_1, vB1_0, vB1_1;
    { int R, C; stage_rc(tid * 16, R, C); const int Rb = (R & ~31) + perm32(R & 31);
      vA0_0 = (unsigned)(R * K0 + C) * 2u; vB0_0 = (unsigned)(Rb * K0 + C) * 2u; vA1_0 = (unsigned)(R * K1 + C) * 2u; vB1_0 = (unsigned)(Rb * K1 + C) * 2u; }
    { int R, C; stage_rc(tid * 16 + 8192, R, C); const int Rb = (R & ~31) + perm32(R & 31);
      vA0_1 = (unsigned)(R * K0 + C) * 2u; vB0_1 = (unsigned)(Rb * K0 + C) * 2u; vA1_1 = (unsigned)(R * K1 + C) * 2u; vB1_1 = (unsigned)(Rb * K1 + C) * 2u; }
    const size_t kstep = (size_t)(BK * 2);
    const size_t hst0 = (size_t)HALF * K0 * 2, hst1 = (size_t)HALF * K1 * 2;
    const unsigned ldsw = (unsigned)wid * 1024u;
    const int aoff = lds_byte(wr * 64 + fr, fq * 8), boff = lds_byte(wc * 32 + fr, fq * 8);
#define PG8_SA(b, h) (((b) * 2 + (h)) * HTB)
#define PG8_SB(b, h) ((4 + (b) * 2 + (h)) * HTB)
#define PG8_STAGE2(bufoff, gbase, v0, v1) do { \
        __builtin_amdgcn_global_load_lds((const unsigned*)((const char*)(gbase) + (v0)), (PG8_LAS unsigned*)(lds + (bufoff) + ldsw), 16, 0, 0); \
        __builtin_amdgcn_global_load_lds((const unsigned*)((const char*)(gbase) + (v1)), (PG8_LAS unsigned*)(lds + (bufoff) + ldsw + 8192), 16, 0, 0); } while (0)
#define PG8_LDA(dst, b, h) do { _Pragma("unroll") for (int m = 0; m < 4; ++m) _Pragma("unroll") for (int k = 0; k < 2; ++k) dst[m][k] = *(const PG8_LAS bf16x8*)(lds + PG8_SA(b, h) + aoff + m * 2048 + k * 1024); } while (0)
#define PG8_LDB(dst, b, h) do { _Pragma("unroll") for (int n = 0; n < 2; ++n) _Pragma("unroll") for (int k = 0; k < 2; ++k) dst[n][k] = *(const PG8_LAS bf16x8*)(lds + PG8_SB(b, h) + boff + n * 2048 + k * 1024); } while (0)
#define PG8_MMA(ai, bj, At, Bt) do { __builtin_amdgcn_s_setprio(1); _Pragma("unroll") for (int m = 0; m < 4; ++m) _Pragma("unroll") for (int n = 0; n < 2; ++n) _Pragma("unroll") for (int k = 0; k < 2; ++k) \
        acc[ai][bj][m][n] = __builtin_amdgcn_mfma_f32_16x16x32_bf16(Bt[n][k], At[m][k], acc[ai][bj][m][n], 0, 0, 0); __builtin_amdgcn_s_setprio(0); } while (0)
#define PG8_WAIT_V(n) asm volatile("s_waitcnt vmcnt(" #n ")" ::: "memory")
#define PG8_WAIT_L(n) asm volatile("s_waitcnt lgkmcnt(" #n ")" ::: "memory")
#define PG8_BAR __builtin_amdgcn_s_barrier()
#define PG8_SCHED __builtin_amdgcn_sched_barrier(0)
    Unit cur, nxt; int ui = 0;
    if (!S.next(0, cur)) return;
    f32x4 acc[2][2][4][2];
#pragma unroll
    for (int a = 0; a < 2; ++a)
#pragma unroll
        for (int b = 0; b < 2; ++b)
#pragma unroll
            for (int m = 0; m < 4; ++m)
#pragma unroll
                for (int n = 0; n < 2; ++n) acc[a][b][m][n] = (f32x4){0.f, 0.f, 0.f, 0.f};
    bf16x8 At[4][2], B0[2][2], B1[2][2];
    int ty = 0;
    const char* cA = (const char*)A0 + (size_t)cur.pm * (2 * hst0); const char* cB = (const char*)Bt0 + (size_t)cur.pn * (2 * hst0);
    PG8_STAGE2(PG8_SB(0, 0), cB, vB0_0, vB0_1); PG8_STAGE2(PG8_SB(0, 1), cB + hst0, vB0_0, vB0_1); PG8_STAGE2(PG8_SA(0, 0), cA, vA0_0, vA0_1); PG8_STAGE2(PG8_SA(0, 1), cA + hst0, vA0_0, vA0_1);
    if (wr == 1) PG8_BAR;
    PG8_WAIT_V(2); PG8_BAR;
    PG8_STAGE2(PG8_SB(1, 0), cB + kstep, vB0_0, vB0_1); PG8_STAGE2(PG8_SA(1, 0), cA + kstep, vA0_0, vA0_1); PG8_STAGE2(PG8_SB(1, 1), cB + hst0 + kstep, vB0_0, vB0_1);
    PG8_WAIT_V(6); PG8_BAR;
    for (;;) {
        const bool has_next = (ty == 0) ? true : S.next(ui + 1, nxt);
        const int pty = has_next ? (ty ^ 1) : ty;
        const int npm = (ty == 0) ? cur.pm : nxt.pm, npn = (ty == 0) ? cur.pn : nxt.pn;
        const size_t hsc = ty ? hst1 : hst0, hsn = pty ? hst1 : hst0;
        const char* nA = has_next ? (const char*)(pty ? A1 : A0) + (size_t)npm * (2 * hsn) : cA;
        const char* nB = has_next ? (const char*)(pty ? Bt1 : Bt0) + (size_t)npn * (2 * hsn) : cB;
        const unsigned vAc0 = ty ? vA1_0 : vA0_0, vAc1 = ty ? vA1_1 : vA0_1, vBc0 = ty ? vB1_0 : vB0_0, vBc1 = ty ? vB1_1 : vB0_1;
        const unsigned vAn0 = pty ? vA1_0 : vA0_0, vAn1 = pty ? vA1_1 : vA0_1, vBn0 = pty ? vB1_0 : vB0_0, vBn1 = pty ? vB1_1 : vB0_1;
        const int nt = (ty ? K1 : K0) / BK;
        for (int t = 0; t < nt; t += 2) {
            const bool last = (t == nt - 2);
            const char* a1 = cA + (size_t)(t + 1) * kstep;
            const char* a2 = last ? nA : cA + (size_t)(t + 2) * kstep; const char* b2 = last ? nB : cB + (size_t)(t + 2) * kstep;
            const char* a3 = a2 + kstep; const char* b3 = b2 + kstep;
            const size_t hs2 = last ? hsn : hsc;
            const unsigned wA0 = last ? vAn0 : vAc0, wA1 = last ? vAn1 : vAc1, wB0 = last ? vBn0 : vBc0, wB1 = last ? vBn1 : vBc1;
            PG8_LDB(B0, 0, 0); PG8_LDB(B1, 0, 1); PG8_SCHED; PG8_LDA(At, 0, 0); PG8_STAGE2(PG8_SA(1, 1), a1 + hsc, vAc0, vAc1);
            PG8_WAIT_V(8); PG8_WAIT_L(0); PG8_BAR; PG8_MMA(0, 0, At, B0); PG8_MMA(0, 1, At, B1); PG8_BAR; PG8_SCHED;
            PG8_LDA(At, 0, 1); PG8_STAGE2(PG8_SB(0, 0), b2, wB0, wB1); PG8_STAGE2(PG8_SB(0, 1), b2 + hs2, wB0, wB1); PG8_STAGE2(PG8_SA(0, 0), a2, wA0, wA1);
            PG8_WAIT_V(8); PG8_WAIT_L(0); PG8_BAR; PG8_MMA(1, 0, At, B0); PG8_MMA(1, 1, At, B1); PG8_BAR; PG8_SCHED;
            PG8_LDB(B0, 1, 0); PG8_LDB(B1, 1, 1); PG8_SCHED; PG8_LDA(At, 1, 0); PG8_STAGE2(PG8_SA(0, 1), a2 + hs2, wA0, wA1);
            PG8_WAIT_V(8); PG8_WAIT_L(0); PG8_BAR; PG8_MMA(0, 0, At, B0); PG8_MMA(0, 1, At, B1); PG8_BAR; PG8_SCHED;
            PG8_LDA(At, 1, 1); PG8_STAGE2(PG8_SB(1, 0), b3, wB0, wB1); PG8_STAGE2(PG8_SB(1, 1), b3 + hs2, wB0, wB1); PG8_STAGE2(PG8_SA(1, 0), a3, wA0, wA1);
            PG8_WAIT_V(8); PG8_WAIT_L(0); PG8_BAR; PG8_MMA(1, 0, At, B0); PG8_MMA(1, 1, At, B1); PG8_BAR; PG8_SCHED;
        }
        if (wr == 0) PG8_BAR;
        if (ty == 0) E.mid(acc, cur, wr, wc, fr, fq); else E(acc, cur, wr, wc, fr, fq);
        if (!has_next) break;
        if (ty == 1) {
#pragma unroll
            for (int a = 0; a < 2; ++a)
#pragma unroll
                for (int b = 0; b < 2; ++b)
#pragma unroll
                    for (int m = 0; m < 4; ++m)
#pragma unroll
                        for (int n = 0; n < 2; ++n) acc[a][b][m][n] = (f32x4){0.f, 0.f, 0.f, 0.f};
            cur = nxt; ++ui;
        }
        ty ^= 1; cA = nA; cB = nB;
        if (wr == 1) PG8_BAR;
    }
    PG8_WAIT_V(0);
    PG8_BAR;
#undef PG8_SA
#undef PG8_SB
#undef PG8_STAGE2
#undef PG8_LDA
#undef PG8_LDB
#undef PG8_MMA
#undef PG8_WAIT_V
#undef PG8_WAIT_L
#undef PG8_BAR
#undef PG8_SCHED
}
}

#define GAS __attribute__((address_space(1)))
#define LAS __attribute__((address_space(3)))
typedef unsigned short bf16;
typedef unsigned v4u __attribute__((ext_vector_type(4)));
typedef float f32x4 __attribute__((ext_vector_type(4)));
typedef short bf16x8 __attribute__((ext_vector_type(8)));
typedef GAS unsigned gu32;
typedef GAS unsigned long long gu64;
#define RLX_AGENT __ATOMIC_RELAXED, __HIP_MEMORY_SCOPE_AGENT
#define LDS_WAIT() asm volatile("s_waitcnt lgkmcnt(0)" ::: "memory")
#define VM_WAIT() asm volatile("s_waitcnt vmcnt(0)" ::: "memory")
__device__ __forceinline__ unsigned long long rt() { return __builtin_amdgcn_s_memrealtime(); }
__device__ __forceinline__ unsigned f2bf(float f) { unsigned u = __builtin_bit_cast(unsigned, f); return (u + 0x7fffu + ((u >> 16) & 1u)) >> 16; }
__device__ __forceinline__ unsigned pk2(float lo, float hi) { return f2bf(lo) | (f2bf(hi) << 16); }

#define XB_TMO      128
#define XB_XCNT(j)  (256  + 64 * (j))
#define XB_XSUB(j)  (1280 + 64 * (j))
#define XB_XGEN(j)  (2304 + 64 * (j))
#define XB_TOP      3328
#define XB_TOPGEN   3392
#define XCD_BAR_WORDS 3456
#define XB_SPIN_CAP (1u << 18)

__device__ __forceinline__ unsigned xb_ld(unsigned* p)              { return __hip_atomic_load(p, __ATOMIC_RELAXED, __HIP_MEMORY_SCOPE_AGENT); }
__device__ __forceinline__ unsigned xb_add(unsigned* p, unsigned v) { return __hip_atomic_fetch_add(p, v, __ATOMIC_RELAXED, __HIP_MEMORY_SCOPE_AGENT); }
__device__ __forceinline__ unsigned xb_xcc_id() { return (unsigned)__builtin_amdgcn_s_getreg((3 << 11) | 20) & 0xFu; }
#define XB_SPIN(cond, bar) do { unsigned _sp = 0; while (cond) { __builtin_amdgcn_s_sleep(1); \
    if ((++_sp & 255u) == 0u) { if (xb_ld(&(bar)[XB_TMO])) break; if (_sp > XB_SPIN_CAP) { atomicAdd(&(bar)[XB_TMO], 1u); break; } } } } while (0)

struct XcdBarrier {
    unsigned* bar; unsigned x;
    volatile LAS unsigned* st;
};

__device__ __forceinline__ XcdBarrier xcd_barrier_post(unsigned* bar, volatile LAS unsigned* st) {
    XcdBarrier b; b.bar = bar; b.x = xb_xcc_id(); b.st = st;
    if (threadIdx.x == 0) (void)xb_add(&bar[XB_XCNT(b.x)], 1u);
    return b;
}
__device__ __forceinline__ void xcd_barrier_complete(unsigned* bar, unsigned x, unsigned& nloc, unsigned& nx) {
    const unsigned G = gridDim.x * gridDim.y * gridDim.z;
    unsigned sum, cnt, mine, sp = 0u;
    for (;;) {
        sum = 0u; cnt = 0u; mine = 0u;
#pragma unroll
        for (unsigned j = 0; j < 16; ++j) { const unsigned c = xb_ld(&bar[XB_XCNT(j)]); sum += c; cnt += (c > 0u) ? 1u : 0u; mine = (j == x) ? c : mine; }
        if (sum == G) break;
        __builtin_amdgcn_s_sleep(1);
        if ((++sp & 255u) == 0u) { if (xb_ld(&bar[XB_TMO])) break; if (sp > XB_SPIN_CAP) { atomicAdd(&bar[XB_TMO], 1u); break; } }
    }
    nloc = mine > 0u ? mine : 1u; nx = cnt > 0u ? cnt : 1u;
}

__device__ __forceinline__ void xcd_barrier(const XcdBarrier& b) {
    asm volatile("s_waitcnt vmcnt(0)" ::: "memory");
    __syncthreads();
    if (threadIdx.x == 0) {
        unsigned* bar = b.bar;
        __builtin_amdgcn_s_waitcnt(0);
        unsigned nloc = b.st[0], nx = b.st[1];
        if (nloc == 0u) { xcd_barrier_complete(bar, b.x, nloc, nx); b.st[0] = nloc; b.st[1] = nx; }
        const unsigned old = xb_add(&bar[XB_XSUB(b.x)], 1u);
        const unsigned gen = old / nloc;
        if (old + 1u == (gen + 1u) * nloc) {
            __builtin_amdgcn_fence(__ATOMIC_RELEASE, "agent");
            asm volatile("s_waitcnt vmcnt(0)" ::: "memory");
            const unsigned og = xb_add(&bar[XB_TOP], 1u);
            const unsigned tg = og / nx;
            if (og + 1u == (tg + 1u) * nx) xb_add(&bar[XB_TOPGEN], 1u);
            else XB_SPIN(xb_ld(&bar[XB_TOPGEN]) == tg, bar);
            __builtin_amdgcn_fence(__ATOMIC_ACQUIRE, "agent");
            xb_add(&bar[XB_XGEN(b.x)], 1u);
            asm volatile("s_waitcnt vmcnt(0)" ::: "memory");
        } else {
            XB_SPIN(xb_ld(&bar[XB_XGEN(b.x)]) == gen, bar);
            __builtin_amdgcn_fence(__ATOMIC_ACQUIRE, "agent");
            asm volatile("s_waitcnt vmcnt(0)" ::: "memory");
        }
    }
    __syncthreads();
}

namespace att {
constexpr int D = 128;
constexpr float THR = 8.f;
constexpr bool WSKIP = false;
constexpr float SCALE = 0.08838834764831845f;
constexpr int NW = 8, QBLK = 32, KVBLK = 64, QB = NW * QBLK;
constexpr int SHM_V = KVBLK * D * 2, SHM_K = KVBLK * D * 2;
constexpr int LDS_BYTES = 2 * SHM_V + 2 * SHM_K + NW * 64 * 4;
typedef short bf16x8 __attribute__((ext_vector_type(8)));
typedef short s16x4 __attribute__((ext_vector_type(4)));
typedef float f32x16 __attribute__((ext_vector_type(16)));
typedef float f32x4 __attribute__((ext_vector_type(4)));
typedef unsigned u32x4 __attribute__((ext_vector_type(4)));
template <class A, class Bt> struct same_t { static constexpr bool v = false; };
template <class A> struct same_t<A, A> { static constexpr bool v = true; };

#define KSWZ(row, colB) ((row) * 256 + ((colB) ^ (((row) & 7) << 4)))
#define SBAR() __builtin_amdgcn_sched_barrier(0)
__device__ __forceinline__ int v_st(int k, int c) { const int kk = (k & ~0xC) | ((k & 4) << 1) | ((k & 8) >> 1); return ((kk >> 3) * 4 + (c >> 5)) * 512 + ((kk & 7) * 32 + (c & 31)) * 2; }
__device__ __forceinline__ int v_rd_base(int lane) { return ((lane & 3) << 3) | (((lane >> 2) & 3) << 6) | (((lane >> 4) & 1) << 5) | (((lane >> 5) & 1) << 8); }
constexpr int v_rd_off(int d0, int ks, int half) { return d0 * 512 + ks * 4096 + half * 2048; }
__device__ __forceinline__ int crow(int r, int hi) { return (r & 3) + 8 * (r >> 2) + 4 * hi; }
__device__ __forceinline__ unsigned cvtpk(float lo, float hi) {
    unsigned r; asm volatile("v_cvt_pk_bf16_f32 %0, %1, %2" : "=v"(r) : "v"(lo), "v"(hi)); return r;
}
__device__ __forceinline__ bf16x8 pack8(f32x4 a, f32x4 b) {
    u32x4 w = {cvtpk(a[0], a[1]), cvtpk(a[2], a[3]), cvtpk(b[0], b[1]), cvtpk(b[2], b[3])};
    return *reinterpret_cast<bf16x8*>(&w);
}
template <class T> __device__ __forceinline__ bf16x8 load8(const T* p) {
    if constexpr (same_t<T, float>::v) { return pack8(*(const f32x4*)p, *(const f32x4*)(p + 4)); }
    else { return *reinterpret_cast<const bf16x8*>(p); }
}
__device__ __forceinline__ void mask_tile(f32x16& p0, f32x16& p1, int dq, unsigned W) {
    const float NEG = -__builtin_inff();
#pragma unroll
    for (int r = 0; r < 16; ++r) {
        const int c = (r & 3) + 8 * (r >> 2);
        if ((unsigned)(dq - c) >= W) p0[r] = NEG;
        if ((unsigned)(dq - c - 32) >= W) p1[r] = NEG;
    }
}
__device__ __forceinline__ void partialSM(f32x16& p0, f32x16& p1, float& m_reg, float& mn, float& alpha) {
    float pmax = p0[0]; for (int r = 1; r < 16; ++r) pmax = fmaxf(pmax, p0[r]); for (int r = 0; r < 16; ++r) pmax = fmaxf(pmax, p1[r]);
    { auto rr = __builtin_amdgcn_permlane32_swap(__float_as_uint(pmax), __float_as_uint(pmax), false, false);
      pmax = fmaxf(__uint_as_float(rr[0]), __uint_as_float(rr[1])); }
    constexpr float C2 = 1.4426950408889634f * SCALE;
    if (__builtin_expect(__all((pmax - m_reg) * SCALE <= THR), 1)) { mn = m_reg; alpha = 1.f; }
    else { mn = fmaxf(m_reg, pmax); alpha = __builtin_amdgcn_exp2f((m_reg - mn) * C2); m_reg = mn; }
    const float mnL = -mn * C2;
    for (int r = 0; r < 16; ++r) p0[r] = fmaf(p0[r], C2, mnL); for (int r = 0; r < 16; ++r) p1[r] = fmaf(p1[r], C2, mnL);
    for (int r = 0; r < 16; ++r) p0[r] = __builtin_amdgcn_exp2f(p0[r]);
}
__device__ __forceinline__ void finishSM(f32x16& p0, f32x16& p1, float alpha, float& l_reg, bf16x8& pa0, bf16x8& pa1, bf16x8& pa2, bf16x8& pa3) {
    for (int r = 0; r < 16; ++r) p1[r] = __builtin_amdgcn_exp2f(p1[r]);
    float ps = 0; for (int r = 0; r < 16; ++r) ps += p0[r]; for (int r = 0; r < 16; ++r) ps += p1[r];
    { auto rr = __builtin_amdgcn_permlane32_swap(__float_as_uint(ps), __float_as_uint(ps), false, false);
      ps = __uint_as_float(rr[0]) + __uint_as_float(rr[1]); }
    l_reg = l_reg * alpha + ps;
#define PK4(P, B_, OUT) do { unsigned a0 = cvtpk(P[B_+0], P[B_+1]), a1 = cvtpk(P[B_+2], P[B_+3]);                          \
        unsigned b0 = cvtpk(P[B_+4], P[B_+5]), b1 = cvtpk(P[B_+6], P[B_+7]);                                             \
        auto r0 = __builtin_amdgcn_permlane32_swap(a0, b0, false, false); auto r1 = __builtin_amdgcn_permlane32_swap(a1, b1, false, false); \
        u32x4 w = {r0[0], r1[0], r0[1], r1[1]}; OUT = *reinterpret_cast<bf16x8*>(&w); } while (0)
    PK4(p0, 0, pa0); PK4(p0, 8, pa1); PK4(p1, 0, pa2); PK4(p1, 8, pa3);
#undef PK4
}
template <int KB, bool SK>
__device__ __forceinline__ void qkt(f32x16& p0, f32x16& p1, const char* K_lds, int r32, int hi, const bf16x8* qr, bool act) {
    if (SK && !act) { const float NEG = -__builtin_inff();
#pragma unroll
        for (int r = 0; r < 16; ++r) { p0[r] = NEG; p1[r] = NEG; } return; }
    p0 = f32x16{}; p1 = f32x16{};
    const char* kb[4];
#pragma unroll
    for (int dd = 0; dd < 4; ++dd) kb[dd] = K_lds + KB * SHM_K + KSWZ(r32, (dd * 16 + hi * 8) * 2);
#pragma unroll
    for (int d0 = 0; d0 < 8; ++d0) { const char* a = kb[d0 & 3] + (d0 >> 2) * 128;
        bf16x8 b0 = *reinterpret_cast<const bf16x8*>(a);
        bf16x8 b1 = *reinterpret_cast<const bf16x8*>(a + 32 * 256);
        p0 = __builtin_amdgcn_mfma_f32_32x32x16_bf16(b0, qr[d0], p0, 0, 0, 0);
        p1 = __builtin_amdgcn_mfma_f32_32x32x16_bf16(b1, qr[d0], p1, 0, 0, 0); }
}
template <int VB, bool SK>
__device__ __forceinline__ void pv_tile(f32x16* o, int vb0, bf16x8 pa0, bf16x8 pa1, bf16x8 pa2, bf16x8 pa3, bool act) {
    if (SK && !act) return;
#define TRRD(dst, off) asm volatile("ds_read_b64_tr_b16 %0, %1 offset:%2" : "=&v"(dst) : "v"(vb0), "i"(off) : "memory")
#define PV_D0(d0) do { s16x4 l0, l1, l2, l3, h0, h1, h2, h3; constexpr int b_ = VB * SHM_V + v_rd_off(d0, 0, 0);     \
        TRRD(l0, b_); TRRD(h0, b_ + 2048); TRRD(l1, b_ + 4096); TRRD(h1, b_ + 6144); TRRD(l2, b_ + 8192); TRRD(h2, b_ + 10240); TRRD(l3, b_ + 12288); TRRD(h3, b_ + 14336); \
        asm volatile("s_waitcnt lgkmcnt(0)" ::: "memory"); SBAR();                 \
        o[d0] = __builtin_amdgcn_mfma_f32_32x32x16_bf16(pa0, (bf16x8){l0[0], l0[1], l0[2], l0[3], h0[0], h0[1], h0[2], h0[3]}, o[d0], 0, 0, 0);   \
        o[d0] = __builtin_amdgcn_mfma_f32_32x32x16_bf16(pa1, (bf16x8){l1[0], l1[1], l1[2], l1[3], h1[0], h1[1], h1[2], h1[3]}, o[d0], 0, 0, 0);   \
        o[d0] = __builtin_amdgcn_mfma_f32_32x32x16_bf16(pa2, (bf16x8){l2[0], l2[1], l2[2], l2[3], h2[0], h2[1], h2[2], h2[3]}, o[d0], 0, 0, 0);   \
        o[d0] = __builtin_amdgcn_mfma_f32_32x32x16_bf16(pa3, (bf16x8){l3[0], l3[1], l3[2], l3[3], h3[0], h3[1], h3[2], h3[3]}, o[d0], 0, 0, 0); } while (0)
    PV_D0(0); PV_D0(1); PV_D0(2); PV_D0(3);
#undef PV_D0
#undef TRRD
}

template <class TIn, class TOut> struct BlockRef { const TIn* Q; const TIn* K; const TIn* V; TOut* O; int P0; };
template <class TIn> struct Seam {
    bf16x8 qr[8];
    bf16x8 st_v0, st_v1, st_k0, st_k1; f32x4 sf0, sf1, sf2, sf3;
    f32x4 tq[16];
};
__device__ __forceinline__ int swa_jlo(int P0, int W) { const int lowk = P0 - W + 1; return lowk > 0 ? lowk / KVBLK : 0; }
#define ROW(p, k0, rr) ((p) + (size_t)((k0) + (rr)) * D + sc)
#define VMW() asm volatile("s_waitcnt vmcnt(0)" ::: "memory")
#define VMWN(n) asm volatile("s_waitcnt vmcnt(%0)" :: "i"(n) : "memory")
#define SLOAD_H(Kp, Vp, k0) do { S.st_v0 = load8<TIn>(ROW(Vp, k0, sr)); S.st_v1 = load8<TIn>(ROW(Vp, k0, 32 + sr));              \
                         S.st_k0 = load8<TIn>(ROW(Kp, k0, sr)); S.st_k1 = load8<TIn>(ROW(Kp, k0, 32 + sr)); } while (0)
#define SWRITE_HK(bf) do { *(bf16x8*)(K_lds + (bf) * SHM_K + kws) = S.st_k0; *(bf16x8*)(K_lds + (bf) * SHM_K + kws + 32 * 256) = S.st_k1; } while (0)
#define SWRITE_HV(bf) do { *(bf16x8*)(V_lds + (bf) * SHM_V + vst0) = S.st_v0; *(bf16x8*)(V_lds + (bf) * SHM_V + vst1) = S.st_v1; } while (0)
#define SWRITE_H(bf) do { SWRITE_HV(bf); SWRITE_HK(bf); } while (0)
#define SLOAD_F(p, k0) do { S.sf0 = *(const f32x4*)ROW(p, k0, sr); S.sf1 = *(const f32x4*)(ROW(p, k0, sr) + 4);                \
                            S.sf2 = *(const f32x4*)ROW(p, k0, 32 + sr); S.sf3 = *(const f32x4*)(ROW(p, k0, 32 + sr) + 4); } while (0)
#define SWRITE_KF(bf) do { *(bf16x8*)(K_lds + (bf) * SHM_K + kws) = pack8(S.sf0, S.sf1); *(bf16x8*)(K_lds + (bf) * SHM_K + kws + 32 * 256) = pack8(S.sf2, S.sf3); } while (0)
#define SWRITE_VF(bf) do { *(bf16x8*)(V_lds + (bf) * SHM_V + vst0) = pack8(S.sf0, S.sf1); *(bf16x8*)(V_lds + (bf) * SHM_V + vst1) = pack8(S.sf2, S.sf3); } while (0)
template <class TIn, class TOut>
__device__ __forceinline__ void causal_swa_prime(const BlockRef<TIn, TOut>& cur, int W, char* lds, Seam<TIn>& S) {
    constexpr bool F32 = same_t<TIn, float>::v;
    const int tid = tid_fresh(), wid = __builtin_amdgcn_readfirstlane(tid >> 6), lane = tid & 63, r32 = lane & 31, hi = lane >> 5;
    const int sr = tid >> 4, sc = (tid & 15) * 8, kws = KSWZ(sr, sc * 2); char* K_lds = lds + 2 * SHM_V;
    const int kb0 = swa_jlo(cur.P0, W) * KVBLK;
    for (int d0 = 0; d0 < 8; ++d0) S.qr[d0] = load8<TIn>(cur.Q + (size_t)(wid * QBLK + r32) * D + d0 * 16 + hi * 8);
    if constexpr (F32) { SLOAD_F((const float*)cur.K, kb0); VMW(); SWRITE_KF(0); SBAR(); SLOAD_F((const float*)cur.V, kb0); }
    else { SLOAD_H(cur.K, cur.V, kb0); VMW(); SWRITE_HK(0); }
    __syncthreads();
}
template <class TIn, class TOut>
__device__ __forceinline__ void causal_swa_block(const BlockRef<TIn, TOut>& cur, const BlockRef<TIn, TOut>& nxt, int skv, int W, char* lds, Seam<TIn>& S) {
    constexpr bool F32 = same_t<TIn, float>::v;
    const int tid = tid_fresh(), wid = __builtin_amdgcn_readfirstlane(tid >> 6), lane = tid & 63, r32 = lane & 31, hi = lane >> 5;
    const int j_lo = swa_jlo(cur.P0, W);
    int j_hi = (cur.P0 + QB - 1) / KVBLK + 1; if (j_hi > skv / KVBLK) j_hi = skv / KVBLK;
    const int NT = j_hi - j_lo;
    const int kbn = swa_jlo(nxt.P0, W) * KVBLK;
    const int qlo = cur.P0 + wid * QBLK, qm = qlo + r32 - 4 * hi;
    char* V_lds = lds; char* K_lds = lds + 2 * SHM_V;
    float* ws = (float*)(lds + 2 * SHM_V + 2 * SHM_K) + wid * 64; float* li_l = ws, * al_l = ws + 32;
    float m_reg = -1e30f, l_reg = 0; f32x16 o[4] = {};
    const int sr = tid >> 4, sc = (tid & 15) * 8, vst0 = v_st(sr, sc), vst1 = v_st(32 + sr, sc), kws = KSWZ(sr, sc * 2);
    const int vb0 = (int)(uintptr_t)V_lds + v_rd_base(lane);
    const TIn* Kh = cur.K; const TIn* Vh = cur.V;
#define RESC(a) do { if (__any((a) < 1.f)) { if (hi == 0) al_l[r32] = (a); asm volatile("s_waitcnt lgkmcnt(0)" ::: "memory");              \
                     for (int d_ = 0; d_ < 4; ++d_) for (int r = 0; r < 16; ++r) o[d_][r] *= al_l[crow(r, hi)]; } } while (0)
#define KBASE(t) ((j_lo + (t)) * KVBLK)
#define ACT(t) (KBASE(t) <= qlo + QBLK - 1 && KBASE(t) + KVBLK - 1 >= qlo - W + 1)
#define MASKT(P0_, P1_, t) do { const int kb_ = KBASE(t); if ((!SK || ACT(t)) && (kb_ + KVBLK - 1 > qlo || kb_ <= qlo + QBLK - 1 - W)) mask_tile(P0_, P1_, qm - kb_, (unsigned)W); } while (0)
    constexpr int NQL = F32 ? 16 : 8;
    constexpr bool SK = WSKIP && !F32;
#define SEAM_K0() do { VMWN(NQL); if constexpr (F32) { SWRITE_KF(0); SBAR(); SLOAD_F((const float*)nxt.V, kbn); } else { SWRITE_HK(0); } SBAR(); } while (0)
    f32x16 pA0, pA1, pB0, pB1; float mnA, mnB, alA, alB; bf16x8 pa0, pa1, pa2, pa3;
    if constexpr (F32) { VMW(); SWRITE_VF(0); SBAR(); } else { SWRITE_HV(0); SBAR(); }
    if (NT > 1) { if constexpr (F32) SLOAD_F((const float*)Kh, KBASE(1)); else SLOAD_H(Kh, Vh, KBASE(1)); }
    SBAR(); qkt<0, SK>(pA0, pA1, K_lds, r32, hi, S.qr, ACT(0));
    if constexpr (F32) { if (NT > 1) { VMW(); SWRITE_KF(1); SBAR(); SLOAD_F((const float*)Vh, KBASE(1)); } }
    MASKT(pA0, pA1, 0); partialSM(pA0, pA1, m_reg, mnA, alA);
    if (NT > 1) { VMW(); if constexpr (F32) { SWRITE_VF(1); SBAR(); if (NT > 2) SLOAD_F((const float*)Kh, KBASE(2)); } else SWRITE_H(1); }
    __syncthreads();
#define HALF_STEP(PX0, PX1, mnX, alX, PY0, PY1, alY, t, KB, VB, SB) do {                                                      \
        SBAR(); qkt<KB, SK>(PX0, PX1, K_lds, r32, hi, S.qr, ACT(t));                                             \
        finishSM(PY0, PY1, alY, l_reg, pa0, pa1, pa2, pa3); SBAR();                                                           \
        if ((t) + 1 < NT) { if constexpr (F32) { VMW(); SWRITE_KF(SB); SBAR(); SLOAD_F((const float*)Vh, KBASE((t) + 1)); }  \
                            else { SLOAD_H(Kh, Vh, KBASE((t) + 1)); } SBAR(); }                                               \
        pv_tile<VB, SK>(o, vb0, pa0, pa1, pa2, pa3, ACT((t) - 1)); MASKT(PX0, PX1, (t)); partialSM(PX0, PX1, m_reg, mnX, alX);                                        \
        __syncthreads();                                                                                                      \
        if ((t) + 1 < NT) { VMW(); if constexpr (F32) { SWRITE_VF(SB); SBAR(); if ((t) + 2 < NT) SLOAD_F((const float*)Kh, KBASE((t) + 2)); } \
                            else { SWRITE_H(SB); } }                                                                          \
        RESC(alX); __syncthreads(); } while (0)
    for (int t = 1; t + 1 < NT; t += 2) {
        HALF_STEP(pB0, pB1, mnB, alB, pA0, pA1, alA, t, 1, 0, 0);
        HALF_STEP(pA0, pA1, mnA, alA, pB0, pB1, alB, t + 1, 0, 1, 1);
    }
    const bool even = (NT & 1) == 0;
    if (even) { SBAR(); qkt<1, SK>(pB0, pB1, K_lds, r32, hi, S.qr, ACT(NT - 1)); SBAR(); }
#define QROW(e) (nxt.Q + (size_t)(wid * QBLK + r32) * D + ((e) >> 1) * 16 + hi * 8 + ((e) & 1) * 4)
    if constexpr (F32) { SLOAD_F((const float*)nxt.K, kbn); SBAR();
#pragma unroll
        for (int e = 0; e < 8; ++e) S.tq[e] = *(const f32x4*)QROW(e); }
    else { SLOAD_H(nxt.K, nxt.V, kbn); SBAR();
#pragma unroll
        for (int d0 = 0; d0 < 8; ++d0) S.qr[d0] = load8<TIn>(nxt.Q + (size_t)(wid * QBLK + r32) * D + d0 * 16 + hi * 8); }
    SBAR();
    finishSM(pA0, pA1, alA, l_reg, pa0, pa1, pa2, pa3); SBAR();
    if constexpr (F32) {
#pragma unroll
        for (int e = 8; e < 16; ++e) S.tq[e] = *(const f32x4*)QROW(e); SBAR(); }
#undef QROW
    pv_tile<0, SK>(o, vb0, pa0, pa1, pa2, pa3, ACT(even ? NT - 2 : NT - 1));
    if (even) { MASKT(pB0, pB1, NT - 1); partialSM(pB0, pB1, m_reg, mnB, alB); __syncthreads(); RESC(alB);
        finishSM(pB0, pB1, alB, l_reg, pa0, pa1, pa2, pa3); SBAR(); pv_tile<1, SK>(o, vb0, pa0, pa1, pa2, pa3, ACT(NT - 1)); }
    SBAR(); SEAM_K0();
    if (hi == 0) li_l[r32] = l_reg; asm volatile("s_waitcnt lgkmcnt(0)" ::: "memory");
    float rli[16];
#pragma unroll
    for (int r = 0; r < 16; ++r) rli[r] = __builtin_amdgcn_rcpf(li_l[crow(r, hi)]);
    TOut* Ow = cur.O + (size_t)(wid * QBLK) * D;
#pragma unroll
    for (int r = 0; r < 16; ++r) { const int orow = crow(r, hi);
#pragma unroll
        for (int d0 = 0; d0 < 4; ++d0) { const float v = o[d0][r] * rli[r];
            if constexpr (same_t<TOut, float>::v) { Ow[(size_t)orow * D + d0 * 32 + r32] = v; }
            else { const float vn = __shfl_xor(v, 1);
                   if ((r32 & 1) == 0) *(unsigned*)(Ow + (size_t)orow * D + d0 * 32 + r32) = cvtpk(v, vn); } } }
    if constexpr (F32) {
#pragma unroll
        for (int d0 = 0; d0 < 8; ++d0) S.qr[d0] = pack8(S.tq[2 * d0], S.tq[2 * d0 + 1]); }
    __syncthreads();
#undef RESC
#undef KBASE
#undef ACT
#undef MASKT
#undef SEAM_K0
#undef HALF_STEP
}
#undef ROW
#undef VMW
#undef VMWN
#undef SLOAD_H
#undef SWRITE_HK
#undef SWRITE_HV
#undef SWRITE_H
#undef SLOAD_F
#undef SWRITE_KF
#undef SWRITE_VF
constexpr int LDS256_V = 0, LDS256_K = 4 * SHM_V, LDS256_WS = LDS256_K + 2 * SHM_K, LDS256_BYTES = LDS256_WS + NW * 64 * 4;
template <bool COMB>
__device__ __forceinline__ void diff_attn_block(const unsigned short* Q, const unsigned short* K, const unsigned short* V0, const unsigned short* V1, unsigned short* O, int P0, int skv, char* lds,
                                                unsigned short* AOut, int AOP, float lam, const float* sl, float eps) {
    const int tid = tid_fresh(), wid = __builtin_amdgcn_readfirstlane(tid >> 6), lane = tid & 63, r32 = lane & 31, hi = lane >> 5;
    int NT = (P0 + QB - 1) / KVBLK + 1; if (NT > skv / KVBLK) NT = skv / KVBLK;
    const int qlo = P0 + wid * QBLK, qm = qlo + r32 - 4 * hi;
    char* V_lds = lds + LDS256_V; char* K_lds = lds + LDS256_K;
    float* ws = (float*)(lds + LDS256_WS) + wid * 64; float* li_l = ws, * al_l = ws + 32;
    float m_reg = -1e30f, l_reg = 0; f32x16 o[8] = {};
    const int vb0 = (int)(uintptr_t)V_lds + v_rd_base(lane);
    bf16x8 qr[8];
#pragma unroll
    for (int d0 = 0; d0 < 8; ++d0) qr[d0] = *reinterpret_cast<const bf16x8*>(Q + (size_t)(wid * QBLK + r32) * D + d0 * 16 + hi * 8);
    typedef __attribute__((address_space(3))) unsigned* ldsu_t;
    unsigned koff[2], voff[2];
#pragma unroll
    for (int i = 0; i < 2; ++i) { const int q = (2 * wid + i) * 64 + lane;
        { const int row = q >> 4, cs = q & 15; koff[i] = (unsigned)(row * 256 + ((cs ^ (row & 7)) << 4)); }
        { const int st = q >> 5, kk = 8 * (st >> 2) + ((q & 31) >> 2), k = (kk & ~0xC) | ((kk & 4) << 1) | ((kk & 8) >> 1), c = 32 * (st & 3) + 8 * (q & 3); voff[i] = (unsigned)(k * 256 + c * 2); } }
    const unsigned ldsw = (unsigned)wid * 2048u;
#define A256_DMA(t, bf) do { const size_t tb_ = (size_t)(t) * (KVBLK * D * 2); \
        _Pragma("unroll") for (int i = 0; i < 2; ++i) { \
            __builtin_amdgcn_global_load_lds((const unsigned*)((const char*)K + tb_ + koff[i]), (ldsu_t)(K_lds + (bf) * SHM_K + ldsw + i * 1024), 16, 0, 0); \
            __builtin_amdgcn_global_load_lds((const unsigned*)((const char*)V0 + tb_ + voff[i]), (ldsu_t)(V_lds + (2 * (bf)) * SHM_V + ldsw + i * 1024), 16, 0, 0); \
            __builtin_amdgcn_global_load_lds((const unsigned*)((const char*)V1 + tb_ + voff[i]), (ldsu_t)(V_lds + (2 * (bf) + 1) * SHM_V + ldsw + i * 1024), 16, 0, 0); } } while (0)
#define A256_RESC(a) do { if (__any((a) < 1.f)) { if (hi == 0) al_l[r32] = (a); asm volatile("s_waitcnt lgkmcnt(0)" ::: "memory"); \
        _Pragma("unroll") for (int d_ = 0; d_ < 8; ++d_) _Pragma("unroll") for (int r = 0; r < 16; ++r) o[d_][r] *= al_l[crow(r, hi)]; } } while (0)
#define A256_STEP(BUF, tt) do { \
        if ((tt) + 1 < NT) A256_DMA((tt) + 1, 1 - BUF); \
        f32x16 p0, p1; float mn, alpha; bf16x8 pa0, pa1, pa2, pa3; \
        SBAR(); qkt<BUF, false>(p0, p1, K_lds, r32, hi, qr, true); \
        { const int kb_ = (tt) * KVBLK; if (kb_ + KVBLK - 1 > qlo) mask_tile(p0, p1, qm - kb_, 1u << 30); } \
        partialSM(p0, p1, m_reg, mn, alpha); \
        finishSM(p0, p1, alpha, l_reg, pa0, pa1, pa2, pa3); SBAR(); \
        A256_RESC(alpha); \
        pv_tile<2 * BUF, false>(o, vb0, pa0, pa1, pa2, pa3, true); pv_tile<2 * BUF + 1, false>(o + 4, vb0, pa0, pa1, pa2, pa3, true); \
        __syncthreads(); } while (0)
    A256_DMA(0, 0);
    __syncthreads();
    if (wid >= 4) __builtin_amdgcn_s_setprio(1);
    for (int t = 0; t < NT; t += 2) {
        A256_STEP(0, t);
        if (t + 1 < NT) A256_STEP(1, t + 1);
    }
    if (wid >= 4) __builtin_amdgcn_s_setprio(0);
    if (hi == 0) li_l[r32] = l_reg; asm volatile("s_waitcnt lgkmcnt(0)" ::: "memory");
    float rli[16];
#pragma unroll
    for (int r = 0; r < 16; ++r) rli[r] = __builtin_amdgcn_rcpf(li_l[crow(r, hi)]);
#define A256_DPP(v_, ctrl_) __builtin_bit_cast(float, __builtin_amdgcn_update_dpp(0, __builtin_bit_cast(int, (float)(v_)), (ctrl_), 0xf, 0xf, true))
#define A256_SHX(v_, m_) __builtin_bit_cast(float, __builtin_amdgcn_ds_bpermute((lane ^ (m_)) << 2, __builtin_bit_cast(int, (float)(v_))))
    unsigned short* Ow = O + (size_t)(wid * QBLK) * 256;
    if constexpr (!COMB) {
#pragma unroll
        for (int j = 0; j < 16; ++j) { const int d0 = j >> 1, rb = (j & 1) * 8;
            u32x4 w; w.x = cvtpk(o[d0][rb] * rli[rb], o[d0][rb + 1] * rli[rb + 1]); w.y = cvtpk(o[d0][rb + 2] * rli[rb + 2], o[d0][rb + 3] * rli[rb + 3]);
            w.z = cvtpk(o[d0][rb + 4] * rli[rb + 4], o[d0][rb + 5] * rli[rb + 5]); w.w = cvtpk(o[d0][rb + 6] * rli[rb + 6], o[d0][rb + 7] * rli[rb + 7]);
            *(u32x4*)(Ow + (size_t)(j * 64 + lane) * 8) = w; }
    } else {
        float slv[8];
#pragma unroll
        for (int d0 = 0; d0 < 8; ++d0) slv[d0] = sl[d0 * 32 + r32];
        u32x4 pw[16];
#pragma unroll
        for (int j = 0; j < 16; ++j) pw[j] = *(const u32x4*)(Ow + (size_t)(j * 64 + lane) * 8);
#pragma unroll
        for (int r = 0; r < 16; ++r) { const int orow = crow(r, hi); float ss = 0.f;
#pragma unroll
            for (int d0 = 0; d0 < 8; ++d0) { const unsigned wv = pw[2 * d0 + (r >> 3)][(r & 7) >> 1]; const float o0 = (r & 1) ? __uint_as_float(wv & 0xffff0000u) : __uint_as_float(wv << 16);
                const float x = o0 - lam * (o[d0][r] * rli[r]); o[d0][r] = x; ss += x * x; }
            ss += A256_DPP(ss, 0xB1); ss += A256_DPP(ss, 0x4E); ss += A256_DPP(ss, 0x141); ss += A256_DPP(ss, 0x140); ss += A256_SHX(ss, 16);
            const float rs = rsqrtf(ss * (1.0f / 256.0f) + eps);
            unsigned short* ao = AOut + (size_t)(wid * QBLK + orow) * AOP;
#pragma unroll
            for (int d0 = 0; d0 < 8; ++d0) { const float v = o[d0][r] * rs * slv[d0]; const float vn = A256_DPP(v, 0xB1);
                if ((r32 & 1) == 0) *(unsigned*)(ao + d0 * 32 + r32) = cvtpk(v, vn); } }
    }
    asm volatile("s_waitcnt lgkmcnt(0)\n\ts_barrier" ::: "memory");
#undef A256_SHX
#undef A256_DPP
#undef A256_DMA
#undef A256_RESC
#undef A256_STEP
}
#undef KSWZ
#undef SBAR
}
constexpr int DM = 2048, NB = 4, SEQ = 4096, NMETA = 16, MR = NB * SEQ  , MROWS = MR + NMETA, MPAD = MR + 256;
constexpr int DFF = 5632, NGU = 2 * DFF, NIN = 15360, LW = 2560, NHEAD = 8, KVLEN = 4160, DEPTH = 4;
constexpr float EPS = 1e-6f;
constexpr int NWAVES = 8;
#ifndef MK_MULTI
#define MK_MULTI 0
#endif
#ifndef DUAL_BR
#define DUAL_BR 1
#endif
#ifndef FINAL_BF16
#define FINAL_BF16 1
#endif
#ifndef EN_MASK
#define EN_MASK 0xFFFF
#endif
#define EN(k) (((EN_MASK) >> (k)) & 1)
#ifndef PROBE_SEAM
#define PROBE_SEAM -1
#endif
#ifndef PROBE_GAIN
#define PROBE_GAIN 1.0f
#endif
#ifndef DUP_PHASE
#define DUP_PHASE -1
#endif
#define DRY(k) ((k) == (DUP_PHASE) && rep_ == 0)
#define REPM(k) for (int rep_ = 0; rep_ < ((DUP_PHASE) == 20 ? 2 : 1); ++rep_)
#define DRYM ((DUP_PHASE) == 20 && rep_ == 0)
#define REP(k) for (int rep_ = 0; rep_ < ((k) == (DUP_PHASE) ? 2 : 1); ++rep_)
#ifndef NO_META
#define NO_META 0
#endif
constexpr int PH_PER_LAYER = 10, N_PHASES = 2 + DEPTH * PH_PER_LAYER;

constexpr size_t MiB = 1u << 20;
constexpr size_t WS_CTL = 0, CTL_ZERO_BYTES = 2 * MiB;
constexpr size_t WS_ROPE = 2 * MiB;
constexpr size_t WS_QM = 3 * MiB + 512 * 1024;
constexpr size_t WS_W = 4 * MiB, WBUF_STRIDE = 0 * MiB;
constexpr size_t W_GU1 = WS_W, W_DN1 = W_GU1 + 44 * MiB, W_IN = W_DN1 + 22 * MiB, W_BA = W_IN + 60 * MiB, W_BL = W_BA + 8 * MiB, W_O = W_BL + 10 * MiB,
                 W_GU2 = W_O + 8 * MiB, W_DN2 = W_GU2 + 44 * MiB;
constexpr size_t WS_H = 224 * MiB;
constexpr size_t WS_HB = 354 * MiB;
constexpr size_t WS_HID = 420 * MiB;
constexpr size_t WS_Q = 600 * MiB;
constexpr size_t WS_K = 664 * MiB;
constexpr size_t WS_V = 729 * MiB;
constexpr size_t WS_XR = 794 * MiB;
constexpr size_t WS_GY = 876 * MiB;
constexpr size_t WS_G = 958 * MiB;
constexpr size_t WS_OP = 1088 * MiB;
constexpr size_t WS_AO = 1216 * MiB;
constexpr size_t WS_LO = 1281 * MiB;
constexpr size_t WS_TMP = 1363 * MiB;
constexpr size_t WS_MIX = 1493 * MiB;
constexpr size_t WS_END = 1558 * MiB;
static_assert(W_DN2 + 22 * MiB <= WS_H && WS_H + (size_t)MPAD * DM * 4 <= WS_HB && WS_HB + (size_t)MPAD * DM * 2 <= WS_HID && WS_HID + (size_t)MPAD * DFF * 2 <= WS_Q, "ws map 1");
static_assert(WS_K + (size_t)64 * KVLEN * 256 <= WS_V && WS_V + (size_t)64 * KVLEN * 256 <= WS_XR && WS_XR + (size_t)MPAD * LW * 2 <= WS_GY && WS_GY + (size_t)MPAD * LW * 2 <= WS_G, "ws map 2");
static_assert(WS_LO + (size_t)MPAD * LW * 2 <= WS_TMP && WS_TMP + (size_t)MPAD * DM * 4 <= WS_MIX && WS_MIX + (size_t)MPAD * DM * 2 <= WS_END, "ws map 3");
constexpr int CW_TMO = 0, CW_CODE = 1, CW_BAR = 4096, CW_REACH = 8192  , CW_ITEM = 12288  ;
constexpr size_t SSQ_OFF = 65536;
constexpr int N_SSQ = 13;
static_assert(SSQ_OFF + (size_t)N_SSQ * MPAD * 8 <= CTL_ZERO_BYTES, "ssq inside the memset region");

constexpr int RING_BYTES = 143360, LDSCTL_OFF = RING_BYTES, MISC_OFF = LDSCTL_OFF + 320, LDS_BYTES = 147456;

using pg8::bf16_t; using pg8::bf16x8; using pg8::f32x4; using pg8::u32x4; using pg8::cvt_pk_bf16;

__device__ __forceinline__ float wave_sum(float v) {
#pragma unroll
    for (int o = 1; o < 64; o <<= 1) v += __shfl_xor(v, o);
    return v;
}
__device__ __forceinline__ float bf2f(unsigned short u) { return __uint_as_float((unsigned)u << 16); }
__device__ __forceinline__ float bflo(unsigned u) { return __uint_as_float(u << 16); }
__device__ __forceinline__ float bfhi(unsigned u) { return __uint_as_float(u & 0xffff0000u); }
__device__ __forceinline__ unsigned short f2bf16(float f) { return (unsigned short)(cvt_pk_bf16(f, 0.f) & 0xffffu); }
typedef unsigned long long u64;
typedef float f32x2 __attribute__((ext_vector_type(2)));
__device__ __forceinline__ float rstd_from(float ssq) { return rsqrtf(ssq * (1.0f / 2048.0f) + EPS); }
__device__ __forceinline__ float rstd_fx(u64 v) { return rsqrtf((float)v * (1.0f / 4294967296.0f / 2048.0f) + EPS); }
__device__ __forceinline__ u64 ssq_fx(float ss) { return (u64)(ss * 4294967296.0f); }
__device__ __forceinline__ float sigmoid_f(float x) { return __builtin_amdgcn_rcpf(1.0f + __expf(-x)); }
__device__ __forceinline__ float gelu_tanh_f(float y) { const float u = 1.5957691216057308f * (y + 0.044715f * y * y * y); return y * __builtin_amdgcn_rcpf(1.0f + __expf(-u)); }
__device__ __forceinline__ f32x4 sigmoid4(f32x4 x) { f32x4 t = x * -1.4426950408889634f;
#pragma unroll
    for (int e = 0; e < 4; ++e) t[e] = __builtin_amdgcn_exp2f(t[e]);
    t = t + 1.0f;
#pragma unroll
    for (int e = 0; e < 4; ++e) t[e] = __builtin_amdgcn_rcpf(t[e]);
    return t; }
__device__ __forceinline__ f32x4 gelu_tanh4(f32x4 y) { return y * sigmoid4(y * ((y * y) * (0.044715f * 1.5957691216057308f) + 1.5957691216057308f)); }
__device__ __forceinline__ u32x4 pack8f(f32x4 a, f32x4 b) { u32x4 w; w.x = cvt_pk_bf16(a[0], a[1]); w.y = cvt_pk_bf16(a[2], a[3]); w.z = cvt_pk_bf16(b[0], b[1]); w.w = cvt_pk_bf16(b[2], b[3]); return w; }

namespace pg8 {
template <class E> __device__ __forceinline__ void run_epi(const E& e, const f32x4 (&acc)[2][2][4][2], const Unit& u, int wr, int wc, int fr, int fq) {
    const int colin = wc * 32 + 8 * fq, row0 = u.pm * BM + wr * 64 + fr;
    const typename E::Tile tl = e.tile(u.pn, colin);
    typename E::Pre q[8];
#pragma unroll
    for (int i = 0; i < 8; ++i) if (i < E::DEPTH) q[i] = e.pre(row0 + (i >> 2) * HALF + (i & 3) * 16, u.pn, colin);
    asm volatile("" ::: "memory");
#pragma unroll
    for (int i = 0; i < 8; ++i) {
        if (i + E::DEPTH < 8) { q[i + E::DEPTH] = e.pre(row0 + ((i + E::DEPTH) >> 2) * HALF + ((i + E::DEPTH) & 3) * 16, u.pn, colin); asm volatile("" ::: "memory"); }
        e.template frag<false>(row0 + (i >> 2) * HALF + (i & 3) * 16, u.pn, colin, acc[i >> 2][0][i & 3][0], acc[i >> 2][0][i & 3][1], acc[i >> 2][1][i & 3][0], acc[i >> 2][1][i & 3][1], q[i], tl);
    }
}
}
#define EPI_COMMON static constexpr bool PERM = true, AFTER_DRAIN = false; \
    __device__ __forceinline__ void operator()(const f32x4 (&acc)[2][2][4][2], const pg8::Unit& u, int wr, int wc, int fr, int fq) const { pg8::run_epi(*this, acc, u, wr, wc, fr, fq); } \
    template <bool META> __device__ __forceinline__ void frag1(int row, int pn, int colin, f32x4 a0, f32x4 a1, f32x4 b0, f32x4 b1) const { this->template frag<META>(row, pn, colin, a0, a1, b0, b1, pre(row, pn, colin), tile(pn, colin)); }
struct EpiNone {};
__device__ __forceinline__ void unpack8(u32x4 w, f32x4& lo, f32x4& hi) { lo = (f32x4){bflo(w.x), bfhi(w.x), bflo(w.y), bfhi(w.y)}; hi = (f32x4){bflo(w.z), bfhi(w.z), bflo(w.w), bfhi(w.w)}; }

struct EpiNull {
    typedef EpiNone Pre; typedef EpiNone Tile; static constexpr int DEPTH = 1;
    __device__ __forceinline__ Pre pre(int, int, int) const { return Pre{}; }
    __device__ __forceinline__ Tile tile(int, int) const { return Tile{}; }
    template <bool META> __device__ __forceinline__ void frag(int row, int pn, int colin, f32x4 a0, f32x4 a1, f32x4 b0, f32x4 b1, const Pre&, const Tile&) const { asm volatile("" :: "v"(a0), "v"(a1), "v"(b0), "v"(b1)); }
    EPI_COMMON
};
struct PreSsq { u64 v; };
struct EpiSwiGLU {
    bf16_t* HID; const u64* ssq;
    typedef PreSsq Pre; typedef EpiNone Tile; static constexpr int DEPTH = 8;
    __device__ __forceinline__ Pre pre(int row, int, int) const { return Pre{ssq[row]}; }
    __device__ __forceinline__ Tile tile(int, int) const { return Tile{}; }
    template <bool META> __device__ __forceinline__ void frag(int row, int pn, int colin, f32x4 a0, f32x4 a1, f32x4 b0, f32x4 b1, const Pre& p, const Tile&) const {
        const float rs = rstd_fx(p.v), c1 = rs * -1.4426950408889634f, rs2 = rs * rs;
        f32x4 t0 = a0 * c1, t1 = a1 * c1;
#pragma unroll
        for (int e = 0; e < 4; ++e) { t0[e] = __builtin_amdgcn_exp2f(t0[e]); t1[e] = __builtin_amdgcn_exp2f(t1[e]); }
        t0 = t0 + 1.0f; t1 = t1 + 1.0f;
#pragma unroll
        for (int e = 0; e < 4; ++e) { t0[e] = __builtin_amdgcn_rcpf(t0[e]); t1[e] = __builtin_amdgcn_rcpf(t1[e]); }
        const f32x4 o0 = (a0 * b0) * t0 * rs2, o1 = (a1 * b1) * t1 * rs2;
        *(u32x4*)(HID + (size_t)row * DFF + pn * 128 + colin) = pack8f(o0, o1);
    }
    EPI_COMMON
};
struct PreH { f32x4 h0, h1, h2, h3; };
struct PreHb { u32x4 lo, hi; };
struct EpiResid {
    float* Hf; bf16_t* HB; u64* ssqn; float alpha, ssw;
    typedef PreHb Pre; typedef EpiNone Tile; static constexpr int DEPTH = 4;
    __device__ __forceinline__ Pre pre(int row, int pn, int colin) const { const bf16_t* bp = HB + (size_t)row * DM + pn * 256 + colin; return Pre{*(const u32x4*)bp, *(const u32x4*)(bp + 128)}; }
    __device__ __forceinline__ Tile tile(int, int) const { return Tile{}; }
    template <bool META> __device__ __forceinline__ void frag(int row, int pn, int colin, f32x4 a0, f32x4 a1, f32x4 b0, f32x4 b1, const Pre& p, const Tile&) const {
        const int c0 = pn * 256 + colin;
        f32x4 h0, h1, h2, h3; unpack8(p.lo, h0, h1); unpack8(p.hi, h2, h3);
        h0 = h0 + alpha * a0; h1 = h1 + alpha * a1; h2 = h2 + alpha * b0; h3 = h3 + alpha * b1;
        bf16_t* bp = HB + (size_t)row * DM + c0;
        *(u32x4*)bp = pack8f(h0, h1); *(u32x4*)(bp + 128) = pack8f(h2, h3);
        if (Hf) { float* hp = Hf + (size_t)row * DM + c0; *(f32x4*)hp = h0; *(f32x4*)(hp + 4) = h1; *(f32x4*)(hp + 128) = h2; *(f32x4*)(hp + 132) = h3; }
        float ss = 0.f;
#pragma unroll
        for (int e = 0; e < 4; ++e) ss += h0[e] * h0[e] + h1[e] * h1[e] + h2[e] * h2[e] + h3[e] * h3[e];
        ss += __shfl_xor(ss, 16); ss += __shfl_xor(ss, 32);
        if ((threadIdx.x & 48) == 0) __hip_atomic_fetch_add(ssqn + row, ssq_fx(ss * ssw), __ATOMIC_RELAXED, __HIP_MEMORY_SCOPE_AGENT);
    }
    EPI_COMMON
};
struct PreWin { u64 v; f32x4 c, s; };
struct TileWin { f32x4 g0, g1, g2, g3; };
struct EpiWin {
    bf16_t *Q, *K, *V, *XR, *GY, *G, *QM; const float* bgate; const u64* ssq; const float* rc; const float* rsn;
    typedef PreWin Pre; typedef TileWin Tile; static constexpr int DEPTH = 3;
    __device__ __forceinline__ Pre pre(int row, int pn, int colin) const {
        Pre p; p.v = ssq[row]; p.c = (f32x4){0.f, 0.f, 0.f, 0.f}; p.s = p.c;
        if (pn < 16 && colin < 32) { const int pos = row >= MR ? row - MR : (row & 4095) + NMETA; p.c = *(const f32x4*)(rc + pos * 16 + (colin >> 1)); p.s = *(const f32x4*)(rsn + pos * 16 + (colin >> 1)); }
        return p; }
    __device__ __forceinline__ Tile tile(int pn, int colin) const {
        Tile t; t.g0 = (f32x4){0.f, 0.f, 0.f, 0.f}; t.g1 = t.g0; t.g2 = t.g0; t.g3 = t.g0;
        if (pn >= 44) { const float* bp = bgate + (pn - 44) * 256 + colin; t.g0 = *(const f32x4*)bp; t.g1 = *(const f32x4*)(bp + 4); t.g2 = *(const f32x4*)(bp + 128); t.g3 = *(const f32x4*)(bp + 132); }
        return t; }
    template <bool META> __device__ __forceinline__ void frag(int row, int pn, int colin, f32x4 a0, f32x4 a1, f32x4 b0, f32x4 b1, const Pre& pq, const Tile& tl) const {
        const float rs = rstd_fx(pq.v);
        a0 = a0 * rs; a1 = a1 * rs; b0 = b0 * rs; b1 = b1 * rs;
        const int mi = row - MR, b = row >> 12, t = row & 4095, pos = META ? mi : t + NMETA;
        if (pn < 24) {
            if (pn < 16 && colin < 32) {
                const f32x4 c = pq.c, s = pq.s;
                const f32x4 r1 = a0 * c - a1 * s, r2 = a1 * c + a0 * s, r3 = b0 * c - b1 * s, r4 = b1 * c + b0 * s;
                a0 = r1; a1 = r2; b0 = r3; b1 = r4;
            }
            const u32x4 wa = pack8f(a0, a1), wb = pack8f(b0, b1);
            const int h = pn & 7;
            if (pn < 8) {
                if (META) { bf16_t* p = QM + ((size_t)(2 * h) * NMETA + mi) * 128 + colin; *(u32x4*)p = wa; *(u32x4*)(p + NMETA * 128) = wb; }
                else { bf16_t* p = Q + ((size_t)(b * 16 + 2 * h) * SEQ + t) * 128 + colin; *(u32x4*)p = wa; *(u32x4*)(p + (size_t)SEQ * 128) = wb; }
            } else {
                bf16_t* base = pn < 16 ? K : V;
                if (META) {
#pragma unroll
                    for (int bb = 0; bb < NB; ++bb) { bf16_t* p = base + ((size_t)(bb * 16 + 2 * h) * KVLEN + mi) * 128 + colin; *(u32x4*)p = wa; *(u32x4*)(p + (size_t)KVLEN * 128) = wb; }
                } else { bf16_t* p = base + ((size_t)(b * 16 + 2 * h) * KVLEN + pos) * 128 + colin; *(u32x4*)p = wa; *(u32x4*)(p + (size_t)KVLEN * 128) = wb; }
            }
        } else if (pn < 34) {
            bf16_t* p = XR + (size_t)row * LW + (pn - 24) * 256 + colin; *(u32x4*)p = pack8f(a0, a1); *(u32x4*)(p + 128) = pack8f(b0, b1);
        } else if (pn < 44) {
            a0 = gelu_tanh4(a0); a1 = gelu_tanh4(a1); b0 = gelu_tanh4(b0); b1 = gelu_tanh4(b1);
            bf16_t* p = GY + (size_t)row * LW + (pn - 34) * 256 + colin; *(u32x4*)p = pack8f(a0, a1); *(u32x4*)(p + 128) = pack8f(b0, b1);
        } else {
            const int c0 = (pn - 44) * 256 + colin;
            a0 = sigmoid4(a0 + tl.g0); a1 = sigmoid4(a1 + tl.g1); b0 = sigmoid4(b0 + tl.g2); b1 = sigmoid4(b1 + tl.g3);
            bf16_t* p = G + (size_t)row * 4096 + c0; *(u32x4*)p = pack8f(a0, a1); *(u32x4*)(p + 128) = pack8f(b0, b1);
        }
    }
    EPI_COMMON
};
struct PreG { u32x4 g0, g1; };
struct EpiBa {
    bf16_t* TMP; const bf16_t* G;
    typedef PreG Pre; typedef EpiNone Tile; static constexpr int DEPTH = 4;
    __device__ __forceinline__ Pre pre(int row, int pn, int colin) const { const bf16_t* gp = G + (size_t)row * 4096 + pn * 256 + colin; return Pre{*(const u32x4*)gp, *(const u32x4*)(gp + 128)}; }
    __device__ __forceinline__ Tile tile(int, int) const { return Tile{}; }
    template <bool META> __device__ __forceinline__ void frag(int row, int pn, int colin, f32x4 a0, f32x4 a1, f32x4 b0, f32x4 b1, const Pre& p, const Tile&) const {
        const int c0 = pn * 256 + colin;
        f32x4 g0, g1, g2, g3; unpack8(p.g0, g0, g1); unpack8(p.g1, g2, g3);
        bf16_t* tp = TMP + (size_t)row * DM + c0;
        *(u32x4*)tp = pack8f(g0 * a0, g1 * a1); *(u32x4*)(tp + 128) = pack8f(g2 * b0, g3 * b1);
    }
    EPI_COMMON
};
struct PreTG { u32x4 t0, t1, g0, g1; };
struct EpiBl {
    const bf16_t* TMP; const bf16_t* G; bf16_t* MIX;
    typedef PreTG Pre; typedef EpiNone Tile; static constexpr int DEPTH = 2;
    __device__ __forceinline__ Pre pre(int row, int pn, int colin) const { const int c0 = pn * 256 + colin; const bf16_t* tp = TMP + (size_t)row * DM + c0; const bf16_t* gp = G + (size_t)row * 4096 + 2048 + c0;
        return Pre{*(const u32x4*)tp, *(const u32x4*)(tp + 128), *(const u32x4*)gp, *(const u32x4*)(gp + 128)}; }
    __device__ __forceinline__ Tile tile(int, int) const { return Tile{}; }
    template <bool META> __device__ __forceinline__ void frag(int row, int pn, int colin, f32x4 a0, f32x4 a1, f32x4 b0, f32x4 b1, const Pre& p, const Tile&) const {
        const int c0 = pn * 256 + colin;
        f32x4 g0, g1, g2, g3, t0, t1, t2, t3; unpack8(p.g0, g0, g1); unpack8(p.g1, g2, g3); unpack8(p.t0, t0, t1); unpack8(p.t1, t2, t3);
        t0 = t0 + g0 * a0; t1 = t1 + g1 * a1; t2 = t2 + g2 * b0; t3 = t3 + g3 * b1;
        bf16_t* mp = MIX + (size_t)row * DM + c0;
        *(u32x4*)mp = pack8f(t0, t1); *(u32x4*)(mp + 128) = pack8f(t2, t3);
    }
    EPI_COMMON
};

struct PreGG { u32x4 a0, a1, l0, l1; };
struct EpiDual {
    const bf16_t* G; bf16_t* MIX;
    typedef PreG Pre; typedef EpiNone Tile; static constexpr int DEPTH = 4;
    __device__ __forceinline__ Pre pre(int row, int pn, int colin) const { const bf16_t* gp = G + (size_t)row * 4096 + 2048 + pn * 256 + colin; return Pre{*(const u32x4*)gp, *(const u32x4*)(gp + 128)}; }
    __device__ __forceinline__ Tile tile(int, int) const { return Tile{}; }
    template <bool META> __device__ __forceinline__ void frag(int row, int pn, int colin, f32x4 a0, f32x4 a1, f32x4 b0, f32x4 b1, const Pre& p, const Tile&) const {
        f32x4 g0, g1, g2, g3; unpack8(p.g0, g0, g1); unpack8(p.g1, g2, g3);
#pragma unroll
        for (int e = 0; e < 4; ++e) { g0[e] = fmaxf(g0[e], 1e-20f); g1[e] = fmaxf(g1[e], 1e-20f); g2[e] = fmaxf(g2[e], 1e-20f); g3[e] = fmaxf(g3[e], 1e-20f); }
        bf16_t* mp = MIX + (size_t)row * DM + pn * 256 + colin;
        *(u32x4*)mp = pack8f(g0 * a0, g1 * a1); *(u32x4*)(mp + 128) = pack8f(g2 * b0, g3 * b1);
    }
    __device__ __forceinline__ PreGG pre2(int row, int pn, int colin) const { const bf16_t* gp = G + (size_t)row * 4096 + pn * 256 + colin;
        return PreGG{*(const u32x4*)gp, *(const u32x4*)(gp + 128), *(const u32x4*)(gp + 2048), *(const u32x4*)(gp + 2048 + 128)}; }
    static __device__ __forceinline__ f32x4 ratio4(f32x4 ga, f32x4 gl) { f32x4 r;
#pragma unroll
        for (int e = 0; e < 4; ++e) r[e] = ga[e] * __builtin_amdgcn_rcpf(fmaxf(gl[e], 1e-20f));
        return r; }
    __device__ __forceinline__ void mid(f32x4 (&acc)[2][2][4][2], const pg8::Unit& u, int wr, int wc, int fr, int fq) const {
        const int colin = wc * 32 + 8 * fq, row0 = u.pm * pg8::BM + wr * 64 + fr;
        PreGG q[8];
#pragma unroll
        for (int i = 0; i < 2; ++i) q[i] = pre2(row0 + (i >> 2) * pg8::HALF + (i & 3) * 16, u.pn, colin);
        asm volatile("" ::: "memory");
#pragma unroll
        for (int i = 0; i < 8; ++i) {
            if (i + 2 < 8) { q[i + 2] = pre2(row0 + ((i + 2) >> 2) * pg8::HALF + ((i + 2) & 3) * 16, u.pn, colin); asm volatile("" ::: "memory"); }
            f32x4 a0, a1, a2, a3, l0, l1, l2, l3; unpack8(q[i].a0, a0, a1); unpack8(q[i].a1, a2, a3); unpack8(q[i].l0, l0, l1); unpack8(q[i].l1, l2, l3);
            acc[i >> 2][0][i & 3][0] = acc[i >> 2][0][i & 3][0] * ratio4(a0, l0); acc[i >> 2][0][i & 3][1] = acc[i >> 2][0][i & 3][1] * ratio4(a1, l1);
            acc[i >> 2][1][i & 3][0] = acc[i >> 2][1][i & 3][0] * ratio4(a2, l2); acc[i >> 2][1][i & 3][1] = acc[i >> 2][1][i & 3][1] * ratio4(a3, l3);
        }
    }
    EPI_COMMON
};

template <class Epi> __device__ __forceinline__ void meta_gemm(LAS unsigned char* lds, const bf16_t* A16, const bf16_t* Bt, int N, int K, const Epi& E) {
    const int tid = tid_fresh(), wid = __builtin_amdgcn_readfirstlane(tid >> 6), lane = tid & 63, fr = lane & 15, fq = lane >> 4;
    const int nitems = N / 64, ks = K / 8;
    LAS f32x4* red = (LAS f32x4*)lds;
    for (int it = blockIdx.x; it < nitems; it += gridDim.x) {
        const int pn = it >> 2, wc = it & 3;
        typename Epi::Pre pq{}; typename Epi::Tile tl{};
        if (wid == 0) { pq = E.pre(MR + fr, pn, wc * 32 + 8 * fq); tl = E.tile(pn, wc * 32 + 8 * fq); }
        f32x4 acc[4];
#pragma unroll
        for (int q = 0; q < 4; ++q) acc[q] = (f32x4){0.f, 0.f, 0.f, 0.f};
        const bf16_t* ap = A16 + (size_t)fr * K + wid * ks + 8 * fq;
        const bf16_t* bp[4];
#pragma unroll
        for (int q = 0; q < 4; ++q) bp[q] = Bt + (size_t)(pn * 256 + (q >> 1) * 128 + wc * 32 + pg8::perm32(16 * (q & 1) + fr)) * K + wid * ks + 8 * fq;
#pragma unroll 8
        for (int kk = 0; kk < ks; kk += 32) {
            const bf16x8 a = *(const bf16x8*)(ap + kk);
#pragma unroll
            for (int q = 0; q < 4; ++q) { const bf16x8 bv = *(const bf16x8*)(bp[q] + kk); acc[q] = __builtin_amdgcn_mfma_f32_16x16x32_bf16(bv, a, acc[q], 0, 0, 0); }
        }
#pragma unroll
        for (int q = 0; q < 4; ++q) red[(wid * 4 + q) * 64 + lane] = acc[q];
        __syncthreads();
        if (wid == 0) {
            f32x4 s[4];
#pragma unroll
            for (int q = 0; q < 4; ++q) { s[q] = red[q * 64 + lane];
#pragma unroll
                for (int w = 1; w < 8; ++w) s[q] = s[q] + red[(w * 4 + q) * 64 + lane]; }
            E.template frag<true>(MR + fr, pn, wc * 32 + 8 * fq, s[0], s[1], s[2], s[3], pq, tl);
        }
        __syncthreads();
    }
}

template <int K> __device__ __forceinline__ void meta_resid(LAS unsigned char* lds, const bf16_t* A16, const bf16_t* Bt, bf16_t* HBo, u64* ssqn, float alpha) {
    const int tid = tid_fresh(), wid = __builtin_amdgcn_readfirstlane(tid >> 6), lane = tid & 63, fr = lane & 15, fq = lane >> 4;
    constexpr int ks = K / 8, NST = ks / 32;
    LAS f32x4* red = (LAS f32x4*)lds;
    for (int it = blockIdx.x; it < DM / 16; it += gridDim.x) {
        const int pn = it >> 4, bj = (it >> 3) & 1, wc = (it >> 1) & 3, n = it & 1;
        const int c0 = pn * 256 + bj * 128 + wc * 32 + 8 * fq + 4 * n;
        bf16_t* hp = HBo + (size_t)(MR + fr) * DM + c0;
        unsigned long long hw = 0ull;
        if (wid == 0) hw = *(const unsigned long long*)hp;
        const bf16_t* ap = A16 + (size_t)fr * K + wid * ks + 8 * fq;
        const bf16_t* bp = Bt + (size_t)(pn * 256 + bj * 128 + wc * 32 + pg8::perm32(16 * n + fr)) * K + wid * ks + 8 * fq;
        bf16x8 av[NST], bv[NST];
#pragma unroll
        for (int i = 0; i < NST; ++i) { av[i] = *(const bf16x8*)(ap + 32 * i); bv[i] = *(const bf16x8*)(bp + 32 * i); }
        f32x4 acc = (f32x4){0.f, 0.f, 0.f, 0.f};
#pragma unroll
        for (int i = 0; i < NST; ++i) acc = __builtin_amdgcn_mfma_f32_16x16x32_bf16(bv[i], av[i], acc, 0, 0, 0);
        red[wid * 64 + lane] = acc;
        __syncthreads();
        if (wid == 0) {
            f32x4 sm = red[lane];
#pragma unroll
            for (int w = 1; w < 8; ++w) sm = sm + red[w * 64 + lane];
            const unsigned w0 = (unsigned)hw, w1 = (unsigned)(hw >> 32);
            const f32x4 h = (f32x4){bflo(w0), bfhi(w0), bflo(w1), bfhi(w1)} + alpha * sm;
            *(unsigned long long*)hp = (unsigned long long)cvt_pk_bf16(h[0], h[1]) | ((unsigned long long)cvt_pk_bf16(h[2], h[3]) << 32);
            float ss = h[0] * h[0] + h[1] * h[1] + h[2] * h[2] + h[3] * h[3];
            ss += __shfl_xor(ss, 16); ss += __shfl_xor(ss, 32);
            if (fq == 0) __hip_atomic_fetch_add(ssqn + MR + fr, ssq_fx(ss), __ATOMIC_RELAXED, __HIP_MEMORY_SCOPE_AGENT);
        }
        __syncthreads();
    }
}
__device__ __forceinline__ void meta_dual(LAS unsigned char* lds, const bf16_t* A0, const bf16_t* Bt0, const bf16_t* A1, const bf16_t* Bt1, const bf16_t* G, bf16_t* MIXo) {
    const int tid = tid_fresh(), wid = __builtin_amdgcn_readfirstlane(tid >> 6), lane = tid & 63, fr = lane & 15, fq = lane >> 4;
    constexpr int K0 = DM, K1 = LW, ks0 = K0 / 8, ks1 = K1 / 8, N0 = ks0 / 32, N1 = ks1 / 32;
    LAS f32x4* red = (LAS f32x4*)lds;
    for (int it = blockIdx.x; it < DM / 16; it += gridDim.x) {
        const int pn = it >> 4, bj = (it >> 3) & 1, wc = (it >> 1) & 3, n = it & 1;
        const int c0 = pn * 256 + bj * 128 + wc * 32 + 8 * fq + 4 * n, brow = pn * 256 + bj * 128 + wc * 32 + pg8::perm32(16 * n + fr);
        unsigned long long gaw = 0ull, glw = 0ull;
        if (wid == 0) { const bf16_t* gp = G + (size_t)(MR + fr) * 4096 + c0; gaw = *(const unsigned long long*)gp; glw = *(const unsigned long long*)(gp + 2048); }
        const bf16_t* ap0 = A0 + (size_t)fr * K0 + wid * ks0 + 8 * fq; const bf16_t* bp0 = Bt0 + (size_t)brow * K0 + wid * ks0 + 8 * fq;
        const bf16_t* ap1 = A1 + (size_t)fr * K1 + wid * ks1 + 8 * fq; const bf16_t* bp1 = Bt1 + (size_t)brow * K1 + wid * ks1 + 8 * fq;
        bf16x8 av0[N0], bv0[N0], av1[N1], bv1[N1];
#pragma unroll
        for (int i = 0; i < N0; ++i) { av0[i] = *(const bf16x8*)(ap0 + 32 * i); bv0[i] = *(const bf16x8*)(bp0 + 32 * i); }
#pragma unroll
        for (int i = 0; i < N1; ++i) { av1[i] = *(const bf16x8*)(ap1 + 32 * i); bv1[i] = *(const bf16x8*)(bp1 + 32 * i); }
        f32x4 acca = (f32x4){0.f, 0.f, 0.f, 0.f}, accb = acca;
#pragma unroll
        for (int i = 0; i < N0; ++i) acca = __builtin_amdgcn_mfma_f32_16x16x32_bf16(bv0[i], av0[i], acca, 0, 0, 0);
#pragma unroll
        for (int i = 0; i < N1; ++i) accb = __builtin_amdgcn_mfma_f32_16x16x32_bf16(bv1[i], av1[i], accb, 0, 0, 0);
        red[(wid * 2) * 64 + lane] = acca; red[(wid * 2 + 1) * 64 + lane] = accb;
        __syncthreads();
        if (wid == 0) {
            f32x4 sa = red[lane], sb = red[64 + lane];
#pragma unroll
            for (int w = 1; w < 8; ++w) { sa = sa + red[(w * 2) * 64 + lane]; sb = sb + red[(w * 2 + 1) * 64 + lane]; }
            const unsigned a0 = (unsigned)gaw, a1 = (unsigned)(gaw >> 32), l0 = (unsigned)glw, l1 = (unsigned)(glw >> 32);
            const f32x4 o = (f32x4){bflo(a0), bfhi(a0), bflo(a1), bfhi(a1)} * sa + (f32x4){bflo(l0), bfhi(l0), bflo(l1), bfhi(l1)} * sb;
            *(unsigned long long*)(MIXo + (size_t)(MR + fr) * DM + c0) = (unsigned long long)cvt_pk_bf16(o[0], o[1]) | ((unsigned long long)cvt_pk_bf16(o[2], o[3]) << 32);
        }
        __syncthreads();
    }
}

template <int MODE> __device__ __forceinline__ int wmap(int n) {
    if (MODE == 1) return ((n >> 7) << 8) + (n & 127);
    if (MODE == 2) return ((n >> 7) << 8) + 128 + (n & 127);
    if (MODE == 3) { if (n >= 4096) return n; const int d = n & 127; if (d >= 32) return n; const int s = d < 16 ? 8 * (d >> 2) + (d & 3) : 8 * ((d - 16) >> 2) + 4 + (d & 3); return (n & ~127) + s; }
    return n;
}
template <int MODE> __device__ __forceinline__ void transpose_item(const float* W, int K, int N, bf16_t* WT, LAS float* scr, int item, int lane, const float* gk = nullptr) {
    const int nblk = N / 32, kb = item / nblk, nb = item % nblk, k0 = 64 * kb, n0 = 32 * nb;
    const int c = lane & 7;
    f32x4 ga = (f32x4){1.f, 1.f, 1.f, 1.f}, gb = ga;
    if (gk) { ga = *(const f32x4*)(gk + k0 + 8 * c); gb = *(const f32x4*)(gk + k0 + 8 * c + 4); }
    { float wv[32];
      const float* wp = W + (size_t)(k0 + (lane >> 5)) * N + n0 + (lane & 31);
#pragma unroll
      for (int i = 0; i < 32; ++i) wv[i] = wp[(size_t)(2 * i) * N];
#pragma unroll
      for (int i = 0; i < 32; ++i) scr[(2 * i + (lane >> 5)) * 33 + (lane & 31)] = wv[i]; }
    asm volatile("s_waitcnt lgkmcnt(0)" ::: "memory");
#pragma unroll
    for (int j = 0; j < 4; ++j) { const int n = (lane >> 3) + 8 * j; const LAS float* s = scr + (8 * c) * 33 + n;
        u32x4 o; o.x = cvt_pk_bf16(s[0 * 33] * ga[0], s[1 * 33] * ga[1]); o.y = cvt_pk_bf16(s[2 * 33] * ga[2], s[3 * 33] * ga[3]); o.z = cvt_pk_bf16(s[4 * 33] * gb[0], s[5 * 33] * gb[1]); o.w = cvt_pk_bf16(s[6 * 33] * gb[2], s[7 * 33] * gb[3]);
        *(u32x4*)(WT + (size_t)wmap<MODE>(n0 + n) * K + k0 + 8 * c) = o; }
    asm volatile("s_waitcnt lgkmcnt(0)" ::: "memory");
}

struct Args { const float* in[29]; float* out; unsigned char* ws; float invf[16]; int ph_lo, ph_hi; };
static_assert(sizeof(Args) == 31 * 8 + 16 * 4 + 8, "Args has no padding");

__device__ __forceinline__ void conv_pass(const bf16_t* XR, bf16_t* XCg, const float* conv_w, const float* conv_b, int gtid, int ngt) {
    constexpr int NCH = LW / 8, RUNS = (SEQ + NMETA) / 8, NTASK = NB * RUNS * NCH;
    for (int task = gtid; task < NTASK; task += ngt) {
        const int c8 = task % NCH, u = (task / NCH) % RUNS, b = task / (NCH * RUNS), p0 = 8 * u;
        if (u < 2 && b > 0) continue;
        float cw[4][8], cb[8], o[8][8];
        { const f32x4 b0 = *(const f32x4*)(conv_b + 8 * c8), b1 = *(const f32x4*)(conv_b + 8 * c8 + 4);
#pragma unroll
          for (int e = 0; e < 4; ++e) { cb[e] = b0[e]; cb[4 + e] = b1[e]; }
#pragma unroll
          for (int j = 0; j < 4; ++j) { const f32x4 w0 = *(const f32x4*)(conv_w + j * LW + 8 * c8), w1 = *(const f32x4*)(conv_w + j * LW + 8 * c8 + 4);
#pragma unroll
              for (int e = 0; e < 4; ++e) { cw[j][e] = w0[e]; cw[j][4 + e] = w1[e]; } } }
#pragma unroll
        for (int i = 0; i < 8; ++i)
#pragma unroll
            for (int e = 0; e < 8; ++e) o[i][e] = cb[e];
        u32x4 raw[11];
#pragma unroll
        for (int m = 0; m < 11; ++m) { const int p = p0 - 3 + m; raw[m] = (u32x4){0u, 0u, 0u, 0u};
            if (p >= 0) { const int row = p < NMETA ? MR + p : b * SEQ + p - NMETA; raw[m] = *(const u32x4*)(XR + (size_t)row * LW + 8 * c8); } }
#pragma unroll
        for (int m = 0; m < 11; ++m) {
            const u32x4 xv = raw[m];
            const float x[8] = {bflo(xv.x), bfhi(xv.x), bflo(xv.y), bfhi(xv.y), bflo(xv.z), bfhi(xv.z), bflo(xv.w), bfhi(xv.w)};
#pragma unroll
            for (int i = 0; i < 8; ++i) { const int j = i + 3 - m; if (j >= 0 && j < 4) {
#pragma unroll
                for (int e = 0; e < 8; ++e) o[i][e] += cw[j][e] * x[e]; } }
        }
#pragma unroll
        for (int i = 0; i < 8; ++i) { const int p = p0 + i, row = p < NMETA ? MR + p : b * SEQ + p - NMETA;
            u32x4 w; w.x = cvt_pk_bf16(o[i][0], o[i][1]); w.y = cvt_pk_bf16(o[i][2], o[i][3]); w.z = cvt_pk_bf16(o[i][4], o[i][5]); w.w = cvt_pk_bf16(o[i][6], o[i][7]);
            *(u32x4*)(XCg + (size_t)row * LW + 8 * c8) = w; }
    }
}
constexpr int LRU_TT = 128, LRU_XCS = 168;
constexpr int LRU_XC = 0, LRU_WS = LRU_XC + 128 * 336, LRU_GYS = LRU_WS + 80 * 336, LRU_SEG = LRU_GYS + 2 * 10240, LRU_HIN = LRU_SEG + 2 * 1280, LRU_HW = LRU_HIN + 2 * 160, LRU_END = LRU_HW + 8 * 160;
static_assert(LRU_END <= RING_BYTES, "LRU LDS map");
template <int SH> __device__ __forceinline__ float dpp_shr(float old, float v) {
    return __builtin_bit_cast(float, __builtin_amdgcn_update_dpp(__builtin_bit_cast(int, old), __builtin_bit_cast(int, v), 0x110 + SH, 0xf, 0xf, false));
}
#define LRU_SCAN_STEP(SH) asm volatile("s_nop 1\n\t" \
        "v_fmac_f32_dpp %0, %0, %10 row_shr:" #SH " row_mask:0xf bank_mask:0xf\n\t" \
        "v_fmac_f32_dpp %1, %1, %11 row_shr:" #SH " row_mask:0xf bank_mask:0xf\n\t" \
        "v_fmac_f32_dpp %2, %2, %12 row_shr:" #SH " row_mask:0xf bank_mask:0xf\n\t" \
        "v_fmac_f32_dpp %3, %3, %13 row_shr:" #SH " row_mask:0xf bank_mask:0xf\n\t" \
        "v_fmac_f32_dpp %4, %4, %14 row_shr:" #SH " row_mask:0xf bank_mask:0xf\n\t" \
        "v_fmac_f32_dpp %5, %5, %15 row_shr:" #SH " row_mask:0xf bank_mask:0xf\n\t" \
        "v_fmac_f32_dpp %6, %6, %16 row_shr:" #SH " row_mask:0xf bank_mask:0xf\n\t" \
        "v_fmac_f32_dpp %7, %7, %17 row_shr:" #SH " row_mask:0xf bank_mask:0xf\n\t" \
        "v_fmac_f32_dpp %8, %8, %18 row_shr:" #SH " row_mask:0xf bank_mask:0xf\n\t" \
        "v_fmac_f32_dpp %9, %9, %19 row_shr:" #SH " row_mask:0xf bank_mask:0xf\n\t" \
        "v_mul_f32_dpp %10, %10, %10 row_shr:" #SH " row_mask:0xf bank_mask:0xf\n\t" \
        "v_mul_f32_dpp %11, %11, %11 row_shr:" #SH " row_mask:0xf bank_mask:0xf\n\t" \
        "v_mul_f32_dpp %12, %12, %12 row_shr:" #SH " row_mask:0xf bank_mask:0xf\n\t" \
        "v_mul_f32_dpp %13, %13, %13 row_shr:" #SH " row_mask:0xf bank_mask:0xf\n\t" \
        "v_mul_f32_dpp %14, %14, %14 row_shr:" #SH " row_mask:0xf bank_mask:0xf\n\t" \
        "v_mul_f32_dpp %15, %15, %15 row_shr:" #SH " row_mask:0xf bank_mask:0xf\n\t" \
        "v_mul_f32_dpp %16, %16, %16 row_shr:" #SH " row_mask:0xf bank_mask:0xf\n\t" \
        "v_mul_f32_dpp %17, %17, %17 row_shr:" #SH " row_mask:0xf bank_mask:0xf\n\t" \
        "v_mul_f32_dpp %18, %18, %18 row_shr:" #SH " row_mask:0xf bank_mask:0xf\n\t" \
        "v_mul_f32_dpp %19, %19, %19 row_shr:" #SH " row_mask:0xf bank_mask:0xf\n\t" \
        : "+v"(Bv[0][0]), "+v"(Bv[0][1]), "+v"(Bv[1][0]), "+v"(Bv[1][1]), "+v"(Bv[2][0]), "+v"(Bv[2][1]), "+v"(Bv[3][0]), "+v"(Bv[3][1]), "+v"(Bv[4][0]), "+v"(Bv[4][1]), "+v"(Av[0][0]), "+v"(Av[0][1]), "+v"(Av[1][0]), "+v"(Av[1][1]), "+v"(Av[2][0]), "+v"(Av[2][1]), "+v"(Av[3][0]), "+v"(Av[3][1]), "+v"(Av[4][0]), "+v"(Av[4][1]))
__device__ __forceinline__ void lru_item(LAS unsigned char* lds, int it, const bf16_t* XCg, const bf16_t* GY, bf16_t* LO,
                                         const float* gx_w, const float* gx_b, const float* ga_w, const float* ga_b, const float* a_param) {
    const int tid = tid_fresh(), wid = __builtin_amdgcn_readfirstlane(tid >> 6), lane = tid & 63, fr = lane & 15, fq = lane >> 4;
    const int b = it >> 6, n = (it >> 2) & 15, s = it & 3, cl0 = 40 * s, cg0 = 160 * n + cl0;
    LAS bf16_t* XC = (LAS bf16_t*)(lds + LRU_XC); LAS bf16_t* WSM = (LAS bf16_t*)(lds + LRU_WS); LAS bf16_t* GYS = (LAS bf16_t*)(lds + LRU_GYS);
    LAS float* SEGA = (LAS float*)(lds + LRU_SEG); LAS float* SEGB = SEGA + 320; LAS float* HIN = (LAS float*)(lds + LRU_HIN); LAS float* HW = (LAS float*)(lds + LRU_HW);
    { float wv[25];
#pragma unroll
      for (int i = 0; i < 25; ++i) { const int e = tid + 512 * i, k = e / 80, j = e % 80, gate = j / 40, ch = j % 40; wv[i] = *((gate ? gx_w : ga_w) + ((size_t)n * 160 + k) * 160 + cl0 + ch); }
#pragma unroll
      for (int i = 0; i < 25; ++i) { const int e = tid + 512 * i, k = e / 80, j = e % 80, gate = j / 40, ch = j % 40, row = 16 * (ch >> 3) + 4 * ((ch >> 1) & 3) + 2 * gate + (ch & 1); WSM[row * LRU_XCS + k] = f2bf16(wv[i]); } }
    if (tid < 40) HIN[tid] = 0.f;
    float gab[5][2], gxb[5][2], lsa[5][2];
#pragma unroll
    for (int mt = 0; mt < 5; ++mt)
#pragma unroll
        for (int e = 0; e < 2; ++e) { const int c = cg0 + 8 * mt + 2 * fq + e; gab[mt][e] = -1.4426950408889634f * ga_b[c]; gxb[mt][e] = -1.4426950408889634f * gx_b[c];
            lsa[mt][e] = -8.0f * 1.4426950408889634f * log1pf(__expf(-a_param[c])); }
    u32x4 px[5], pg[2];
#define LRU_LOAD(kk) do { const int p0_ = (kk) == 0 ? 0 : NMETA + LRU_TT * ((kk) - 1);     \
        _Pragma("unroll") for (int i = 0; i < 5; ++i) { const int e = tid + 512 * i, t_ = e / 20, ch = e % 20, p = p0_ + t_; \
            const int row = p < NMETA ? MR + p : b * SEQ + p - NMETA; px[i] = *(const u32x4*)(XCg + (size_t)row * LW + 160 * n + 8 * ch); } \
        _Pragma("unroll") for (int i = 0; i < 2; ++i) { const int e = (tid + 512 * i) % 640, t_ = e / 5, ch = e % 5, p = p0_ + t_; \
            const int row = p < NMETA ? MR + p : b * SEQ + p - NMETA; pg[i] = *(const u32x4*)(GY + (size_t)row * LW + cg0 + 8 * ch); } } while (0)
#define LRU_STORE(kk) do { const int ps_ = (kk) == 0 ? 0 : NMETA + LRU_TT * ((kk) - 1), nvs_ = (kk) == 0 ? NMETA : LRU_TT; const LAS bf16_t* gs_ = GYS + ((kk) & 1) * 5120; \
        if ((kk) > 0 || b == 0) { _Pragma("unroll") for (int i = 0; i < 2; ++i) { const int e = tid + 512 * i, tt = e / 5, ch = e % 5, p = ps_ + tt, row = p < NMETA ? MR + p : b * SEQ + p - NMETA; \
            if (e < nvs_ * 5) *(u32x4*)(LO + (size_t)row * LW + cg0 + 8 * ch) = *(const LAS u32x4*)(gs_ + tt * 40 + 8 * ch); } } } while (0)
    LRU_LOAD(0);
    __syncthreads();
    for (int k = 0; k <= 32; ++k) {
        LAS bf16_t* GYc = GYS + (k & 1) * 5120;
#pragma unroll
        for (int i = 0; i < 5; ++i) { const int e = tid + 512 * i, t_ = e / 20, ch = e % 20; *(LAS u32x4*)(XC + t_ * LRU_XCS + 8 * ch) = px[i]; }
#pragma unroll
        for (int i = 0; i < 2; ++i) { const int e = tid + 512 * i, t_ = e / 5, ch = e % 5; if (e < 128 * 5) *(LAS u32x4*)(GYc + t_ * 40 + 8 * ch) = pg[i]; }
        asm volatile("s_waitcnt lgkmcnt(0)\n\ts_barrier" ::: "memory");
        if (k > 0) LRU_STORE(k - 1);
        if (k < 32) LRU_LOAD(k + 1);
        float Av[5][2], Bv[5][2];
        const int t = 16 * wid + fr;
        {
            bf16x8 xcf[5];
#pragma unroll
            for (int kk = 0; kk < 5; ++kk) xcf[kk] = *(const LAS bf16x8*)(XC + t * LRU_XCS + 32 * kk + 8 * fq);
#pragma unroll
            for (int mt = 0; mt < 5; ++mt) {
                f32x4 acc = (f32x4){0.f, 0.f, 0.f, 0.f};
#pragma unroll
                for (int kk = 0; kk < 5; ++kk) { const bf16x8 wf = *(const LAS bf16x8*)(WSM + (16 * mt + fr) * LRU_XCS + 32 * kk + 8 * fq); acc = __builtin_amdgcn_mfma_f32_16x16x32_bf16(wf, xcf[kk], acc, 0, 0, 0); }
                const unsigned xw = *(const LAS unsigned*)(XC + t * LRU_XCS + cl0 + 8 * mt + 2 * fq);
#pragma unroll
                for (int e = 0; e < 2; ++e) {
                    const float rr = __builtin_amdgcn_rcpf(1.0f + __builtin_amdgcn_exp2f(acc[e] * -1.4426950408889634f + gab[mt][e]));
                    const float ii = __builtin_amdgcn_rcpf(1.0f + __builtin_amdgcn_exp2f(acc[2 + e] * -1.4426950408889634f + gxb[mt][e]));
                    const float a = __builtin_amdgcn_exp2f(rr * lsa[mt][e]);
                    Av[mt][e] = a; Bv[mt][e] = __builtin_amdgcn_sqrtf(1.0f - a * a) * ii * (e ? bfhi(xw) : bflo(xw));
                }
            }
            if (k == 0 && wid > 0) {
#pragma unroll
                for (int mt = 0; mt < 5; ++mt) { Av[mt][0] = 1.f; Av[mt][1] = 1.f; Bv[mt][0] = 0.f; Bv[mt][1] = 0.f; }
            }
        }
        LRU_SCAN_STEP(1); LRU_SCAN_STEP(2); LRU_SCAN_STEP(4); LRU_SCAN_STEP(8);
        if (fr == 15) {
#pragma unroll
            for (int mt = 0; mt < 5; ++mt) { const int c = 8 * mt + 2 * fq; *(LAS f32x2*)(SEGA + wid * 40 + c) = (f32x2){Av[mt][0], Av[mt][1]}; *(LAS f32x2*)(SEGB + wid * 40 + c) = (f32x2){Bv[mt][0], Bv[mt][1]}; }
        }
        asm volatile("s_waitcnt lgkmcnt(0)\n\ts_barrier" ::: "memory");
        if (lane < 40) { float sa[8], sb[8];
#pragma unroll
            for (int v = 0; v < 8; ++v) { sa[v] = SEGA[v * 40 + lane]; sb[v] = SEGB[v * 40 + lane]; }
            float h = HIN[(k & 1) * 40 + lane];
#pragma unroll
            for (int v = 0; v < 7; ++v) if (v < wid) h = sa[v] * h + sb[v];
            HW[wid * 40 + lane] = h;
            if (wid == 7) HIN[((k + 1) & 1) * 40 + lane] = sa[7] * h + sb[7]; }
        asm volatile("s_waitcnt lgkmcnt(0)" ::: "memory");
#pragma unroll
        for (int mt = 0; mt < 5; ++mt) { const int c = 8 * mt + 2 * fq; const f32x2 hin = *(const LAS f32x2*)(HW + wid * 40 + c);
            LAS unsigned* gp = (LAS unsigned*)(GYc + t * 40 + c); const unsigned gw_ = *gp;
            const float h0 = Bv[mt][0] + Av[mt][0] * hin[0], h1 = Bv[mt][1] + Av[mt][1] * hin[1];
            *gp = cvt_pk_bf16(h0 * bflo(gw_), h1 * bfhi(gw_)); }
    }
    __syncthreads();
    LRU_STORE(32);
    __syncthreads();
#undef LRU_STORE
#undef LRU_LOAD
}
#undef LRU_SCAN_STEP

__device__ __forceinline__ att::BlockRef<bf16_t, bf16_t> attn_ref(const bf16_t* Qb, const bf16_t* Kb, const bf16_t* Vb, bf16_t* OP, int b, int h, int s, int idx) {
    const int cj = idx >> 1, c = cj >> 1, j = cj & 1, qb = (idx & 1) ? 15 - s : s;
    att::BlockRef<bf16_t, bf16_t> r;
    r.Q = Qb + ((size_t)(b * 16 + 2 * h + c) * SEQ + (size_t)qb * 256) * 128;
    r.K = Kb + (size_t)(b * 16 + 2 * h + c) * KVLEN * 128;
    r.V = Vb + (size_t)(b * 16 + 2 * h + j) * KVLEN * 128;
    r.O = OP + ((size_t)((b * 8 + h) * 4 + cj) * SEQ + (size_t)qb * 256) * 128;
    r.P0 = NMETA + qb * 256;
    return r;
}
__device__ __forceinline__ void attn_phase(char* lds, const bf16_t* Qb, const bf16_t* Kb, const bf16_t* Vb, bf16_t* OP, int vcu, int G) {
    constexpr int W = 1 << 20;
    for (int vw = vcu; vw < 256; vw += G) {
        const int bh = vw >> 3, s = vw & 7, b = bh >> 3, h = bh & 7;
        att::Seam<bf16_t> S;
        att::BlockRef<bf16_t, bf16_t> cur = attn_ref(Qb, Kb, Vb, OP, b, h, s, 0);
        att::causal_swa_prime<bf16_t, bf16_t>(cur, W, lds, S);
#pragma nounroll
        for (int idx = 0; idx < 8; ++idx) {
            const att::BlockRef<bf16_t, bf16_t> nxt = idx < 7 ? attn_ref(Qb, Kb, Vb, OP, b, h, s, idx + 1) : cur;
            att::causal_swa_block<bf16_t, bf16_t>(cur, nxt, KVLEN, W, lds, S);
            cur = nxt;
        }
    }
}

__device__ __forceinline__ void attn_phase256(char* lds, const bf16_t* Qb, const bf16_t* Kb, const bf16_t* Vb, bf16_t* OP, bf16_t* AO, float lam, const float* sl, int vcu, int G) {
    for (int vw = vcu; vw < 256; vw += G) {
        const int bh = vw >> 3, s = vw & 7, b = bh >> 3, h = bh & 7;
#pragma nounroll
        for (int pass = 0; pass < 2; ++pass) {
            const int qb = pass ? 15 - s : s;
            const bf16_t* v0 = Vb + (size_t)(b * 16 + 2 * h) * KVLEN * 128; const bf16_t* v1 = v0 + (size_t)KVLEN * 128;
            bf16_t* op = OP + ((size_t)(b * 8 + h) * SEQ + (size_t)qb * 256) * 256;
            bf16_t* ao = AO + (size_t)(b * SEQ + qb * 256) * DM + h * 256;
            att::diff_attn_block<false>(Qb + ((size_t)(b * 16 + 2 * h) * SEQ + (size_t)qb * 256) * 128, Kb + (size_t)(b * 16 + 2 * h) * KVLEN * 128, v0, v1, op, NMETA + qb * 256, KVLEN, lds, ao, DM, lam, sl, EPS);
            att::diff_attn_block<true>(Qb + ((size_t)(b * 16 + 2 * h + 1) * SEQ + (size_t)qb * 256) * 128, Kb + (size_t)(b * 16 + 2 * h + 1) * KVLEN * 128, v0, v1, op, NMETA + qb * 256, KVLEN, lds, ao, DM, lam, sl, EPS);
        }
    }
}
__device__ __forceinline__ float lam_of(const float* lq1, const float* lk1, const float* lq2, const float* lk2, float lam_init, int lane) {
    const float d1 = wave_sum(lq1[lane] * lk1[lane] + lq1[lane + 64] * lk1[lane + 64]), d2 = wave_sum(lq2[lane] * lk2[lane] + lq2[lane + 64] * lk2[lane + 64]);
    return __uint_as_float(__builtin_amdgcn_readfirstlane(__float_as_uint(expf(d1) - expf(d2) + lam_init)));
}
__device__ __forceinline__ void combine_phase(const bf16_t* OP, bf16_t* AO, const bf16_t* QM, const bf16_t* Kb, const bf16_t* Vb, const float* subln, float lam, float lam_init, int gw, int ngw, int lane) {
    const f32x4 sl = *(const f32x4*)(subln + 4 * lane) * (1.0f - lam_init);
    for (int it = gw; it < NHEAD * NMETA; it += ngw) {
        const int h = it >> 4, i = it & 15, kj = lane & 15, part = lane >> 4;
        float pc[2];
#pragma unroll
        for (int c = 0; c < 2; ++c) {
            const bf16_t* qp = QM + ((size_t)(2 * h + c) * NMETA + i) * 128 + 32 * part;
            const bf16_t* kp = Kb + ((size_t)(2 * h + c) * KVLEN + kj) * 128 + 32 * part;
            float d = 0.f;
#pragma unroll
            for (int e = 0; e < 4; ++e) { const u32x4 qv = *(const u32x4*)(qp + 8 * e), kv = *(const u32x4*)(kp + 8 * e);
                d += bflo(qv.x) * bflo(kv.x) + bfhi(qv.x) * bfhi(kv.x) + bflo(qv.y) * bflo(kv.y) + bfhi(qv.y) * bfhi(kv.y) + bflo(qv.z) * bflo(kv.z) + bfhi(qv.z) * bfhi(kv.z) + bflo(qv.w) * bflo(kv.w) + bfhi(qv.w) * bfhi(kv.w); }
            d += __shfl_xor(d, 16); d += __shfl_xor(d, 32);
            float sv = kj <= i ? d * 0.08838834764831845f : -INFINITY;
            float m = sv;
#pragma unroll
            for (int o = 1; o < 16; o <<= 1) m = fmaxf(m, __shfl_xor(m, o));
            float p = __expf(sv - m), l = p;
#pragma unroll
            for (int o = 1; o < 16; o <<= 1) l += __shfl_xor(l, o);
            pc[c] = p / l;
        }
        const int j = lane >> 5, dd = 4 * (lane & 31);
        f32x4 o0 = (f32x4){0.f, 0.f, 0.f, 0.f}, o1 = o0;
        for (int k2 = 0; k2 <= i; ++k2) {
            const unsigned long long w = *(const unsigned long long*)(Vb + ((size_t)(2 * h + j) * KVLEN + k2) * 128 + dd);
            const f32x4 v = (f32x4){bflo((unsigned)w), bfhi((unsigned)w), bflo((unsigned)(w >> 32)), bfhi((unsigned)(w >> 32))};
            o0 = o0 + __shfl(pc[0], k2) * v; o1 = o1 + __shfl(pc[1], k2) * v;
        }
        f32x4 x = o0 - lam * o1;
        const float ss = wave_sum(x[0] * x[0] + x[1] * x[1] + x[2] * x[2] + x[3] * x[3]);
        const float rs = rsqrtf(ss * (1.0f / 256.0f) + EPS);
        x = x * rs * sl;
        *(unsigned long long*)(AO + (size_t)(MR + i) * DM + h * 256 + 4 * lane) = (unsigned long long)cvt_pk_bf16(x[0], x[1]) | ((unsigned long long)cvt_pk_bf16(x[2], x[3]) << 32);
    }
}

__device__ __forceinline__ float sgpr_fresh_f(float v) { asm volatile("" : "+s"(v)); return v; }
__device__ __forceinline__ int sgpr_fresh(int v) { asm volatile("" : "+s"(v)); return v; }
typedef const __attribute__((address_space(4))) Args* ArgsP;
__device__ __forceinline__ ArgsP fresh_args() { ArgsP p = (ArgsP)__builtin_amdgcn_kernarg_segment_ptr(); asm volatile("" : "+s"(p)); return p; }
#define PH_ARGS ArgsP A = fresh_args(); unsigned char* const ws = A->ws; (void)ws; \
    const int G = sgpr_fresh(G0), bx = sgpr_fresh(bx0), vcu = sgpr_fresh(vcu0); (void)bx; \
    const int tid = tid_fresh(), lane = tid & 63, wave = __builtin_amdgcn_readfirstlane(tid >> 6), gw = vcu * NWAVES + wave, ngw = G * NWAVES; (void)lane; (void)gw; (void)ngw
#define ssq_base ((u64*)(ws + SSQ_OFF))
#define H ((float*)(ws + WS_H))
#define HB ((bf16_t*)(ws + WS_HB))
#define HID ((bf16_t*)(ws + WS_HID))
#define Qb ((bf16_t*)(ws + WS_Q))
#define Kb ((bf16_t*)(ws + WS_K))
#define Vb ((bf16_t*)(ws + WS_V))
#define QM ((bf16_t*)(ws + WS_QM))
#define XR ((bf16_t*)(ws + WS_XR))
#define GY ((bf16_t*)(ws + WS_GY))
#define GG ((bf16_t*)(ws + WS_G))
#define OP ((bf16_t*)(ws + WS_OP))
#define AO ((bf16_t*)(ws + WS_AO))
#define LO ((bf16_t*)(ws + WS_LO))
#define TMP ((bf16_t*)(ws + WS_TMP))
#define XCG ((bf16_t*)(ws + WS_TMP))
#define MIX ((bf16_t*)(ws + WS_MIX))
#define LAM_INIT(ll) ((ll) == 0 ? 0.2f : (ll) == 1 ? 0.35550906759096926f : (ll) == 2 ? 0.47071301834358416f : 0.5560582041556405f)
#define SLV ((float*)(ws + WS_QM + 131072))
#define ropec ((float*)(ws + WS_ROPE))
#define ropes ((float*)(ws + WS_ROPE + 512 * 1024))
#define SSQ(i) (ssq_base + (size_t)(i) * MPAD)
constexpr int CV_G = (DM / 64) * (DFF / 32), CV_D = (DFF / 64) * (DM / 32), CV_IN = (DM / 64) * (NIN / 32), CV_S = (DM / 64) * (DM / 32), CV_L = (LW / 64) * (DM / 32);
constexpr int CV_NIT = 2 * (2 * CV_G + CV_D) + CV_IN + 2 * CV_S + CV_L;
__device__ __forceinline__ void convert_item(ArgsP A, unsigned char* ws, int l, int it, LAS float* scr, int lane) {
    unsigned char* wb = ws + (size_t)(l & 1) * WBUF_STRIDE;
    int r = it;
    if (r < CV_G) { transpose_item<1>(A->in[3] + (size_t)l * DM * DFF, DM, DFF, (bf16_t*)(wb + W_GU1), scr, r, lane, A->in[2] + (size_t)l * DM); return; } r -= CV_G;
    if (r < CV_G) { transpose_item<2>(A->in[4] + (size_t)l * DM * DFF, DM, DFF, (bf16_t*)(wb + W_GU1), scr, r, lane, A->in[2] + (size_t)l * DM); return; } r -= CV_G;
    if (r < CV_D) { transpose_item<0>(A->in[5] + (size_t)l * DFF * DM, DFF, DM, (bf16_t*)(wb + W_DN1), scr, r, lane); return; } r -= CV_D;
    if (r < CV_IN) { transpose_item<3>(A->in[7] + (size_t)l * DM * NIN, DM, NIN, (bf16_t*)(wb + W_IN), scr, r, lane, A->in[6] + (size_t)l * DM); return; } r -= CV_IN;
    if (r < CV_S) { transpose_item<0>(A->in[21] + (size_t)l * DM * DM, DM, DM, (bf16_t*)(wb + W_BA), scr, r, lane); return; } r -= CV_S;
    if (r < CV_L) { transpose_item<0>(A->in[22] + (size_t)l * LW * DM, LW, DM, (bf16_t*)(wb + W_BL), scr, r, lane); return; } r -= CV_L;
    if (r < CV_S) { transpose_item<0>(A->in[23] + (size_t)l * DM * DM, DM, DM, (bf16_t*)(wb + W_O), scr, r, lane); return; } r -= CV_S;
    if (r < CV_G) { transpose_item<1>(A->in[25] + (size_t)l * DM * DFF, DM, DFF, (bf16_t*)(wb + W_GU2), scr, r, lane, A->in[24] + (size_t)l * DM); return; } r -= CV_G;
    if (r < CV_G) { transpose_item<2>(A->in[26] + (size_t)l * DM * DFF, DM, DFF, (bf16_t*)(wb + W_GU2), scr, r, lane, A->in[24] + (size_t)l * DM); return; } r -= CV_G;
    transpose_item<0>(A->in[27] + (size_t)l * DFF * DM, DFF, DM, (bf16_t*)(wb + W_DN2), scr, r, lane);
}
__device__ __forceinline__ void fill_seam(ArgsP A, gu32* ctl, LAS unsigned char* L, volatile LAS unsigned* MISC, int seam, int G, bool drain, int lnext) {
    unsigned char* const ws = A->ws;
    const int tid = tid_fresh(), lane = tid & 63, wave = __builtin_amdgcn_readfirstlane(tid >> 6);
    LAS float* scr = (LAS float*)(L + wave * 16384);
    if (tid == 0) __hip_atomic_fetch_add(ctl + CW_REACH + 64 * seam, 1u, RLX_AGENT);
    for (;;) {
        if (tid == 0) {
            unsigned base = (unsigned)CV_NIT;
            const bool stop = !drain && __hip_atomic_load(ctl + CW_REACH + 64 * seam, RLX_AGENT) >= (unsigned)(G - 16);
            if (!stop) base = __hip_atomic_fetch_add(ctl + CW_ITEM + 64 * lnext, 8u, RLX_AGENT);
            MISC[12] = base;
        }
        __syncthreads();
        const unsigned base = MISC[12];
        __syncthreads();
        if (base >= (unsigned)CV_NIT) break;
        const int it = (int)base + wave;
        if (it < CV_NIT) convert_item(A, ws, lnext, it, scr, lane);
    }
}
constexpr int CVR_GU1 = 0, CVR_DN1 = 2 * CV_G, CVR_IN = CVR_DN1 + CV_D, CVR_BA = CVR_IN + CV_IN, CVR_O = CVR_BA + CV_S + CV_L, CVR_GU2 = CVR_O + CV_S, CVR_DN2 = CVR_GU2 + 2 * CV_G;
static_assert(CVR_DN2 + CV_D == CV_NIT, "conversion ranges");
#define CONVERT(ll, first, count) do { if (EN(0)) { ArgsP A_ = fresh_args(); const int tid_ = tid_fresh(), lane_ = tid_ & 63, wave_ = __builtin_amdgcn_readfirstlane(tid_ >> 6), gw_ = vcu * NWAVES + wave_; \
        LAS float* scr_ = (LAS float*)(L + wave_ * 16384); REP(0) for (int it_ = (first) + gw_; it_ < (first) + (count); it_ += G * NWAVES) convert_item(A_, A_->ws, (ll), it_, scr_, lane_); } } while (0)
__global__ void __launch_bounds__(NWAVES * 64, 2) mk_fwd(Args args) {
    extern __shared__ __attribute__((aligned(16))) unsigned char lds[];
    LAS unsigned char* L = (LAS unsigned char*)lds;
    volatile LAS unsigned* MISC = (volatile LAS unsigned*)(L + MISC_OFF);
    const int G0 = gridDim.x, bx0 = blockIdx.x, vcu0 = (G0 % 8 == 0) ? (bx0 % 8) * (G0 / 8) + bx0 / 8 : bx0;
    gu32* ctl = (gu32*)(args.ws + WS_CTL);
    for (int u = threadIdx.x; u < (LDS_BYTES - LDSCTL_OFF) / 4; u += NWAVES * 64) ((LAS unsigned*)(L + LDSCTL_OFF))[u] = 0u;
    __syncthreads();
    XcdBarrier bar; bar.bar = (unsigned*)(ctl + CW_BAR); bar.x = 0; bar.st = nullptr;
    if (!MK_MULTI) bar = xcd_barrier_post((unsigned*)(ctl + CW_BAR), MISC + 8);
    const int lo = args.ph_lo, hi = args.ph_hi;
    unsigned long long twait = 0; const unsigned long long tstart = (DUP_PHASE == 40) ? __builtin_amdgcn_s_memrealtime() : 0ull;
#define IN(k) (lo <= (k) && (k) < hi)
#define SEAM(k) do { if (IN((k) + 1)) { unsigned long long tb0_ = 0; if (DUP_PHASE == 40) tb0_ = __builtin_amdgcn_s_memrealtime(); xcd_barrier(bar); if (DUP_PHASE == 40 && (PROBE_SEAM < 0 || ((k) - 1) % PH_PER_LAYER == PROBE_SEAM)) { twait += __builtin_amdgcn_s_memrealtime() - tb0_; } if (DUP_PHASE == 30) { xcd_barrier(bar); xcd_barrier(bar); xcd_barrier(bar); xcd_barrier(bar); } } } while (0)

    if (EN(10) && IN(0)) {
        PH_ARGS; const float* x = A->in[0]; const float* meta = A->in[1];
        for (int m = gw; m < MROWS; m += ngw) {
            const float* src = m < MR ? x + (size_t)m * DM : meta + (size_t)(m - MR) * DM; float ss = 0.f;
#pragma unroll
            for (int j = 0; j < 8; ++j) { const int c = 4 * (64 * j + lane); const f32x4 v = *(const f32x4*)(src + c);
                ss += v[0] * v[0] + v[1] * v[1] + v[2] * v[2] + v[3] * v[3];
                *(unsigned long long*)(HB + (size_t)m * DM + c) = (unsigned long long)cvt_pk_bf16(v[0], v[1]) | ((unsigned long long)cvt_pk_bf16(v[2], v[3]) << 32); }
            ss = wave_sum(ss); if (lane == 0) ssq_base[m] = ssq_fx(ss);
        }
        for (int e = gw * 64 + lane; e < DEPTH * 256; e += ngw * 64) SLV[e] = A->in[13][e] * (1.0f - LAM_INIT(e >> 8));
        for (int e = gw * 64 + lane; e < (SEQ + NMETA) * 16; e += ngw * 64) { const int pos = e >> 4, i = e & 15; const float ang = (float)pos * A->invf[i]; ropec[e] = cosf(ang); ropes[e] = sinf(ang); }
        for (int e = gw * 64 + lane; e < 2 * 64 * 48 * 16; e += ngw * 64) { const int kv = e / (64 * 48 * 16), r = e % (64 * 48 * 16), bh = r / (48 * 16), rr = (r / 16) % 48, ch = r % 16;
            *(u32x4*)((kv ? Vb : Kb) + ((size_t)bh * KVLEN + (SEQ + NMETA) + rr) * 128 + 8 * ch) = (u32x4){0u, 0u, 0u, 0u}; }
    }
#pragma nounroll
    for (int l = 0; l < DEPTH; ++l) {
        const int pb = 1 + l * PH_PER_LAYER;
        if (EN(0) && IN(pb + 0)) {
            PH_ARGS;
            LAS float* scr = (LAS float*)(L + wave * 16384);
            REP(0) for (int it = gw; it < CV_NIT; it += ngw) convert_item(A, ws, l, it, scr, lane);
            SEAM(pb + 0);
        }
        if (EN(1) && IN(pb + 1)) {
            PH_ARGS;
            pg8::Gemm g{HB, (const bf16_t*)(ws + W_GU1 + (size_t)(l & 1) * WBUF_STRIDE), MR, NGU, DM}; pg8::StaticOrder S; S.init(MR, NGU, G, bx);
            EpiSwiGLU E{HID, SSQ(3 * l)};
            REP(1) pg8::gemm_phase<EpiSwiGLU, pg8::StaticOrder, true, true>(L, g, S, E);
            if (DUP_PHASE == 21) { EpiNull EN_; pg8::gemm_phase<EpiNull, pg8::StaticOrder, true, true>(L, g, S, EN_); }
            REPM(1) meta_gemm(L, HB + (size_t)MR * DM, g.Bt, NGU, DM, E);
            SEAM(pb + 1);
        }
        if (EN(2) && IN(pb + 2)) {
            PH_ARGS;
            pg8::Gemm g{HID, (const bf16_t*)(ws + W_DN1 + (size_t)(l & 1) * WBUF_STRIDE), MR, DM, DFF}; pg8::StaticOrder S; S.init(MR, DM, G, bx);
            REP(2) { EpiResid E{nullptr, HB, SSQ(3 * l + 1), DRY(2) ? 0.f : 0.5f, DRY(2) ? 0.f : 1.f};
            pg8::gemm_phase<EpiResid, pg8::StaticOrder, true, true>(L, g, S, E); }
            meta_resid<DFF>(L, HID + (size_t)MR * DFF, g.Bt, HB, SSQ(3 * l + 1), 0.5f);
            SEAM(pb + 2);
        }
        if (EN(3) && IN(pb + 3)) {
            PH_ARGS;
            pg8::Gemm g{HB, (const bf16_t*)(ws + W_IN + (size_t)(l & 1) * WBUF_STRIDE), MR, NIN, DM}; pg8::StaticOrder S; S.init(MR, NIN, G, bx);
            EpiWin E{Qb, Kb, Vb, XR, GY, GG, QM, A->in[8] + (size_t)l * 2 * DM, SSQ(3 * l + 1), ropec, ropes};
            REP(3) pg8::gemm_phase<EpiWin, pg8::StaticOrder, true, true>(L, g, S, E);
            REPM(3) meta_gemm(L, HB + (size_t)MR * DM, g.Bt, NIN, DM, E);
            SEAM(pb + 3);
        }
        if (EN(4) && IN(pb + 4)) {
            PH_ARGS;
            if (EN(12)) REP(14) conv_pass(XR, XCG, A->in[14] + (size_t)l * 4 * LW, A->in[15] + (size_t)l * LW, gw * 64 + lane, ngw * 64);
            if (EN(13)) { const float lam_init = LAM_INIT(sgpr_fresh(l)); const float lam = lam_of(A->in[9] + l * 128, A->in[10] + l * 128, A->in[11] + l * 128, A->in[12] + l * 128, lam_init, lane);
                REP(13) attn_phase256((char*)lds, Qb, Kb, Vb, OP, AO, lam, SLV + l * 256, vcu, G); }
            SEAM(pb + 4);
        }
        if (EN(5) && IN(pb + 5)) {
            PH_ARGS;
            const float lam_init = LAM_INIT(sgpr_fresh(l)); const float lam = lam_of(A->in[9] + l * 128, A->in[10] + l * 128, A->in[11] + l * 128, A->in[12] + l * 128, lam_init, lane);
            if (EN(12)) REP(12) for (int it = vcu; it < 256; it += G)
                lru_item(L, it, XCG, GY, LO, A->in[16] + (size_t)l * 16 * 160 * 160, A->in[17] + (size_t)l * LW, A->in[18] + (size_t)l * 16 * 160 * 160, A->in[19] + (size_t)l * LW, A->in[20] + (size_t)l * LW);
            REP(5) combine_phase(OP, AO, QM, Kb, Vb, A->in[13] + l * 256, lam, lam_init, gw, ngw, lane);
            SEAM(pb + 5);
        }
        if (EN(6) && IN(pb + 6)) {
            PH_ARGS;
            pg8::StaticOrder S; S.init(MR, DM, G, bx);
            REP(6) {
#if DUAL_BR
            { EpiDual E{GG, MIX};
              pg8::gemm_dual_phase<EpiDual, pg8::StaticOrder>(L, AO, (const bf16_t*)(ws + W_BA), DM, LO, (const bf16_t*)(ws + W_BL), LW, S, E); }
            if (l + 1 < DEPTH) {
                meta_dual(L, AO + (size_t)MR * DM, (const bf16_t*)(ws + W_BA), LO + (size_t)MR * LW, (const bf16_t*)(ws + W_BL), GG, MIX);
            }
#else
            { pg8::Gemm g{AO, (const bf16_t*)(ws + W_BA + (size_t)(l & 1) * WBUF_STRIDE), MR, DM, DM}; EpiBa E{TMP, GG};
              pg8::gemm_phase<EpiBa, pg8::StaticOrder, true, true>(L, g, S, E); if (l + 1 < DEPTH) REPM(6) meta_gemm(L, AO + (size_t)MR * DM, g.Bt, DM, DM, E); }
            { pg8::Gemm g{LO, (const bf16_t*)(ws + W_BL + (size_t)(l & 1) * WBUF_STRIDE), MR, DM, LW}; EpiBl E{TMP, GG, MIX};
              pg8::gemm_phase<EpiBl, pg8::StaticOrder, true, true>(L, g, S, E); if (l + 1 < DEPTH) REPM(6) meta_gemm(L, LO + (size_t)MR * LW, g.Bt, DM, LW, E); }
#endif
            }
            SEAM(pb + 6);
        }
        if (EN(7) && IN(pb + 7)) {
            PH_ARGS;
            pg8::Gemm g{MIX, (const bf16_t*)(ws + W_O + (size_t)(l & 1) * WBUF_STRIDE), MR, DM, DM}; pg8::StaticOrder S; S.init(MR, DM, G, bx);
            REP(7) { EpiResid E{nullptr, HB, SSQ(3 * l + 2), DRY(7) ? 0.f : 1.0f, DRY(7) ? 0.f : 1.f};
            pg8::gemm_phase<EpiResid, pg8::StaticOrder, true, true>(L, g, S, E); }
            if (l + 1 < DEPTH) meta_resid<DM>(L, MIX + (size_t)MR * DM, g.Bt, HB, SSQ(3 * l + 2), 1.0f);
            SEAM(pb + 7);
        }
        if (EN(8) && IN(pb + 8)) {
            PH_ARGS;
            pg8::Gemm g{HB, (const bf16_t*)(ws + W_GU2 + (size_t)(l & 1) * WBUF_STRIDE), MR, NGU, DM}; pg8::StaticOrder S; S.init(MR, NGU, G, bx);
            EpiSwiGLU E{HID, SSQ(3 * l + 2)};
            pg8::gemm_phase<EpiSwiGLU, pg8::StaticOrder, true, true>(L, g, S, E);
            if (l + 1 < DEPTH) REPM(1) meta_gemm(L, HB + (size_t)MR * DM, g.Bt, NGU, DM, E);
            SEAM(pb + 8);
        }
        if (EN(9) && IN(pb + 9)) {
            PH_ARGS;
            pg8::Gemm g{HID, (const bf16_t*)(ws + W_DN2 + (size_t)(l & 1) * WBUF_STRIDE), MR, DM, DFF}; pg8::StaticOrder S; S.init(MR, DM, G, bx);
            { EpiResid E{(FINAL_BF16 || l + 1 < DEPTH) ? nullptr : H, HB, SSQ(3 * l + 3), 0.5f, 1.f};
            pg8::gemm_phase<EpiResid, pg8::StaticOrder, true, true>(L, g, S, E); }
            if (l + 1 < DEPTH) meta_resid<DFF>(L, HID + (size_t)MR * DFF, g.Bt, HB, SSQ(3 * l + 3), 0.5f);
            SEAM(pb + 9);
        }
    }
    if (EN(11) && IN(N_PHASES - 1)) {
        PH_ARGS;
        float probe_scale = 1.0f;
        if (DUP_PHASE == 40) {
            u64* acc_ = (u64*)(ws + 2000000);
            if (threadIdx.x == 0) __hip_atomic_fetch_add(acc_, twait, __ATOMIC_RELAXED, __HIP_MEMORY_SCOPE_AGENT);
            xcd_barrier(bar);
            const u64 tot_ = __hip_atomic_load(acc_, __ATOMIC_RELAXED, __HIP_MEMORY_SCOPE_AGENT);
            const float frac_ = (float)tot_ / ((float)G * (float)(__builtin_amdgcn_s_memrealtime() - tstart));
            probe_scale = 1.0f + 0.02f * rintf(frac_ * 50.0f * PROBE_GAIN);
        }
        const float* gf = A->in[28];
#if FINAL_BF16
        const u64* ssqf = SSQ(3 * DEPTH);
        f32x4 gv[8];
#pragma unroll
        for (int j = 0; j < 4; ++j) { gv[2 * j] = *(const f32x4*)(gf + 8 * (64 * j + lane)); gv[2 * j + 1] = *(const f32x4*)(gf + 8 * (64 * j + lane) + 4); }
        static_assert(MR % 2 == 0, "row pairs");
        for (int m = 2 * gw; m < MR; m += 2 * ngw) {
            u32x4 w[8];
#pragma unroll
            for (int j = 0; j < 8; ++j) w[j] = *(const u32x4*)(HB + (size_t)(m + (j >> 2)) * DM + 8 * (64 * (j & 3) + lane));
            const float rs0 = rstd_fx(ssqf[m]) * probe_scale, rs1 = rstd_fx(ssqf[m + 1]) * probe_scale;
#pragma unroll
            for (int j = 0; j < 8; ++j) { const int c = 8 * (64 * (j & 3) + lane); const float rs = (j >> 2) ? rs1 : rs0; f32x4 lo, hi; unpack8(w[j], lo, hi);
                float* op = A->out + (size_t)(m + (j >> 2)) * DM + c;
                *(f32x4*)op = lo * rs * gv[2 * (j & 3)]; *(f32x4*)(op + 4) = hi * rs * gv[2 * (j & 3) + 1]; }
        }
#else
        for (int m = gw; m < MR; m += ngw) {
            f32x4 v[8]; float ss = 0.f;
#pragma unroll
            for (int j = 0; j < 8; ++j) { v[j] = *(const f32x4*)(H + (size_t)m * DM + 4 * (64 * j + lane)); ss += v[j][0] * v[j][0] + v[j][1] * v[j][1] + v[j][2] * v[j][2] + v[j][3] * v[j][3]; }
            const float rs = rstd_from(wave_sum(ss));
#pragma unroll
            for (int j = 0; j < 8; ++j) { const int c = 4 * (64 * j + lane); *(f32x4*)(A->out + (size_t)m * DM + c) = v[j] * (rs * probe_scale) * *(const f32x4*)(gf + c); }
        }
#endif
    }
#undef IN
#undef SEAM
}

extern "C" void kernel_launch(void* const* d_in, const int* in_sizes, int n_in, void* d_out, int out_size, void* d_ws, size_t ws_size, hipStream_t stream) {
    static int grid = 0;
    if (grid == 0) {
        if (n_in != 29 || in_sizes[0] != MR * DM || out_size != MR * DM || ws_size < WS_END) { fprintf(stderr, "kernel_launch: unexpected shapes (n_in %d, ws %zu < %zu?); nothing launched\n", n_in, ws_size, (size_t)WS_END); grid = -1; return; }
        int dev = 0, cus = 0, per_cu = 0;
        if (hipGetDevice(&dev) != hipSuccess || hipDeviceGetAttribute(&cus, hipDeviceAttributeMultiprocessorCount, dev) != hipSuccess) { grid = -1; return; }
        if (hipFuncSetAttribute((const void*)mk_fwd, hipFuncAttributeMaxDynamicSharedMemorySize, LDS_BYTES) != hipSuccess) { fprintf(stderr, "kernel_launch: hipFuncSetAttribute failed\n"); grid = -1; return; }
        if (hipOccupancyMaxActiveBlocksPerMultiprocessor(&per_cu, (const void*)mk_fwd, NWAVES * 64, LDS_BYTES) != hipSuccess || per_cu < 1) { fprintf(stderr, "kernel_launch: occupancy query says %d\n", per_cu); }
        (void)hipGetLastError();
        grid = cus;
    }
    if (grid < 0) return;
    if (hipMemsetAsync((char*)d_ws + WS_CTL, 0, CTL_ZERO_BYTES, stream) != hipSuccess) return;
    Args a{};
    for (int i = 0; i < 29; ++i) a.in[i] = (const float*)d_in[i];
    a.out = (float*)d_out; a.ws = (unsigned char*)d_ws;
    for (int i = 0; i < 16; ++i) a.invf[i] = (float)pow(500000.0, -(double)i / 16.0);
#if MK_MULTI
    for (int p = 0; p < N_PHASES; ++p) { a.ph_lo = p; a.ph_hi = p + 1; hipLaunchKernelGGL(mk_fwd, dim3(grid), dim3(NWAVES * 64), LDS_BYTES, stream, a); }
#else
    a.ph_lo = 0; a.ph_hi = N_PHASES;
    hipLaunchKernelGGL(mk_fwd, dim3(grid), dim3(NWAVES * 64), LDS_BYTES, stream, a);
#endif
    const hipError_t le = hipPeekAtLastError();
    if (le != hipSuccess) fprintf(stderr, "kernel_launch: launch failed: %s\n", hipGetErrorName(le));
}
```

```cpp
#include <hip/hip_runtime.h>
#include <cstdio>
#include <cstdint>
#include <cmath>
__device__ __forceinline__ int tid_fresh() { int t = threadIdx.x; asm volatile("" : "+v"(t)); return t; }
namespace pg8 {
#define PG8_LAS __attribute__((address_space(3)))
typedef unsigned short bf16_t;
typedef short bf16x8 __attribute__((ext_vector_type(8)));
typedef float f32x4 __attribute__((ext_vector_type(4)));
typedef unsigned u32x4 __attribute__((ext_vector_type(4)));
constexpr int BM = 256, BK = 64, HALF = 128, HTB = HALF * BK * 2  , STAGE_BYTES = 8 * HTB, NXCD = 8, WGM = 8;

__host__ __device__ __forceinline__ int lds_byte(int r, int c) { const int st = (r >> 4) * 2 + (c >> 5), rr = r & 15, cc = c & 31, ob = rr * 64 + cc * 2; return st * 1024 + (ob ^ (((ob >> 9) & 1) << 5)); }
__host__ __device__ __forceinline__ void stage_rc(int b, int& R, int& C) { const int st = b / 1024, sb = b % 1024, swz = sb ^ (((sb >> 9) & 1) << 5); R = (st >> 1) * 16 + swz / 64; C = (st & 1) * 32 + (swz % 64) / 2; }
__host__ __device__ __forceinline__ int perm32(int rho) { const int n = rho >> 4, i = rho & 15; return 8 * (i >> 2) + 4 * n + (i & 3); }

struct Unit { int pm, pn; };
struct Gemm { const bf16_t* A; const bf16_t* Bt; int M, N, K; };

struct StaticOrder {
    int nM, nN, nwg, G, c;
    __host__ __device__ void init(int M, int N, int G_, int c_) { nM = M / BM; nN = N / BM; nwg = nM * nN; G = G_; c = c_; }
    __host__ __device__ bool next(int i, Unit& u) const {
        const long L = (long)i * G + c; if (L >= nwg) return false;
        int wgid = (int)L; { const int q = nwg / NXCD, r = nwg % NXCD, xcd = wgid % NXCD, off = wgid / NXCD; wgid = (xcd < r ? xcd * (q + 1) : r * (q + 1) + (xcd - r) * q) + off; }
        const int nig = WGM * nN, gid = wgid / nig, fm = gid * WGM, gsz = (nM - fm) < WGM ? (nM - fm) : WGM;
        u.pm = fm + ((wgid % nig) % gsz); u.pn = (wgid % nig) / gsz; return true;
    }
    __device__ __forceinline__ void a_ready(const Unit&) const {}
    __device__ __forceinline__ void done(const Unit&) const {}
};

__device__ __forceinline__ unsigned cvt_pk_bf16(float lo, float hi) { unsigned r; asm volatile("v_cvt_pk_bf16_f32 %0, %1, %2" : "=v"(r) : "v"(lo), "v"(hi)); return r; }
typedef float f32x2 __attribute__((ext_vector_type(2)));
template <class Epi, class Sched, bool ALIGN_EPI = false, bool SP2 = false>
__device__ __forceinline__ void gemm_phase(PG8_LAS unsigned char* lds, const Gemm g, const Sched& S, const Epi& E) {
    const int tid = tid_fresh(), wid = __builtin_amdgcn_readfirstlane(tid >> 6), lane = tid & 63, wr = wid >> 2, wc = wid & 3, fr = lane & 15, fq = lane >> 4;
    const int K = g.K, nt = K / BK;
    unsigned voffA[2], voffB[2];
#pragma unroll
    for (int i = 0; i < 2; ++i) { int R, C; stage_rc(tid * 16 + i * 8192, R, C); const int Rb = Epi::PERM ? ((R & ~31) + perm32(R & 31)) : R;
        voffA[i] = (unsigned)(R * K + C) * 2u; voffB[i] = (unsigned)(Rb * K + C) * 2u; }
    const size_t kstep = (size_t)(BK * 2);
    const size_t hstep = (size_t)HALF * K * 2;
    const size_t tstep = 2 * hstep;
    const unsigned ldsw = (unsigned)wid * 1024u;
    const int aoff = lds_byte(wr * 64 + fr, fq * 8), boff = lds_byte(wc * 32 + fr, fq * 8);
#define PG8_SA(b, h) (((b) * 2 + (h)) * HTB)
#define PG8_SB(b, h) ((4 + (b) * 2 + (h)) * HTB)
#define PG8_STAGE(bufoff, gbase, voff) do { _Pragma("unroll") for (int _i = 0; _i < 2; ++_i) \
        __builtin_amdgcn_global_load_lds((const unsigned*)((const char*)(gbase) + (voff)[_i]), (PG8_LAS unsigned*)(lds + (bufoff) + ldsw + _i * 8192), 16, 0, 0); } while (0)
#define PG8_LDA(dst, b, h) do { _Pragma("unroll") for (int m = 0; m < 4; ++m) _Pragma("unroll") for (int k = 0; k < 2; ++k) dst[m][k] = *(const PG8_LAS bf16x8*)(lds + PG8_SA(b, h) + aoff + m * 2048 + k * 1024); } while (0)
#define PG8_LDB(dst, b, h) do { _Pragma("unroll") for (int n = 0; n < 2; ++n) _Pragma("unroll") for (int k = 0; k < 2; ++k) dst[n][k] = *(const PG8_LAS bf16x8*)(lds + PG8_SB(b, h) + boff + n * 2048 + k * 1024); } while (0)
#define PG8_MMA(ai, bj, At, Bt) do { __builtin_amdgcn_s_setprio(1); _Pragma("unroll") for (int m = 0; m < 4; ++m) _Pragma("unroll") for (int n = 0; n < 2; ++n) _Pragma("unroll") for (int k = 0; k < 2; ++k) \
        acc[ai][bj][m][n] = __builtin_amdgcn_mfma_f32_16x16x32_bf16(Bt[n][k], At[m][k], acc[ai][bj][m][n], 0, 0, 0); __builtin_amdgcn_s_setprio(0); } while (0)
#define PG8_WAIT_V(n) asm volatile("s_waitcnt vmcnt(" #n ")" ::: "memory")
#define PG8_WAIT_L(n) asm volatile("s_waitcnt lgkmcnt(" #n ")" ::: "memory")
#define PG8_BAR __builtin_amdgcn_s_barrier()
#define PG8_SCHED __builtin_amdgcn_sched_barrier(0)
    Unit cur, nxt; int ui = 0;
    if (!S.next(0, cur)) return;
    f32x4 acc[2][2][4][2];
#pragma unroll
    for (int a = 0; a < 2; ++a)
#pragma unroll
        for (int b = 0; b < 2; ++b)
#pragma unroll
            for (int m = 0; m < 4; ++m)
#pragma unroll
                for (int n = 0; n < 2; ++n) acc[a][b][m][n] = (f32x4){0.f, 0.f, 0.f, 0.f};
    bf16x8 At[4][2], B0[2][2], B1[2][2];
    const char* cA = (const char*)g.A + (size_t)cur.pm * tstep; const char* cB = (const char*)g.Bt + (size_t)cur.pn * tstep;
    S.a_ready(cur);
    if constexpr (SP2) {
        PG8_STAGE(PG8_SB(0, 0), cB, voffB); PG8_STAGE(PG8_SB(0, 1), cB + hstep, voffB); PG8_STAGE(PG8_SA(0, 0), cA, voffA); PG8_STAGE(PG8_SA(0, 1), cA + hstep, voffA);
        if (wr == 1) PG8_BAR;
        PG8_WAIT_V(2); PG8_BAR;
        PG8_STAGE(PG8_SB(1, 0), cB + kstep, voffB); PG8_STAGE(PG8_SA(1, 0), cA + kstep, voffA); PG8_STAGE(PG8_SB(1, 1), cB + hstep + kstep, voffB);
        PG8_WAIT_V(6); PG8_BAR;
    } else {
        PG8_STAGE(PG8_SB(0, 0), cB, voffB); PG8_STAGE(PG8_SA(0, 0), cA, voffA); PG8_STAGE(PG8_SB(0, 1), cB + hstep, voffB); PG8_STAGE(PG8_SA(0, 1), cA + hstep, voffA);
        if (wr == 1) PG8_BAR;
        PG8_WAIT_V(4); PG8_BAR;
        PG8_STAGE(PG8_SB(1, 0), cB + kstep, voffB); PG8_STAGE(PG8_SA(1, 0), cA + kstep, voffA); PG8_STAGE(PG8_SB(1, 1), cB + hstep + kstep, voffB);
        PG8_WAIT_V(6); PG8_BAR;
    }
    for (;;) {
        const bool has_next = S.next(ui + 1, nxt);
        const char* nA = has_next ? (const char*)g.A + (size_t)nxt.pm * tstep : cA; const char* nB = has_next ? (const char*)g.Bt + (size_t)nxt.pn * tstep : cB;
        for (int t = 0; t < nt; t += 2) {
            const bool last = (t == nt - 2);
            const char* a1 = cA + (size_t)(t + 1) * kstep;
            const char* a2 = last ? nA : cA + (size_t)(t + 2) * kstep; const char* b2 = last ? nB : cB + (size_t)(t + 2) * kstep;
            const char* a3 = a2 + kstep; const char* b3 = b2 + kstep;
            if (last && has_next) S.a_ready(nxt);
            if constexpr (SP2) {
            PG8_LDB(B0, 0, 0); PG8_LDB(B1, 0, 1); PG8_SCHED; PG8_LDA(At, 0, 0); PG8_STAGE(PG8_SA(1, 1), a1 + hstep, voffA);
            PG8_WAIT_V(8); PG8_WAIT_L(0); PG8_BAR; PG8_MMA(0, 0, At, B0); PG8_MMA(0, 1, At, B1); PG8_BAR; PG8_SCHED;
            PG8_LDA(At, 0, 1); PG8_STAGE(PG8_SB(0, 0), b2, voffB); PG8_STAGE(PG8_SB(0, 1), b2 + hstep, voffB); PG8_STAGE(PG8_SA(0, 0), a2, voffA);
            PG8_WAIT_V(8); PG8_WAIT_L(0); PG8_BAR; PG8_MMA(1, 0, At, B0); PG8_MMA(1, 1, At, B1); PG8_BAR; PG8_SCHED;
            PG8_LDB(B0, 1, 0); PG8_LDB(B1, 1, 1); PG8_SCHED; PG8_LDA(At, 1, 0); PG8_STAGE(PG8_SA(0, 1), a2 + hstep, voffA);
            PG8_WAIT_V(8); PG8_WAIT_L(0); PG8_BAR; PG8_MMA(0, 0, At, B0); PG8_MMA(0, 1, At, B1); PG8_BAR; PG8_SCHED;
            PG8_LDA(At, 1, 1); PG8_STAGE(PG8_SB(1, 0), b3, voffB); PG8_STAGE(PG8_SB(1, 1), b3 + hstep, voffB); PG8_STAGE(PG8_SA(1, 0), a3, voffA);
            PG8_WAIT_V(8); PG8_WAIT_L(0); PG8_BAR; PG8_MMA(1, 0, At, B0); PG8_MMA(1, 1, At, B1); PG8_BAR; PG8_SCHED;
            } else {
            PG8_LDB(B0, 0, 0); PG8_SCHED; PG8_LDA(At, 0, 0); PG8_STAGE(PG8_SA(1, 1), a1 + hstep, voffA);
            PG8_WAIT_L(8); PG8_BAR; PG8_WAIT_L(0); PG8_MMA(0, 0, At, B0); PG8_BAR; PG8_SCHED;
            PG8_LDB(B1, 0, 1); PG8_STAGE(PG8_SB(0, 0), b2, voffB);
            PG8_BAR; PG8_WAIT_L(0); PG8_MMA(0, 1, At, B1); PG8_BAR;
            PG8_LDA(At, 0, 1); PG8_STAGE(PG8_SA(0, 0), a2, voffA);
            PG8_BAR; PG8_WAIT_L(0); PG8_MMA(1, 0, At, B0); PG8_BAR; PG8_SCHED;
            PG8_STAGE(PG8_SB(0, 1), b2 + hstep, voffB);
            PG8_WAIT_V(6); PG8_BAR; PG8_MMA(1, 1, At, B1); PG8_BAR;
            PG8_LDB(B0, 1, 0); PG8_SCHED; PG8_LDA(At, 1, 0); PG8_STAGE(PG8_SA(0, 1), a2 + hstep, voffA);
            PG8_WAIT_L(8); PG8_BAR; PG8_WAIT_L(0); PG8_MMA(0, 0, At, B0); PG8_BAR; PG8_SCHED;
            PG8_LDB(B1, 1, 1); PG8_STAGE(PG8_SB(1, 0), b3, voffB);
            PG8_BAR; PG8_WAIT_L(0); PG8_MMA(0, 1, At, B1); PG8_BAR;
            PG8_LDA(At, 1, 1); PG8_STAGE(PG8_SA(1, 0), a3, voffA);
            PG8_BAR; PG8_WAIT_L(0); PG8_MMA(1, 0, At, B0); PG8_BAR; PG8_SCHED;
            PG8_STAGE(PG8_SB(1, 1), b3 + hstep, voffB);
            PG8_WAIT_V(6); PG8_BAR; PG8_MMA(1, 1, At, B1); PG8_BAR;
            }
        }
        if constexpr (ALIGN_EPI) { if (wr == 0) PG8_BAR; }
        if constexpr (!Epi::AFTER_DRAIN) { E(acc, cur, wr, wc, fr, fq); S.done(cur); }
        if (!has_next) break;
#pragma unroll
        for (int a = 0; a < 2; ++a)
#pragma unroll
            for (int b = 0; b < 2; ++b)
#pragma unroll
                for (int m = 0; m < 4; ++m)
#pragma unroll
                    for (int n = 0; n < 2; ++n) acc[a][b][m][n] = (f32x4){0.f, 0.f, 0.f, 0.f};
        cur = nxt; cA = nA; cB = nB; ++ui;
        if constexpr (ALIGN_EPI) { if (wr == 1) PG8_BAR; }
    }
    PG8_WAIT_V(0);
    if constexpr (!ALIGN_EPI) { if (wr == 0) PG8_BAR; }
    PG8_BAR;
    if constexpr (Epi::AFTER_DRAIN) { E.fused(acc, cur, wr, wc, fr, fq, lds, wid, lane); S.done(cur); }
#undef PG8_SA
#undef PG8_SB
#undef PG8_STAGE
#undef PG8_LDA
#undef PG8_LDB
#undef PG8_MMA
#undef PG8_WAIT_V
#undef PG8_WAIT_L
#undef PG8_BAR
#undef PG8_SCHED
}
}
namespace pg8 {
template <class Epi, class Sched>
__device__ __forceinline__ void gemm_dual_phase(PG8_LAS unsigned char* lds, const bf16_t* A0, const bf16_t* Bt0, int K0, const bf16_t* A1, const bf16_t* Bt1, int K1, const Sched& S, const Epi& E) {
    const int tid = tid_fresh(), wid = __builtin_amdgcn_readfirstlane(tid >> 6), lane = tid & 63, wr = wid >> 2, wc = wid & 3, fr = lane & 15, fq = lane >> 4;
    unsigned vA0_0, vA0_1, vB0_0, vB0_1, vA1_0, vA1_1, vB1_0, vB1_1;
    { int R, C; stage_rc(tid * 16, R, C); const int Rb = (R & ~31) + perm32(R & 31);
      vA0_0 = (unsigned)(R * K0 + C) * 2u; vB0_0 = (unsigned)(Rb * K0 + C) * 2u; vA1_0 = (unsigned)(R * K1 + C) * 2u; vB1_0 = (unsigned)(Rb * K1 + C) * 2u; }
    { int R, C; stage_rc(tid * 16 + 8192, R, C); const int Rb = (R & ~31) + perm32(R & 31);
      vA0_1 = (unsigned)(R * K0 + C) * 2u; vB0_1 = (unsigned)(Rb * K0 + C) * 2u; vA1_1 = (unsigned)(R * K1 + C) * 2u; vB1_1 = (unsigned)(Rb * K1 + C) * 2u; }
    const size_t kstep = (size_t)(BK * 2);
    const size_t hst0 = (size_t)HALF * K0 * 2, hst1 = (size_t)HALF * K1 * 2;
    const unsigned ldsw = (unsigned)wid * 1024u;
    const int aoff = lds_byte(wr * 64 + fr, fq * 8), boff = lds_byte(wc * 32 + fr, fq * 8);
#define PG8_SA(b, h) (((b) * 2 + (h)) * HTB)
#define PG8_SB(b, h) ((4 + (b) * 2 + (h)) * HTB)
#define PG8_STAGE2(bufoff, gbase, v0, v1) do { \
        __builtin_amdgcn_global_load_lds((const unsigned*)((const char*)(gbase) + (v0)), (PG8_LAS unsigned*)(lds + (bufoff) + ldsw), 16, 0, 0); \
        __builtin_amdgcn_global_load_lds((const unsigned*)((const char*)(gbase) + (v1)), (PG8_LAS unsigned*)(lds + (bufoff) + ldsw + 8192), 16, 0, 0); } while (0)
#define PG8_LDA(dst, b, h) do { _Pragma("unroll") for (int m = 0; m < 4; ++m) _Pragma("unroll") for (int k = 0; k < 2; ++k) dst[m][k] = *(const PG8_LAS bf16x8*)(lds + PG8_SA(b, h) + aoff + m * 2048 + k * 1024); } while (0)
#define PG8_LDB(dst, b, h) do { _Pragma("unroll") for (int n = 0; n < 2; ++n) _Pragma("unroll") for (int k = 0; k < 2; ++k) dst[n][k] = *(const PG8_LAS bf16x8*)(lds + PG8_SB(b, h) + boff + n * 2048 + k * 1024); } while (0)
#define PG8_MMA(ai, bj, At, Bt) do { __builtin_amdgcn_s_setprio(1); _Pragma("unroll") for (int m = 0; m < 4; ++m) _Pragma("unroll") for (int n = 0; n < 2; ++n) _Pragma("unroll") for (int k = 0; k < 2; ++k) \
        acc[ai][bj][m][n] = __builtin_amdgcn_mfma_f32_16x16x32_bf16(Bt[n][k], At[m][k], acc[ai][bj][m][n], 0, 0, 0); __builtin_amdgcn_s_setprio(0); } while (0)
#define PG8_WAIT_V(n) asm volatile("s_waitcnt vmcnt(" #n ")" ::: "memory")
#define PG8_WAIT_L(n) asm volatile("s_waitcnt lgkmcnt(" #n ")" ::: "memory")
#define PG8_BAR __builtin_amdgcn_s_barrier()
#define PG8_SCHED __builtin_amdgcn_sched_barrier(0)
    Unit cur, nxt; int ui = 0;
    if (!S.next(0, cur)) return;
    f32x4 acc[2][2][4][2];
#pragma unroll
    for (int a = 0; a < 2; ++a)
#pragma unroll
        for (int b = 0; b < 2; ++b)
#pragma unroll
            for (int m = 0; m < 4; ++m)
#pragma unroll
                for (int n = 0; n < 2; ++n) acc[a][b][m][n] = (f32x4){0.f, 0.f, 0.f, 0.f};
    bf16x8 At[4][2], B0[2][2], B1[2][2];
    int ty = 0;
    const char* cA = (const char*)A0 + (size_t)cur.pm * (2 * hst0); const char* cB = (const char*)Bt0 + (size_t)cur.pn * (2 * hst0);
    PG8_STAGE2(PG8_SB(0, 0), cB, vB0_0, vB0_1); PG8_STAGE2(PG8_SB(0, 1), cB + hst0, vB0_0, vB0_1); PG8_STAGE2(PG8_SA(0, 0), cA, vA0_0, vA0_1); PG8_STAGE2(PG8_SA(0, 1), cA + hst0, vA0_0, vA0_1);
    if (wr == 1) PG8_BAR;
    PG8_WAIT_V(2); PG8_BAR;
    PG8_STAGE2(PG8_SB(1, 0), cB + kstep, vB0_0, vB0_1); PG8_STAGE2(PG8_SA(1, 0), cA + kstep, vA0_0, vA0_1); PG8_STAGE2(PG8_SB(1, 1), cB + hst0 + kstep, vB0_0, vB0_1);
    PG8_WAIT_V(6); PG8_BAR;
    for (;;) {
        const bool has_next = (ty == 0) ? true : S.next(ui + 1, nxt);
        const int pty = has_next ? (ty ^ 1) : ty;
        const int npm = (ty == 0) ? cur.pm : nxt.pm, npn = (ty == 0) ? cur.pn : nxt.pn;
        const size_t hsc = ty ? hst1 : hst0, hsn = pty ? hst1 : hst0;
        const char* nA = has_next ? (const char*)(pty ? A1 : A0) + (size_t)npm * (2 * hsn) : cA;
        const char* nB = has_next ? (const char*)(pty ? Bt1 : Bt0) + (size_t)npn * (2 * hsn) : cB;
        const unsigned vAc0 = ty ? vA1_0 : vA0_0, vAc1 = ty ? vA1_1 : vA0_1, vBc0 = ty ? vB1_0 : vB0_0, vBc1 = ty ? vB1_1 : vB0_1;
        const unsigned vAn0 = pty ? vA1_0 : vA0_0, vAn1 = pty ? vA1_1 : vA0_1, vBn0 = pty ? vB1_0 : vB0_0, vBn1 = pty ? vB1_1 : vB0_1;
        const int nt = (ty ? K1 : K0) / BK;
        for (int t = 0; t < nt; t += 2) {
            const bool last = (t == nt - 2);
            const char* a1 = cA + (size_t)(t + 1) * kstep;
            const char* a2 = last ? nA : cA + (size_t)(t + 2) * kstep; const char* b2 = last ? nB : cB + (size_t)(t + 2) * kstep;
            const char* a3 = a2 + kstep; const char* b3 = b2 + kstep;
            const size_t hs2 = last ? hsn : hsc;
            const unsigned wA0 = last ? vAn0 : vAc0, wA1 = last ? vAn1 : vAc1, wB0 = last ? vBn0 : vBc0, wB1 = last ? vBn1 : vBc1;
            PG8_LDB(B0, 0, 0); PG8_LDB(B1, 0, 1); PG8_SCHED; PG8_LDA(At, 0, 0); PG8_STAGE2(PG8_SA(1, 1), a1 + hsc, vAc0, vAc1);
            PG8_WAIT_V(8); PG8_WAIT_L(0); PG8_BAR; PG8_MMA(0, 0, At, B0); PG8_MMA(0, 1, At, B1); PG8_BAR; PG8_SCHED;
            PG8_LDA(At, 0, 1); PG8_STAGE2(PG8_SB(0, 0), b2, wB0, wB1); PG8_STAGE2(PG8_SB(0, 1), b2 + hs2, wB0, wB1); PG8_STAGE2(PG8_SA(0, 0), a2, wA0, wA1);
            PG8_WAIT_V(8); PG8_WAIT_L(0); PG8_BAR; PG8_MMA(1, 0, At, B0); PG8_MMA(1, 1, At, B1); PG8_BAR; PG8_SCHED;
            PG8_LDB(B0, 1, 0); PG8_LDB(B1, 1, 1); PG8_SCHED; PG8_LDA(At, 1, 0); PG8_STAGE2(PG8_SA(0, 1), a2 + hs2, wA0, wA1);
            PG8_WAIT_V(8); PG8_WAIT_L(0); PG8_BAR; PG8_MMA(0, 0, At, B0); PG8_MMA(0, 1, At, B1); PG8_BAR; PG8_SCHED;
            PG8_LDA(At, 1, 1); PG8_STAGE2(PG8_SB(1, 0), b3, wB0, wB1); PG8_STAGE2(PG8_SB(1, 1), b3 + hs2, wB0, wB1); PG8_STAGE2(PG8_SA(1, 0), a3, wA0, wA1);
            PG8_WAIT_V(8); PG8_WAIT_L(0); PG8_BAR; PG8_MMA(1, 0, At, B0); PG8_MMA(1, 1, At, B1); PG8_BAR; PG8_SCHED;
        }
        if (wr == 0) PG8_BAR;
        if (ty == 0) E.mid(acc, cur, wr, wc, fr, fq); else E(acc, cur, wr, wc, fr, fq);
        if (!has_next) break;
        if (ty == 1) {
#pragma unroll
            for (int a = 0; a < 2; ++a)
#pragma unroll
                for (int b = 0; b < 2; ++b)
#pragma unroll
                    for (int m = 0; m < 4; ++m)
#pragma unroll
                        for (int n = 0; n < 2; ++n) acc[a][b][m][n] = (f32x4){0.f, 0.f, 0.f, 0.f};
            cur = nxt; ++ui;
        }
        ty ^= 1; cA = nA; cB = nB;
        if (wr == 1) PG8_BAR;
    }
    PG8_WAIT_V(0);
    PG8_BAR;
#undef PG8_SA
#undef PG8_SB
#undef PG8_STAGE2
#undef PG8_LDA
#undef PG8_LDB
#undef PG8_MMA
#undef PG8_WAIT_V
#undef PG8_WAIT_L
#undef PG8_BAR
#undef PG8_SCHED
}
}

#define GAS __attribute__((address_space(1)))
#define LAS __attribute__((address_space(3)))
typedef unsigned short bf16;
typedef unsigned v4u __attribute__((ext_vector_type(4)));
typedef float f32x4 __attribute__((ext_vector_type(4)));
typedef short bf16x8 __attribute__((ext_vector_type(8)));
typedef GAS unsigned gu32;
typedef GAS unsigned long long gu64;
#define RLX_AGENT __ATOMIC_RELAXED, __HIP_MEMORY_SCOPE_AGENT
#define LDS_WAIT() asm volatile("s_waitcnt lgkmcnt(0)" ::: "memory")
#define VM_WAIT() asm volatile("s_waitcnt vmcnt(0)" ::: "memory")
__device__ __forceinline__ unsigned long long rt() { return __builtin_amdgcn_s_memrealtime(); }
__device__ __forceinline__ unsigned f2bf(float f) { unsigned u = __builtin_bit_cast(unsigned, f); return (u + 0x7fffu + ((u >> 16) & 1u)) >> 16; }
__device__ __forceinline__ unsigned pk2(float lo, float hi) { return f2bf(lo) | (f2bf(hi) << 16); }

#define XB_TMO      128
#define XB_XCNT(j)  (256  + 64 * (j))
#define XB_XSUB(j)  (1280 + 64 * (j))
#define XB_XGEN(j)  (2304 + 64 * (j))
#define XB_TOP      3328
#define XB_TOPGEN   3392
#define XCD_BAR_WORDS 3456
#define XB_SPIN_CAP (1u << 18)

__device__ __forceinline__ unsigned xb_ld(unsigned* p)              { return __hip_atomic_load(p, __ATOMIC_RELAXED, __HIP_MEMORY_SCOPE_AGENT); }
__device__ __forceinline__ unsigned xb_add(unsigned* p, unsigned v) { return __hip_atomic_fetch_add(p, v, __ATOMIC_RELAXED, __HIP_MEMORY_SCOPE_AGENT); }
__device__ __forceinline__ unsigned xb_xcc_id() { return (unsigned)__builtin_amdgcn_s_getreg((3 << 11) | 20) & 0xFu; }
#define XB_SPIN(cond, bar) do { unsigned _sp = 0; while (cond) { __builtin_amdgcn_s_sleep(1); \
    if ((++_sp & 255u) == 0u) { if (xb_ld(&(bar)[XB_TMO])) break; if (_sp > XB_SPIN_CAP) { atomicAdd(&(bar)[XB_TMO], 1u); break; } } } } while (0)

struct XcdBarrier {
    unsigned* bar; unsigned x;
    volatile LAS unsigned* st;
};

__device__ __forceinline__ XcdBarrier xcd_barrier_post(unsigned* bar, volatile LAS unsigned* st) {
    XcdBarrier b; b.bar = bar; b.x = xb_xcc_id(); b.st = st;
    if (threadIdx.x == 0) (void)xb_add(&bar[XB_XCNT(b.x)], 1u);
    return b;
}
__device__ __forceinline__ void xcd_barrier_complete(unsigned* bar, unsigned x, unsigned& nloc, unsigned& nx) {
    const unsigned G = gridDim.x * gridDim.y * gridDim.z;
    unsigned sum, cnt, mine, sp = 0u;
    for (;;) {
        sum = 0u; cnt = 0u; mine = 0u;
#pragma unroll
        for (unsigned j = 0; j < 16; ++j) { const unsigned c = xb_ld(&bar[XB_XCNT(j)]); sum += c; cnt += (c > 0u) ? 1u : 0u; mine = (j == x) ? c : mine; }
        if (sum == G) break;
        __builtin_amdgcn_s_sleep(1);
        if ((++sp & 255u) == 0u) { if (xb_ld(&bar[XB_TMO])) break; if (sp > XB_SPIN_CAP) { atomicAdd(&bar[XB_TMO], 1u); break; } }
    }
    nloc = mine > 0u ? mine : 1u; nx = cnt > 0u ? cnt : 1u;
}

__device__ __forceinline__ void xcd_barrier(const XcdBarrier& b) {
    asm volatile("s_waitcnt vmcnt(0)" ::: "memory");
    __syncthreads();
    if (threadIdx.x == 0) {
        unsigned* bar = b.bar;
        __builtin_amdgcn_s_waitcnt(0);
        unsigned nloc = b.st[0], nx = b.st[1];
        if (nloc == 0u) { xcd_barrier_complete(bar, b.x, nloc, nx); b.st[0] = nloc; b.st[1] = nx; }
        const unsigned old = xb_add(&bar[XB_XSUB(b.x)], 1u);
        const unsigned gen = old / nloc;
        if (old + 1u == (gen + 1u) * nloc) {
            __builtin_amdgcn_fence(__ATOMIC_RELEASE, "agent");
            asm volatile("s_waitcnt vmcnt(0)" ::: "memory");
            const unsigned og = xb_add(&bar[XB_TOP], 1u);
            const unsigned tg = og / nx;
            if (og + 1u == (tg + 1u) * nx) xb_add(&bar[XB_TOPGEN], 1u);
            else XB_SPIN(xb_ld(&bar[XB_TOPGEN]) == tg, bar);
            __builtin_amdgcn_fence(__ATOMIC_ACQUIRE, "agent");
            xb_add(&bar[XB_XGEN(b.x)], 1u);
            asm volatile("s_waitcnt vmcnt(0)" ::: "memory");
        } else {
            XB_SPIN(xb_ld(&bar[XB_XGEN(b.x)]) == gen, bar);
            __builtin_amdgcn_fence(__ATOMIC_ACQUIRE, "agent");
            asm volatile("s_waitcnt vmcnt(0)" ::: "memory");
        }
    }
    __syncthreads();
}

namespace att {
constexpr int D = 128;
constexpr float THR = 8.f;
constexpr bool WSKIP = false;
constexpr float SCALE = 0.08838834764831845f;
constexpr int NW = 8, QBLK = 32, KVBLK = 64, QB = NW * QBLK;
constexpr int SHM_V = KVBLK * D * 2, SHM_K = KVBLK * D * 2;
constexpr int LDS_BYTES = 2 * SHM_V + 2 * SHM_K + NW * 64 * 4;
typedef short bf16x8 __attribute__((ext_vector_type(8)));
typedef short s16x4 __attribute__((ext_vector_type(4)));
typedef float f32x16 __attribute__((ext_vector_type(16)));
typedef float f32x4 __attribute__((ext_vector_type(4)));
typedef unsigned u32x4 __attribute__((ext_vector_type(4)));
template <class A, class Bt> struct same_t { static constexpr bool v = false; };
template <class A> struct same_t<A, A> { static constexpr bool v = true; };

#define KSWZ(row, colB) ((row) * 256 + ((colB) ^ (((row) & 7) << 4)))
#define SBAR() __builtin_amdgcn_sched_barrier(0)
__device__ __forceinline__ int v_st(int k, int c) { const int kk = (k & ~0xC) | ((k & 4) << 1) | ((k & 8) >> 1); return ((kk >> 3) * 4 + (c >> 5)) * 512 + ((kk & 7) * 32 + (c & 31)) * 2; }
__device__ __forceinline__ int v_rd_base(int lane) { return ((lane & 3) << 3) | (((lane >> 2) & 3) << 6) | (((lane >> 4) & 1) << 5) | (((lane >> 5) & 1) << 8); }
constexpr int v_rd_off(int d0, int ks, int half) { return d0 * 512 + ks * 4096 + half * 2048; }
__device__ __forceinline__ int crow(int r, int hi) { return (r & 3) + 8 * (r >> 2) + 4 * hi; }
__device__ __forceinline__ unsigned cvtpk(float lo, float hi) {
    unsigned r; asm volatile("v_cvt_pk_bf16_f32 %0, %1, %2" : "=v"(r) : "v"(lo), "v"(hi)); return r;
}
__device__ __forceinline__ bf16x8 pack8(f32x4 a, f32x4 b) {
    u32x4 w = {cvtpk(a[0], a[1]), cvtpk(a[2], a[3]), cvtpk(b[0], b[1]), cvtpk(b[2], b[3])};
    return *reinterpret_cast<bf16x8*>(&w);
}
template <class T> __device__ __forceinline__ bf16x8 load8(const T* p) {
    if constexpr (same_t<T, float>::v) { return pack8(*(const f32x4*)p, *(const f32x4*)(p + 4)); }
    else { return *reinterpret_cast<const bf16x8*>(p); }
}
__device__ __forceinline__ void mask_tile(f32x16& p0, f32x16& p1, int dq, unsigned W) {
    const float NEG = -__builtin_inff();
#pragma unroll
    for (int r = 0; r < 16; ++r) {
        const int c = (r & 3) + 8 * (r >> 2);
        if ((unsigned)(dq - c) >= W) p0[r] = NEG;
        if ((unsigned)(dq - c - 32) >= W) p1[r] = NEG;
    }
}
__device__ __forceinline__ void partialSM(f32x16& p0, f32x16& p1, float& m_reg, float& mn, float& alpha) {
    float pmax = p0[0]; for (int r = 1; r < 16; ++r) pmax = fmaxf(pmax, p0[r]); for (int r = 0; r < 16; ++r) pmax = fmaxf(pmax, p1[r]);
    { auto rr = __builtin_amdgcn_permlane32_swap(__float_as_uint(pmax), __float_as_uint(pmax), false, false);
      pmax = fmaxf(__uint_as_float(rr[0]), __uint_as_float(rr[1])); }
    constexpr float C2 = 1.4426950408889634f * SCALE;
    if (__builtin_expect(__all((pmax - m_reg) * SCALE <= THR), 1)) { mn = m_reg; alpha = 1.f; }
    else { mn = fmaxf(m_reg, pmax); alpha = __builtin_amdgcn_exp2f((m_reg - mn) * C2); m_reg = mn; }
    const float mnL = -mn * C2;
    for (int r = 0; r < 16; ++r) p0[r] = fmaf(p0[r], C2, mnL); for (int r = 0; r < 16; ++r) p1[r] = fmaf(p1[r], C2, mnL);
    for (int r = 0; r < 16; ++r) p0[r] = __builtin_amdgcn_exp2f(p0[r]);
}
__device__ __forceinline__ void finishSM(f32x16& p0, f32x16& p1, float alpha, float& l_reg, bf16x8& pa0, bf16x8& pa1, bf16x8& pa2, bf16x8& pa3) {
    for (int r = 0; r < 16; ++r) p1[r] = __builtin_amdgcn_exp2f(p1[r]);
    float ps = 0; for (int r = 0; r < 16; ++r) ps += p0[r]; for (int r = 0; r < 16; ++r) ps += p1[r];
    { auto rr = __builtin_amdgcn_permlane32_swap(__float_as_uint(ps), __float_as_uint(ps), false, false);
      ps = __uint_as_float(rr[0]) + __uint_as_float(rr[1]); }
    l_reg = l_reg * alpha + ps;
#define PK4(P, B_, OUT) do { unsigned a0 = cvtpk(P[B_+0], P[B_+1]), a1 = cvtpk(P[B_+2], P[B_+3]);                          \
        unsigned b0 = cvtpk(P[B_+4], P[B_+5]), b1 = cvtpk(P[B_+6], P[B_+7]);                                             \
        auto r0 = __builtin_amdgcn_permlane32_swap(a0, b0, false, false); auto r1 = __builtin_amdgcn_permlane32_swap(a1, b1, false, false); \
        u32x4 w = {r0[0], r1[0], r0[1], r1[1]}; OUT = *reinterpret_cast<bf16x8*>(&w); } while (0)
    PK4(p0, 0, pa0); PK4(p0, 8, pa1); PK4(p1, 0, pa2); PK4(p1, 8, pa3);
#undef PK4
}
template <int KB, bool SK>
__device__ __forceinline__ void qkt(f32x16& p0, f32x16& p1, const char* K_lds, int r32, int hi, const bf16x8* qr, bool act) {
    if (SK && !act) { const float NEG = -__builtin_inff();
#pragma unroll
        for (int r = 0; r < 16; ++r) { p0[r] = NEG; p1[r] = NEG; } return; }
    p0 = f32x16{}; p1 = f32x16{};
    const char* kb[4];
#pragma unroll
    for (int dd = 0; dd < 4; ++dd) kb[dd] = K_lds + KB * SHM_K + KSWZ(r32, (dd * 16 + hi * 8) * 2);
#pragma unroll
    for (int d0 = 0; d0 < 8; ++d0) { const char* a = kb[d0 & 3] + (d0 >> 2) * 128;
        bf16x8 b0 = *reinterpret_cast<const bf16x8*>(a);
        bf16x8 b1 = *reinterpret_cast<const bf16x8*>(a + 32 * 256);
        p0 = __builtin_amdgcn_mfma_f32_32x32x16_bf16(b0, qr[d0], p0, 0, 0, 0);
        p1 = __builtin_amdgcn_mfma_f32_32x32x16_bf16(b1, qr[d0], p1, 0, 0, 0); }
}
template <int VB, bool SK>
__device__ __forceinline__ void pv_tile(f32x16* o, int vb0, bf16x8 pa0, bf16x8 pa1, bf16x8 pa2, bf16x8 pa3, bool act) {
    if (SK && !act) return;
#define TRRD(dst, off) asm volatile("ds_read_b64_tr_b16 %0, %1 offset:%2" : "=&v"(dst) : "v"(vb0), "i"(off) : "memory")
#define PV_D0(d0) do { s16x4 l0, l1, l2, l3, h0, h1, h2, h3; constexpr int b_ = VB * SHM_V + v_rd_off(d0, 0, 0);     \
        TRRD(l0, b_); TRRD(h0, b_ + 2048); TRRD(l1, b_ + 4096); TRRD(h1, b_ + 6144); TRRD(l2, b_ + 8192); TRRD(h2, b_ + 10240); TRRD(l3, b_ + 12288); TRRD(h3, b_ + 14336); \
        asm volatile("s_waitcnt lgkmcnt(0)" ::: "memory"); SBAR();                 \
        o[d0] = __builtin_amdgcn_mfma_f32_32x32x16_bf16(pa0, (bf16x8){l0[0], l0[1], l0[2], l0[3], h0[0], h0[1], h0[2], h0[3]}, o[d0], 0, 0, 0);   \
        o[d0] = __builtin_amdgcn_mfma_f32_32x32x16_bf16(pa1, (bf16x8){l1[0], l1[1], l1[2], l1[3], h1[0], h1[1], h1[2], h1[3]}, o[d0], 0, 0, 0);   \
        o[d0] = __builtin_amdgcn_mfma_f32_32x32x16_bf16(pa2, (bf16x8){l2[0], l2[1], l2[2], l2[3], h2[0], h2[1], h2[2], h2[3]}, o[d0], 0, 0, 0);   \
        o[d0] = __builtin_amdgcn_mfma_f32_32x32x16_bf16(pa3, (bf16x8){l3[0], l3[1], l3[2], l3[3], h3[0], h3[1], h3[2], h3[3]}, o[d0], 0, 0, 0); } while (0)
    PV_D0(0); PV_D0(1); PV_D0(2); PV_D0(3);
#undef PV_D0
#undef TRRD
}

template <class TIn, class TOut> struct BlockRef { const TIn* Q; const TIn* K; const TIn* V; TOut* O; int P0; };
template <class TIn> struct Seam {
    bf16x8 qr[8];
    bf16x8 st_v0, st_v1, st_k0, st_k1; f32x4 sf0, sf1, sf2, sf3;
    f32x4 tq[16];
};
__device__ __forceinline__ int swa_jlo(int P0, int W) { const int lowk = P0 - W + 1; return lowk > 0 ? lowk / KVBLK : 0; }
#define ROW(p, k0, rr) ((p) + (size_t)((k0) + (rr)) * D + sc)
#define VMW() asm volatile("s_waitcnt vmcnt(0)" ::: "memory")
#define VMWN(n) asm volatile("s_waitcnt vmcnt(%0)" :: "i"(n) : "memory")
#define SLOAD_H(Kp, Vp, k0) do { S.st_v0 = load8<TIn>(ROW(Vp, k0, sr)); S.st_v1 = load8<TIn>(ROW(Vp, k0, 32 + sr));              \
                         S.st_k0 = load8<TIn>(ROW(Kp, k0, sr)); S.st_k1 = load8<TIn>(ROW(Kp, k0, 32 + sr)); } while (0)
#define SWRITE_HK(bf) do { *(bf16x8*)(K_lds + (bf) * SHM_K + kws) = S.st_k0; *(bf16x8*)(K_lds + (bf) * SHM_K + kws + 32 * 256) = S.st_k1; } while (0)
#define SWRITE_HV(bf) do { *(bf16x8*)(V_lds + (bf) * SHM_V + vst0) = S.st_v0; *(bf16x8*)(V_lds + (bf) * SHM_V + vst1) = S.st_v1; } while (0)
#define SWRITE_H(bf) do { SWRITE_HV(bf); SWRITE_HK(bf); } while (0)
#define SLOAD_F(p, k0) do { S.sf0 = *(const f32x4*)ROW(p, k0, sr); S.sf1 = *(const f32x4*)(ROW(p, k0, sr) + 4);                \
                            S.sf2 = *(const f32x4*)ROW(p, k0, 32 + sr); S.sf3 = *(const f32x4*)(ROW(p, k0, 32 + sr) + 4); } while (0)
#define SWRITE_KF(bf) do { *(bf16x8*)(K_lds + (bf) * SHM_K + kws) = pack8(S.sf0, S.sf1); *(bf16x8*)(K_lds + (bf) * SHM_K + kws + 32 * 256) = pack8(S.sf2, S.sf3); } while (0)
#define SWRITE_VF(bf) do { *(bf16x8*)(V_lds + (bf) * SHM_V + vst0) = pack8(S.sf0, S.sf1); *(bf16x8*)(V_lds + (bf) * SHM_V + vst1) = pack8(S.sf2, S.sf3); } while (0)
template <class TIn, class TOut>
__device__ __forceinline__ void causal_swa_prime(const BlockRef<TIn, TOut>& cur, int W, char* lds, Seam<TIn>& S) {
    constexpr bool F32 = same_t<TIn, float>::v;
    const int tid = tid_fresh(), wid = __builtin_amdgcn_readfirstlane(tid >> 6), lane = tid & 63, r32 = lane & 31, hi = lane >> 5;
    const int sr = tid >> 4, sc = (tid & 15) * 8, kws = KSWZ(sr, sc * 2); char* K_lds = lds + 2 * SHM_V;
    const int kb0 = swa_jlo(cur.P0, W) * KVBLK;
    for (int d0 = 0; d0 < 8; ++d0) S.qr[d0] = load8<TIn>(cur.Q + (size_t)(wid * QBLK + r32) * D + d0 * 16 + hi * 8);
    if constexpr (F32) { SLOAD_F((const float*)cur.K, kb0); VMW(); SWRITE_KF(0); SBAR(); SLOAD_F((const float*)cur.V, kb0); }
    else { SLOAD_H(cur.K, cur.V, kb0); VMW(); SWRITE_HK(0); }
    __syncthreads();
}
template <class TIn, class TOut>
__device__ __forceinline__ void causal_swa_block(const BlockRef<TIn, TOut>& cur, const BlockRef<TIn, TOut>& nxt, int skv, int W, char* lds, Seam<TIn>& S) {
    constexpr bool F32 = same_t<TIn, float>::v;
    const int tid = tid_fresh(), wid = __builtin_amdgcn_readfirstlane(tid >> 6), lane = tid & 63, r32 = lane & 31, hi = lane >> 5;
    const int j_lo = swa_jlo(cur.P0, W);
    int j_hi = (cur.P0 + QB - 1) / KVBLK + 1; if (j_hi > skv / KVBLK) j_hi = skv / KVBLK;
    const int NT = j_hi - j_lo;
    const int kbn = swa_jlo(nxt.P0, W) * KVBLK;
    const int qlo = cur.P0 + wid * QBLK, qm = qlo + r32 - 4 * hi;
    char* V_lds = lds; char* K_lds = lds + 2 * SHM_V;
    float* ws = (float*)(lds + 2 * SHM_V + 2 * SHM_K) + wid * 64; float* li_l = ws, * al_l = ws + 32;
    float m_reg = -1e30f, l_reg = 0; f32x16 o[4] = {};
    const int sr = tid >> 4, sc = (tid & 15) * 8, vst0 = v_st(sr, sc), vst1 = v_st(32 + sr, sc), kws = KSWZ(sr, sc * 2);
    const int vb0 = (int)(uintptr_t)V_lds + v_rd_base(lane);
    const TIn* Kh = cur.K; const TIn* Vh = cur.V;
#define RESC(a) do { if (__any((a) < 1.f)) { if (hi == 0) al_l[r32] = (a); asm volatile("s_waitcnt lgkmcnt(0)" ::: "memory");              \
                     for (int d_ = 0; d_ < 4; ++d_) for (int r = 0; r < 16; ++r) o[d_][r] *= al_l[crow(r, hi)]; } } while (0)
#define KBASE(t) ((j_lo + (t)) * KVBLK)
#define ACT(t) (KBASE(t) <= qlo + QBLK - 1 && KBASE(t) + KVBLK - 1 >= qlo - W + 1)
#define MASKT(P0_, P1_, t) do { const int kb_ = KBASE(t); if ((!SK || ACT(t)) && (kb_ + KVBLK - 1 > qlo || kb_ <= qlo + QBLK - 1 - W)) mask_tile(P0_, P1_, qm - kb_, (unsigned)W); } while (0)
    constexpr int NQL = F32 ? 16 : 8;
    constexpr bool SK = WSKIP && !F32;
#define SEAM_K0() do { VMWN(NQL); if constexpr (F32) { SWRITE_KF(0); SBAR(); SLOAD_F((const float*)nxt.V, kbn); } else { SWRITE_HK(0); } SBAR(); } while (0)
    f32x16 pA0, pA1, pB0, pB1; float mnA, mnB, alA, alB; bf16x8 pa0, pa1, pa2, pa3;
    if constexpr (F32) { VMW(); SWRITE_VF(0); SBAR(); } else { SWRITE_HV(0); SBAR(); }
    if (NT > 1) { if constexpr (F32) SLOAD_F((const float*)Kh, KBASE(1)); else SLOAD_H(Kh, Vh, KBASE(1)); }
    SBAR(); qkt<0, SK>(pA0, pA1, K_lds, r32, hi, S.qr, ACT(0));
    if constexpr (F32) { if (NT > 1) { VMW(); SWRITE_KF(1); SBAR(); SLOAD_F((const float*)Vh, KBASE(1)); } }
    MASKT(pA0, pA1, 0); partialSM(pA0, pA1, m_reg, mnA, alA);
    if (NT > 1) { VMW(); if constexpr (F32) { SWRITE_VF(1); SBAR(); if (NT > 2) SLOAD_F((const float*)Kh, KBASE(2)); } else SWRITE_H(1); }
    __syncthreads();
#define HALF_STEP(PX0, PX1, mnX, alX, PY0, PY1, alY, t, KB, VB, SB) do {                                                      \
        SBAR(); qkt<KB, SK>(PX0, PX1, K_lds, r32, hi, S.qr, ACT(t));                                             \
        finishSM(PY0, PY1, alY, l_reg, pa0, pa1, pa2, pa3); SBAR();                                                           \
        if ((t) + 1 < NT) { if constexpr (F32) { VMW(); SWRITE_KF(SB); SBAR(); SLOAD_F((const float*)Vh, KBASE((t) + 1)); }  \
                            else { SLOAD_H(Kh, Vh, KBASE((t) + 1)); } SBAR(); }                                               \
        pv_tile<VB, SK>(o, vb0, pa0, pa1, pa2, pa3, ACT((t) - 1)); MASKT(PX0, PX1, (t)); partialSM(PX0, PX1, m_reg, mnX, alX);                                        \
        __syncthreads();                                                                                                      \
        if ((t) + 1 < NT) { VMW(); if constexpr (F32) { SWRITE_VF(SB); SBAR(); if ((t) + 2 < NT) SLOAD_F((const float*)Kh, KBASE((t) + 2)); } \
                            else { SWRITE_H(SB); } }                                                                          \
        RESC(alX); __syncthreads(); } while (0)
    for (int t = 1; t + 1 < NT; t += 2) {
        HALF_STEP(pB0, pB1, mnB, alB, pA0, pA1, alA, t, 1, 0, 0);
        HALF_STEP(pA0, pA1, mnA, alA, pB0, pB1, alB, t + 1, 0, 1, 1);
    }
    const bool even = (NT & 1) == 0;
    if (even) { SBAR(); qkt<1, SK>(pB0, pB1, K_lds, r32, hi, S.qr, ACT(NT - 1)); SBAR(); }
#define QROW(e) (nxt.Q + (size_t)(wid * QBLK + r32) * D + ((e) >> 1) * 16 + hi * 8 + ((e) & 1) * 4)
    if constexpr (F32) { SLOAD_F((const float*)nxt.K, kbn); SBAR();
#pragma unroll
        for (int e = 0; e < 8; ++e) S.tq[e] = *(const f32x4*)QROW(e); }
    else { SLOAD_H(nxt.K, nxt.V, kbn); SBAR();
#pragma unroll
        for (int d0 = 0; d0 < 8; ++d0) S.qr[d0] = load8<TIn>(nxt.Q + (size_t)(wid * QBLK + r32) * D + d0 * 16 + hi * 8); }
    SBAR();
    finishSM(pA0, pA1, alA, l_reg, pa0, pa1, pa2, pa3); SBAR();
    if constexpr (F32) {
#pragma unroll
        for (int e = 8; e < 16; ++e) S.tq[e] = *(const f32x4*)QROW(e); SBAR(); }
#undef QROW
    pv_tile<0, SK>(o, vb0, pa0, pa1, pa2, pa3, ACT(even ? NT - 2 : NT - 1));
    if (even) { MASKT(pB0, pB1, NT - 1); partialSM(pB0, pB1, m_reg, mnB, alB); __syncthreads(); RESC(alB);
        finishSM(pB0, pB1, alB, l_reg, pa0, pa1, pa2, pa3); SBAR(); pv_tile<1, SK>(o, vb0, pa0, pa1, pa2, pa3, ACT(NT - 1)); }
    SBAR(); SEAM_K0();
    if (hi == 0) li_l[r32] = l_reg; asm volatile("s_waitcnt lgkmcnt(0)" ::: "memory");
    float rli[16];
#pragma unroll
    for (int r = 0; r < 16; ++r) rli[r] = __builtin_amdgcn_rcpf(li_l[crow(r, hi)]);
    TOut* Ow = cur.O + (size_t)(wid * QBLK) * D;
#pragma unroll
    for (int r = 0; r < 16; ++r) { const int orow = crow(r, hi);
#pragma unroll
        for (int d0 = 0; d0 < 4; ++d0) { const float v = o[d0][r] * rli[r];
            if constexpr (same_t<TOut, float>::v) { Ow[(size_t)orow * D + d0 * 32 + r32] = v; }
            else { const float vn = __shfl_xor(v, 1);
                   if ((r32 & 1) == 0) *(unsigned*)(Ow + (size_t)orow * D + d0 * 32 + r32) = cvtpk(v, vn); } } }
    if constexpr (F32) {
#pragma unroll
        for (int d0 = 0; d0 < 8; ++d0) S.qr[d0] = pack8(S.tq[2 * d0], S.tq[2 * d0 + 1]); }
    __syncthreads();
#undef RESC
#undef KBASE
#undef ACT
#undef MASKT
#undef SEAM_K0
#undef HALF_STEP
}
#undef ROW
#undef VMW
#undef VMWN
#undef SLOAD_H
#undef SWRITE_HK
#undef SWRITE_HV
#undef SWRITE_H
#undef SLOAD_F
#undef SWRITE_KF
#undef SWRITE_VF
constexpr int LDS256_V = 0, LDS256_K = 4 * SHM_V, LDS256_WS = LDS256_K + 2 * SHM_K, LDS256_BYTES = LDS256_WS + NW * 64 * 4;
template <bool COMB>
__device__ __forceinline__ void diff_attn_block(const unsigned short* Q, const unsigned short* K, const unsigned short* V0, const unsigned short* V1, unsigned short* O, int P0, int skv, char* lds,
                                                unsigned short* AOut, int AOP, float lam, const float* sl, float eps) {
    const int tid = tid_fresh(), wid = __builtin_amdgcn_readfirstlane(tid >> 6), lane = tid & 63, r32 = lane & 31, hi = lane >> 5;
    int NT = (P0 + QB - 1) / KVBLK + 1; if (NT > skv / KVBLK) NT = skv / KVBLK;
    const int qlo = P0 + wid * QBLK, qm = qlo + r32 - 4 * hi;
    char* V_lds = lds + LDS256_V; char* K_lds = lds + LDS256_K;
    float* ws = (float*)(lds + LDS256_WS) + wid * 64; float* li_l = ws, * al_l = ws + 32;
    float m_reg = -1e30f, l_reg = 0; f32x16 o[8] = {};
    const int vb0 = (int)(uintptr_t)V_lds + v_rd_base(lane);
    bf16x8 qr[8];
#pragma unroll
    for (int d0 = 0; d0 < 8; ++d0) qr[d0] = *reinterpret_cast<const bf16x8*>(Q + (size_t)(wid * QBLK + r32) * D + d0 * 16 + hi * 8);
    typedef __attribute__((address_space(3))) unsigned* ldsu_t;
    unsigned koff[2], voff[2];
#pragma unroll
    for (int i = 0; i < 2; ++i) { const int q = (2 * wid + i) * 64 + lane;
        { const int row = q >> 4, cs = q & 15; koff[i] = (unsigned)(row * 256 + ((cs ^ (row & 7)) << 4)); }
        { const int st = q >> 5, kk = 8 * (st >> 2) + ((q & 31) >> 2), k = (kk & ~0xC) | ((kk & 4) << 1) | ((kk & 8) >> 1), c = 32 * (st & 3) + 8 * (q & 3); voff[i] = (unsigned)(k * 256 + c * 2); } }
    const unsigned ldsw = (unsigned)wid * 2048u;
#define A256_DMA(t, bf) do { const size_t tb_ = (size_t)(t) * (KVBLK * D * 2); \
        _Pragma("unroll") for (int i = 0; i < 2; ++i) { \
            __builtin_amdgcn_global_load_lds((const unsigned*)((const char*)K + tb_ + koff[i]), (ldsu_t)(K_lds + (bf) * SHM_K + ldsw + i * 1024), 16, 0, 0); \
            __builtin_amdgcn_global_load_lds((const unsigned*)((const char*)V0 + tb_ + voff[i]), (ldsu_t)(V_lds + (2 * (bf)) * SHM_V + ldsw + i * 1024), 16, 0, 0); \
            __builtin_amdgcn_global_load_lds((const unsigned*)((const char*)V1 + tb_ + voff[i]), (ldsu_t)(V_lds + (2 * (bf) + 1) * SHM_V + ldsw + i * 1024), 16, 0, 0); } } while (0)
#define A256_RESC(a) do { if (__any((a) < 1.f)) { if (hi == 0) al_l[r32] = (a); asm volatile("s_waitcnt lgkmcnt(0)" ::: "memory"); \
        _Pragma("unroll") for (int d_ = 0; d_ < 8; ++d_) _Pragma("unroll") for (int r = 0; r < 16; ++r) o[d_][r] *= al_l[crow(r, hi)]; } } while (0)
#define A256_STEP(BUF, tt) do { \
        if ((tt) + 1 < NT) A256_DMA((tt) + 1, 1 - BUF); \
        f32x16 p0, p1; float mn, alpha; bf16x8 pa0, pa1, pa2, pa3; \
        SBAR(); qkt<BUF, false>(p0, p1, K_lds, r32, hi, qr, true); \
        { const int kb_ = (tt) * KVBLK; if (kb_ + KVBLK - 1 > qlo) mask_tile(p0, p1, qm - kb_, 1u << 30); } \
        partialSM(p0, p1, m_reg, mn, alpha); \
        finishSM(p0, p1, alpha, l_reg, pa0, pa1, pa2, pa3); SBAR(); \
        A256_RESC(alpha); \
        pv_tile<2 * BUF, false>(o, vb0, pa0, pa1, pa2, pa3, true); pv_tile<2 * BUF + 1, false>(o + 4, vb0, pa0, pa1, pa2, pa3, true); \
        __syncthreads(); } while (0)
    A256_DMA(0, 0);
    __syncthreads();
    if (wid >= 4) __builtin_amdgcn_s_setprio(1);
    for (int t = 0; t < NT; t += 2) {
        A256_STEP(0, t);
        if (t + 1 < NT) A256_STEP(1, t + 1);
    }
    if (wid >= 4) __builtin_amdgcn_s_setprio(0);
    if (hi == 0) li_l[r32] = l_reg; asm volatile("s_waitcnt lgkmcnt(0)" ::: "memory");
    float rli[16];
#pragma unroll
    for (int r = 0; r < 16; ++r) rli[r] = __builtin_amdgcn_rcpf(li_l[crow(r, hi)]);
#define A256_DPP(v_, ctrl_) __builtin_bit_cast(float, __builtin_amdgcn_update_dpp(0, __builtin_bit_cast(int, (float)(v_)), (ctrl_), 0xf, 0xf, true))
#define A256_SHX(v_, m_) __builtin_bit_cast(float, __builtin_amdgcn_ds_bpermute((lane ^ (m_)) << 2, __builtin_bit_cast(int, (float)(v_))))
    unsigned short* Ow = O + (size_t)(wid * QBLK) * 256;
    if constexpr (!COMB) {
#pragma unroll
        for (int j = 0; j < 16; ++j) { const int d0 = j >> 1, rb = (j & 1) * 8;
            u32x4 w; w.x = cvtpk(o[d0][rb] * rli[rb], o[d0][rb + 1] * rli[rb + 1]); w.y = cvtpk(o[d0][rb + 2] * rli[rb + 2], o[d0][rb + 3] * rli[rb + 3]);
            w.z = cvtpk(o[d0][rb + 4] * rli[rb + 4], o[d0][rb + 5] * rli[rb + 5]); w.w = cvtpk(o[d0][rb + 6] * rli[rb + 6], o[d0][rb + 7] * rli[rb + 7]);
            *(u32x4*)(Ow + (size_t)(j * 64 + lane) * 8) = w; }
    } else {
        float slv[8];
#pragma unroll
        for (int d0 = 0; d0 < 8; ++d0) slv[d0] = sl[d0 * 32 + r32];
        u32x4 pw[16];
#pragma unroll
        for (int j = 0; j < 16; ++j) pw[j] = *(const u32x4*)(Ow + (size_t)(j * 64 + lane) * 8);
#pragma unroll
        for (int r = 0; r < 16; ++r) { const int orow = crow(r, hi); float ss = 0.f;
#pragma unroll
            for (int d0 = 0; d0 < 8; ++d0) { const unsigned wv = pw[2 * d0 + (r >> 3)][(r & 7) >> 1]; const float o0 = (r & 1) ? __uint_as_float(wv & 0xffff0000u) : __uint_as_float(wv << 16);
                const float x = o0 - lam * (o[d0][r] * rli[r]); o[d0][r] = x; ss += x * x; }
            ss += A256_DPP(ss, 0xB1); ss += A256_DPP(ss, 0x4E); ss += A256_DPP(ss, 0x141); ss += A256_DPP(ss, 0x140); ss += A256_SHX(ss, 16);
            const float rs = rsqrtf(ss * (1.0f / 256.0f) + eps);
            unsigned short* ao = AOut + (size_t)(wid * QBLK + orow) * AOP;
#pragma unroll
            for (int d0 = 0; d0 < 8; ++d0) { const float v = o[d0][r] * rs * slv[d0]; const float vn = A256_DPP(v, 0xB1);
                if ((r32 & 1) == 0) *(unsigned*)(ao + d0 * 32 + r32) = cvtpk(v, vn); } }
    }
    asm volatile("s_waitcnt lgkmcnt(0)\n\ts_barrier" ::: "memory");
#undef A256_SHX
#undef A256_DPP
#undef A256_DMA
#undef A256_RESC
#undef A256_STEP
}
#undef KSWZ
#undef SBAR
}
constexpr int DM = 2048, NB = 4, SEQ = 4096, NMETA = 16, MR = NB * SEQ  , MROWS = MR + NMETA, MPAD = MR + 256;
constexpr int DFF = 5632, NGU = 2 * DFF, NIN = 15360, LW = 2560, NHEAD = 8, KVLEN = 4160, DEPTH = 4;
constexpr float EPS = 1e-6f;
constexpr int NWAVES = 8;
#ifndef MK_MULTI
#define MK_MULTI 0
#endif
#ifndef DUAL_BR
#define DUAL_BR 1
#endif
#ifndef FINAL_BF16
#define FINAL_BF16 1
#endif
#ifndef EN_MASK
#define EN_MASK 0xFFFF
#endif
#define EN(k) (((EN_MASK) >> (k)) & 1)
#ifndef PROBE_SEAM
#define PROBE_SEAM -1
#endif
#ifndef PROBE_GAIN
#define PROBE_GAIN 1.0f
#endif
#ifndef DUP_PHASE
#define DUP_PHASE -1
#endif
#define DRY(k) ((k) == (DUP_PHASE) && rep_ == 0)
#define REPM(k) for (int rep_ = 0; rep_ < ((DUP_PHASE) == 20 ? 2 : 1); ++rep_)
#define DRYM ((DUP_PHASE) == 20 && rep_ == 0)
#define REP(k) for (int rep_ = 0; rep_ < ((k) == (DUP_PHASE) ? 2 : 1); ++rep_)
#ifndef NO_META
#define NO_META 0
#endif
constexpr int PH_PER_LAYER = 10, N_PHASES = 2 + DEPTH * PH_PER_LAYER;

constexpr size_t MiB = 1u << 20;
constexpr size_t WS_CTL = 0, CTL_ZERO_BYTES = 2 * MiB;
constexpr size_t WS_ROPE = 2 * MiB;
constexpr size_t WS_QM = 3 * MiB + 512 * 1024;
constexpr size_t WS_W = 4 * MiB, WBUF_STRIDE = 0 * MiB;
constexpr size_t W_GU1 = WS_W, W_DN1 = W_GU1 + 44 * MiB, W_IN = W_DN1 + 22 * MiB, W_BA = W_IN + 60 * MiB, W_BL = W_BA + 8 * MiB, W_O = W_BL + 10 * MiB,
                 W_GU2 = W_O + 8 * MiB, W_DN2 = W_GU2 + 44 * MiB;
constexpr size_t WS_H = 224 * MiB;
constexpr size_t WS_HB = 354 * MiB;
constexpr size_t WS_HID = 420 * MiB;
constexpr size_t WS_Q = 600 * MiB;
constexpr size_t WS_K = 664 * MiB;
constexpr size_t WS_V = 729 * MiB;
constexpr size_t WS_XR = 794 * MiB;
constexpr size_t WS_GY = 876 * MiB;
constexpr size_t WS_G = 958 * MiB;
constexpr size_t WS_OP = 1088 * MiB;
constexpr size_t WS_AO = 1216 * MiB;
constexpr size_t WS_LO = 1281 * MiB;
constexpr size_t WS_TMP = 1363 * MiB;
constexpr size_t WS_MIX = 1493 * MiB;
constexpr size_t WS_END = 1558 * MiB;
static_assert(W_DN2 + 22 * MiB <= WS_H && WS_H + (size_t)MPAD * DM * 4 <= WS_HB && WS_HB + (size_t)MPAD * DM * 2 <= WS_HID && WS_HID + (size_t)MPAD * DFF * 2 <= WS_Q, "ws map 1");
static_assert(WS_K + (size_t)64 * KVLEN * 256 <= WS_V && WS_V + (size_t)64 * KVLEN * 256 <= WS_XR && WS_XR + (size_t)MPAD * LW * 2 <= WS_GY && WS_GY + (size_t)MPAD * LW * 2 <= WS_G, "ws map 2");
static_assert(WS_LO + (size_t)MPAD * LW * 2 <= WS_TMP && WS_TMP + (size_t)MPAD * DM * 4 <= WS_MIX && WS_MIX + (size_t)MPAD * DM * 2 <= WS_END, "ws map 3");
constexpr int CW_TMO = 0, CW_CODE = 1, CW_BAR = 4096, CW_REACH = 8192  , CW_ITEM = 12288  ;
constexpr size_t SSQ_OFF = 65536;
constexpr int N_SSQ = 13;
static_assert(SSQ_OFF + (size_t)N_SSQ * MPAD * 8 <= CTL_ZERO_BYTES, "ssq inside the memset region");

constexpr int RING_BYTES = 143360, LDSCTL_OFF = RING_BYTES, MISC_OFF = LDSCTL_OFF + 320, LDS_BYTES = 147456;

using pg8::bf16_t; using pg8::bf16x8; using pg8::f32x4; using pg8::u32x4; using pg8::cvt_pk_bf16;

__device__ __forceinline__ float wave_sum(float v) {
#pragma unroll
    for (int o = 1; o < 64; o <<= 1) v += __shfl_xor(v, o);
    return v;
}
__device__ __forceinline__ float bf2f(unsigned short u) { return __uint_as_float((unsigned)u << 16); }
__device__ __forceinline__ float bflo(unsigned u) { return __uint_as_float(u << 16); }
__device__ __forceinline__ float bfhi(unsigned u) { return __uint_as_float(u & 0xffff0000u); }
__device__ __forceinline__ unsigned short f2bf16(float f) { return (unsigned short)(cvt_pk_bf16(f, 0.f) & 0xffffu); }
typedef unsigned long long u64;
typedef float f32x2 __attribute__((ext_vector_type(2)));
__device__ __forceinline__ float rstd_from(float ssq) { return rsqrtf(ssq * (1.0f / 2048.0f) + EPS); }
__device__ __forceinline__ float rstd_fx(u64 v) { return rsqrtf((float)v * (1.0f / 4294967296.0f / 2048.0f) + EPS); }
__device__ __forceinline__ u64 ssq_fx(float ss) { return (u64)(ss * 4294967296.0f); }
__device__ __forceinline__ float sigmoid_f(float x) { return __builtin_amdgcn_rcpf(1.0f + __expf(-x)); }
__device__ __forceinline__ float gelu_tanh_f(float y) { const float u = 1.5957691216057308f * (y + 0.044715f * y * y * y); return y * __builtin_amdgcn_rcpf(1.0f + __expf(-u)); }
__device__ __forceinline__ f32x4 sigmoid4(f32x4 x) { f32x4 t = x * -1.4426950408889634f;
#pragma unroll
    for (int e = 0; e < 4; ++e) t[e] = __builtin_amdgcn_exp2f(t[e]);
    t = t + 1.0f;
#pragma unroll
    for (int e = 0; e < 4; ++e) t[e] = __builtin_amdgcn_rcpf(t[e]);
    return t; }
__device__ __forceinline__ f32x4 gelu_tanh4(f32x4 y) { return y * sigmoid4(y * ((y * y) * (0.044715f * 1.5957691216057308f) + 1.5957691216057308f)); }
__device__ __forceinline__ u32x4 pack8f(f32x4 a, f32x4 b) { u32x4 w; w.x = cvt_pk_bf16(a[0], a[1]); w.y = cvt_pk_bf16(a[2], a[3]); w.z = cvt_pk_bf16(b[0], b[1]); w.w = cvt_pk_bf16(b[2], b[3]); return w; }

namespace pg8 {
template <class E> __device__ __forceinline__ void run_epi(const E& e, const f32x4 (&acc)[2][2][4][2], const Unit& u, int wr, int wc, int fr, int fq) {
    const int colin = wc * 32 + 8 * fq, row0 = u.pm * BM + wr * 64 + fr;
    const typename E::Tile tl = e.tile(u.pn, colin);
    typename E::Pre q[8];
#pragma unroll
    for (int i = 0; i < 8; ++i) if (i < E::DEPTH) q[i] = e.pre(row0 + (i >> 2) * HALF + (i & 3) * 16, u.pn, colin);
    asm volatile("" ::: "memory");
#pragma unroll
    for (int i = 0; i < 8; ++i) {
        if (i + E::DEPTH < 8) { q[i + E::DEPTH] = e.pre(row0 + ((i + E::DEPTH) >> 2) * HALF + ((i + E::DEPTH) & 3) * 16, u.pn, colin); asm volatile("" ::: "memory"); }
        e.template frag<false>(row0 + (i >> 2) * HALF + (i & 3) * 16, u.pn, colin, acc[i >> 2][0][i & 3][0], acc[i >> 2][0][i & 3][1], acc[i >> 2][1][i & 3][0], acc[i >> 2][1][i & 3][1], q[i], tl);
    }
}
}
#define EPI_COMMON static constexpr bool PERM = true, AFTER_DRAIN = false; \
    __device__ __forceinline__ void operator()(const f32x4 (&acc)[2][2][4][2], const pg8::Unit& u, int wr, int wc, int fr, int fq) const { pg8::run_epi(*this, acc, u, wr, wc, fr, fq); } \
    template <bool META> __device__ __forceinline__ void frag1(int row, int pn, int colin, f32x4 a0, f32x4 a1, f32x4 b0, f32x4 b1) const { this->template frag<META>(row, pn, colin, a0, a1, b0, b1, pre(row, pn, colin), tile(pn, colin)); }
struct EpiNone {};
__device__ __forceinline__ void unpack8(u32x4 w, f32x4& lo, f32x4& hi) { lo = (f32x4){bflo(w.x), bfhi(w.x), bflo(w.y), bfhi(w.y)}; hi = (f32x4){bflo(w.z), bfhi(w.z), bflo(w.w), bfhi(w.w)}; }

struct EpiNull {
    typedef EpiNone Pre; typedef EpiNone Tile; static constexpr int DEPTH = 1;
    __device__ __forceinline__ Pre pre(int, int, int) const { return Pre{}; }
    __device__ __forceinline__ Tile tile(int, int) const { return Tile{}; }
    template <bool META> __device__ __forceinline__ void frag(int row, int pn, int colin, f32x4 a0, f32x4 a1, f32x4 b0, f32x4 b1, const Pre&, const Tile&) const { asm volatile("" :: "v"(a0), "v"(a1), "v"(b0), "v"(b1)); }
    EPI_COMMON
};
struct PreSsq { u64 v; };
struct EpiSwiGLU {
    bf16_t* HID; const u64* ssq;
    typedef PreSsq Pre; typedef EpiNone Tile; static constexpr int DEPTH = 8;
    __device__ __forceinline__ Pre pre(int row, int, int) const { return Pre{ssq[row]}; }
    __device__ __forceinline__ Tile tile(int, int) const { return Tile{}; }
    template <bool META> __device__ __forceinline__ void frag(int row, int pn, int colin, f32x4 a0, f32x4 a1, f32x4 b0, f32x4 b1, const Pre& p, const Tile&) const {
        const float rs = rstd_fx(p.v), c1 = rs * -1.4426950408889634f, rs2 = rs * rs;
        f32x4 t0 = a0 * c1, t1 = a1 * c1;
#pragma unroll
        for (int e = 0; e < 4; ++e) { t0[e] = __builtin_amdgcn_exp2f(t0[e]); t1[e] = __builtin_amdgcn_exp2f(t1[e]); }
        t0 = t0 + 1.0f; t1 = t1 + 1.0f;
#pragma unroll
        for (int e = 0; e < 4; ++e) { t0[e] = __builtin_amdgcn_rcpf(t0[e]); t1[e] = __builtin_amdgcn_rcpf(t1[e]); }
        const f32x4 o0 = (a0 * b0) * t0 * rs2, o1 = (a1 * b1) * t1 * rs2;
        *(u32x4*)(HID + (size_t)row * DFF + pn * 128 + colin) = pack8f(o0, o1);
    }
    EPI_COMMON
};
struct PreH { f32x4 h0, h1, h2, h3; };
struct PreHb { u32x4 lo, hi; };
struct EpiResid {
    float* Hf; bf16_t* HB; u64* ssqn; float alpha, ssw;
    typedef PreHb Pre; typedef EpiNone Tile; static constexpr int DEPTH = 4;
    __device__ __forceinline__ Pre pre(int row, int pn, int colin) const { const bf16_t* bp = HB + (size_t)row * DM + pn * 256 + colin; return Pre{*(const u32x4*)bp, *(const u32x4*)(bp + 128)}; }
    __device__ __forceinline__ Tile tile(int, int) const { return Tile{}; }
    template <bool META> __device__ __forceinline__ void frag(int row, int pn, int colin, f32x4 a0, f32x4 a1, f32x4 b0, f32x4 b1, const Pre& p, const Tile&) const {
        const int c0 = pn * 256 + colin;
        f32x4 h0, h1, h2, h3; unpack8(p.lo, h0, h1); unpack8(p.hi, h2, h3);
        h0 = h0 + alpha * a0; h1 = h1 + alpha * a1; h2 = h2 + alpha * b0; h3 = h3 + alpha * b1;
        bf16_t* bp = HB + (size_t)row * DM + c0;
        *(u32x4*)bp = pack8f(h0, h1); *(u32x4*)(bp + 128) = pack8f(h2, h3);
        if (Hf) { float* hp = Hf + (size_t)row * DM + c0; *(f32x4*)hp = h0; *(f32x4*)(hp + 4) = h1; *(f32x4*)(hp + 128) = h2; *(f32x4*)(hp + 132) = h3; }
        float ss = 0.f;
#pragma unroll
        for (int e = 0; e < 4; ++e) ss += h0[e] * h0[e] + h1[e] * h1[e] + h2[e] * h2[e] + h3[e] * h3[e];
        ss += __shfl_xor(ss, 16); ss += __shfl_xor(ss, 32);
        if ((threadIdx.x & 48) == 0) __hip_atomic_fetch_add(ssqn + row, ssq_fx(ss * ssw), __ATOMIC_RELAXED, __HIP_MEMORY_SCOPE_AGENT);
    }
    EPI_COMMON
};
struct PreWin { u64 v; f32x4 c, s; };
struct TileWin { f32x4 g0, g1, g2, g3; };
struct EpiWin {
    bf16_t *Q, *K, *V, *XR, *GY, *G, *QM; const float* bgate; const u64* ssq; const float* rc; const float* rsn;
    typedef PreWin Pre; typedef TileWin Tile; static constexpr int DEPTH = 3;
    __device__ __forceinline__ Pre pre(int row, int pn, int colin) const {
        Pre p; p.v = ssq[row]; p.c = (f32x4){0.f, 0.f, 0.f, 0.f}; p.s = p.c;
        if (pn < 16 && colin < 32) { const int pos = row >= MR ? row - MR : (row & 4095) + NMETA; p.c = *(const f32x4*)(rc + pos * 16 + (colin >> 1)); p.s = *(const f32x4*)(rsn + pos * 16 + (colin >> 1)); }
        return p; }
    __device__ __forceinline__ Tile tile(int pn, int colin) const {
        Tile t; t.g0 = (f32x4){0.f, 0.f, 0.f, 0.f}; t.g1 = t.g0; t.g2 = t.g0; t.g3 = t.g0;
        if (pn >= 44) { const float* bp = bgate + (pn - 44) * 256 + colin; t.g0 = *(const f32x4*)bp; t.g1 = *(const f32x4*)(bp + 4); t.g2 = *(const f32x4*)(bp + 128); t.g3 = *(const f32x4*)(bp + 132); }
        return t; }
    template <bool META> __device__ __forceinline__ void frag(int row, int pn, int colin, f32x4 a0, f32x4 a1, f32x4 b0, f32x4 b1, const Pre& pq, const Tile& tl) const {
        const float rs = rstd_fx(pq.v);
        a0 = a0 * rs; a1 = a1 * rs; b0 = b0 * rs; b1 = b1 * rs;
        const int mi = row - MR, b = row >> 12, t = row & 4095, pos = META ? mi : t + NMETA;
        if (pn < 24) {
            if (pn < 16 && colin < 32) {
                const f32x4 c = pq.c, s = pq.s;
                const f32x4 r1 = a0 * c - a1 * s, r2 = a1 * c + a0 * s, r3 = b0 * c - b1 * s, r4 = b1 * c + b0 * s;
                a0 = r1; a1 = r2; b0 = r3; b1 = r4;
            }
            const u32x4 wa = pack8f(a0, a1), wb = pack8f(b0, b1);
            const int h = pn & 7;
            if (pn < 8) {
                if (META) { bf16_t* p = QM + ((size_t)(2 * h) * NMETA + mi) * 128 + colin; *(u32x4*)p = wa; *(u32x4*)(p + NMETA * 128) = wb; }
                else { bf16_t* p = Q + ((size_t)(b * 16 + 2 * h) * SEQ + t) * 128 + colin; *(u32x4*)p = wa; *(u32x4*)(p + (size_t)SEQ * 128) = wb; }
            } else {
                bf16_t* base = pn < 16 ? K : V;
                if (META) {
#pragma unroll
                    for (int bb = 0; bb < NB; ++bb) { bf16_t* p = base + ((size_t)(bb * 16 + 2 * h) * KVLEN + mi) * 128 + colin; *(u32x4*)p = wa; *(u32x4*)(p + (size_t)KVLEN * 128) = wb; }
                } else { bf16_t* p = base + ((size_t)(b * 16 + 2 * h) * KVLEN + pos) * 128 + colin; *(u32x4*)p = wa; *(u32x4*)(p + (size_t)KVLEN * 128) = wb; }
            }
        } else if (pn < 34) {
            bf16_t* p = XR + (size_t)row * LW + (pn - 24) * 256 + colin; *(u32x4*)p = pack8f(a0, a1); *(u32x4*)(p + 128) = pack8f(b0, b1);
        } else if (pn < 44) {
            a0 = gelu_tanh4(a0); a1 = gelu_tanh4(a1); b0 = gelu_tanh4(b0); b1 = gelu_tanh4(b1);
            bf16_t* p = GY + (size_t)row * LW + (pn - 34) * 256 + colin; *(u32x4*)p = pack8f(a0, a1); *(u32x4*)(p + 128) = pack8f(b0, b1);
        } else {
            const int c0 = (pn - 44) * 256 + colin;
            a0 = sigmoid4(a0 + tl.g0); a1 = sigmoid4(a1 + tl.g1); b0 = sigmoid4(b0 + tl.g2); b1 = sigmoid4(b1 + tl.g3);
            bf16_t* p = G + (size_t)row * 4096 + c0; *(u32x4*)p = pack8f(a0, a1); *(u32x4*)(p + 128) = pack8f(b0, b1);
        }
    }
    EPI_COMMON
};
struct PreG { u32x4 g0, g1; };
struct EpiBa {
    bf16_t* TMP; const bf16_t* G;
    typedef PreG Pre; typedef EpiNone Tile; static constexpr int DEPTH = 4;
    __device__ __forceinline__ Pre pre(int row, int pn, int colin) const { const bf16_t* gp = G + (size_t)row * 4096 + pn * 256 + colin; return Pre{*(const u32x4*)gp, *(const u32x4*)(gp + 128)}; }
    __device__ __forceinline__ Tile tile(int, int) const { return Tile{}; }
    template <bool META> __device__ __forceinline__ void frag(int row, int pn, int colin, f32x4 a0, f32x4 a1, f32x4 b0, f32x4 b1, const Pre& p, const Tile&) const {
        const int c0 = pn * 256 + colin;
        f32x4 g0, g1, g2, g3; unpack8(p.g0, g0, g1); unpack8(p.g1, g2, g3);
        bf16_t* tp = TMP + (size_t)row * DM + c0;
        *(u32x4*)tp = pack8f(g0 * a0, g1 * a1); *(u32x4*)(tp + 128) = pack8f(g2 * b0, g3 * b1);
    }
    EPI_COMMON
};
struct PreTG { u32x4 t0, t1, g0, g1; };
struct EpiBl {
    const bf16_t* TMP; const bf16_t* G; bf16_t* MIX;
    typedef PreTG Pre; typedef EpiNone Tile; static constexpr int DEPTH = 2;
    __device__ __forceinline__ Pre pre(int row, int pn, int colin) const { const int c0 = pn * 256 + colin; const bf16_t* tp = TMP + (size_t)row * DM + c0; const bf16_t* gp = G + (size_t)row * 4096 + 2048 + c0;
        return Pre{*(const u32x4*)tp, *(const u32x4*)(tp + 128), *(const u32x4*)gp, *(const u32x4*)(gp + 128)}; }
    __device__ __forceinline__ Tile tile(int, int) const { return Tile{}; }
    template <bool META> __device__ __forceinline__ void frag(int row, int pn, int colin, f32x4 a0, f32x4 a1, f32x4 b0, f32x4 b1, const Pre& p, const Tile&) const {
        const int c0 = pn * 256 + colin;
        f32x4 g0, g1, g2, g3, t0, t1, t2, t3; unpack8(p.g0, g0, g1); unpack8(p.g1, g2, g3); unpack8(p.t0, t0, t1); unpack8(p.t1, t2, t3);
        t0 = t0 + g0 * a0; t1 = t1 + g1 * a1; t2 = t2 + g2 * b0; t3 = t3 + g3 * b1;
        bf16_t* mp = MIX + (size_t)row * DM + c0;
        *(u32x4*)mp = pack8f(t0, t1); *(u32x4*)(mp + 128) = pack8f(t2, t3);
    }
    EPI_COMMON
};

struct PreGG { u32x4 a0, a1, l0, l1; };
struct EpiDual {
    const bf16_t* G; bf16_t* MIX;
    typedef PreG Pre; typedef EpiNone Tile; static constexpr int DEPTH = 4;
    __device__ __forceinline__ Pre pre(int row, int pn, int colin) const { const bf16_t* gp = G + (size_t)row * 4096 + 2048 + pn * 256 + colin; return Pre{*(const u32x4*)gp, *(const u32x4*)(gp + 128)}; }
    __device__ __forceinline__ Tile tile(int, int) const { return Tile{}; }
    template <bool META> __device__ __forceinline__ void frag(int row, int pn, int colin, f32x4 a0, f32x4 a1, f32x4 b0, f32x4 b1, const Pre& p, const Tile&) const {
        f32x4 g0, g1, g2, g3; unpack8(p.g0, g0, g1); unpack8(p.g1, g2, g3);
#pragma unroll
        for (int e = 0; e < 4; ++e) { g0[e] = fmaxf(g0[e], 1e-20f); g1[e] = fmaxf(g1[e], 1e-20f); g2[e] = fmaxf(g2[e], 1e-20f); g3[e] = fmaxf(g3[e], 1e-20f); }
        bf16_t* mp = MIX + (size_t)row * DM + pn * 256 + colin;
        *(u32x4*)mp = pack8f(g0 * a0, g1 * a1); *(u32x4*)(mp + 128) = pack8f(g2 * b0, g3 * b1);
    }
    __device__ __forceinline__ PreGG pre2(int row, int pn, int colin) const { const bf16_t* gp = G + (size_t)row * 4096 + pn * 256 + colin;
        return PreGG{*(const u32x4*)gp, *(const u32x4*)(gp + 128), *(const u32x4*)(gp + 2048), *(const u32x4*)(gp + 2048 + 128)}; }
    static __device__ __forceinline__ f32x4 ratio4(f32x4 ga, f32x4 gl) { f32x4 r;
#pragma unroll
        for (int e = 0; e < 4; ++e) r[e] = ga[e] * __builtin_amdgcn_rcpf(fmaxf(gl[e], 1e-20f));
        return r; }
    __device__ __forceinline__ void mid(f32x4 (&acc)[2][2][4][2], const pg8::Unit& u, int wr, int wc, int fr, int fq) const {
        const int colin = wc * 32 + 8 * fq, row0 = u.pm * pg8::BM + wr * 64 + fr;
        PreGG q[8];
#pragma unroll
        for (int i = 0; i < 2; ++i) q[i] = pre2(row0 + (i >> 2) * pg8::HALF + (i & 3) * 16, u.pn, colin);
        asm volatile("" ::: "memory");
#pragma unroll
        for (int i = 0; i < 8; ++i) {
            if (i + 2 < 8) { q[i + 2] = pre2(row0 + ((i + 2) >> 2) * pg8::HALF + ((i + 2) & 3) * 16, u.pn, colin); asm volatile("" ::: "memory"); }
            f32x4 a0, a1, a2, a3, l0, l1, l2, l3; unpack8(q[i].a0, a0, a1); unpack8(q[i].a1, a2, a3); unpack8(q[i].l0, l0, l1); unpack8(q[i].l1, l2, l3);
            acc[i >> 2][0][i & 3][0] = acc[i >> 2][0][i & 3][0] * ratio4(a0, l0); acc[i >> 2][0][i & 3][1] = acc[i >> 2][0][i & 3][1] * ratio4(a1, l1);
            acc[i >> 2][1][i & 3][0] = acc[i >> 2][1][i & 3][0] * ratio4(a2, l2); acc[i >> 2][1][i & 3][1] = acc[i >> 2][1][i & 3][1] * ratio4(a3, l3);
        }
    }
    EPI_COMMON
};

template <class Epi> __device__ __forceinline__ void meta_gemm(LAS unsigned char* lds, const bf16_t* A16, const bf16_t* Bt, int N, int K, const Epi& E) {
    const int tid = tid_fresh(), wid = __builtin_amdgcn_readfirstlane(tid >> 6), lane = tid & 63, fr = lane & 15, fq = lane >> 4;
    const int nitems = N / 64, ks = K / 8;
    LAS f32x4* red = (LAS f32x4*)lds;
    for (int it = blockIdx.x; it < nitems; it += gridDim.x) {
        const int pn = it >> 2, wc = it & 3;
        typename Epi::Pre pq{}; typename Epi::Tile tl{};
        if (wid == 0) { pq = E.pre(MR + fr, pn, wc * 32 + 8 * fq); tl = E.tile(pn, wc * 32 + 8 * fq); }
        f32x4 acc[4];
#pragma unroll
        for (int q = 0; q < 4; ++q) acc[q] = (f32x4){0.f, 0.f, 0.f, 0.f};
        const bf16_t* ap = A16 + (size_t)fr * K + wid * ks + 8 * fq;
        const bf16_t* bp[4];
#pragma unroll
        for (int q = 0; q < 4; ++q) bp[q] = Bt + (size_t)(pn * 256 + (q >> 1) * 128 + wc * 32 + pg8::perm32(16 * (q & 1) + fr)) * K + wid * ks + 8 * fq;
#pragma unroll 8
        for (int kk = 0; kk < ks; kk += 32) {
            const bf16x8 a = *(const bf16x8*)(ap + kk);
#pragma unroll
            for (int q = 0; q < 4; ++q) { const bf16x8 bv = *(const bf16x8*)(bp[q] + kk); acc[q] = __builtin_amdgcn_mfma_f32_16x16x32_bf16(bv, a, acc[q], 0, 0, 0); }
        }
#pragma unroll
        for (int q = 0; q < 4; ++q) red[(wid * 4 + q) * 64 + lane] = acc[q];
        __syncthreads();
        if (wid == 0) {
            f32x4 s[4];
#pragma unroll
            for (int q = 0; q < 4; ++q) { s[q] = red[q * 64 + lane];
#pragma unroll
                for (int w = 1; w < 8; ++w) s[q] = s[q] + red[(w * 4 + q) * 64 + lane]; }
            E.template frag<true>(MR + fr, pn, wc * 32 + 8 * fq, s[0], s[1], s[2], s[3], pq, tl);
        }
        __syncthreads();
    }
}

template <int K> __device__ __forceinline__ void meta_resid(LAS unsigned char* lds, const bf16_t* A16, const bf16_t* Bt, bf16_t* HBo, u64* ssqn, float alpha) {
    const int tid = tid_fresh(), wid = __builtin_amdgcn_readfirstlane(tid >> 6), lane = tid & 63, fr = lane & 15, fq = lane >> 4;
    constexpr int ks = K / 8, NST = ks / 32;
    LAS f32x4* red = (LAS f32x4*)lds;
    for (int it = blockIdx.x; it < DM / 16; it += gridDim.x) {
        const int pn = it >> 4, bj = (it >> 3) & 1, wc = (it >> 1) & 3, n = it & 1;
        const int c0 = pn * 256 + bj * 128 + wc * 32 + 8 * fq + 4 * n;
        bf16_t* hp = HBo + (size_t)(MR + fr) * DM + c0;
        unsigned long long hw = 0ull;
        if (wid == 0) hw = *(const unsigned long long*)hp;
        const bf16_t* ap = A16 + (size_t)fr * K + wid * ks + 8 * fq;
        const bf16_t* bp = Bt + (size_t)(pn * 256 + bj * 128 + wc * 32 + pg8::perm32(16 * n + fr)) * K + wid * ks + 8 * fq;
        bf16x8 av[NST], bv[NST];
#pragma unroll
        for (int i = 0; i < NST; ++i) { av[i] = *(const bf16x8*)(ap + 32 * i); bv[i] = *(const bf16x8*)(bp + 32 * i); }
        f32x4 acc = (f32x4){0.f, 0.f, 0.f, 0.f};
#pragma unroll
        for (int i = 0; i < NST; ++i) acc = __builtin_amdgcn_mfma_f32_16x16x32_bf16(bv[i], av[i], acc, 0, 0, 0);
        red[wid * 64 + lane] = acc;
        __syncthreads();
        if (wid == 0) {
            f32x4 sm = red[lane];
#pragma unroll
            for (int w = 1; w < 8; ++w) sm = sm + red[w * 64 + lane];
            const unsigned w0 = (unsigned)hw, w1 = (unsigned)(hw >> 32);
            const f32x4 h = (f32x4){bflo(w0), bfhi(w0), bflo(w1), bfhi(w1)} + alpha * sm;
            *(unsigned long long*)hp = (unsigned long long)cvt_pk_bf16(h[0], h[1]) | ((unsigned long long)cvt_pk_bf16(h[2], h[3]) << 32);
            float ss = h[0] * h[0] + h[1] * h[1] + h[2] * h[2] + h[3] * h[3];
            ss += __shfl_xor(ss, 16); ss += __shfl_xor(ss, 32);
            if (fq == 0) __hip_atomic_fetch_add(ssqn + MR + fr, ssq_fx(ss), __ATOMIC_RELAXED, __HIP_MEMORY_SCOPE_AGENT);
        }
        __syncthreads();
    }
}
__device__ __forceinline__ void meta_dual(LAS unsigned char* lds, const bf16_t* A0, const bf16_t* Bt0, const bf16_t* A1, const bf16_t* Bt1, const bf16_t* G, bf16_t* MIXo) {
    const int tid = tid_fresh(), wid = __builtin_amdgcn_readfirstlane(tid >> 6), lane = tid & 63, fr = lane & 15, fq = lane >> 4;
    constexpr int K0 = DM, K1 = LW, ks0 = K0 / 8, ks1 = K1 / 8, N0 = ks0 / 32, N1 = ks1 / 32;
    LAS f32x4* red = (LAS f32x4*)lds;
    for (int it = blockIdx.x; it < DM / 16; it += gridDim.x) {
        const int pn = it >> 4, bj = (it >> 3) & 1, wc = (it >> 1) & 3, n = it & 1;
        const int c0 = pn * 256 + bj * 128 + wc * 32 + 8 * fq + 4 * n, brow = pn * 256 + bj * 128 + wc * 32 + pg8::perm32(16 * n + fr);
        unsigned long long gaw = 0ull, glw = 0ull;
        if (wid == 0) { const bf16_t* gp = G + (size_t)(MR + fr) * 4096 + c0; gaw = *(const unsigned long long*)gp; glw = *(const unsigned long long*)(gp + 2048); }
        const bf16_t* ap0 = A0 + (size_t)fr * K0 + wid * ks0 + 8 * fq; const bf16_t* bp0 = Bt0 + (size_t)brow * K0 + wid * ks0 + 8 * fq;
        const bf16_t* ap1 = A1 + (size_t)fr * K1 + wid * ks1 + 8 * fq; const bf16_t* bp1 = Bt1 + (size_t)brow * K1 + wid * ks1 + 8 * fq;
        bf16x8 av0[N0], bv0[N0], av1[N1], bv1[N1];
#pragma unroll
        for (int i = 0; i < N0; ++i) { av0[i] = *(const bf16x8*)(ap0 + 32 * i); bv0[i] = *(const bf16x8*)(bp0 + 32 * i); }
#pragma unroll
        for (int i = 0; i < N1; ++i) { av1[i] = *(const bf16x8*)(ap1 + 32 * i); bv1[i] = *(const bf16x8*)(bp1 + 32 * i); }
        f32x4 acca = (f32x4){0.f, 0.f, 0.f, 0.f}, accb = acca;
#pragma unroll
        for (int i = 0; i < N0; ++i) acca = __builtin_amdgcn_mfma_f32_16x16x32_bf16(bv0[i], av0[i], acca, 0, 0, 0);
#pragma unroll
        for (int i = 0; i < N1; ++i) accb = __builtin_amdgcn_mfma_f32_16x16x32_bf16(bv1[i], av1[i], accb, 0, 0, 0);
        red[(wid * 2) * 64 + lane] = acca; red[(wid * 2 + 1) * 64 + lane] = accb;
        __syncthreads();
        if (wid == 0) {
            f32x4 sa = red[lane], sb = red[64 + lane];
#pragma unroll
            for (int w = 1; w < 8; ++w) { sa = sa + red[(w * 2) * 64 + lane]; sb = sb + red[(w * 2 + 1) * 64 + lane]; }
            const unsigned a0 = (unsigned)gaw, a1 = (unsigned)(gaw >> 32), l0 = (unsigned)glw, l1 = (unsigned)(glw >> 32);
            const f32x4 o = (f32x4){bflo(a0), bfhi(a0), bflo(a1), bfhi(a1)} * sa + (f32x4){bflo(l0), bfhi(l0), bflo(l1), bfhi(l1)} * sb;
            *(unsigned long long*)(MIXo + (size_t)(MR + fr) * DM + c0) = (unsigned long long)cvt_pk_bf16(o[0], o[1]) | ((unsigned long long)cvt_pk_bf16(o[2], o[3]) << 32);
        }
        __syncthreads();
    }
}

template <int MODE> __device__ __forceinline__ int wmap(int n) {
    if (MODE == 1) return ((n >> 7) << 8) + (n & 127);
    if (MODE == 2) return ((n >> 7) << 8) + 128 + (n & 127);
    if (MODE == 3) { if (n >= 4096) return n; const int d = n & 127; if (d >= 32) return n; const int s = d < 16 ? 8 * (d >> 2) + (d & 3) : 8 * ((d - 16) >> 2) + 4 + (d & 3); return (n & ~127) + s; }
    return n;
}
template <int MODE> __device__ __forceinline__ void transpose_item(const float* W, int K, int N, bf16_t* WT, LAS float* scr, int item, int lane, const float* gk = nullptr) {
    const int nblk = N / 32, kb = item / nblk, nb = item % nblk, k0 = 64 * kb, n0 = 32 * nb;
    const int c = lane & 7;
    f32x4 ga = (f32x4){1.f, 1.f, 1.f, 1.f}, gb = ga;
    if (gk) { ga = *(const f32x4*)(gk + k0 + 8 * c); gb = *(const f32x4*)(gk + k0 + 8 * c + 4); }
    { float wv[32];
      const float* wp = W + (size_t)(k0 + (lane >> 5)) * N + n0 + (lane & 31);
#pragma unroll
      for (int i = 0; i < 32; ++i) wv[i] = wp[(size_t)(2 * i) * N];
#pragma unroll
      for (int i = 0; i < 32; ++i) scr[(2 * i + (lane >> 5)) * 33 + (lane & 31)] = wv[i]; }
    asm volatile("s_waitcnt lgkmcnt(0)" ::: "memory");
#pragma unroll
    for (int j = 0; j < 4; ++j) { const int n = (lane >> 3) + 8 * j; const LAS float* s = scr + (8 * c) * 33 + n;
        u32x4 o; o.x = cvt_pk_bf16(s[0 * 33] * ga[0], s[1 * 33] * ga[1]); o.y = cvt_pk_bf16(s[2 * 33] * ga[2], s[3 * 33] * ga[3]); o.z = cvt_pk_bf16(s[4 * 33] * gb[0], s[5 * 33] * gb[1]); o.w = cvt_pk_bf16(s[6 * 33] * gb[2], s[7 * 33] * gb[3]);
        *(u32x4*)(WT + (size_t)wmap<MODE>(n0 + n) * K + k0 + 8 * c) = o; }
    asm volatile("s_waitcnt lgkmcnt(0)" ::: "memory");
}

struct Args { const float* in[29]; float* out; unsigned char* ws; float invf[16]; int ph_lo, ph_hi; };
static_assert(sizeof(Args) == 31 * 8 + 16 * 4 + 8, "Args has no padding");

__device__ __forceinline__ void conv_pass(const bf16_t* XR, bf16_t* XCg, const float* conv_w, const float* conv_b, int gtid, int ngt) {
    constexpr int NCH = LW / 8, RUNS = (SEQ + NMETA) / 8, NTASK = NB * RUNS * NCH;
    for (int task = gtid; task < NTASK; task += ngt) {
        const int c8 = task % NCH, u = (task / NCH) % RUNS, b = task / (NCH * RUNS), p0 = 8 * u;
        if (u < 2 && b > 0) continue;
        float cw[4][8], cb[8], o[8][8];
        { const f32x4 b0 = *(const f32x4*)(conv_b + 8 * c8), b1 = *(const f32x4*)(conv_b + 8 * c8 + 4);
#pragma unroll
          for (int e = 0; e < 4; ++e) { cb[e] = b0[e]; cb[4 + e] = b1[e]; }
#pragma unroll
          for (int j = 0; j < 4; ++j) { const f32x4 w0 = *(const f32x4*)(conv_w + j * LW + 8 * c8), w1 = *(const f32x4*)(conv_w + j * LW + 8 * c8 + 4);
#pragma unroll
              for (int e = 0; e < 4; ++e) { cw[j][e] = w0[e]; cw[j][4 + e] = w1[e]; } } }
#pragma unroll
        for (int i = 0; i < 8; ++i)
#pragma unroll
            for (int e = 0; e < 8; ++e) o[i][e] = cb[e];
        u32x4 raw[11];
#pragma unroll
        for (int m = 0; m < 11; ++m) { const int p = p0 - 3 + m; raw[m] = (u32x4){0u, 0u, 0u, 0u};
            if (p >= 0) { const int row = p < NMETA ? MR + p : b * SEQ + p - NMETA; raw[m] = *(const u32x4*)(XR + (size_t)row * LW + 8 * c8); } }
#pragma unroll
        for (int m = 0; m < 11; ++m) {
            const u32x4 xv = raw[m];
            const float x[8] = {bflo(xv.x), bfhi(xv.x), bflo(xv.y), bfhi(xv.y), bflo(xv.z), bfhi(xv.z), bflo(xv.w), bfhi(xv.w)};
#pragma unroll
            for (int i = 0; i < 8; ++i) { const int j = i + 3 - m; if (j >= 0 && j < 4) {
#pragma unroll
                for (int e = 0; e < 8; ++e) o[i][e] += cw[j][e] * x[e]; } }
        }
#pragma unroll
        for (int i = 0; i < 8; ++i) { const int p = p0 + i, row = p < NMETA ? MR + p : b * SEQ + p - NMETA;
            u32x4 w; w.x = cvt_pk_bf16(o[i][0], o[i][1]); w.y = cvt_pk_bf16(o[i][2], o[i][3]); w.z = cvt_pk_bf16(o[i][4], o[i][5]); w.w = cvt_pk_bf16(o[i][6], o[i][7]);
            *(u32x4*)(XCg + (size_t)row * LW + 8 * c8) = w; }
    }
}
constexpr int LRU_TT = 128, LRU_XCS = 168;
constexpr int LRU_XC = 0, LRU_WS = LRU_XC + 128 * 336, LRU_GYS = LRU_WS + 80 * 336, LRU_SEG = LRU_GYS + 2 * 10240, LRU_HIN = LRU_SEG + 2 * 1280, LRU_HW = LRU_HIN + 2 * 160, LRU_END = LRU_HW + 8 * 160;
static_assert(LRU_END <= RING_BYTES, "LRU LDS map");
template <int SH> __device__ __forceinline__ float dpp_shr(float old, float v) {
    return __builtin_bit_cast(float, __builtin_amdgcn_update_dpp(__builtin_bit_cast(int, old), __builtin_bit_cast(int, v), 0x110 + SH, 0xf, 0xf, false));
}
#define LRU_SCAN_STEP(SH) asm volatile("s_nop 1\n\t" \
        "v_fmac_f32_dpp %0, %0, %10 row_shr:" #SH " row_mask:0xf bank_mask:0xf\n\t" \
        "v_fmac_f32_dpp %1, %1, %11 row_shr:" #SH " row_mask:0xf bank_mask:0xf\n\t" \
        "v_fmac_f32_dpp %2, %2, %12 row_shr:" #SH " row_mask:0xf bank_mask:0xf\n\t" \
        "v_fmac_f32_dpp %3, %3, %13 row_shr:" #SH " row_mask:0xf bank_mask:0xf\n\t" \
        "v_fmac_f32_dpp %4, %4, %14 row_shr:" #SH " row_mask:0xf bank_mask:0xf\n\t" \
        "v_fmac_f32_dpp %5, %5, %15 row_shr:" #SH " row_mask:0xf bank_mask:0xf\n\t" \
        "v_fmac_f32_dpp %6, %6, %16 row_shr:" #SH " row_mask:0xf bank_mask:0xf\n\t" \
        "v_fmac_f32_dpp %7, %7, %17 row_shr:" #SH " row_mask:0xf bank_mask:0xf\n\t" \
        "v_fmac_f32_dpp %8, %8, %18 row_shr:" #SH " row_mask:0xf bank_mask:0xf\n\t" \
        "v_fmac_f32_dpp %9, %9, %19 row_shr:" #SH " row_mask:0xf bank_mask:0xf\n\t" \
        "v_mul_f32_dpp %10, %10, %10 row_shr:" #SH " row_mask:0xf bank_mask:0xf\n\t" \
        "v_mul_f32_dpp %11, %11, %11 row_shr:" #SH " row_mask:0xf bank_mask:0xf\n\t" \
        "v_mul_f32_dpp %12, %12, %12 row_shr:" #SH " row_mask:0xf bank_mask:0xf\n\t" \
        "v_mul_f32_dpp %13, %13, %13 row_shr:" #SH " row_mask:0xf bank_mask:0xf\n\t" \
        "v_mul_f32_dpp %14, %14, %14 row_shr:" #SH " row_mask:0xf bank_mask:0xf\n\t" \
        "v_mul_f32_dpp %15, %15, %15 row_shr:" #SH " row_mask:0xf bank_mask:0xf\n\t" \
        "v_mul_f32_dpp %16, %16, %16 row_shr:" #SH " row_mask:0xf bank_mask:0xf\n\t" \
        "v_mul_f32_dpp %17, %17, %17 row_shr:" #SH " row_mask:0xf bank_mask:0xf\n\t" \
        "v_mul_f32_dpp %18, %18, %18 row_shr:" #SH " row_mask:0xf bank_mask:0xf\n\t" \
        "v_mul_f32_dpp %19, %19, %19 row_shr:" #SH " row_mask:0xf bank_mask:0xf\n\t" \
        : "+v"(Bv[0][0]), "+v"(Bv[0][1]), "+v"(Bv[1][0]), "+v"(Bv[1][1]), "+v"(Bv[2][0]), "+v"(Bv[2][1]), "+v"(Bv[3][0]), "+v"(Bv[3][1]), "+v"(Bv[4][0]), "+v"(Bv[4][1]), "+v"(Av[0][0]), "+v"(Av[0][1]), "+v"(Av[1][0]), "+v"(Av[1][1]), "+v"(Av[2][0]), "+v"(Av[2][1]), "+v"(Av[3][0]), "+v"(Av[3][1]), "+v"(Av[4][0]), "+v"(Av[4][1]))
__device__ __forceinline__ void lru_item(LAS unsigned char* lds, int it, const bf16_t* XCg, const bf16_t* GY, bf16_t* LO,
                                         const float* gx_w, const float* gx_b, const float* ga_w, const float* ga_b, const float* a_param) {
    const int tid = tid_fresh(), wid = __builtin_amdgcn_readfirstlane(tid >> 6), lane = tid & 63, fr = lane & 15, fq = lane >> 4;
    const int b = it >> 6, n = (it >> 2) & 15, s = it & 3, cl0 = 40 * s, cg0 = 160 * n + cl0;
    LAS bf16_t* XC = (LAS bf16_t*)(lds + LRU_XC); LAS bf16_t* WSM = (LAS bf16_t*)(lds + LRU_WS); LAS bf16_t* GYS = (LAS bf16_t*)(lds + LRU_GYS);
    LAS float* SEGA = (LAS float*)(lds + LRU_SEG); LAS float* SEGB = SEGA + 320; LAS float* HIN = (LAS float*)(lds + LRU_HIN); LAS float* HW = (LAS float*)(lds + LRU_HW);
    { float wv[25];
#pragma unroll
      for (int i = 0; i < 25; ++i) { const int e = tid + 512 * i, k = e / 80, j = e % 80, gate = j / 40, ch = j % 40; wv[i] = *((gate ? gx_w : ga_w) + ((size_t)n * 160 + k) * 160 + cl0 + ch); }
#pragma unroll
      for (int i = 0; i < 25; ++i) { const int e = tid + 512 * i, k = e / 80, j = e % 80, gate = j / 40, ch = j % 40, row = 16 * (ch >> 3) + 4 * ((ch >> 1) & 3) + 2 * gate + (ch & 1); WSM[row * LRU_XCS + k] = f2bf16(wv[i]); } }
    if (tid < 40) HIN[tid] = 0.f;
    float gab[5][2], gxb[5][2], lsa[5][2];
#pragma unroll
    for (int mt = 0; mt < 5; ++mt)
#pragma unroll
        for (int e = 0; e < 2; ++e) { const int c = cg0 + 8 * mt + 2 * fq + e; gab[mt][e] = -1.4426950408889634f * ga_b[c]; gxb[mt][e] = -1.4426950408889634f * gx_b[c];
            lsa[mt][e] = -8.0f * 1.4426950408889634f * log1pf(__expf(-a_param[c])); }
    u32x4 px[5], pg[2];
#define LRU_LOAD(kk) do { const int p0_ = (kk) == 0 ? 0 : NMETA + LRU_TT * ((kk) - 1);     \
        _Pragma("unroll") for (int i = 0; i < 5; ++i) { const int e = tid + 512 * i, t_ = e / 20, ch = e % 20, p = p0_ + t_; \
            const int row = p < NMETA ? MR + p : b * SEQ + p - NMETA; px[i] = *(const u32x4*)(XCg + (size_t)row * LW + 160 * n + 8 * ch); } \
        _Pragma("unroll") for (int i = 0; i < 2; ++i) { const int e = (tid + 512 * i) % 640, t_ = e / 5, ch = e % 5, p = p0_ + t_; \
            const int row = p < NMETA ? MR + p : b * SEQ + p - NMETA; pg[i] = *(const u32x4*)(GY + (size_t)row * LW + cg0 + 8 * ch); } } while (0)
#define LRU_STORE(kk) do { const int ps_ = (kk) == 0 ? 0 : NMETA + LRU_TT * ((kk) - 1), nvs_ = (kk) == 0 ? NMETA : LRU_TT; const LAS bf16_t* gs_ = GYS + ((kk) & 1) * 5120; \
        if ((kk) > 0 || b == 0) { _Pragma("unroll") for (int i = 0; i < 2; ++i) { const int e = tid + 512 * i, tt = e / 5, ch = e % 5, p = ps_ + tt, row = p < NMETA ? MR + p : b * SEQ + p - NMETA; \
            if (e < nvs_ * 5) *(u32x4*)(LO + (size_t)row * LW + cg0 + 8 * ch) = *(const LAS u32x4*)(gs_ + tt * 40 + 8 * ch); } } } while (0)
    LRU_LOAD(0);
    __syncthreads();
    for (int k = 0; k <= 32; ++k) {
        LAS bf16_t* GYc = GYS + (k & 1) * 5120;
#pragma unroll
        for (int i = 0; i < 5; ++i) { const int e = tid + 512 * i, t_ = e / 20, ch = e % 20; *(LAS u32x4*)(XC + t_ * LRU_XCS + 8 * ch) = px[i]; }
#pragma unroll
        for (int i = 0; i < 2; ++i) { const int e = tid + 512 * i, t_ = e / 5, ch = e % 5; if (e < 128 * 5) *(LAS u32x4*)(GYc + t_ * 40 + 8 * ch) = pg[i]; }
        asm volatile("s_waitcnt lgkmcnt(0)\n\ts_barrier" ::: "memory");
        if (k > 0) LRU_STORE(k - 1);
        if (k < 32) LRU_LOAD(k + 1);
        float Av[5][2], Bv[5][2];
        const int t = 16 * wid + fr;
        {
            bf16x8 xcf[5];
#pragma unroll
            for (int kk = 0; kk < 5; ++kk) xcf[kk] = *(const LAS bf16x8*)(XC + t * LRU_XCS + 32 * kk + 8 * fq);
#pragma unroll
            for (int mt = 0; mt < 5; ++mt) {
                f32x4 acc = (f32x4){0.f, 0.f, 0.f, 0.f};
#pragma unroll
                for (int kk = 0; kk < 5; ++kk) { const bf16x8 wf = *(const LAS bf16x8*)(WSM + (16 * mt + fr) * LRU_XCS + 32 * kk + 8 * fq); acc = __builtin_amdgcn_mfma_f32_16x16x32_bf16(wf, xcf[kk], acc, 0, 0, 0); }
                const unsigned xw = *(const LAS unsigned*)(XC + t * LRU_XCS + cl0 + 8 * mt + 2 * fq);
#pragma unroll
                for (int e = 0; e < 2; ++e) {
                    const float rr = __builtin_amdgcn_rcpf(1.0f + __builtin_amdgcn_exp2f(acc[e] * -1.4426950408889634f + gab[mt][e]));
                    const float ii = __builtin_amdgcn_rcpf(1.0f + __builtin_amdgcn_exp2f(acc[2 + e] * -1.4426950408889634f + gxb[mt][e]));
                    const float a = __builtin_amdgcn_exp2f(rr * lsa[mt][e]);
                    Av[mt][e] = a; Bv[mt][e] = __builtin_amdgcn_sqrtf(1.0f - a * a) * ii * (e ? bfhi(xw) : bflo(xw));
                }
            }
            if (k == 0 && wid > 0) {
#pragma unroll
                for (int mt = 0; mt < 5; ++mt) { Av[mt][0] = 1.f; Av[mt][1] = 1.f; Bv[mt][0] = 0.f; Bv[mt][1] = 0.f; }
            }
        }
        LRU_SCAN_STEP(1); LRU_SCAN_STEP(2); LRU_SCAN_STEP(4); LRU_SCAN_STEP(8);
        if (fr == 15) {
#pragma unroll
            for (int mt = 0; mt < 5; ++mt) { const int c = 8 * mt + 2 * fq; *(LAS f32x2*)(SEGA + wid * 40 + c) = (f32x2){Av[mt][0], Av[mt][1]}; *(LAS f32x2*)(SEGB + wid * 40 + c) = (f32x2){Bv[mt][0], Bv[mt][1]}; }
        }
        asm volatile("s_waitcnt lgkmcnt(0)\n\ts_barrier" ::: "memory");
        if (lane < 40) { float sa[8], sb[8];
#pragma unroll
            for (int v = 0; v < 8; ++v) { sa[v] = SEGA[v * 40 + lane]; sb[v] = SEGB[v * 40 + lane]; }
            float h = HIN[(k & 1) * 40 + lane];
#pragma unroll
            for (int v = 0; v < 7; ++v) if (v < wid) h = sa[v] * h + sb[v];
            HW[wid * 40 + lane] = h;
            if (wid == 7) HIN[((k + 1) & 1) * 40 + lane] = sa[7] * h + sb[7]; }
        asm volatile("s_waitcnt lgkmcnt(0)" ::: "memory");
#pragma unroll
        for (int mt = 0; mt < 5; ++mt) { const int c = 8 * mt + 2 * fq; const f32x2 hin = *(const LAS f32x2*)(HW + wid * 40 + c);
            LAS unsigned* gp = (LAS unsigned*)(GYc + t * 40 + c); const unsigned gw_ = *gp;
            const float h0 = Bv[mt][0] + Av[mt][0] * hin[0], h1 = Bv[mt][1] + Av[mt][1] * hin[1];
            *gp = cvt_pk_bf16(h0 * bflo(gw_), h1 * bfhi(gw_)); }
    }
    __syncthreads();
    LRU_STORE(32);
    __syncthreads();
#undef LRU_STORE
#undef LRU_LOAD
}
#undef LRU_SCAN_STEP

__device__ __forceinline__ att::BlockRef<bf16_t, bf16_t> attn_ref(const bf16_t* Qb, const bf16_t* Kb, const bf16_t* Vb, bf16_t* OP, int b, int h, int s, int idx) {
    const int cj = idx >> 1, c = cj >> 1, j = cj & 1, qb = (idx & 1) ? 15 - s : s;
    att::BlockRef<bf16_t, bf16_t> r;
    r.Q = Qb + ((size_t)(b * 16 + 2 * h + c) * SEQ + (size_t)qb * 256) * 128;
    r.K = Kb + (size_t)(b * 16 + 2 * h + c) * KVLEN * 128;
    r.V = Vb + (size_t)(b * 16 + 2 * h + j) * KVLEN * 128;
    r.O = OP + ((size_t)((b * 8 + h) * 4 + cj) * SEQ + (size_t)qb * 256) * 128;
    r.P0 = NMETA + qb * 256;
    return r;
}
__device__ __forceinline__ void attn_phase(char* lds, const bf16_t* Qb, const bf16_t* Kb, const bf16_t* Vb, bf16_t* OP, int vcu, int G) {
    constexpr int W = 1 << 20;
    for (int vw = vcu; vw < 256; vw += G) {
        const int bh = vw >> 3, s = vw & 7, b = bh >> 3, h = bh & 7;
        att::Seam<bf16_t> S;
        att::BlockRef<bf16_t, bf16_t> cur = attn_ref(Qb, Kb, Vb, OP, b, h, s, 0);
        att::causal_swa_prime<bf16_t, bf16_t>(cur, W, lds, S);
#pragma nounroll
        for (int idx = 0; idx < 8; ++idx) {
            const att::BlockRef<bf16_t, bf16_t> nxt = idx < 7 ? attn_ref(Qb, Kb, Vb, OP, b, h, s, idx + 1) : cur;
            att::causal_swa_block<bf16_t, bf16_t>(cur, nxt, KVLEN, W, lds, S);
            cur = nxt;
        }
    }
}

__device__ __forceinline__ void attn_phase256(char* lds, const bf16_t* Qb, const bf16_t* Kb, const bf16_t* Vb, bf16_t* OP, bf16_t* AO, float lam, const float* sl, int vcu, int G) {
    for (int vw = vcu; vw < 256; vw += G) {
        const int bh = vw >> 3, s = vw & 7, b = bh >> 3, h = bh & 7;
#pragma nounroll
        for (int pass = 0; pass < 2; ++pass) {
            const int qb = pass ? 15 - s : s;
            const bf16_t* v0 = Vb + (size_t)(b * 16 + 2 * h) * KVLEN * 128; const bf16_t* v1 = v0 + (size_t)KVLEN * 128;
            bf16_t* op = OP + ((size_t)(b * 8 + h) * SEQ + (size_t)qb * 256) * 256;
            bf16_t* ao = AO + (size_t)(b * SEQ + qb * 256) * DM + h * 256;
            att::diff_attn_block<false>(Qb + ((size_t)(b * 16 + 2 * h) * SEQ + (size_t)qb * 256) * 128, Kb + (size_t)(b * 16 + 2 * h) * KVLEN * 128, v0, v1, op, NMETA + qb * 256, KVLEN, lds, ao, DM, lam, sl, EPS);
            att::diff_attn_block<true>(Qb + ((size_t)(b * 16 + 2 * h + 1) * SEQ + (size_t)qb * 256) * 128, Kb + (size_t)(b * 16 + 2 * h + 1) * KVLEN * 128, v0, v1, op, NMETA + qb * 256, KVLEN, lds, ao, DM, lam, sl, EPS);
        }
    }
}
__device__ __forceinline__ float lam_of(const float* lq1, const float* lk1, const float* lq2, const float* lk2, float lam_init, int lane) {
    const float d1 = wave_sum(lq1[lane] * lk1[lane] + lq1[lane + 64] * lk1[lane + 64]), d2 = wave_sum(lq2[lane] * lk2[lane] + lq2[lane + 64] * lk2[lane + 64]);
    return __uint_as_float(__builtin_amdgcn_readfirstlane(__float_as_uint(expf(d1) - expf(d2) + lam_init)));
}
__device__ __forceinline__ void combine_phase(const bf16_t* OP, bf16_t* AO, const bf16_t* QM, const bf16_t* Kb, const bf16_t* Vb, const float* subln, float lam, float lam_init, int gw, int ngw, int lane) {
    const f32x4 sl = *(const f32x4*)(subln + 4 * lane) * (1.0f - lam_init);
    for (int it = gw; it < NHEAD * NMETA; it += ngw) {
        const int h = it >> 4, i = it & 15, kj = lane & 15, part = lane >> 4;
        float pc[2];
#pragma unroll
        for (int c = 0; c < 2; ++c) {
            const bf16_t* qp = QM + ((size_t)(2 * h + c) * NMETA + i) * 128 + 32 * part;
            const bf16_t* kp = Kb + ((size_t)(2 * h + c) * KVLEN + kj) * 128 + 32 * part;
            float d = 0.f;
#pragma unroll
            for (int e = 0; e < 4; ++e) { const u32x4 qv = *(const u32x4*)(qp + 8 * e), kv = *(const u32x4*)(kp + 8 * e);
                d += bflo(qv.x) * bflo(kv.x) + bfhi(qv.x) * bfhi(kv.x) + bflo(qv.y) * bflo(kv.y) + bfhi(qv.y) * bfhi(kv.y) + bflo(qv.z) * bflo(kv.z) + bfhi(qv.z) * bfhi(kv.z) + bflo(qv.w) * bflo(kv.w) + bfhi(qv.w) * bfhi(kv.w); }
            d += __shfl_xor(d, 16); d += __shfl_xor(d, 32);
            float sv = kj <= i ? d * 0.08838834764831845f : -INFINITY;
            float m = sv;
#pragma unroll
            for (int o = 1; o < 16; o <<= 1) m = fmaxf(m, __shfl_xor(m, o));
            float p = __expf(sv - m), l = p;
#pragma unroll
            for (int o = 1; o < 16; o <<= 1) l += __shfl_xor(l, o);
            pc[c] = p / l;
        }
        const int j = lane >> 5, dd = 4 * (lane & 31);
        f32x4 o0 = (f32x4){0.f, 0.f, 0.f, 0.f}, o1 = o0;
        unsigned long long wv[NMETA];
#pragma unroll
        for (int k2 = 0; k2 < NMETA; ++k2) wv[k2] = *(const unsigned long long*)(Vb + ((size_t)(2 * h + j) * KVLEN + k2) * 128 + dd);
#pragma unroll
        for (int k2 = 0; k2 < NMETA; ++k2) { const unsigned long long w = wv[k2];
            const f32x4 v = (f32x4){bflo((unsigned)w), bfhi((unsigned)w), bflo((unsigned)(w >> 32)), bfhi((unsigned)(w >> 32))};
            o0 = o0 + __shfl(pc[0], k2) * v; o1 = o1 + __shfl(pc[1], k2) * v;
        }
        f32x4 x = o0 - lam * o1;
        const float ss = wave_sum(x[0] * x[0] + x[1] * x[1] + x[2] * x[2] + x[3] * x[3]);
        const float rs = rsqrtf(ss * (1.0f / 256.0f) + EPS);
        x = x * rs * sl;
        *(unsigned long long*)(AO + (size_t)(MR + i) * DM + h * 256 + 4 * lane) = (unsigned long long)cvt_pk_bf16(x[0], x[1]) | ((unsigned long long)cvt_pk_bf16(x[2], x[3]) << 32);
    }
}

__device__ __forceinline__ float sgpr_fresh_f(float v) { asm volatile("" : "+s"(v)); return v; }
__device__ __forceinline__ int sgpr_fresh(int v) { asm volatile("" : "+s"(v)); return v; }
typedef const __attribute__((address_space(4))) Args* ArgsP;
__device__ __forceinline__ ArgsP fresh_args() { ArgsP p = (ArgsP)__builtin_amdgcn_kernarg_segment_ptr(); asm volatile("" : "+s"(p)); return p; }
#define PH_ARGS ArgsP A = fresh_args(); unsigned char* const ws = A->ws; (void)ws; \
    const int G = sgpr_fresh(G0), bx = sgpr_fresh(bx0), vcu = sgpr_fresh(vcu0); (void)bx; \
    const int tid = tid_fresh(), lane = tid & 63, wave = __builtin_amdgcn_readfirstlane(tid >> 6), gw = vcu * NWAVES + wave, ngw = G * NWAVES; (void)lane; (void)gw; (void)ngw
#define ssq_base ((u64*)(ws + SSQ_OFF))
#define H ((float*)(ws + WS_H))
#define HB ((bf16_t*)(ws + WS_HB))
#define HID ((bf16_t*)(ws + WS_HID))
#define Qb ((bf16_t*)(ws + WS_Q))
#define Kb ((bf16_t*)(ws + WS_K))
#define Vb ((bf16_t*)(ws + WS_V))
#define QM ((bf16_t*)(ws + WS_QM))
#define XR ((bf16_t*)(ws + WS_XR))
#define GY ((bf16_t*)(ws + WS_GY))
#define GG ((bf16_t*)(ws + WS_G))
#define OP ((bf16_t*)(ws + WS_OP))
#define AO ((bf16_t*)(ws + WS_AO))
#define LO ((bf16_t*)(ws + WS_LO))
#define TMP ((bf16_t*)(ws + WS_TMP))
#define XCG ((bf16_t*)(ws + WS_TMP))
#define MIX ((bf16_t*)(ws + WS_MIX))
#define LAM_INIT(ll) ((ll) == 0 ? 0.2f : (ll) == 1 ? 0.35550906759096926f : (ll) == 2 ? 0.47071301834358416f : 0.5560582041556405f)
#define SLV ((float*)(ws + WS_QM + 131072))
#define ropec ((float*)(ws + WS_ROPE))
#define ropes ((float*)(ws + WS_ROPE + 512 * 1024))
#define SSQ(i) (ssq_base + (size_t)(i) * MPAD)
constexpr int CV_G = (DM / 64) * (DFF / 32), CV_D = (DFF / 64) * (DM / 32), CV_IN = (DM / 64) * (NIN / 32), CV_S = (DM / 64) * (DM / 32), CV_L = (LW / 64) * (DM / 32);
constexpr int CV_NIT = 2 * (2 * CV_G + CV_D) + CV_IN + 2 * CV_S + CV_L;
__device__ __forceinline__ void convert_item(ArgsP A, unsigned char* ws, int l, int it, LAS float* scr, int lane) {
    unsigned char* wb = ws + (size_t)(l & 1) * WBUF_STRIDE;
    int r = it;
    if (r < CV_G) { transpose_item<1>(A->in[3] + (size_t)l * DM * DFF, DM, DFF, (bf16_t*)(wb + W_GU1), scr, r, lane, A->in[2] + (size_t)l * DM); return; } r -= CV_G;
    if (r < CV_G) { transpose_item<2>(A->in[4] + (size_t)l * DM * DFF, DM, DFF, (bf16_t*)(wb + W_GU1), scr, r, lane, A->in[2] + (size_t)l * DM); return; } r -= CV_G;
    if (r < CV_D) { transpose_item<0>(A->in[5] + (size_t)l * DFF * DM, DFF, DM, (bf16_t*)(wb + W_DN1), scr, r, lane); return; } r -= CV_D;
    if (r < CV_IN) { transpose_item<3>(A->in[7] + (size_t)l * DM * NIN, DM, NIN, (bf16_t*)(wb + W_IN), scr, r, lane, A->in[6] + (size_t)l * DM); return; } r -= CV_IN;
    if (r < CV_S) { transpose_item<0>(A->in[21] + (size_t)l * DM * DM, DM, DM, (bf16_t*)(wb + W_BA), scr, r, lane); return; } r -= CV_S;
    if (r < CV_L) { transpose_item<0>(A->in[22] + (size_t)l * LW * DM, LW, DM, (bf16_t*)(wb + W_BL), scr, r, lane); return; } r -= CV_L;
    if (r < CV_S) { transpose_item<0>(A->in[23] + (size_t)l * DM * DM, DM, DM, (bf16_t*)(wb + W_O), scr, r, lane); return; } r -= CV_S;
    if (r < CV_G) { transpose_item<1>(A->in[25] + (size_t)l * DM * DFF, DM, DFF, (bf16_t*)(wb + W_GU2), scr, r, lane, A->in[24] + (size_t)l * DM); return; } r -= CV_G;
    if (r < CV_G) { transpose_item<2>(A->in[26] + (size_t)l * DM * DFF, DM, DFF, (bf16_t*)(wb + W_GU2), scr, r, lane, A->in[24] + (size_t)l * DM); return; } r -= CV_G;
    transpose_item<0>(A->in[27] + (size_t)l * DFF * DM, DFF, DM, (bf16_t*)(wb + W_DN2), scr, r, lane);
}
__device__ __forceinline__ void fill_seam(ArgsP A, gu32* ctl, LAS unsigned char* L, volatile LAS unsigned* MISC, int seam, int G, bool drain, int lnext) {
    unsigned char* const ws = A->ws;
    const int tid = tid_fresh(), lane = tid & 63, wave = __builtin_amdgcn_readfirstlane(tid >> 6);
    LAS float* scr = (LAS float*)(L + wave * 16384);
    if (tid == 0) __hip_atomic_fetch_add(ctl + CW_REACH + 64 * seam, 1u, RLX_AGENT);
    for (;;) {
        if (tid == 0) {
            unsigned base = (unsigned)CV_NIT;
            const bool stop = !drain && __hip_atomic_load(ctl + CW_REACH + 64 * seam, RLX_AGENT) >= (unsigned)(G - 16);
            if (!stop) base = __hip_atomic_fetch_add(ctl + CW_ITEM + 64 * lnext, 8u, RLX_AGENT);
            MISC[12] = base;
        }
        __syncthreads();
        const unsigned base = MISC[12];
        __syncthreads();
        if (base >= (unsigned)CV_NIT) break;
        const int it = (int)base + wave;
        if (it < CV_NIT) convert_item(A, ws, lnext, it, scr, lane);
    }
}
constexpr int CVR_GU1 = 0, CVR_DN1 = 2 * CV_G, CVR_IN = CVR_DN1 + CV_D, CVR_BA = CVR_IN + CV_IN, CVR_O = CVR_BA + CV_S + CV_L, CVR_GU2 = CVR_O + CV_S, CVR_DN2 = CVR_GU2 + 2 * CV_G;
static_assert(CVR_DN2 + CV_D == CV_NIT, "conversion ranges");
#define CONVERT(ll, first, count) do { if (EN(0)) { ArgsP A_ = fresh_args(); const int tid_ = tid_fresh(), lane_ = tid_ & 63, wave_ = __builtin_amdgcn_readfirstlane(tid_ >> 6), gw_ = vcu * NWAVES + wave_; \
        LAS float* scr_ = (LAS float*)(L + wave_ * 16384); REP(0) for (int it_ = (first) + gw_; it_ < (first) + (count); it_ += G * NWAVES) convert_item(A_, A_->ws, (ll), it_, scr_, lane_); } } while (0)
__global__ void __launch_bounds__(NWAVES * 64, 2) mk_fwd(Args args) {
    extern __shared__ __attribute__((aligned(16))) unsigned char lds[];
    LAS unsigned char* L = (LAS unsigned char*)lds;
    volatile LAS unsigned* MISC = (volatile LAS unsigned*)(L + MISC_OFF);
    const int G0 = gridDim.x, bx0 = blockIdx.x, vcu0 = (G0 % 8 == 0) ? (bx0 % 8) * (G0 / 8) + bx0 / 8 : bx0;
    gu32* ctl = (gu32*)(args.ws + WS_CTL);
    for (int u = threadIdx.x; u < (LDS_BYTES - LDSCTL_OFF) / 4; u += NWAVES * 64) ((LAS unsigned*)(L + LDSCTL_OFF))[u] = 0u;
    __syncthreads();
    XcdBarrier bar; bar.bar = (unsigned*)(ctl + CW_BAR); bar.x = 0; bar.st = nullptr;
    if (!MK_MULTI) bar = xcd_barrier_post((unsigned*)(ctl + CW_BAR), MISC + 8);
    const int lo = args.ph_lo, hi = args.ph_hi;
    unsigned long long twait = 0; const unsigned long long tstart = (DUP_PHASE == 40) ? __builtin_amdgcn_s_memrealtime() : 0ull;
#define IN(k) (lo <= (k) && (k) < hi)
#define SEAM(k) do { if (IN((k) + 1)) { unsigned long long tb0_ = 0; if (DUP_PHASE == 40) tb0_ = __builtin_amdgcn_s_memrealtime(); xcd_barrier(bar); if (DUP_PHASE == 40 && (PROBE_SEAM < 0 || ((k) - 1) % PH_PER_LAYER == PROBE_SEAM)) { twait += __builtin_amdgcn_s_memrealtime() - tb0_; } if (DUP_PHASE == 30) { xcd_barrier(bar); xcd_barrier(bar); xcd_barrier(bar); xcd_barrier(bar); } } } while (0)

    if (EN(10) && IN(0)) {
        PH_ARGS; const float* x = A->in[0]; const float* meta = A->in[1];
        for (int m = gw; m < MROWS; m += ngw) {
            const float* src = m < MR ? x + (size_t)m * DM : meta + (size_t)(m - MR) * DM; float ss = 0.f;
#pragma unroll
            for (int j = 0; j < 8; ++j) { const int c = 4 * (64 * j + lane); const f32x4 v = *(const f32x4*)(src + c);
                ss += v[0] * v[0] + v[1] * v[1] + v[2] * v[2] + v[3] * v[3];
                *(unsigned long long*)(HB + (size_t)m * DM + c) = (unsigned long long)cvt_pk_bf16(v[0], v[1]) | ((unsigned long long)cvt_pk_bf16(v[2], v[3]) << 32); }
            ss = wave_sum(ss); if (lane == 0) ssq_base[m] = ssq_fx(ss);
        }
        for (int e = gw * 64 + lane; e < DEPTH * 256; e += ngw * 64) SLV[e] = A->in[13][e] * (1.0f - LAM_INIT(e >> 8));
        for (int e = gw * 64 + lane; e < (SEQ + NMETA) * 16; e += ngw * 64) { const int pos = e >> 4, i = e & 15; const float ang = (float)pos * A->invf[i]; ropec[e] = cosf(ang); ropes[e] = sinf(ang); }
        for (int e = gw * 64 + lane; e < 2 * 64 * 48 * 16; e += ngw * 64) { const int kv = e / (64 * 48 * 16), r = e % (64 * 48 * 16), bh = r / (48 * 16), rr = (r / 16) % 48, ch = r % 16;
            *(u32x4*)((kv ? Vb : Kb) + ((size_t)bh * KVLEN + (SEQ + NMETA) + rr) * 128 + 8 * ch) = (u32x4){0u, 0u, 0u, 0u}; }
    }
#pragma nounroll
    for (int l = 0; l < DEPTH; ++l) {
        const int pb = 1 + l * PH_PER_LAYER;
        if (EN(0) && IN(pb + 0)) {
            PH_ARGS;
            LAS float* scr = (LAS float*)(L + wave * 16384);
            REP(0) for (int it = gw; it < CV_NIT; it += ngw) convert_item(A, ws, l, it, scr, lane);
            SEAM(pb + 0);
        }
        if (EN(1) && IN(pb + 1)) {
            PH_ARGS;
            pg8::Gemm g{HB, (const bf16_t*)(ws + W_GU1 + (size_t)(l & 1) * WBUF_STRIDE), MR, NGU, DM}; pg8::StaticOrder S; S.init(MR, NGU, G, bx);
            EpiSwiGLU E{HID, SSQ(3 * l)};
            REP(1) pg8::gemm_phase<EpiSwiGLU, pg8::StaticOrder, true, true>(L, g, S, E);
            if (DUP_PHASE == 21) { EpiNull EN_; pg8::gemm_phase<EpiNull, pg8::StaticOrder, true, true>(L, g, S, EN_); }
            REPM(1) meta_gemm(L, HB + (size_t)MR * DM, g.Bt, NGU, DM, E);
            SEAM(pb + 1);
        }
        if (EN(2) && IN(pb + 2)) {
            PH_ARGS;
            pg8::Gemm g{HID, (const bf16_t*)(ws + W_DN1 + (size_t)(l & 1) * WBUF_STRIDE), MR, DM, DFF}; pg8::StaticOrder S; S.init(MR, DM, G, bx);
            REP(2) { EpiResid E{nullptr, HB, SSQ(3 * l + 1), DRY(2) ? 0.f : 0.5f, DRY(2) ? 0.f : 1.f};
            pg8::gemm_phase<EpiResid, pg8::StaticOrder, true, true>(L, g, S, E); }
            meta_resid<DFF>(L, HID + (size_t)MR * DFF, g.Bt, HB, SSQ(3 * l + 1), 0.5f);
            SEAM(pb + 2);
        }
        if (EN(3) && IN(pb + 3)) {
            PH_ARGS;
            pg8::Gemm g{HB, (const bf16_t*)(ws + W_IN + (size_t)(l & 1) * WBUF_STRIDE), MR, NIN, DM}; pg8::StaticOrder S; S.init(MR, NIN, G, bx);
            EpiWin E{Qb, Kb, Vb, XR, GY, GG, QM, A->in[8] + (size_t)l * 2 * DM, SSQ(3 * l + 1), ropec, ropes};
            REP(3) pg8::gemm_phase<EpiWin, pg8::StaticOrder, true, true>(L, g, S, E);
            REPM(3) meta_gemm(L, HB + (size_t)MR * DM, g.Bt, NIN, DM, E);
            SEAM(pb + 3);
        }
        if (EN(4) && IN(pb + 4)) {
            PH_ARGS;
            if (EN(12)) REP(14) conv_pass(XR, XCG, A->in[14] + (size_t)l * 4 * LW, A->in[15] + (size_t)l * LW, gw * 64 + lane, ngw * 64);
            if (EN(13)) { const float lam_init = LAM_INIT(sgpr_fresh(l)); const float lam = lam_of(A->in[9] + l * 128, A->in[10] + l * 128, A->in[11] + l * 128, A->in[12] + l * 128, lam_init, lane);
                REP(13) attn_phase256((char*)lds, Qb, Kb, Vb, OP, AO, lam, SLV + l * 256, vcu, G); }
            SEAM(pb + 4);
        }
        if (EN(5) && IN(pb + 5)) {
            PH_ARGS;
            const float lam_init = LAM_INIT(sgpr_fresh(l)); const float lam = lam_of(A->in[9] + l * 128, A->in[10] + l * 128, A->in[11] + l * 128, A->in[12] + l * 128, lam_init, lane);
            if (EN(12)) REP(12) for (int it = vcu; it < 256; it += G)
                lru_item(L, it, XCG, GY, LO, A->in[16] + (size_t)l * 16 * 160 * 160, A->in[17] + (size_t)l * LW, A->in[18] + (size_t)l * 16 * 160 * 160, A->in[19] + (size_t)l * LW, A->in[20] + (size_t)l * LW);
            if (l + 1 < DEPTH) REP(5) combine_phase(OP, AO, QM, Kb, Vb, A->in[13] + l * 256, lam, lam_init, gw, ngw, lane);
            SEAM(pb + 5);
        }
        if (EN(6) && IN(pb + 6)) {
            PH_ARGS;
            pg8::StaticOrder S; S.init(MR, DM, G, bx);
            REP(6) {
#if DUAL_BR
            { EpiDual E{GG, MIX};
              pg8::gemm_dual_phase<EpiDual, pg8::StaticOrder>(L, AO, (const bf16_t*)(ws + W_BA), DM, LO, (const bf16_t*)(ws + W_BL), LW, S, E); }
            if (l + 1 < DEPTH) {
                meta_dual(L, AO + (size_t)MR * DM, (const bf16_t*)(ws + W_BA), LO + (size_t)MR * LW, (const bf16_t*)(ws + W_BL), GG, MIX);
            }
#else
            { pg8::Gemm g{AO, (const bf16_t*)(ws + W_BA + (size_t)(l & 1) * WBUF_STRIDE), MR, DM, DM}; EpiBa E{TMP, GG};
              pg8::gemm_phase<EpiBa, pg8::StaticOrder, true, true>(L, g, S, E); if (l + 1 < DEPTH) REPM(6) meta_gemm(L, AO + (size_t)MR * DM, g.Bt, DM, DM, E); }
            { pg8::Gemm g{LO, (const bf16_t*)(ws + W_BL + (size_t)(l & 1) * WBUF_STRIDE), MR, DM, LW}; EpiBl E{TMP, GG, MIX};
              pg8::gemm_phase<EpiBl, pg8::StaticOrder, true, true>(L, g, S, E); if (l + 1 < DEPTH) REPM(6) meta_gemm(L, LO + (size_t)MR * LW, g.Bt, DM, LW, E); }
#endif
            }
            SEAM(pb + 6);
        }
        if (EN(7) && IN(pb + 7)) {
            PH_ARGS;
            pg8::Gemm g{MIX, (const bf16_t*)(ws + W_O + (size_t)(l & 1) * WBUF_STRIDE), MR, DM, DM}; pg8::StaticOrder S; S.init(MR, DM, G, bx);
            REP(7) { EpiResid E{nullptr, HB, SSQ(3 * l + 2), DRY(7) ? 0.f : 1.0f, DRY(7) ? 0.f : 1.f};
            pg8::gemm_phase<EpiResid, pg8::StaticOrder, true, true>(L, g, S, E); }
            if (l + 1 < DEPTH) meta_resid<DM>(L, MIX + (size_t)MR * DM, g.Bt, HB, SSQ(3 * l + 2), 1.0f);
            SEAM(pb + 7);
        }
        if (EN(8) && IN(pb + 8)) {
            PH_ARGS;
            pg8::Gemm g{HB, (const bf16_t*)(ws + W_GU2 + (size_t)(l & 1) * WBUF_STRIDE), MR, NGU, DM}; pg8::StaticOrder S; S.init(MR, NGU, G, bx);
            EpiSwiGLU E{HID, SSQ(3 * l + 2)};
            pg8::gemm_phase<EpiSwiGLU, pg8::StaticOrder, true, true>(L, g, S, E);
            if (l + 1 < DEPTH) REPM(1) meta_gemm(L, HB + (size_t)MR * DM, g.Bt, NGU, DM, E);
            SEAM(pb + 8);
        }
        if (EN(9) && IN(pb + 9)) {
            PH_ARGS;
            pg8::Gemm g{HID, (const bf16_t*)(ws + W_DN2 + (size_t)(l & 1) * WBUF_STRIDE), MR, DM, DFF}; pg8::StaticOrder S; S.init(MR, DM, G, bx);
            { EpiResid E{(FINAL_BF16 || l + 1 < DEPTH) ? nullptr : H, HB, SSQ(3 * l + 3), 0.5f, 1.f};
            pg8::gemm_phase<EpiResid, pg8::StaticOrder, true, true>(L, g, S, E); }
            if (l + 1 < DEPTH) meta_resid<DFF>(L, HID + (size_t)MR * DFF, g.Bt, HB, SSQ(3 * l + 3), 0.5f);
            SEAM(pb + 9);
        }
    }
    if (EN(11) && IN(N_PHASES - 1)) {
        PH_ARGS;
        float probe_scale = 1.0f;
        if (DUP_PHASE == 40) {
            u64* acc_ = (u64*)(ws + 2000000);
            if (threadIdx.x == 0) __hip_atomic_fetch_add(acc_, twait, __ATOMIC_RELAXED, __HIP_MEMORY_SCOPE_AGENT);
            xcd_barrier(bar);
            const u64 tot_ = __hip_atomic_load(acc_, __ATOMIC_RELAXED, __HIP_MEMORY_SCOPE_AGENT);
            const float frac_ = (float)tot_ / ((float)G * (float)(__builtin_amdgcn_s_memrealtime() - tstart));
            probe_scale = 1.0f + 0.02f * rintf(frac_ * 50.0f * PROBE_GAIN);
        }
        const float* gf = A->in[28];
#if FINAL_BF16
        const u64* ssqf = SSQ(3 * DEPTH);
        f32x4 gv[8];
#pragma unroll
        for (int j = 0; j < 4; ++j) { gv[2 * j] = *(const f32x4*)(gf + 8 * (64 * j + lane)); gv[2 * j + 1] = *(const f32x4*)(gf + 8 * (64 * j + lane) + 4); }
        static_assert(MR % 2 == 0, "row pairs");
        for (int m = 2 * gw; m < MR; m += 2 * ngw) {
            u32x4 w[8];
#pragma unroll
            for (int j = 0; j < 8; ++j) w[j] = *(const u32x4*)(HB + (size_t)(m + (j >> 2)) * DM + 8 * (64 * (j & 3) + lane));
            const float rs0 = rstd_fx(ssqf[m]) * probe_scale, rs1 = rstd_fx(ssqf[m + 1]) * probe_scale;
#pragma unroll
            for (int j = 0; j < 8; ++j) { const int c = 8 * (64 * (j & 3) + lane); const float rs = (j >> 2) ? rs1 : rs0; f32x4 lo, hi; unpack8(w[j], lo, hi);
                float* op = A->out + (size_t)(m + (j >> 2)) * DM + c;
                *(f32x4*)op = lo * rs * gv[2 * (j & 3)]; *(f32x4*)(op + 4) = hi * rs * gv[2 * (j & 3) + 1]; }
        }
#else
        for (int m = gw; m < MR; m += ngw) {
            f32x4 v[8]; float ss = 0.f;
#pragma unroll
            for (int j = 0; j < 8; ++j) { v[j] = *(const f32x4*)(H + (size_t)m * DM + 4 * (64 * j + lane)); ss += v[j][0] * v[j][0] + v[j][1] * v[j][1] + v[j][2] * v[j][2] + v[j][3] * v[j][3]; }
            const float rs = rstd_from(wave_sum(ss));
#pragma unroll
            for (int j = 0; j < 8; ++j) { const int c = 4 * (64 * j + lane); *(f32x4*)(A->out + (size_t)m * DM + c) = v[j] * (rs * probe_scale) * *(const f32x4*)(gf + c); }
        }
#endif
    }
#undef IN
#undef SEAM
}

extern "C" void kernel_launch(void* const* d_in, const int* in_sizes, int n_in, void* d_out, int out_size, void* d_ws, size_t ws_size, hipStream_t stream) {
    static int grid = 0;
    if (grid == 0) {
        if (n_in != 29 || in_sizes[0] != MR * DM || out_size != MR * DM || ws_size < WS_END) { fprintf(stderr, "kernel_launch: unexpected shapes (n_in %d, ws %zu < %zu?); nothing launched\n", n_in, ws_size, (size_t)WS_END); grid = -1; return; }
        int dev = 0, cus = 0, per_cu = 0;
        if (hipGetDevice(&dev) != hipSuccess || hipDeviceGetAttribute(&cus, hipDeviceAttributeMultiprocessorCount, dev) != hipSuccess) { grid = -1; return; }
        if (hipFuncSetAttribute((const void*)mk_fwd, hipFuncAttributeMaxDynamicSharedMemorySize, LDS_BYTES) != hipSuccess) { fprintf(stderr, "kernel_launch: hipFuncSetAttribute failed\n"); grid = -1; return; }
        if (hipOccupancyMaxActiveBlocksPerMultiprocessor(&per_cu, (const void*)mk_fwd, NWAVES * 64, LDS_BYTES) != hipSuccess || per_cu < 1) { fprintf(stderr, "kernel_launch: occupancy query says %d\n", per_cu); }
        (void)hipGetLastError();
        grid = cus;
    }
    if (grid < 0) return;
    if (hipMemsetAsync((char*)d_ws + WS_CTL, 0, CTL_ZERO_BYTES, stream) != hipSuccess) return;
    Args a{};
    for (int i = 0; i < 29; ++i) a.in[i] = (const float*)d_in[i];
    a.out = (float*)d_out; a.ws = (unsigned char*)d_ws;
    for (int i = 0; i < 16; ++i) a.invf[i] = (float)pow(500000.0, -(double)i / 16.0);
#if MK_MULTI
    for (int p = 0; p < N_PHASES; ++p) { a.ph_lo = p; a.ph_hi = p + 1; hipLaunchKernelGGL(mk_fwd, dim3(grid), dim3(NWAVES * 64), LDS_BYTES, stream, a); }
#else
    a.ph_lo = 0; a.ph_hi = N_PHASES;
    hipLaunchKernelGGL(mk_fwd, dim3(grid), dim3(NWAVES * 64), LDS_BYTES, stream, a);
#endif
    const hipError_t le = hipPeekAtLastError();
    if (le != hipSuccess) fprintf(stderr, "kernel_launch: launch failed: %s\n", hipGetErrorName(le));
}
```
